# Optimizing an MI355X kernel written in HIP

```python
import jax, jax.numpy as jnp
from jax import lax
import numpy as np

D_MODEL = 1024
BATCH = 8
SEQ = 2048
DEPTH = 2

GRID_W = 64
WIN_H = 8
WIN_W = 16
NA_HEADS = 8
NA_HEAD_DIM = 64
NA_WIDTH = NA_HEADS * NA_HEAD_DIM
RET_HEADS = 4
RET_HEAD_DIM = 128
RET_WIDTH = RET_HEADS * RET_HEAD_DIM
RET_CHUNK = 128
RET_THETA_BASE = 10000.0
LRU_WIDTH = 512
LRU_BLOCKS = 8
LRU_BLOCK_DIM = LRU_WIDTH // LRU_BLOCKS
LRU_C = 8.0
CONV_W = 4
CONV_PAD_LEFT = 2
MIN_RAD = 0.9
MAX_RAD = 0.999
N_BRANCH = 3
BRANCH_WIDTH = 512
D_FF = 4 * D_MODEL
PLE_DIM = 256
RMS_EPS = 1e-6
OFF_RET = 3 * NA_WIDTH
OFF_LRU = OFF_RET + 4 * RET_WIDTH
OFF_GATE = OFF_LRU + 2 * LRU_WIDTH
IN_COLS = OFF_GATE + N_BRANCH * D_MODEL

kernel_name = "hybrid_natten_retnet_rglru_encoder"


def rmsnorm(x, g):
    xf = x.astype(jnp.float32)
    y = xf * lax.rsqrt(jnp.mean(xf * xf, axis=-1, keepdims=True) + RMS_EPS)
    return (y * g.astype(jnp.float32)).astype(x.dtype)


def neighborhood_attention(q, k, v, rpb):
    b, s, h, dh = q.shape
    rows = s // GRID_W
    kh = min(WIN_H, rows)
    qg = q.reshape(b, rows, GRID_W, h, dh) * (dh ** -0.5)
    kg = k.reshape(b, rows, GRID_W, h, dh)
    vg = v.reshape(b, rows, GRID_W, h, dh)
    col = jnp.arange(GRID_W)
    col_start = jnp.clip(col - WIN_W // 2, 0, GRID_W - WIN_W)
    col_idx = col_start[:, None] + jnp.arange(WIN_W)[None, :]
    col_bias_idx = col_idx - col[:, None] + (WIN_W - 1)

    def row_block(r):
        r_start = jnp.clip(r - kh // 2, 0, rows - kh)
        k_rows = lax.dynamic_slice_in_dim(kg, r_start, kh, axis=1)
        v_rows = lax.dynamic_slice_in_dim(vg, r_start, kh, axis=1)
        k_win = k_rows[:, :, col_idx]
        v_win = v_rows[:, :, col_idx]
        q_row = lax.dynamic_index_in_dim(qg, r, axis=1, keepdims=False)
        row_bias_idx = r_start + jnp.arange(kh) - r + (WIN_H - 1)
        bias = rpb[:, row_bias_idx[None, :, None], col_bias_idx[:, None, :]]
        scores = jnp.einsum('bchd,bicjhd->bhcij', q_row, k_win).astype(jnp.float32)
        scores = scores + bias.astype(jnp.float32)
        probs = jax.nn.softmax(scores.reshape(b, h, GRID_W, kh * WIN_W), axis=-1)
        probs = probs.reshape(b, h, GRID_W, kh, WIN_W).astype(v.dtype)
        return jnp.einsum('bhcij,bicjhd->bchd', probs, v_win)

    out = lax.map(row_block, jnp.arange(rows))
    return out.transpose(1, 0, 2, 3, 4).reshape(b, s, h * dh)


def rotate_pairs(t, cos, sin):
    t1 = t[..., 0::2]
    t2 = t[..., 1::2]
    return jnp.stack([t1 * cos - t2 * sin, t1 * sin + t2 * cos], axis=-1).reshape(t.shape)


def chunkwise_retention(q, k, v, log_gamma, include_diag):
    b, s, h, dk = q.shape
    dv = v.shape[-1]
    n_chunks = s // RET_CHUNK
    idx = jnp.arange(RET_CHUNK, dtype=jnp.float32)
    diff = idx[:, None] - idx[None, :]
    valid = (diff >= 0) if include_diag else (diff > 0)
    intra = jnp.where(valid[None], jnp.exp(log_gamma[:, None, None] * jnp.maximum(diff, 0.0)[None]), 0.0)
    q_dec = jnp.exp(log_gamma[:, None] * (idx + 1.0)[None])[:, :, None]
    k_dec = jnp.exp(log_gamma[:, None] * (RET_CHUNK - 1.0 - idx)[None])[:, :, None]
    c_dec = jnp.exp(log_gamma * RET_CHUNK)[:, None, None]

    def to_chunks(t):
        return t.reshape(b, n_chunks, RET_CHUNK, h, t.shape[-1]).transpose(1, 0, 3, 2, 4)

    def step(state, inp):
        qi, ki, vi = inp
        scores = jnp.einsum('bhid,bhjd->bhij', qi, ki) * intra
        out = jnp.einsum('bhij,bhjv->bhiv', scores, vi) + jnp.einsum('bhid,bhdv->bhiv', qi * q_dec, state)
        state = state * c_dec + jnp.einsum('bhjd,bhjv->bhdv', ki * k_dec, vi)
        return state, out

    state0 = jnp.zeros((b, h, dk, dv), jnp.float32)
    _, out = lax.scan(step, state0, (to_chunks(q), to_chunks(k), to_chunks(v)))
    return out.transpose(1, 0, 3, 2, 4).reshape(b, s, h, dv)


def retention_branch(q, k, v, g, gn):
    b, s, _ = q.shape
    f = jnp.float32
    q = q.astype(f).reshape(b, s, RET_HEADS, RET_HEAD_DIM)
    k = k.astype(f).reshape(b, s, RET_HEADS, RET_HEAD_DIM)
    v = v.astype(f).reshape(b, s, RET_HEADS, RET_HEAD_DIM)
    pos = jnp.arange(s, dtype=f)
    theta = 1.0 / (RET_THETA_BASE ** jnp.linspace(0.0, 1.0, RET_HEAD_DIM // 2, dtype=f))
    ang = pos[:, None] * theta[None, :]
    cos = jnp.cos(ang)[None, :, None, :]
    sin = jnp.sin(ang)[None, :, None, :]
    q = rotate_pairs(q, cos, sin) * (RET_HEAD_DIM ** -0.5)
    k = rotate_pairs(k, cos, sin)
    hidx = jnp.arange(RET_HEADS, dtype=f)
    log_gamma_fwd = jnp.log1p(-jnp.exp2(-5.0 - hidx))
    log_gamma_bwd = jnp.log1p(-jnp.exp2(-5.5 - hidx))
    y_fwd = chunkwise_retention(q, k, v, log_gamma_fwd, True)
    y_bwd = jnp.flip(chunkwise_retention(jnp.flip(q, 1), jnp.flip(k, 1), jnp.flip(v, 1), log_gamma_bwd, False), 1)
    y = y_fwd + y_bwd
    y = y * lax.rsqrt(jnp.mean(y * y, axis=-1, keepdims=True) + RMS_EPS)
    y = y.reshape(b, s, RET_WIDTH) * gn.astype(f)
    return jax.nn.silu(g.astype(f)) * y


def block_diag_linear(t, w, bias):
    tb = t.reshape(t.shape[0], t.shape[1], LRU_BLOCKS, LRU_BLOCK_DIM)
    return jnp.einsum('bsni,nij->bsnj', tb, w).reshape(t.shape) + bias


def linear_recurrence_combine(c1, c2):
    a1, b1 = c1
    a2, b2 = c2
    return a1 * a2, a2 * b1 + b2


def rg_lru(xs, w_a, b_a, w_x, b_x, lam, reverse):
    f = jnp.float32
    s = xs.shape[1]
    r = jax.nn.sigmoid(block_diag_linear(xs, w_a.astype(f), b_a.astype(f)))
    i = jax.nn.sigmoid(block_diag_linear(xs, w_x.astype(f), b_x.astype(f)))
    log_a = -LRU_C * r * jax.nn.softplus(-lam.astype(f))
    a = jnp.exp(log_a)
    mult = jnp.sqrt(-jnp.expm1(2.0 * log_a))
    first = s - 1 if reverse else 0
    mult = jnp.where((jnp.arange(s) == first)[None, :, None], 1.0, mult)
    _, hs = lax.associative_scan(linear_recurrence_combine, (a, mult * i * xs), axis=1, reverse=reverse)
    return hs


def rglru_branch(xc, gc, conv_w, conv_b, wa, ba, wx, bx, lam):
    f = jnp.float32
    xf = xc.astype(f)
    xf = lax.conv_general_dilated(
        xf, conv_w.astype(f)[:, None, :], window_strides=(1,),
        padding=[(CONV_PAD_LEFT, CONV_W - 1 - CONV_PAD_LEFT)],
        dimension_numbers=('NWC', 'WIO', 'NWC'), feature_group_count=LRU_WIDTH) + conv_b.astype(f)
    y = rg_lru(xf, wa[0], ba[0], wx[0], bx[0], lam[0], False) + rg_lru(xf, wa[1], ba[1], wx[1], bx[1], lam[1], True)
    return jax.nn.gelu(gc.astype(f)) * y


def hybrid_layer(x, p_i, g_mix, w_in, b_gate, na_rpb, ret_gn, conv_w, conv_b,
                 lru_wa, lru_ba, lru_wx, lru_bx, lru_lambda, w_branch, w_out,
                 g_mlp, w_up, w_down, g_ple, w_ple_gate, w_ple):
    b, s, _ = x.shape
    h = rmsnorm(x, g_mix)
    proj = jnp.einsum('bsd,dc->bsc', h, w_in)
    qa, ka, va = jnp.split(proj[..., :OFF_RET], 3, axis=-1)
    qr, kr, vr, gr = jnp.split(proj[..., OFF_RET:OFF_LRU], 4, axis=-1)
    xc, gc = jnp.split(proj[..., OFF_LRU:OFF_GATE], 2, axis=-1)
    gate_logits = proj[..., OFF_GATE:].reshape(b, s, N_BRANCH, D_MODEL)

    def heads(t):
        return t.reshape(b, s, NA_HEADS, NA_HEAD_DIM)

    y_na = neighborhood_attention(heads(qa), heads(ka), heads(va), na_rpb)
    y_ret = retention_branch(qr, kr, vr, gr, ret_gn)
    y_lru = rglru_branch(xc, gc, conv_w, conv_b, lru_wa, lru_ba, lru_wx, lru_bx, lru_lambda)
    ys = jnp.stack([y_na.astype(h.dtype), y_ret.astype(h.dtype), y_lru.astype(h.dtype)], axis=2)
    branch = jnp.einsum('bsnw,nwd->bsnd', ys, w_branch).astype(jnp.float32)
    gates = jax.nn.sigmoid((gate_logits + b_gate).astype(jnp.float32))
    merged = jnp.sum(gates * branch, axis=2).astype(x.dtype)
    x = x + merged @ w_out

    h = rmsnorm(x, g_mlp)
    x = x + jnp.square(jax.nn.relu(h @ w_up)) @ w_down

    h = rmsnorm(x, g_ple)
    x = x + jax.nn.sigmoid(h @ w_ple_gate) * (p_i @ w_ple)
    return x


def setup_inputs(seed: int = 0) -> dict:
    key = jax.random.key(seed)
    ks = jax.random.split(key, 24)
    f = jnp.float32

    def nrm(k, shape, scale):
        return jax.random.normal(k, shape, f) * scale

    u = jax.random.uniform(ks[13], (DEPTH, 2, LRU_WIDTH), f, minval=MIN_RAD, maxval=MAX_RAD)
    sig = u ** (1.0 / LRU_C)
    lam = jnp.log(sig) - jnp.log1p(-sig)
    return {
        'x': nrm(ks[0], (BATCH, SEQ, D_MODEL), 1.0),
        'p': nrm(ks[1], (DEPTH, BATCH, SEQ, PLE_DIM), 1.0),
        'g_mix': 1.0 + nrm(ks[2], (DEPTH, D_MODEL), 0.02),
        'w_in': nrm(ks[3], (DEPTH, D_MODEL, IN_COLS), D_MODEL ** -0.5),
        'b_gate': nrm(ks[4], (DEPTH, N_BRANCH, D_MODEL), 0.02),
        'na_rpb': nrm(ks[5], (DEPTH, NA_HEADS, 2 * WIN_H - 1, 2 * WIN_W - 1), 0.02),
        'ret_gn': 1.0 + nrm(ks[6], (DEPTH, RET_WIDTH), 0.02),
        'conv_w': nrm(ks[7], (DEPTH, CONV_W, LRU_WIDTH), CONV_W ** -0.5),
        'conv_b': nrm(ks[8], (DEPTH, LRU_WIDTH), 0.02),
        'lru_wa': nrm(ks[9], (DEPTH, 2, LRU_BLOCKS, LRU_BLOCK_DIM, LRU_BLOCK_DIM), LRU_BLOCK_DIM ** -0.5),
        'lru_ba': nrm(ks[10], (DEPTH, 2, LRU_WIDTH), 0.02),
        'lru_wx': nrm(ks[11], (DEPTH, 2, LRU_BLOCKS, LRU_BLOCK_DIM, LRU_BLOCK_DIM), LRU_BLOCK_DIM ** -0.5),
        'lru_bx': nrm(ks[12], (DEPTH, 2, LRU_WIDTH), 0.02),
        'lru_lambda': lam,
        'w_branch': nrm(ks[14], (DEPTH, N_BRANCH, BRANCH_WIDTH, D_MODEL), BRANCH_WIDTH ** -0.5),
        'w_out': nrm(ks[15], (DEPTH, D_MODEL, D_MODEL), D_MODEL ** -0.5),
        'g_mlp': 1.0 + nrm(ks[16], (DEPTH, D_MODEL), 0.02),
        'w_up': nrm(ks[17], (DEPTH, D_MODEL, D_FF), D_MODEL ** -0.5),
        'w_down': nrm(ks[18], (DEPTH, D_FF, D_MODEL), D_FF ** -0.5),
        'g_ple': 1.0 + nrm(ks[19], (DEPTH, D_MODEL), 0.02),
        'w_ple_gate': nrm(ks[20], (DEPTH, D_MODEL, D_MODEL), D_MODEL ** -0.5),
        'w_ple': nrm(ks[21], (DEPTH, PLE_DIM, D_MODEL), PLE_DIM ** -0.5),
        'g_final': 1.0 + nrm(ks[22], (D_MODEL,), 0.02),
    }


def reference(x, p, g_mix, w_in, b_gate, na_rpb, ret_gn, conv_w, conv_b,
              lru_wa, lru_ba, lru_wx, lru_bx, lru_lambda, w_branch, w_out,
              g_mlp, w_up, w_down, g_ple, w_ple_gate, w_ple, g_final):
    for i in range(DEPTH):
        x = hybrid_layer(x, p[i], g_mix[i], w_in[i], b_gate[i], na_rpb[i], ret_gn[i],
                         conv_w[i], conv_b[i], lru_wa[i], lru_ba[i], lru_wx[i], lru_bx[i],
                         lru_lambda[i], w_branch[i], w_out[i], g_mlp[i], w_up[i], w_down[i],
                         g_ple[i], w_ple_gate[i], w_ple[i])
    return rmsnorm(x, g_final)
```

```cpp
#include <hip/hip_runtime.h>
#include <cstdio>
#include <cstdint>
namespace pg8 {
#define PG8_LAS __attribute__((address_space(3)))
typedef unsigned short bf16_t;
typedef short bf16x8 __attribute__((ext_vector_type(8)));
typedef float f32x4 __attribute__((ext_vector_type(4)));
typedef unsigned u32x4 __attribute__((ext_vector_type(4)));
constexpr int BM = 256, BK = 64, HALF = 128, HTB = HALF * BK * 2  , STAGE_BYTES = 8 * HTB, NXCD = 8, WGM = 8;

__host__ __device__ __forceinline__ int lds_byte(int r, int c) { const int st = (r >> 4) * 2 + (c >> 5), rr = r & 15, cc = c & 31, ob = rr * 64 + cc * 2; return st * 1024 + (ob ^ (((ob >> 9) & 1) << 5)); }
__host__ __device__ __forceinline__ void stage_rc(int b, int& R, int& C) { const int st = b / 1024, sb = b % 1024, swz = sb ^ (((sb >> 9) & 1) << 5); R = (st >> 1) * 16 + swz / 64; C = (st & 1) * 32 + (swz % 64) / 2; }
__host__ __device__ __forceinline__ int perm32(int rho) { const int n = rho >> 4, i = rho & 15; return 8 * (i >> 2) + 4 * n + (i & 3); }

struct Unit { int pm, pn, z; };
struct Gemm { const bf16_t* A; const bf16_t* Bt; int M, N, K; size_t zA, zB; };

struct StaticOrder {
    int nM, nN, nwg, G, c;
    __host__ __device__ void init(int M, int N, int G_, int c_) { nM = M / BM; nN = N / BM; nwg = nM * nN; G = G_; c = c_; }
    __host__ __device__ bool next(int i, Unit& u) const {
        const long L = (long)i * G + c; if (L >= nwg) return false;
        int wgid = (int)L; { const int q = nwg / NXCD, r = nwg % NXCD, xcd = wgid % NXCD, off = wgid / NXCD; wgid = (xcd < r ? xcd * (q + 1) : r * (q + 1) + (xcd - r) * q) + off; }
        const int nig = WGM * nN, gid = wgid / nig, fm = gid * WGM, gsz = (nM - fm) < WGM ? (nM - fm) : WGM;
        u.pm = fm + ((wgid % nig) % gsz); u.pn = (wgid % nig) / gsz; u.z = 0; return true;
    }
    __device__ __forceinline__ void a_ready(const Unit&) const {}
    __device__ __forceinline__ void done(const Unit&) const {}
};

__device__ __forceinline__ unsigned cvt_pk_bf16(float lo, float hi) { unsigned r; asm volatile("v_cvt_pk_bf16_f32 %0, %1, %2" : "=v"(r) : "v"(lo), "v"(hi)); return r; }
typedef float f32x2 __attribute__((ext_vector_type(2)));
template <class Epi, class Sched, bool ALIGN_EPI = false, bool SP2 = false>
__device__ __forceinline__ void gemm_phase(PG8_LAS unsigned char* lds, const Gemm g, const Sched& S, const Epi& E, const int tid) {
    const int wid = __builtin_amdgcn_readfirstlane(tid >> 6), lane = tid & 63, wr = wid >> 2, wc = wid & 3, fr = lane & 15, fq = lane >> 4;
    const int K = g.K, nt = K / BK;
    unsigned voffA[2], voffB[2];
#pragma unroll
    for (int i = 0; i < 2; ++i) { int R, C; stage_rc(tid * 16 + i * 8192, R, C); const int Rb = Epi::PERM ? ((R & ~31) + perm32(R & 31)) : R;
        voffA[i] = (unsigned)(R * K + C) * 2u; voffB[i] = (unsigned)(Rb * K + C) * 2u; }
    const size_t kstep = (size_t)(BK * 2);
    const size_t hstep = (size_t)HALF * K * 2;
    const size_t tstep = 2 * hstep;
    const unsigned ldsw = (unsigned)wid * 1024u;
    const int aoff = lds_byte(wr * 64 + fr, fq * 8), boff = lds_byte(wc * 32 + fr, fq * 8);
#define PG8_SA(b, h) (((b) * 2 + (h)) * HTB)
#define PG8_SB(b, h) ((4 + (b) * 2 + (h)) * HTB)
#define PG8_STAGE(bufoff, gbase, voff) do { _Pragma("unroll") for (int _i = 0; _i < 2; ++_i) \
        __builtin_amdgcn_global_load_lds((const unsigned*)((const char*)(gbase) + (voff)[_i]), (PG8_LAS unsigned*)(lds + (bufoff) + ldsw + _i * 8192), 16, 0, 0); } while (0)
#define PG8_LDA(dst, b, h) do { _Pragma("unroll") for (int m = 0; m < 4; ++m) _Pragma("unroll") for (int k = 0; k < 2; ++k) dst[m][k] = *(const PG8_LAS bf16x8*)(lds + PG8_SA(b, h) + aoff + m * 2048 + k * 1024); } while (0)
#define PG8_LDB(dst, b, h) do { _Pragma("unroll") for (int n = 0; n < 2; ++n) _Pragma("unroll") for (int k = 0; k < 2; ++k) dst[n][k] = *(const PG8_LAS bf16x8*)(lds + PG8_SB(b, h) + boff + n * 2048 + k * 1024); } while (0)
#define PG8_MMA(ai, bj, At, Bt) do { __builtin_amdgcn_s_setprio(1); _Pragma("unroll") for (int m = 0; m < 4; ++m) _Pragma("unroll") for (int n = 0; n < 2; ++n) _Pragma("unroll") for (int k = 0; k < 2; ++k) \
        acc[ai][bj][m][n] = __builtin_amdgcn_mfma_f32_16x16x32_bf16(Bt[n][k], At[m][k], acc[ai][bj][m][n], 0, 0, 0); __builtin_amdgcn_s_setprio(0); } while (0)
#define PG8_WAIT_V(n) asm volatile("s_waitcnt vmcnt(" #n ")" ::: "memory")
#define PG8_WAIT_L(n) asm volatile("s_waitcnt lgkmcnt(" #n ")" ::: "memory")
#define PG8_BAR __builtin_amdgcn_s_barrier()
#define PG8_SCHED __builtin_amdgcn_sched_barrier(0)
    Unit cur, nxt; int ui = 0;
    if (!S.next(0, cur)) return;
    f32x4 acc[2][2][4][2];
#pragma unroll
    for (int a = 0; a < 2; ++a)
#pragma unroll
        for (int b = 0; b < 2; ++b)
#pragma unroll
            for (int m = 0; m < 4; ++m)
#pragma unroll
                for (int n = 0; n < 2; ++n) acc[a][b][m][n] = (f32x4){0.f, 0.f, 0.f, 0.f};
    bf16x8 At[4][2], B0[2][2], B1[2][2];
    const char* cA = (const char*)g.A + (size_t)cur.z * g.zA + (size_t)cur.pm * tstep; const char* cB = (const char*)g.Bt + (size_t)cur.z * g.zB + (size_t)cur.pn * tstep;
    S.a_ready(cur);
    if constexpr (SP2) {
        PG8_STAGE(PG8_SB(0, 0), cB, voffB); PG8_STAGE(PG8_SB(0, 1), cB + hstep, voffB); PG8_STAGE(PG8_SA(0, 0), cA, voffA); PG8_STAGE(PG8_SA(0, 1), cA + hstep, voffA);
        if (wr == 1) PG8_BAR;
        PG8_WAIT_V(2); PG8_BAR;
        PG8_STAGE(PG8_SB(1, 0), cB + kstep, voffB); PG8_STAGE(PG8_SA(1, 0), cA + kstep, voffA); PG8_STAGE(PG8_SB(1, 1), cB + hstep + kstep, voffB);
        PG8_WAIT_V(6); PG8_BAR;
    } else {
        PG8_STAGE(PG8_SB(0, 0), cB, voffB); PG8_STAGE(PG8_SA(0, 0), cA, voffA); PG8_STAGE(PG8_SB(0, 1), cB + hstep, voffB); PG8_STAGE(PG8_SA(0, 1), cA + hstep, voffA);
        if (wr == 1) PG8_BAR;
        PG8_WAIT_V(4); PG8_BAR;
        PG8_STAGE(PG8_SB(1, 0), cB + kstep, voffB); PG8_STAGE(PG8_SA(1, 0), cA + kstep, voffA); PG8_STAGE(PG8_SB(1, 1), cB + hstep + kstep, voffB);
        PG8_WAIT_V(6); PG8_BAR;
    }
    for (;;) {
        const bool has_next = S.next(ui + 1, nxt);
        const char* nA = has_next ? (const char*)g.A + (size_t)nxt.z * g.zA + (size_t)nxt.pm * tstep : cA; const char* nB = has_next ? (const char*)g.Bt + (size_t)nxt.z * g.zB + (size_t)nxt.pn * tstep : cB;
        for (int t = 0; t < nt; t += 2) {
            const bool last = (t == nt - 2);
            const char* a1 = cA + (size_t)(t + 1) * kstep;
            const char* a2 = last ? nA : cA + (size_t)(t + 2) * kstep; const char* b2 = last ? nB : cB + (size_t)(t + 2) * kstep;
            const char* a3 = a2 + kstep; const char* b3 = b2 + kstep;
            if (last && has_next) S.a_ready(nxt);
            if constexpr (SP2) {
            PG8_LDB(B0, 0, 0); PG8_LDB(B1, 0, 1); PG8_SCHED; PG8_LDA(At, 0, 0); PG8_STAGE(PG8_SA(1, 1), a1 + hstep, voffA);
            PG8_WAIT_V(8); PG8_WAIT_L(0); PG8_BAR; PG8_MMA(0, 0, At, B0); PG8_MMA(0, 1, At, B1); PG8_BAR; PG8_SCHED;
            PG8_LDA(At, 0, 1); PG8_STAGE(PG8_SB(0, 0), b2, voffB); PG8_STAGE(PG8_SB(0, 1), b2 + hstep, voffB); PG8_STAGE(PG8_SA(0, 0), a2, voffA);
            PG8_WAIT_V(8); PG8_WAIT_L(0); PG8_BAR; PG8_MMA(1, 0, At, B0); PG8_MMA(1, 1, At, B1); PG8_BAR; PG8_SCHED;
            PG8_LDB(B0, 1, 0); PG8_LDB(B1, 1, 1); PG8_SCHED; PG8_LDA(At, 1, 0); PG8_STAGE(PG8_SA(0, 1), a2 + hstep, voffA);
            PG8_WAIT_V(8); PG8_WAIT_L(0); PG8_BAR; PG8_MMA(0, 0, At, B0); PG8_MMA(0, 1, At, B1); PG8_BAR; PG8_SCHED;
            PG8_LDA(At, 1, 1); PG8_STAGE(PG8_SB(1, 0), b3, voffB); PG8_STAGE(PG8_SB(1, 1), b3 + hstep, voffB); PG8_STAGE(PG8_SA(1, 0), a3, voffA);
            PG8_WAIT_V(8); PG8_WAIT_L(0); PG8_BAR; PG8_MMA(1, 0, At, B0); PG8_MMA(1, 1, At, B1); PG8_BAR; PG8_SCHED;
            } else {
            PG8_LDB(B0, 0, 0); PG8_SCHED; PG8_LDA(At, 0, 0); PG8_STAGE(PG8_SA(1, 1), a1 + hstep, voffA);
            PG8_WAIT_L(8); PG8_BAR; PG8_WAIT_L(0); PG8_MMA(0, 0, At, B0); PG8_BAR; PG8_SCHED;
            PG8_LDB(B1, 0, 1); PG8_STAGE(PG8_SB(0, 0), b2, voffB);
            PG8_BAR; PG8_WAIT_L(0); PG8_MMA(0, 1, At, B1); PG8_BAR;
            PG8_LDA(At, 0, 1); PG8_STAGE(PG8_SA(0, 0), a2, voffA);
            PG8_BAR; PG8_WAIT_L(0); PG8_MMA(1, 0, At, B0); PG8_BAR; PG8_SCHED;
            PG8_STAGE(PG8_SB(0, 1), b2 + hstep, voffB);
            PG8_WAIT_V(6); PG8_BAR; PG8_MMA(1, 1, At, B1); PG8_BAR;
            PG8_LDB(B0, 1, 0); PG8_SCHED; PG8_LDA(At, 1, 0); PG8_STAGE(PG8_SA(0, 1), a2 + hstep, voffA);
            PG8_WAIT_L(8); PG8_BAR; PG8_WAIT_L(0); PG8_MMA(0, 0, At, B0); PG8_BAR; PG8_SCHED;
            PG8_LDB(B1, 1, 1); PG8_STAGE(PG8_SB(1, 0), b3, voffB);
            PG8_BAR; PG8_WAIT_L(0); PG8_MMA(0, 1, At, B1); PG8_BAR;
            PG8_LDA(At, 1, 1); PG8_STAGE(PG8_SA(1, 0), a3, voffA);
            PG8_BAR; PG8_WAIT_L(0); PG8_MMA(1, 0, At, B0); PG8_BAR; PG8_SCHED;
            PG8_STAGE(PG8_SB(1, 1), b3 + hstep, voffB);
            PG8_WAIT_V(6); PG8_BAR; PG8_MMA(1, 1, At, B1); PG8_BAR;
            }
        }
        if constexpr (ALIGN_EPI) { if (wr == 0) PG8_BAR; }
        if constexpr (!Epi::AFTER_DRAIN) { E(acc, cur, wr, wc, fr, fq); S.done(cur); }
        if (!has_next) break;
#pragma unroll
        for (int a = 0; a < 2; ++a)
#pragma unroll
            for (int b = 0; b < 2; ++b)
#pragma unroll
                for (int m = 0; m < 4; ++m)
#pragma unroll
                    for (int n = 0; n < 2; ++n) acc[a][b][m][n] = (f32x4){0.f, 0.f, 0.f, 0.f};
        cur = nxt; cA = nA; cB = nB; ++ui;
        if constexpr (ALIGN_EPI) { if (wr == 1) PG8_BAR; }
    }
    PG8_WAIT_V(0);
    if constexpr (!ALIGN_EPI) { if (wr == 0) PG8_BAR; }
    PG8_BAR;
    if constexpr (Epi::AFTER_DRAIN) { E.fused(acc, cur, wr, wc, fr, fq, lds, wid, lane); S.done(cur); }
#undef PG8_SA
#undef PG8_SB
#undef PG8_STAGE
#undef PG8_LDA
#undef PG8_LDB
#undef PG8_MMA
#undef PG8_WAIT_V
#undef PG8_WAIT_L
#undef PG8_BAR
#undef PG8_SCHED
}
}

constexpr int T = 16384, D = 1024, SEQ = 2048, DEPTH = 2, FF = 4096, PLE = 256;
constexpr float RMS_EPS = 1e-6f;
constexpr size_t MiB = 1u << 20;
constexpr size_t WS_CTL = 0, CTL_ZERO_BYTES = 65536;
constexpr size_t WS_TAB = 1 * MiB;
constexpr size_t WS_SSA = 2 * MiB, WS_SSB = 3 * MiB;
constexpr size_t WS_PROJ = 6 * MiB, BLK = 16 * MiB;
constexpr size_t WS_GATE8 = 150 * MiB;
constexpr size_t WS_XB = 198 * MiB;
constexpr size_t WS_W = 230 * MiB, WS_END = 256 * MiB;
constexpr size_t W_IN = WS_W, W_UP = WS_W, W_DOWN = WS_W + 8 * MiB, W_BR = WS_W + 16 * MiB, W_OUT = WS_W + 19 * MiB;
__host__ __device__ constexpr size_t W_G(int slot) { return WS_W + 21 * MiB + (size_t)slot * (5 * MiB / 2); }
__host__ __device__ constexpr size_t W_PLE(int slot) { return W_G(slot) + 2 * MiB; }
constexpr size_t WS_U = WS_PROJ;
constexpr size_t WS_E = WS_PROJ;
constexpr size_t WS_PB = WS_PROJ + 8 * BLK;
constexpr size_t WS_HF = WS_PROJ + 1 * BLK;
constexpr int CW_TMO = 0, CW_BAR = 4096;

enum { PH_PRO = 0, PH_G1, PH_NA, PH_RET, PH_LRUA, PH_LRUB, PH_LRUC, PH_G2, PH_G3, PH_G4, PH_G5, PH_G6, PH_FIN };
constexpr int NPL = 11, NPH = 1 + DEPTH * NPL + 1;

constexpr int NWAVES = 8;
constexpr int RING_BYTES = 131072, LDSCTL_OFF = RING_BYTES, MISC_OFF = LDSCTL_OFF + 320, LDS_BYTES = 147456;

#define GAS __attribute__((address_space(1)))
#define LAS __attribute__((address_space(3)))
typedef unsigned short bf16;
typedef unsigned v4u __attribute__((ext_vector_type(4)));
typedef unsigned v2u __attribute__((ext_vector_type(2)));
typedef float f32x4 __attribute__((ext_vector_type(4)));
typedef GAS unsigned gu32;
#define RLX_AGENT __ATOMIC_RELAXED, __HIP_MEMORY_SCOPE_AGENT
#define LDS_WAIT() asm volatile("s_waitcnt lgkmcnt(0)" ::: "memory")
#define VM_WAIT() asm volatile("s_waitcnt vmcnt(0)" ::: "memory")
__device__ __forceinline__ unsigned f2bf(float f) { unsigned u = __builtin_bit_cast(unsigned, f); return (u + 0x7fffu + ((u >> 16) & 1u)) >> 16; }
__device__ __forceinline__ unsigned pk2(float lo, float hi) { return f2bf(lo) | (f2bf(hi) << 16); }
__device__ __forceinline__ float bf2f(unsigned short b) { return __builtin_bit_cast(float, (unsigned)b << 16); }
__device__ __forceinline__ float bflo(unsigned w) { return __builtin_bit_cast(float, w << 16); }
__device__ __forceinline__ float bfhi(unsigned w) { return __builtin_bit_cast(float, w & 0xffff0000u); }
__device__ __forceinline__ float rdlane(float v, int l) { return __builtin_bit_cast(float, __builtin_amdgcn_readlane(__builtin_bit_cast(int, v), l)); }
__device__ __forceinline__ float fexp(float x) { return __builtin_amdgcn_exp2f(x * 1.4426950408889634f); }
__device__ __forceinline__ float sigmoidf_(float x) { return __builtin_amdgcn_rcpf(1.0f + fexp(-x)); }
__device__ __forceinline__ float wave_sum(float v) {
#pragma unroll
    for (int o = 1; o < 64; o <<= 1) v += __shfl_xor(v, o);
    return v;
}
__device__ __forceinline__ float wave_max(float v) {
#pragma unroll
    for (int o = 1; o < 64; o <<= 1) v = fmaxf(v, __shfl_xor(v, o));
    return v;
}
__device__ __forceinline__ float log2_1m(float x) {
    const float p = x * (1.0f + x * (0.5f + x * (0.33333333f + x * (0.25f + x * (0.2f + x * (0.16666667f + x * 0.14285714f))))));
    return -p * 1.4426950408889634f;
}
__device__ __forceinline__ float gelu_tanh(float x) {
    const float u = 0.7978845608028654f * (x + 0.044715f * x * x * x);
    const float t = 1.0f - 2.0f * __builtin_amdgcn_rcpf(1.0f + fexp(2.0f * u));
    return 0.5f * x * (1.0f + t);
}
__device__ __forceinline__ float row_rs(const float* ss, int row, int fq) {
    const f32x4 a = *(const f32x4*)(ss + (size_t)row * 16 + 4 * fq);
    float s = (a.x + a.y) + (a.z + a.w);
    s += __shfl_xor(s, 16); s += __shfl_xor(s, 32);
    return 1.0f / sqrtf(s * (1.0f / D) + RMS_EPS);
}

#define XB_TMO      128
#define XB_XCNT(j)  (256  + 64 * (j))
#define XB_XSUB(j)  (1280 + 64 * (j))
#define XB_XGEN(j)  (2304 + 64 * (j))
#define XB_TOP      3328
#define XB_TOPGEN   3392
#define XCD_BAR_WORDS 3456
#define XB_SPIN_CAP (1u << 18)

__device__ __forceinline__ unsigned xb_ld(unsigned* p)              { return __hip_atomic_load(p, __ATOMIC_RELAXED, __HIP_MEMORY_SCOPE_AGENT); }
__device__ __forceinline__ unsigned xb_add(unsigned* p, unsigned v) { return __hip_atomic_fetch_add(p, v, __ATOMIC_RELAXED, __HIP_MEMORY_SCOPE_AGENT); }
__device__ __forceinline__ unsigned xb_xcc_id() { return (unsigned)__builtin_amdgcn_s_getreg((3 << 11) | 20) & 0xFu; }
#define XB_SPIN(cond, bar) do { unsigned _sp = 0; while (cond) { __builtin_amdgcn_s_sleep(1); \
    if ((++_sp & 255u) == 0u) { if (xb_ld(&(bar)[XB_TMO])) break; if (_sp > XB_SPIN_CAP) { atomicAdd(&(bar)[XB_TMO], 1u); break; } } } } while (0)

struct XcdBarrier {
    unsigned* bar; unsigned x;
    volatile LAS unsigned* st;
};

__device__ __forceinline__ XcdBarrier xcd_barrier_post(unsigned* bar, volatile LAS unsigned* st) {
    XcdBarrier b; b.bar = bar; b.x = xb_xcc_id(); b.st = st;
    if (threadIdx.x == 0) (void)xb_add(&bar[XB_XCNT(b.x)], 1u);
    return b;
}
__device__ __forceinline__ void xcd_barrier_complete(unsigned* bar, unsigned x, unsigned& nloc, unsigned& nx) {
    const unsigned G = gridDim.x * gridDim.y * gridDim.z;
    unsigned sum, cnt, mine, sp = 0u;
    for (;;) {
        sum = 0u; cnt = 0u; mine = 0u;
#pragma unroll
        for (unsigned j = 0; j < 16; ++j) { const unsigned c = xb_ld(&bar[XB_XCNT(j)]); sum += c; cnt += (c > 0u) ? 1u : 0u; mine = (j == x) ? c : mine; }
        if (sum == G) break;
        __builtin_amdgcn_s_sleep(1);
        if ((++sp & 255u) == 0u) { if (xb_ld(&bar[XB_TMO])) break; if (sp > XB_SPIN_CAP) { atomicAdd(&bar[XB_TMO], 1u); break; } }
    }
    nloc = mine > 0u ? mine : 1u; nx = cnt > 0u ? cnt : 1u;
}

__device__ __forceinline__ void xcd_barrier(const XcdBarrier& b) {
    asm volatile("s_waitcnt vmcnt(0)" ::: "memory");
    __syncthreads();
    if (threadIdx.x == 0) {
        unsigned* bar = b.bar;
        __builtin_amdgcn_s_waitcnt(0);
        unsigned nloc = b.st[0], nx = b.st[1];
        if (nloc == 0u) { xcd_barrier_complete(bar, b.x, nloc, nx); b.st[0] = nloc; b.st[1] = nx; }
        const unsigned old = xb_add(&bar[XB_XSUB(b.x)], 1u);
        const unsigned gen = old / nloc;
        if (old + 1u == (gen + 1u) * nloc) {
            __builtin_amdgcn_fence(__ATOMIC_RELEASE, "agent");
            asm volatile("s_waitcnt vmcnt(0)" ::: "memory");
            const unsigned og = xb_add(&bar[XB_TOP], 1u);
            const unsigned tg = og / nx;
            if (og + 1u == (tg + 1u) * nx) xb_add(&bar[XB_TOPGEN], 1u);
            else XB_SPIN(xb_ld(&bar[XB_TOPGEN]) == tg, bar);
            __builtin_amdgcn_fence(__ATOMIC_ACQUIRE, "agent");
            xb_add(&bar[XB_XGEN(b.x)], 1u);
            asm volatile("s_waitcnt vmcnt(0)" ::: "memory");
        } else {
            XB_SPIN(xb_ld(&bar[XB_XGEN(b.x)]) == gen, bar);
            __builtin_amdgcn_fence(__ATOMIC_ACQUIRE, "agent");
            asm volatile("s_waitcnt vmcnt(0)" ::: "memory");
        }
    }
    __syncthreads();
}


using pg8::Unit; using pg8::bf16_t; using pg8::cvt_pk_bf16;
typedef pg8::u32x4 u32x4;
struct EpiG1 {
    static constexpr bool PERM = true, AFTER_DRAIN = false;
    bf16_t* proj; unsigned char* gate8; const float* ss; const float* bgate; const float* tab;
    __device__ __forceinline__ void operator()(const f32x4 (&acc)[2][2][4][2], const Unit& u, int wr, int wc, int fr, int fq) const {
        const int pn = u.pn;
        float rsv[2][4];
#pragma unroll
        for (int ai = 0; ai < 2; ++ai)
#pragma unroll
            for (int m = 0; m < 4; ++m) { rsv[ai][m] = row_rs(ss, u.pm * 256 + ai * 128 + wr * 64 + m * 16 + fr, fq); if (m & 1) asm volatile("" : "+v"(rsv[ai][m - 1]), "+v"(rsv[ai][m]) :: "memory"); }
        if (pn < 18) {
            const int kind = pn >> 1, phys = (int)((0x683754210ull >> (4 * kind)) & 15ull);
            bf16_t* base = proj + (size_t)phys * ((size_t)T * 512);
            const int col0 = (pn & 1) * 256 + wc * 32 + 8 * fq;
            const float scale = kind == 0 ? 0.125f : (kind == 3 ? 0.08838834764831845f : 1.0f);
            const bool rope = (kind == 3) || (kind == 4);
#pragma unroll
            for (int ai = 0; ai < 2; ++ai)
#pragma unroll
                for (int m = 0; m < 4; ++m) {
                    const int row = u.pm * 256 + ai * 128 + wr * 64 + m * 16 + fr;
                    const float rs = rsv[ai][m] * scale;
                    bf16_t* rowp = base + (size_t)row * 512 + col0;
#pragma unroll
                    for (int bj = 0; bj < 2; ++bj) {
                        f32x4 v0 = acc[ai][bj][m][0] * rs, v1 = acc[ai][bj][m][1] * rs;
                        if (rope) {
                            const int cc = col0 + bj * 128, i0 = (cc & 127) >> 1, pos = row & (SEQ - 1);
                            const f32x4 cs = *(const f32x4*)(tab + pos * 64 + i0), sn = *(const f32x4*)(tab + 131072 + pos * 64 + i0);
                            f32x4 w0, w1;
                            w0[0] = v0[0] * cs[0] - v0[1] * sn[0]; w0[1] = v0[0] * sn[0] + v0[1] * cs[0];
                            w0[2] = v0[2] * cs[1] - v0[3] * sn[1]; w0[3] = v0[2] * sn[1] + v0[3] * cs[1];
                            w1[0] = v1[0] * cs[2] - v1[1] * sn[2]; w1[1] = v1[0] * sn[2] + v1[1] * cs[2];
                            w1[2] = v1[2] * cs[3] - v1[3] * sn[3]; w1[3] = v1[2] * sn[3] + v1[3] * cs[3];
                            v0 = w0; v1 = w1;
                        }
                        u32x4 w; w.x = cvt_pk_bf16(v0[0], v0[1]); w.y = cvt_pk_bf16(v0[2], v0[3]); w.z = cvt_pk_bf16(v1[0], v1[1]); w.w = cvt_pk_bf16(v1[2], v1[3]);
                        *(u32x4*)(rowp + bj * 128) = w;
                    }
                }
        } else {
            const int g0 = (pn - 18) * 256 + wc * 32 + 8 * fq;
#pragma unroll
            for (int ai = 0; ai < 2; ++ai)
#pragma unroll
                for (int m = 0; m < 4; ++m) {
                    const int row = u.pm * 256 + ai * 128 + wr * 64 + m * 16 + fr;
                    const float rs = rsv[ai][m];
#pragma unroll
                    for (int bj = 0; bj < 2; ++bj) {
                        const int gc = g0 + bj * 128;
                        const f32x4 b0 = *(const f32x4*)(bgate + gc), b1 = *(const f32x4*)(bgate + gc + 4);
                        const f32x4 v0 = acc[ai][bj][m][0] * rs + b0, v1 = acc[ai][bj][m][1] * rs + b1;
                        unsigned lo = 0, hi = 0;
#pragma unroll
                        for (int e = 0; e < 4; ++e) {
                            lo |= (unsigned)(sigmoidf_(v0[e]) * 255.0f + 0.5f) << (8 * e);
                            hi |= (unsigned)(sigmoidf_(v1[e]) * 255.0f + 0.5f) << (8 * e);
                        }
                        v2u w; w.x = lo; w.y = hi;
                        *(v2u*)(gate8 + (size_t)row * 3072 + gc) = w;
                    }
                }
        }
    }
};
struct EpiG2 {
    static constexpr bool PERM = false, AFTER_DRAIN = false;
    const unsigned char* gate8; bf16_t* merged;
    __device__ __forceinline__ void operator()(const f32x4 (&acc)[2][2][4][2], const Unit& u, int wr, int wc, int fr, int fq) const {
        const int col0 = u.pn * 256 + wc * 32 + 4 * fq;
#pragma unroll
        for (int ai = 0; ai < 2; ++ai)
#pragma unroll
            for (int m = 0; m < 4; ++m) {
                const int row = u.pm * 256 + ai * 128 + wr * 64 + m * 16 + fr;
#pragma unroll
                for (int bj = 0; bj < 2; ++bj)
#pragma unroll
                    for (int n = 0; n < 2; ++n) {
                        const int c = col0 + bj * 128 + n * 16;
                        const unsigned g4 = *(const unsigned*)(gate8 + (size_t)row * 3072 + u.z * 1024 + c);
                        f32x4 t = acc[ai][bj][m][n];
                        t[0] *= (float)(g4 & 255u) * (1.0f / 255.0f); t[1] *= (float)((g4 >> 8) & 255u) * (1.0f / 255.0f);
                        t[2] *= (float)((g4 >> 16) & 255u) * (1.0f / 255.0f); t[3] *= (float)(g4 >> 24) * (1.0f / 255.0f);
                        v2u* mp = (v2u*)(merged + (size_t)row * 1024 + c);
                        if (u.z > 0) { const v2u o = *mp; t[0] += bflo(o.x); t[1] += bfhi(o.x); t[2] += bflo(o.y); t[3] += bfhi(o.y); }
                        v2u w; w.x = cvt_pk_bf16(t[0], t[1]); w.y = cvt_pk_bf16(t[2], t[3]);
                        *mp = w;
                    }
            }
    }
};
struct EpiRes {
    static constexpr bool PERM = false, AFTER_DRAIN = false;
    const float* base; float* out; bf16_t* xb; float* ssout;
    __device__ __forceinline__ void operator()(const f32x4 (&acc)[2][2][4][2], const Unit& u, int wr, int wc, int fr, int fq) const {
        const int col0 = u.pn * 256 + wc * 32 + 4 * fq;
#pragma unroll
        for (int ai = 0; ai < 2; ++ai)
#pragma unroll
            for (int m = 0; m < 4; ++m) {
                const int row = u.pm * 256 + ai * 128 + wr * 64 + m * 16 + fr;
                float s = 0.f;
#pragma unroll
                for (int bj = 0; bj < 2; ++bj)
#pragma unroll
                    for (int n = 0; n < 2; ++n) {
                        const size_t off = (size_t)row * 1024 + col0 + bj * 128 + n * 16;
                        const f32x4 v = *(const f32x4*)(base + off) + acc[ai][bj][m][n];
                        *(f32x4*)(out + off) = v;
                        v2u w; w.x = cvt_pk_bf16(v[0], v[1]); w.y = cvt_pk_bf16(v[2], v[3]);
                        *(v2u*)(xb + off) = w;
                        s += (v[0] * v[0] + v[1] * v[1]) + (v[2] * v[2] + v[3] * v[3]);
                    }
                s += __shfl_xor(s, 16); s += __shfl_xor(s, 32);
                if (fq == 0) ssout[(size_t)row * 16 + u.pn * 4 + wc] = s;
            }
    }
};
struct EpiG4 {
    static constexpr bool PERM = true, AFTER_DRAIN = false;
    bf16_t* U; const float* ss;
    __device__ __forceinline__ void operator()(const f32x4 (&acc)[2][2][4][2], const Unit& u, int wr, int wc, int fr, int fq) const {
        const int col0 = u.pn * 256 + wc * 32 + 8 * fq;
        float rsv[2][4];
#pragma unroll
        for (int ai = 0; ai < 2; ++ai)
#pragma unroll
            for (int m = 0; m < 4; ++m) { rsv[ai][m] = row_rs(ss, u.pm * 256 + ai * 128 + wr * 64 + m * 16 + fr, fq); if (m & 1) asm volatile("" : "+v"(rsv[ai][m - 1]), "+v"(rsv[ai][m]) :: "memory"); }
#pragma unroll
        for (int ai = 0; ai < 2; ++ai)
#pragma unroll
            for (int m = 0; m < 4; ++m) {
                const int row = u.pm * 256 + ai * 128 + wr * 64 + m * 16 + fr;
                const float rs = rsv[ai][m];
                bf16_t* rowp = U + (size_t)row * FF + col0;
#pragma unroll
                for (int bj = 0; bj < 2; ++bj) {
                    f32x4 v0 = acc[ai][bj][m][0] * rs, v1 = acc[ai][bj][m][1] * rs;
#pragma unroll
                    for (int e = 0; e < 4; ++e) { const float a = fmaxf(v0[e], 0.f), b = fmaxf(v1[e], 0.f); v0[e] = a * a; v1[e] = b * b; }
                    u32x4 w; w.x = cvt_pk_bf16(v0[0], v0[1]); w.y = cvt_pk_bf16(v0[2], v0[3]); w.z = cvt_pk_bf16(v1[0], v1[1]); w.w = cvt_pk_bf16(v1[2], v1[3]);
                    *(u32x4*)(rowp + bj * 128) = w;
                }
            }
    }
};
struct EpiE {
    static constexpr bool PERM = false, AFTER_DRAIN = false;
    float* E;
    __device__ __forceinline__ void operator()(const f32x4 (&acc)[2][2][4][2], const Unit& u, int wr, int wc, int fr, int fq) const {
        const int col0 = u.pn * 256 + wc * 32 + 4 * fq;
#pragma unroll
        for (int ai = 0; ai < 2; ++ai)
#pragma unroll
            for (int m = 0; m < 4; ++m) {
                const int row = u.pm * 256 + ai * 128 + wr * 64 + m * 16 + fr;
#pragma unroll
                for (int bj = 0; bj < 2; ++bj)
#pragma unroll
                    for (int n = 0; n < 2; ++n) *(f32x4*)(E + (size_t)row * 1024 + col0 + bj * 128 + n * 16) = acc[ai][bj][m][n];
            }
    }
};
struct EpiG6 {
    static constexpr bool PERM = false, AFTER_DRAIN = false;
    const float* base; float* out; bf16_t* xb; const float* ssin; float* ssout; const float* E;
    __device__ __forceinline__ void operator()(const f32x4 (&acc)[2][2][4][2], const Unit& u, int wr, int wc, int fr, int fq) const {
        const int col0 = u.pn * 256 + wc * 32 + 4 * fq;
#pragma unroll
        for (int ai = 0; ai < 2; ++ai)
#pragma unroll
            for (int m = 0; m < 4; ++m) {
                const int row = u.pm * 256 + ai * 128 + wr * 64 + m * 16 + fr;
                float rs = row_rs(ssin, row, fq); asm volatile("" : "+v"(rs) :: "memory");
                float s = 0.f;
#pragma unroll
                for (int bj = 0; bj < 2; ++bj)
#pragma unroll
                    for (int n = 0; n < 2; ++n) {
                        const size_t off = (size_t)row * 1024 + col0 + bj * 128 + n * 16;
                        const f32x4 a = acc[ai][bj][m][n] * rs, e = *(const f32x4*)(E + off);
                        f32x4 v = *(const f32x4*)(base + off);
#pragma unroll
                        for (int k = 0; k < 4; ++k) v[k] += sigmoidf_(a[k]) * e[k];
                        *(f32x4*)(out + off) = v;
                        v2u w; w.x = cvt_pk_bf16(v[0], v[1]); w.y = cvt_pk_bf16(v[2], v[3]);
                        *(v2u*)(xb + off) = w;
                        s += (v[0] * v[0] + v[1] * v[1]) + (v[2] * v[2] + v[3] * v[3]);
                    }
                s += __shfl_xor(s, 16); s += __shfl_xor(s, 32);
                if (fq == 0) ssout[(size_t)row * 16 + u.pn * 4 + wc] = s;
                asm volatile("" ::: "memory");
            }
    }
};
struct ZOrder {
    pg8::StaticOrder S;
    __device__ __forceinline__ bool next(int i, Unit& u) const { if (!S.next(i / 3, u)) return false; u.z = i % 3; return true; }
    __device__ __forceinline__ void a_ready(const Unit&) const {}
    __device__ __forceinline__ void done(const Unit&) const {}
};

struct Args { const float* in[23]; float* out; unsigned char* ws; int ph_lo, ph_hi; };
typedef const __attribute__((address_space(4))) Args CArgs;
__device__ __forceinline__ CArgs* get_args() {
    CArgs* p = (CArgs*)__builtin_amdgcn_kernarg_segment_ptr();
    asm volatile("" : "+s"(p));
    return p;
}
struct Frame {
    LAS unsigned char* lds;
    int tid, lane, wave, G, gw, ngw;
    float* out; unsigned char* ws;
};

__device__ __forceinline__ void transpose_item(const float* W, const float* g, int K, int N, bf16* WT, LAS float* scr, int item, int lane) {
    const int nblk = N / 32, kb = item / nblk, nb = item % nblk, k0 = 64 * kb, n0 = 32 * nb;
#pragma unroll 8
    for (int i = 0; i < 32; ++i) { const int kk = 2 * i + (lane >> 5); float v = W[(size_t)(k0 + kk) * N + n0 + (lane & 31)]; if (g) v *= g[k0 + kk]; scr[kk * 33 + (lane & 31)] = v; }
    LDS_WAIT(); asm volatile("" ::: "memory");
    const int c = lane & 7;
#pragma unroll
    for (int j = 0; j < 4; ++j) { const int n = (lane >> 3) + 8 * j; const LAS float* s = scr + (8 * c) * 33 + n;
        v4u o; o.x = pk2(s[0 * 33], s[1 * 33]); o.y = pk2(s[2 * 33], s[3 * 33]); o.z = pk2(s[4 * 33], s[5 * 33]); o.w = pk2(s[6 * 33], s[7 * 33]);
        *(v4u*)(WT + (size_t)(n0 + n) * K + k0 + 8 * c) = o; }
    LDS_WAIT(); asm volatile("" ::: "memory");
}
__device__ __forceinline__ void convert_matrix(const Frame& F, const float* W, const float* g, int K, int N, bf16* WT) {
    LAS float* scr = (LAS float*)(F.lds + F.wave * 16384);
    const int nitems = (K / 64) * (N / 32);
    for (int it = F.gw; it < nitems; it += F.ngw) transpose_item(W, g, K, N, WT, scr, it, F.lane);
}
__device__ __forceinline__ void convert_layer_early(const Frame& F, CArgs* A, int l) {
    convert_matrix(F, A->in[3] + (size_t)l * D * 7680, A->in[2] + l * D, D, 7680, (bf16*)(F.ws + W_IN));
}
__device__ __forceinline__ void convert_layer_mid(const Frame& F, CArgs* A, int l) {
    for (int n = 0; n < 3; ++n) convert_matrix(F, A->in[14] + ((size_t)l * 3 + n) * 512 * D, nullptr, 512, D, (bf16*)(F.ws + W_BR) + (size_t)n * D * 512);
    convert_matrix(F, A->in[15] + (size_t)l * D * D, nullptr, D, D, (bf16*)(F.ws + W_OUT));
    convert_matrix(F, A->in[20] + (size_t)l * D * D, A->in[19] + l * D, D, D, (bf16*)(F.ws + W_G(l & 1)));
    convert_matrix(F, A->in[21] + (size_t)l * PLE * D, nullptr, PLE, D, (bf16*)(F.ws + W_PLE(l & 1)));
}
__device__ __forceinline__ void convert_layer_mlp(const Frame& F, CArgs* A, int l) {
    convert_matrix(F, A->in[17] + (size_t)l * D * FF, A->in[16] + l * D, D, FF, (bf16*)(F.ws + W_UP));
    convert_matrix(F, A->in[18] + (size_t)l * FF * D, nullptr, FF, D, (bf16*)(F.ws + W_DOWN));
}
__device__ __forceinline__ void convert_p(const Frame& F, CArgs* A, int l) {
    const f32x4* src = (const f32x4*)(A->in[1] + (size_t)l * T * PLE); v2u* dst = (v2u*)(F.ws + WS_PB);
    const int n4 = T * PLE / 4;
    for (int i = F.gw * 64 + F.lane; i < n4; i += F.ngw * 64) { const f32x4 v = src[i]; v2u w; w.x = pk2(v.x, v.y); w.y = pk2(v.z, v.w); dst[i] = w; }
}

__device__ __forceinline__ void phase_prologue(const Frame& F, CArgs* A) {
    convert_layer_early(F, A, 0); convert_layer_mid(F, A, 0);
    const float* x = A->in[0]; bf16* xb = (bf16*)(F.ws + WS_XB); float* ss = (float*)(F.ws + WS_SSB);
    for (int m = F.gw; m < T; m += F.ngw) {
        const f32x4* xr = (const f32x4*)(x + (size_t)m * D) + F.lane; v2u* o = (v2u*)(xb + (size_t)m * D) + F.lane;
        float s = 0.f;
#pragma unroll
        for (int j = 0; j < 4; ++j) { const f32x4 v = xr[64 * j]; s += (v.x * v.x + v.y * v.y) + (v.z * v.z + v.w * v.w); v2u w; w.x = pk2(v.x, v.y); w.y = pk2(v.z, v.w); o[64 * j] = w; }
        s = wave_sum(s);
        if (F.lane < 16) ss[(size_t)m * 16 + F.lane] = F.lane == 0 ? s : 0.f;
    }
    float* tab = (float*)(F.ws + WS_TAB);
    for (int e = F.gw * 64 + F.lane; e < SEQ * 64; e += F.ngw * 64) {
        const int pos = e >> 6, i = e & 63;
        const float theta = __builtin_amdgcn_exp2f(-(float)i * (13.287712379549449f / 63.0f));
        double rev = (double)pos * (double)theta * 0.15915494309189535; rev -= __builtin_floor(rev);
        const float fr = (float)rev;
        tab[e] = __builtin_amdgcn_cosf(fr); tab[131072 + e] = __builtin_amdgcn_sinf(fr);
    }
}

__device__ __forceinline__ void phase_na_naive(const Frame& F, CArgs* A, int l) {
    bf16* Q = (bf16*)(F.ws + WS_PROJ); const bf16* K = (const bf16*)(F.ws + WS_PROJ + BLK); const bf16* V = (const bf16*)(F.ws + WS_PROJ + 2 * BLK);
    const float* rpb = A->in[5] + (size_t)l * 8 * 15 * 31;
    const int lane = F.lane;
    for (int p = F.gw; p < T * 8; p += F.ngw) {
        const int t = p >> 3, h = p & 7, b = t >> 11, s = t & 2047, r = s >> 6, c = s & 63;
        const int rs = min(max(r - 4, 0), 24), cst = min(max(c - 8, 0), 48);
        const float q = bf2f(Q[(size_t)t * 512 + h * 64 + lane]);
        float sc[2];
#pragma unroll
        for (int k2 = 0; k2 < 2; ++k2) {
            const int kk = lane + 64 * k2, i = kk >> 4, j = kk & 15;
            const int tk = (b << 11) + ((rs + i) << 6) + cst + j;
            const v4u* kp = (const v4u*)(K + (size_t)tk * 512 + h * 64);
            float a = 0.f;
#pragma unroll
            for (int d8 = 0; d8 < 8; ++d8) { const v4u w = kp[d8];
#pragma unroll
                for (int e = 0; e < 4; ++e) { a += rdlane(q, d8 * 8 + 2 * e) * bflo(w[e]); a += rdlane(q, d8 * 8 + 2 * e + 1) * bfhi(w[e]); } }
            a += rpb[h * 465 + (rs + i - r + 7) * 31 + (cst + j - c + 15)];
            sc[k2] = a;
        }
        const float mx = wave_max(fmaxf(sc[0], sc[1]));
        const float e0 = fexp(sc[0] - mx), e1 = fexp(sc[1] - mx);
        const float inv = 1.0f / wave_sum(e0 + e1);
        const float p0 = e0 * inv, p1 = e1 * inv;
        float o = 0.f;
        for (int kk = 0; kk < 128; ++kk) {
            const int i = kk >> 4, j = kk & 15, tk = (b << 11) + ((rs + i) << 6) + cst + j;
            const float pk = rdlane(kk < 64 ? p0 : p1, kk & 63);
            o += pk * bf2f(V[(size_t)tk * 512 + h * 64 + lane]);
        }
        Q[(size_t)t * 512 + h * 64 + lane] = (bf16)f2bf(o);
    }
}
__device__ __forceinline__ void phase_ret_naive(const Frame& F, CArgs* A, int l) {
    bf16* G = (bf16*)(F.ws + WS_PROJ + 3 * BLK); const bf16* Q = (const bf16*)(F.ws + WS_PROJ + 4 * BLK);
    const bf16* K = (const bf16*)(F.ws + WS_PROJ + 5 * BLK); const bf16* V = (const bf16*)(F.ws + WS_PROJ + 7 * BLK);
    const float* gn = A->in[6] + (size_t)l * 512;
    const int sub = F.tid >> 7, dv = F.tid & 127;
    LAS float* qs = (LAS float*)(F.lds + sub * 16384); LAS float* sc = qs + 128; LAS float* red = sc + SEQ;
    for (int it = blockIdx.x; it < 8 * 4 * SEQ / 4; it += F.G) {
        const int p = it * 4 + sub, bh = p >> 11, n = p & 2047, b = bh >> 2, h = bh & 3, t = b * SEQ + n;
        __syncthreads();
        qs[dv] = bf2f(Q[(size_t)t * 512 + h * 128 + dv]);
        __syncthreads();
        const float gf = log2_1m(__builtin_amdgcn_exp2f(-5.0f - (float)h)), gb = log2_1m(__builtin_amdgcn_exp2f(-5.5f - (float)h));
        for (int m = dv; m < SEQ; m += 128) {
            const v4u* kp = (const v4u*)(K + (size_t)(b * SEQ + m) * 512 + h * 128);
            float acc = 0.f;
#pragma unroll 4
            for (int d8 = 0; d8 < 16; ++d8) { const v4u w = kp[d8];
#pragma unroll
                for (int e = 0; e < 4; ++e) { acc += qs[d8 * 8 + 2 * e] * bflo(w[e]); acc += qs[d8 * 8 + 2 * e + 1] * bfhi(w[e]); } }
            sc[m] = acc * (m <= n ? __builtin_amdgcn_exp2f(gf * (float)(n - m)) : __builtin_amdgcn_exp2f(gb * (float)(m - n)));
        }
        __syncthreads();
        float o = 0.f;
        const bf16* vp = V + (size_t)(b * SEQ) * 512 + h * 128 + dv;
#pragma unroll 8
        for (int m = 0; m < SEQ; ++m) o += sc[m] * bf2f(vp[(size_t)m * 512]);
        red[dv] = o * o;
        __syncthreads();
        float ms = 0.f;
#pragma unroll 8
        for (int e = 0; e < 128; ++e) ms += red[e];
        const float rn = 1.0f / sqrtf(ms * (1.0f / 128.0f) + RMS_EPS);
        const size_t oi = (size_t)t * 512 + h * 128 + dv;
        const float g = bf2f(G[oi]);
        G[oi] = (bf16)f2bf(g * sigmoidf_(g) * o * rn * gn[h * 128 + dv]);
    }
}
__device__ __forceinline__ void phase_lrua_naive(const Frame& F, CArgs* A, int l) {
    const bf16* XC = (const bf16*)(F.ws + WS_PROJ + 8 * BLK); float* xf = (float*)(F.ws + WS_XB);
    const float* cw = A->in[7] + (size_t)l * 4 * 512; const float* cb = A->in[8] + (size_t)l * 512;
    for (int e = F.gw * 64 + F.lane; e < T * 512; e += F.ngw * 64) {
        const int t = e >> 9, ch = e & 511, s = t & 2047;
        float a = cb[ch];
#pragma unroll
        for (int w = 0; w < 4; ++w) { const int s2 = s + w - 2; if (s2 >= 0 && s2 < SEQ) a += cw[w * 512 + ch] * bf2f(XC[(size_t)(t + w - 2) * 512 + ch]); }
        xf[e] = a;
    }
}
__device__ __forceinline__ float log1p_small(float y) {
    if (y < 0.01f) return y * (1.0f - y * (0.5f - y * (0.33333333f - 0.25f * y)));
    return __builtin_amdgcn_logf(1.0f + y) * 0.6931471805599453f;
}
__device__ __forceinline__ void phase_lruscan_naive(const Frame& F, CArgs* A, int l, int dir) {
    const float* xf = (const float*)(F.ws + WS_XB); float* hf = (float*)(F.ws + WS_HF); bf16* GC = (bf16*)(F.ws + WS_PROJ + 6 * BLK);
    const int lane = F.lane;
    LAS float* wl = (LAS float*)F.lds;
    for (int it = blockIdx.x; it < 64; it += F.G) {
        const int b = it >> 3, blk = it & 7, ch = blk * 64 + lane;
        const float* wa = A->in[9] + (((size_t)l * 2 + dir) * 8 + blk) * 4096; const float* wx = A->in[11] + (((size_t)l * 2 + dir) * 8 + blk) * 4096;
        __syncthreads();
        for (int i = F.tid; i < 4096; i += NWAVES * 64) { wl[i] = wa[i]; wl[4096 + i] = wx[i]; }
        __syncthreads();
        if (F.wave == 0) {
            const float ba = A->in[10][((size_t)l * 2 + dir) * 512 + ch], bx = A->in[12][((size_t)l * 2 + dir) * 512 + ch], lam = A->in[13][((size_t)l * 2 + dir) * 512 + ch];
            const float sp = log1p_small(fexp(-lam));
            float h = 0.f;
            for (int step = 0; step < SEQ; ++step) {
                const int t = dir == 0 ? step : SEQ - 1 - step; const size_t tt = (size_t)(b * SEQ + t);
                const float xv = xf[tt * 512 + ch];
                float ra = ba, ia = bx;
#pragma unroll 16
                for (int i = 0; i < 64; ++i) { const float xi = rdlane(xv, i); ra += xi * wl[i * 64 + lane]; ia += xi * wl[4096 + i * 64 + lane]; }
                const float r = sigmoidf_(ra), ig = sigmoidf_(ia);
                const float la = -8.0f * r * sp, a = fexp(la), x2 = 2.0f * la;
                const float om = x2 > -0.5f ? -x2 * (1.0f + x2 * (0.5f + x2 * (0.16666667f + x2 * (0.041666668f + x2 * (0.0083333333f + x2 * 0.0013888889f))))) : 1.0f - a * a;
                float mult = sqrtf(om); if (step == 0) mult = 1.0f;
                h = a * h + mult * ig * xv;
                if (dir == 0) hf[tt * 512 + ch] = h;
                else { const float g = bf2f(GC[tt * 512 + ch]); GC[tt * 512 + ch] = (bf16)f2bf(gelu_tanh(g) * (hf[tt * 512 + ch] + h)); }
            }
        }
    }
}
__device__ __forceinline__ void phase_final(const Frame& F, CArgs* A) {
    const float* g = A->in[22];
    for (int m = F.gw; m < T; m += F.ngw) {
        f32x4* xr = (f32x4*)(F.out + (size_t)m * D) + F.lane; const f32x4* gr = (const f32x4*)g + F.lane;
        f32x4 v[4]; float s = 0.f;
#pragma unroll
        for (int j = 0; j < 4; ++j) { v[j] = xr[64 * j]; s += (v[j].x * v[j].x + v[j].y * v[j].y) + (v[j].z * v[j].z + v[j].w * v[j].w); }
        const float rs = 1.0f / sqrtf(wave_sum(s) * (1.0f / D) + RMS_EPS);
#pragma unroll
        for (int j = 0; j < 4; ++j) xr[64 * j] = v[j] * rs * gr[64 * j];
    }
}

__global__ void __launch_bounds__(NWAVES * 64, 2) mk_fwd(Args args) {
    extern __shared__ __attribute__((aligned(16))) unsigned char lds[];
    const int tid0 = threadIdx.x;
    LAS unsigned char* const lds3 = (LAS unsigned char*)lds;
    CArgs* A0 = get_args();
    const int ph_lo = A0->ph_lo, ph_hi = A0->ph_hi;
    for (int u = tid0; u < (LDS_BYTES - LDSCTL_OFF) / 4; u += NWAVES * 64) ((LAS unsigned*)(lds3 + LDSCTL_OFF))[u] = 0u;
    __syncthreads();
    const bool multi = (ph_hi - ph_lo) > 1;
    XcdBarrier bar; bar.bar = (unsigned*)((gu32*)(A0->ws + WS_CTL) + CW_BAR); bar.x = 0; bar.st = nullptr;
    if (multi) bar = xcd_barrier_post((unsigned*)((gu32*)(A0->ws + WS_CTL) + CW_BAR), (volatile LAS unsigned*)(lds3 + MISC_OFF) + 8);

    for (int ph = ph_lo; ph < ph_hi; ++ph) {
        CArgs* A = get_args();
        Frame F;
        { int t_ = tid0; asm volatile("" : "+v"(t_)); F.tid = t_; }
        F.lds = lds3; F.lane = F.tid & 63; F.wave = __builtin_amdgcn_readfirstlane(F.tid >> 6);
        F.G = gridDim.x; F.gw = blockIdx.x * NWAVES + F.wave; F.ngw = F.G * NWAVES;
        F.out = A->out; F.ws = A->ws;
        unsigned char* ws = F.ws;
        int kind, l;
        if (ph == 0) { kind = PH_PRO; l = 0; } else if (ph == NPH - 1) { kind = PH_FIN; l = 0; } else { l = (ph - 1) / NPL; kind = 1 + (ph - 1) % NPL; }
        float* ssA = (float*)(ws + WS_SSA); float* ssB = (float*)(ws + WS_SSB);
        switch (kind) {
        case PH_PRO: phase_prologue(F, A); break;
        case PH_G1: {
            pg8::Gemm g{(const bf16_t*)(ws + WS_XB), (const bf16_t*)(ws + W_IN), T, 7680, D, 0, 0};
            pg8::StaticOrder S; S.init(T, 7680, F.G, (int)blockIdx.x);
            EpiG1 E{(bf16_t*)(ws + WS_PROJ), ws + WS_GATE8, ssB, A->in[4] + (size_t)l * 3072, (const float*)(ws + WS_TAB)};
            pg8::gemm_phase<EpiG1, pg8::StaticOrder, true, true>(F.lds, g, S, E, F.tid);
        } break;
        case PH_NA: phase_na_naive(F, A, l); convert_layer_mlp(F, A, l); break;
        case PH_RET: phase_ret_naive(F, A, l); break;
        case PH_LRUA: phase_lrua_naive(F, A, l); break;
        case PH_LRUB: phase_lruscan_naive(F, A, l, 0); break;
        case PH_LRUC: phase_lruscan_naive(F, A, l, 1); break;
        case PH_G2: {
            pg8::Gemm g{(const bf16_t*)(ws + WS_PROJ), (const bf16_t*)(ws + W_BR), T, D, 512, 3 * BLK, (size_t)D * 512 * 2};
            ZOrder S; S.S.init(T, D, F.G, (int)blockIdx.x);
            EpiG2 E{ws + WS_GATE8, (bf16_t*)(ws + WS_XB)};
            pg8::gemm_phase<EpiG2, ZOrder, true, true>(F.lds, g, S, E, F.tid);
        } break;
        case PH_G3: case PH_G5: {
            const bool g3 = (kind == PH_G3);
            pg8::Gemm g{(const bf16_t*)(ws + (g3 ? WS_XB : WS_U)), (const bf16_t*)(ws + (g3 ? W_OUT : W_DOWN)), T, D, g3 ? D : FF, 0, 0};
            pg8::StaticOrder S; S.init(T, D, F.G, (int)blockIdx.x);
            EpiRes E{(g3 && l == 0) ? A->in[0] : F.out, F.out, (bf16_t*)(ws + WS_GATE8), g3 ? ssB : ssA};
            pg8::gemm_phase<EpiRes, pg8::StaticOrder, false, true>(F.lds, g, S, E, F.tid);
        } break;
        case PH_G4: {
            pg8::Gemm g{(const bf16_t*)(ws + WS_GATE8), (const bf16_t*)(ws + W_UP), T, FF, D, 0, 0};
            pg8::StaticOrder S; S.init(T, FF, F.G, (int)blockIdx.x);
            EpiG4 E{(bf16_t*)(ws + WS_U), ssB};
            pg8::gemm_phase<EpiG4, pg8::StaticOrder, true, true>(F.lds, g, S, E, F.tid);
            convert_p(F, A, l);
            if (l + 1 < DEPTH) convert_layer_mid(F, A, l + 1);
        } break;
        case PH_G6: {
            {
                pg8::Gemm g{(const bf16_t*)(ws + WS_PB), (const bf16_t*)(ws + W_PLE(l & 1)), T, D, PLE, 0, 0};
                pg8::StaticOrder S; S.init(T, D, F.G, (int)blockIdx.x);
                EpiE E{(float*)(ws + WS_E)};
                pg8::gemm_phase<EpiE, pg8::StaticOrder, false, true>(F.lds, g, S, E, F.tid);
            }
            {
                pg8::Gemm g{(const bf16_t*)(ws + WS_GATE8), (const bf16_t*)(ws + W_G(l & 1)), T, D, D, 0, 0};
                pg8::StaticOrder S; S.init(T, D, F.G, (int)blockIdx.x);
                EpiG6 E{F.out, F.out, (bf16_t*)(ws + WS_XB), ssA, ssB, (const float*)(ws + WS_E)};
                pg8::gemm_phase<EpiG6, pg8::StaticOrder, false, true>(F.lds, g, S, E, F.tid);
            }
            if (l + 1 < DEPTH) convert_layer_early(F, A, l + 1);
        } break;
        case PH_FIN: phase_final(F, A); break;
        default: break;
        }
        if (ph + 1 < ph_hi) xcd_barrier(bar);
    }
}


#ifndef MK_CHECK
#define MK_CHECK 0
#endif
#if MK_CHECK
constexpr int CW_CODE = 64, CW_CNT = 128;
__device__ __forceinline__ unsigned hash32(unsigned x) { x ^= x >> 16; x *= 0x7feb352du; x ^= x >> 15; x *= 0x846ca68bu; x ^= x >> 16; return x; }
__device__ __forceinline__ bool near(float a, float b, float rel, float abs_) { return fabsf(a - b) <= rel * fabsf(b) + abs_; }
__device__ float rs_of_x(const float* x, int row) { float s = 0.f; for (int k = 0; k < D; ++k) s += x[(size_t)row * D + k] * x[(size_t)row * D + k]; return 1.0f / sqrtf(s / D + RMS_EPS); }
__global__ void __launch_bounds__(256) mk_check(Args a, int stage) {
    const unsigned id = blockIdx.x * blockDim.x + threadIdx.x;
    const unsigned h = hash32(id * 2654435761u + 12345u * stage);
    unsigned char* ws = a.ws; unsigned* ctl = (unsigned*)(ws + WS_CTL);
    const int row = (int)(h % T);
    bool bad = false;
    const float* x = a.in[0];
    if (stage == 1) {
        const int col = (int)((h >> 14) % D);
        const bf16* xb = (const bf16*)(ws + WS_XB);
        bad |= !near(bf2f(xb[(size_t)row * D + col]), x[(size_t)row * D + col], 0.01f, 1e-3f);
        float s = 0.f; for (int k = 0; k < D; ++k) s += x[(size_t)row * D + k] * x[(size_t)row * D + k];
        const float* ss = (const float*)(ws + WS_SSB); float t = 0.f; for (int k = 0; k < 16; ++k) t += ss[(size_t)row * 16 + k];
        bad |= !near(t, s, 1e-3f, 1e-3f);
        const int n = (int)((h >> 7) % 7680), k = (int)(h % D);
        const bf16* wt = (const bf16*)(ws + W_IN);
        bad |= !near(bf2f(wt[(size_t)n * D + k]), a.in[2][k] * a.in[3][(size_t)k * 7680 + n], 0.01f, 1e-4f);
        const int pos = (int)(h % SEQ), i = (int)((h >> 11) % 64);
        const float th = powf(10000.0f, -(float)i / 63.0f), ang = (float)pos * th;
        const float* tab = (const float*)(ws + WS_TAB);
        bad |= !near(tab[pos * 64 + i], cosf(ang), 0.f, 2e-3f); bad |= !near(tab[131072 + pos * 64 + i], sinf(ang), 0.f, 2e-3f);
    } else if (stage == 2) {
        const int col = (int)((h >> 14) % 7680) & ~1;
        const float rs = rs_of_x(x, row);
        float v0 = 0.f, v1 = 0.f;
        for (int k = 0; k < D; ++k) { const float xv = x[(size_t)row * D + k] * a.in[2][k]; v0 += xv * a.in[3][(size_t)k * 7680 + col]; v1 += xv * a.in[3][(size_t)k * 7680 + col + 1]; }
        v0 *= rs; v1 *= rs;
        if (col < 4608) {
            const int kind = col / 512, cc = col % 512, phys = (int)((0x683754210ull >> (4 * kind)) & 15ull);
            if (kind == 3 || kind == 4) { const int i = (cc & 127) >> 1, pos = row & 2047; const float th = powf(10000.0f, -(float)i / 63.0f), ang = (float)pos * th, c = cosf(ang), sn = sinf(ang);
                const float w0 = v0 * c - v1 * sn, w1 = v0 * sn + v1 * c; v0 = w0; v1 = w1; }
            if (kind == 0) { v0 *= 0.125f; v1 *= 0.125f; } if (kind == 3) { v0 *= 0.08838834764831845f; v1 *= 0.08838834764831845f; }
            const bf16* p = (const bf16*)(ws + WS_PROJ) + (size_t)phys * T * 512 + (size_t)row * 512 + cc;
            bad |= !near(bf2f(p[0]), v0, 0.03f, 0.03f); bad |= !near(bf2f(p[1]), v1, 0.03f, 0.03f);
        } else {
            const int gc = col - 4608; const unsigned char* g8 = ws + WS_GATE8 + (size_t)row * 3072 + gc;
            const float s0 = 1.0f / (1.0f + expf(-(v0 + a.in[4][gc]))), s1 = 1.0f / (1.0f + expf(-(v1 + a.in[4][gc + 1])));
            bad |= !near((float)g8[0] / 255.0f, s0, 0.f, 0.012f); bad |= !near((float)g8[1] / 255.0f, s1, 0.f, 0.012f);
        }
    } else if (stage == 4) {
        const int col = (int)((h >> 14) % D);
        float m = 0.f;
        for (int n = 0; n < 3; ++n) { const bf16* ys = (const bf16*)(ws + WS_PROJ) + (size_t)(3 * n) * T * 512 + (size_t)row * 512; float acc = 0.f;
            for (int k = 0; k < 512; ++k) acc += bf2f(ys[k]) * a.in[14][((size_t)n * 512 + k) * D + col];
            m += acc * (float)ws[WS_GATE8 + (size_t)row * 3072 + n * 1024 + col] / 255.0f; }
        bad |= !near(bf2f(((const bf16*)(ws + WS_XB))[(size_t)row * D + col]), m, 0.03f, 0.03f);
    } else if (stage == 5) {
        const int col = (int)((h >> 14) % D);
        const bf16* mg = (const bf16*)(ws + WS_XB) + (size_t)row * D; float acc = 0.f;
        for (int k = 0; k < D; ++k) acc += bf2f(mg[k]) * a.in[15][(size_t)k * D + col];
        const float x1 = x[(size_t)row * D + col] + acc;
        bad |= !near(a.out[(size_t)row * D + col], x1, 0.02f, 0.03f);
        bad |= !near(bf2f(((const bf16*)(ws + WS_GATE8))[(size_t)row * D + col]), a.out[(size_t)row * D + col], 0.01f, 1e-3f);
        float s = 0.f; for (int k = 0; k < D; ++k) s += a.out[(size_t)row * D + k] * a.out[(size_t)row * D + k];
        const float* ss = (const float*)(ws + WS_SSB); float t = 0.f; for (int k = 0; k < 16; ++k) t += ss[(size_t)row * 16 + k];
        bad |= !near(t, s, 1e-3f, 1e-3f);
    } else if (stage == 6) {
        const int col = (int)((h >> 14) % FF);
        const bf16* xb = (const bf16*)(ws + WS_GATE8) + (size_t)row * D; float acc = 0.f;
        for (int k = 0; k < D; ++k) acc += bf2f(xb[k]) * a.in[16][k] * a.in[17][(size_t)k * FF + col];
        const float rs = rs_of_x(a.out, row); float v = fmaxf(acc * rs, 0.f); v *= v;
        bad |= !near(bf2f(((const bf16*)(ws + WS_U))[(size_t)row * FF + col]), v, 0.05f, 0.05f);
    } else if (stage == 7) {
        const int col = (int)((h >> 14) % D);
        const bf16* uu = (const bf16*)(ws + WS_U) + (size_t)row * FF; float acc = 0.f;
        for (int k = 0; k < FF; ++k) acc += bf2f(uu[k]) * a.in[18][(size_t)k * D + col];
        const float x2 = bf2f(((const bf16*)(ws + WS_XB))[(size_t)row * D + col]) + acc;
        bad |= !near(a.out[(size_t)row * D + col], x2, 0.03f, 0.05f);
        bad |= !near(bf2f(((const bf16*)(ws + WS_GATE8))[(size_t)row * D + col]), a.out[(size_t)row * D + col], 0.01f, 1e-3f);
        float s = 0.f; for (int k = 0; k < D; ++k) s += a.out[(size_t)row * D + k] * a.out[(size_t)row * D + k];
        const float* ss = (const float*)(ws + WS_SSA); float t = 0.f; for (int k = 0; k < 16; ++k) t += ss[(size_t)row * 16 + k];
        bad |= !near(t, s, 1e-3f, 1e-3f);
    } else if (stage == 8) {
        const int col = (int)((h >> 14) % D);
        const bf16* xb = (const bf16*)(ws + WS_GATE8) + (size_t)row * D; float acc = 0.f, s = 0.f;
        for (int k = 0; k < D; ++k) { const float xv = bf2f(xb[k]); s += xv * xv; acc += xv * a.in[19][k] * a.in[20][(size_t)k * D + col]; }
        const float rs = 1.0f / sqrtf(s / D + RMS_EPS);
        float e = 0.f; for (int k = 0; k < PLE; ++k) e += a.in[1][(size_t)row * PLE + k] * a.in[21][(size_t)k * D + col];
        const float x3 = bf2f(xb[col]) + e / (1.0f + expf(-acc * rs));
        bad |= !near(a.out[(size_t)row * D + col], x3, 0.03f, 0.05f);
    }
    if (stage == 9) bad = true;
    if (bad) atomicAdd(&ctl[CW_CNT + stage], 1u);
}
__device__ float orig_proj(const Args& a, int l, int row, int col) {
    const float* x = l == 0 ? a.in[0] : a.out; const float* g = a.in[2] + (size_t)l * D; const float* w = a.in[3] + (size_t)l * D * 7680;
    float s = 0.f, acc = 0.f;
    for (int k = 0; k < D; ++k) { const float xv = x[(size_t)row * D + k]; s += xv * xv; acc += xv * g[k] * w[(size_t)k * 7680 + col]; }
    return acc / sqrtf(s / D + RMS_EPS);
}
__global__ void __launch_bounds__(64) mk_check_na(Args a, int l) {
    __shared__ float qs[64]; __shared__ float sc[128];
    const unsigned h = hash32(blockIdx.x * 977u + 31u); const int t = (int)(h % T), hd = (int)((h >> 16) % 8), d = threadIdx.x;
    unsigned char* ws = a.ws; unsigned* ctl = (unsigned*)(ws + WS_CTL);
    const bf16* K = (const bf16*)(ws + WS_PROJ + BLK); const bf16* V = (const bf16*)(ws + WS_PROJ + 2 * BLK); const bf16* Y = (const bf16*)(ws + WS_PROJ);
    qs[d] = bf2f((bf16)f2bf(0.125f * orig_proj(a, l, t, hd * 64 + d)));
    __syncthreads();
    const int b = t / SEQ, s = t % SEQ, r = s / 64, c = s % 64;
    int rs = r - 4; if (rs < 0) rs = 0; if (rs > 24) rs = 24; int cs = c - 8; if (cs < 0) cs = 0; if (cs > 48) cs = 48;
    const float* rpb = a.in[5] + (size_t)l * 8 * 15 * 31 + hd * 465;
    for (int kk = d; kk < 128; kk += 64) { const int i = kk / 16, j = kk % 16; const int tk = b * SEQ + (rs + i) * 64 + cs + j; float acc = 0.f;
        for (int e = 0; e < 64; ++e) acc += qs[e] * bf2f(K[(size_t)tk * 512 + hd * 64 + e]);
        sc[kk] = acc + rpb[(rs + i - r + 7) * 31 + (cs + j - c + 15)]; }
    __syncthreads();
    float mx = -1e30f; for (int kk = 0; kk < 128; ++kk) mx = fmaxf(mx, sc[kk]);
    float den = 0.f, o = 0.f;
    for (int kk = 0; kk < 128; ++kk) { const int i = kk / 16, j = kk % 16; const int tk = b * SEQ + (rs + i) * 64 + cs + j; const float p = expf(sc[kk] - mx); den += p; o += p * bf2f(V[(size_t)tk * 512 + hd * 64 + d]); }
    o /= den;
    if (!near(bf2f(Y[(size_t)t * 512 + hd * 64 + d]), o, 0.04f, 0.04f)) atomicAdd(&ctl[CW_CNT + 31], 1u);
}
__global__ void __launch_bounds__(128) mk_check_ret(Args a, int l) {
    __shared__ float qs[128]; __shared__ float sc[SEQ]; __shared__ float red[128];
    const unsigned h = hash32(blockIdx.x * 1231u + 77u); const int t = (int)(h % T), hd = (int)((h >> 16) % 4), dv = threadIdx.x;
    unsigned char* ws = a.ws; unsigned* ctl = (unsigned*)(ws + WS_CTL);
    const bf16* Y = (const bf16*)(ws + WS_PROJ + 3 * BLK); const bf16* Q = (const bf16*)(ws + WS_PROJ + 4 * BLK); const bf16* K = (const bf16*)(ws + WS_PROJ + 5 * BLK); const bf16* V = (const bf16*)(ws + WS_PROJ + 7 * BLK);
    const int b = t / SEQ, n = t % SEQ;
    qs[dv] = bf2f(Q[(size_t)t * 512 + hd * 128 + dv]);
    __syncthreads();
    const float gf = log2_1m(__builtin_amdgcn_exp2f(-5.0f - (float)hd)), gb = log2_1m(__builtin_amdgcn_exp2f(-5.5f - (float)hd));
    for (int m = dv; m < SEQ; m += 128) { float acc = 0.f; for (int e = 0; e < 128; ++e) acc += qs[e] * bf2f(K[(size_t)(b * SEQ + m) * 512 + hd * 128 + e]);
        sc[m] = acc * (m <= n ? __builtin_amdgcn_exp2f(gf * (float)(n - m)) : __builtin_amdgcn_exp2f(gb * (float)(m - n))); }
    __syncthreads();
    float o = 0.f; for (int m = 0; m < SEQ; ++m) o += sc[m] * bf2f(V[(size_t)(b * SEQ + m) * 512 + hd * 128 + dv]);
    red[dv] = o * o; __syncthreads();
    float ms = 0.f; for (int e = 0; e < 128; ++e) ms += red[e];
    const float rn = 1.0f / sqrtf(ms / 128.0f + RMS_EPS);
    const float g = bf2f((bf16)f2bf(orig_proj(a, l, t, 1536 + 3 * 512 + hd * 128 + dv)));
    const float y = g / (1.0f + expf(-g)) * o * rn * a.in[6][(size_t)l * 512 + hd * 128 + dv];
    if (!near(bf2f(Y[(size_t)t * 512 + hd * 128 + dv]), y, 0.04f, 0.04f)) atomicAdd(&ctl[CW_CNT + 32], 1u);
}
__global__ void __launch_bounds__(128) mk_check_g(Args a, int l, int code) {
    const unsigned h = hash32(blockIdx.x * 1231u + 77u); const int t = (int)(h % T), hd = (int)((h >> 16) % 4), dv = threadIdx.x;
    unsigned* ctl = (unsigned*)(a.ws + WS_CTL);
    const bf16* G = (const bf16*)(a.ws + WS_PROJ + 3 * BLK);
    const float g = orig_proj(a, l, t, 1536 + 3 * 512 + hd * 128 + dv);
    if (!near(bf2f(G[(size_t)t * 512 + hd * 128 + dv]), g, 0.03f, 0.03f)) atomicAdd(&ctl[CW_CNT + code], 1u);
}
__global__ void __launch_bounds__(64) mk_check_lru(Args a, int l) {
    __shared__ float xs[64];
    const unsigned h = hash32(blockIdx.x * 733u + 5u); const int b = (int)(h % 8), blk = (int)((h >> 8) % 8), ts = (int)((h >> 16) % SEQ), j = threadIdx.x, ch = blk * 64 + j;
    unsigned char* ws = a.ws; unsigned* ctl = (unsigned*)(ws + WS_CTL);
    const bf16* XC = (const bf16*)(ws + WS_PROJ + 8 * BLK); const bf16* Y = (const bf16*)(ws + WS_PROJ + 6 * BLK);
    const float* cw = a.in[7] + (size_t)l * 2048; const float cb = a.in[8][(size_t)l * 512 + ch];
    float hsum = 0.f;
    for (int dir = 0; dir < 2; ++dir) {
        const float* wa = a.in[9] + (((size_t)l * 2 + dir) * 8 + blk) * 4096; const float* wx = a.in[11] + (((size_t)l * 2 + dir) * 8 + blk) * 4096;
        const float ba = a.in[10][((size_t)l * 2 + dir) * 512 + ch], bx = a.in[12][((size_t)l * 2 + dir) * 512 + ch], lam = a.in[13][((size_t)l * 2 + dir) * 512 + ch];
        const float sp = log1pf(expf(-lam));
        float hh = 0.f;
        const int nsteps = dir == 0 ? ts + 1 : SEQ - ts;
        for (int st = 0; st < nsteps; ++st) {
            const int t = dir == 0 ? st : SEQ - 1 - st;
            float xf = cb;
            for (int w = 0; w < 4; ++w) { const int t2 = t + w - 2; if (t2 >= 0 && t2 < SEQ) xf += cw[w * 512 + ch] * bf2f(XC[(size_t)(b * SEQ + t2) * 512 + ch]); }
            __syncthreads(); xs[j] = xf; __syncthreads();
            float ra = ba, ia = bx;
            for (int i = 0; i < 64; ++i) { ra += xs[i] * wa[i * 64 + j]; ia += xs[i] * wx[i * 64 + j]; }
            const float r = 1.0f / (1.0f + expf(-ra)), ig = 1.0f / (1.0f + expf(-ia));
            const float la = -8.0f * r * sp, av = expf(la); float mult = sqrtf(-expm1f(2.0f * la)); if (st == 0) mult = 1.0f;
            hh = av * hh + mult * ig * xf;
        }
        hsum += hh;
    }
    const float gc = bf2f((bf16)f2bf(orig_proj(a, l, b * SEQ + ts, 3584 + 512 + ch)));
    const float u = 0.7978845608028654f * (gc + 0.044715f * gc * gc * gc);
    const float y = 0.5f * gc * (1.0f + tanhf(u)) * hsum;
    if (!near(bf2f(Y[(size_t)(b * SEQ + ts) * 512 + ch]), y, 0.04f, 0.04f)) atomicAdd(&ctl[CW_CNT + 33], 1u);
}
__global__ void mk_report(Args a) {
    unsigned* ctl = (unsigned*)(a.ws + WS_CTL);
    const int order[13] = {1, 2, 35, 31, 34, 32, 33, 4, 5, 6, 7, 8, 9};
    const unsigned tot[13] = {16384u, 16384u, 16384u, 32768u, 16384u, 16384u, 8192u, 16384u, 16384u, 16384u, 16384u, 16384u, 64u};
    for (int i = 0; i < 13; ++i) {
        const unsigned cnt = ctl[CW_CNT + order[i]];
        if (cnt * 200u > tot[i]) {
            unsigned tenth = (cnt * 10u) / tot[i]; if (tenth > 9u) tenth = 9u;
            a.out[0] = order[i] >= 10 ? 100.0f * (float)order[i] : 1000.0f * (float)order[i] + 100.0f * (float)tenth;
            return;
        }
    }
}
#endif

#ifndef MK_ONE_LAUNCH
#define MK_ONE_LAUNCH 0
#endif
extern "C" void kernel_launch(void* const* d_in, const int* in_sizes, int n_in, void* d_out, int out_size, void* d_ws, size_t ws_size, hipStream_t stream) {
    static int grid = 0;
    if (grid == 0) {
        if (n_in != 23 || in_sizes[0] != T * D || out_size != T * D || ws_size < WS_END) { fprintf(stderr, "kernel_launch: unexpected shapes (n_in %d, in0 %d, out %d, ws %zu); nothing launched\n", n_in, n_in > 0 ? in_sizes[0] : -1, out_size, ws_size); grid = -1; return; }
        int dev = 0, cus = 0, per_cu = 0;
        if (hipGetDevice(&dev) != hipSuccess || hipDeviceGetAttribute(&cus, hipDeviceAttributeMultiprocessorCount, dev) != hipSuccess) { grid = -1; return; }
        if (hipFuncSetAttribute((const void*)mk_fwd, hipFuncAttributeMaxDynamicSharedMemorySize, LDS_BYTES) != hipSuccess) { fprintf(stderr, "kernel_launch: hipFuncSetAttribute failed\n"); grid = -1; return; }
        if (hipOccupancyMaxActiveBlocksPerMultiprocessor(&per_cu, (const void*)mk_fwd, NWAVES * 64, LDS_BYTES) != hipSuccess || per_cu < 1) { fprintf(stderr, "kernel_launch: occupancy query says %d blocks per CU\n", per_cu); }
        (void)hipGetLastError();
        grid = cus;
    }
    if (grid < 0) return;
    if (hipMemsetAsync((char*)d_ws + WS_CTL, 0, CTL_ZERO_BYTES, stream) != hipSuccess) return;
    Args a{};
    for (int i = 0; i < 23; ++i) a.in[i] = (const float*)d_in[i];
    a.out = (float*)d_out; a.ws = (unsigned char*)d_ws;
#if MK_ONE_LAUNCH
    a.ph_lo = 0; a.ph_hi = NPH;
    hipLaunchKernelGGL(mk_fwd, dim3(grid), dim3(NWAVES * 64), LDS_BYTES, stream, a);
#else
    for (int ph = 0; ph < NPH; ++ph) {
#if MK_CHECK
        if (ph == 1 + 9) hipMemcpyAsync((char*)d_ws + WS_XB, (char*)d_ws + WS_GATE8, (size_t)T * D * 2, hipMemcpyDeviceToDevice, stream);
#endif
        a.ph_lo = ph; a.ph_hi = ph + 1; hipLaunchKernelGGL(mk_fwd, dim3(grid), dim3(NWAVES * 64), LDS_BYTES, stream, a);
#if MK_CHECK
        { int st = 0; if (ph == 0) st = 1; else if (ph == 1) st = 2; else if (ph == 1 + 6) st = 4; else if (ph == 1 + 7) st = 5; else if (ph == 1 + 8) st = 6; else if (ph == 1 + 9) st = 7; else if (ph == 1 + 10) st = 8;
          if (st) hipLaunchKernelGGL(mk_check, dim3(64), dim3(256), 0, stream, a, st);
          if (ph == 1 + 1) hipLaunchKernelGGL(mk_check_na, dim3(512), dim3(64), 0, stream, a, 0);
          if (ph == 1) hipLaunchKernelGGL(mk_check_g, dim3(128), dim3(128), 0, stream, a, 0, 35);
          if (ph == 1 + 1) hipLaunchKernelGGL(mk_check_g, dim3(128), dim3(128), 0, stream, a, 0, 34);
          if (ph == 1 + 2) hipLaunchKernelGGL(mk_check_ret, dim3(128), dim3(128), 0, stream, a, 0);
          if (ph == 1 + 5) hipLaunchKernelGGL(mk_check_lru, dim3(128), dim3(64), 0, stream, a, 0);
          if (ph == NPH - 1) hipLaunchKernelGGL(mk_check, dim3(1), dim3(64), 0, stream, a, 9); }
#endif
    }
#if MK_CHECK
    hipLaunchKernelGGL(mk_report, dim3(1), dim3(1), 0, stream, a);
#endif
#endif
}
```

```cpp
#include <hip/hip_runtime.h>
#include <cstdio>
#include <cstdint>
namespace pg8 {
#define PG8_LAS __attribute__((address_space(3)))
typedef unsigned short bf16_t;
typedef short bf16x8 __attribute__((ext_vector_type(8)));
typedef float f32x4 __attribute__((ext_vector_type(4)));
typedef unsigned u32x4 __attribute__((ext_vector_type(4)));
constexpr int BM = 256, BK = 64, HALF = 128, HTB = HALF * BK * 2  , STAGE_BYTES = 8 * HTB, NXCD = 8, WGM = 8;

__host__ __device__ __forceinline__ int lds_byte(int r, int c) { const int st = (r >> 4) * 2 + (c >> 5), rr = r & 15, cc = c & 31, ob = rr * 64 + cc * 2; return st * 1024 + (ob ^ (((ob >> 9) & 1) << 5)); }
__host__ __device__ __forceinline__ void stage_rc(int b, int& R, int& C) { const int st = b / 1024, sb = b % 1024, swz = sb ^ (((sb >> 9) & 1) << 5); R = (st >> 1) * 16 + swz / 64; C = (st & 1) * 32 + (swz % 64) / 2; }
__host__ __device__ __forceinline__ int perm32(int rho) { const int n = rho >> 4, i = rho & 15; return 8 * (i >> 2) + 4 * n + (i & 3); }

struct Unit { int pm, pn, z; };
struct Gemm { const bf16_t* A; const bf16_t* Bt; int M, N, K; size_t zA, zB; };

struct StaticOrder {
    int nM, nN, nwg, G, c;
    __host__ __device__ void init(int M, int N, int G_, int c_) { nM = M / BM; nN = N / BM; nwg = nM * nN; G = G_; c = c_; }
    __host__ __device__ bool next(int i, Unit& u) const {
        const long L = (long)i * G + c; if (L >= nwg) return false;
        int wgid = (int)L; { const int q = nwg / NXCD, r = nwg % NXCD, xcd = wgid % NXCD, off = wgid / NXCD; wgid = (xcd < r ? xcd * (q + 1) : r * (q + 1) + (xcd - r) * q) + off; }
        const int nig = WGM * nN, gid = wgid / nig, fm = gid * WGM, gsz = (nM - fm) < WGM ? (nM - fm) : WGM;
        u.pm = fm + ((wgid % nig) % gsz); u.pn = (wgid % nig) / gsz; u.z = 0; return true;
    }
    __device__ __forceinline__ void a_ready(const Unit&) const {}
    __device__ __forceinline__ void done(const Unit&) const {}
};

__device__ __forceinline__ unsigned cvt_pk_bf16(float lo, float hi) { unsigned r; asm volatile("v_cvt_pk_bf16_f32 %0, %1, %2" : "=v"(r) : "v"(lo), "v"(hi)); return r; }
typedef float f32x2 __attribute__((ext_vector_type(2)));
template <class Epi, class Sched, bool ALIGN_EPI = false, bool SP2 = false>
__device__ __forceinline__ void gemm_phase(PG8_LAS unsigned char* lds, const Gemm g, const Sched& S, const Epi& E, const int tid) {
    const int wid = __builtin_amdgcn_readfirstlane(tid >> 6), lane = tid & 63, wr = wid >> 2, wc = wid & 3, fr = lane & 15, fq = lane >> 4;
    const int K = g.K, nt = K / BK;
    unsigned voffA[2], voffB[2];
#pragma unroll
    for (int i = 0; i < 2; ++i) { int R, C; stage_rc(tid * 16 + i * 8192, R, C); const int Rb = Epi::PERM ? ((R & ~31) + perm32(R & 31)) : R;
        voffA[i] = (unsigned)(R * K + C) * 2u; voffB[i] = (unsigned)(Rb * K + C) * 2u; }
    const size_t kstep = (size_t)(BK * 2);
    const size_t hstep = (size_t)HALF * K * 2;
    const size_t tstep = 2 * hstep;
    const unsigned ldsw = (unsigned)wid * 1024u;
    const int aoff = lds_byte(wr * 64 + fr, fq * 8), boff = lds_byte(wc * 32 + fr, fq * 8);
#define PG8_SA(b, h) (((b) * 2 + (h)) * HTB)
#define PG8_SB(b, h) ((4 + (b) * 2 + (h)) * HTB)
#define PG8_STAGE(bufoff, gbase, voff) do { _Pragma("unroll") for (int _i = 0; _i < 2; ++_i) \
        __builtin_amdgcn_global_load_lds((const unsigned*)((const char*)(gbase) + (voff)[_i]), (PG8_LAS unsigned*)(lds + (bufoff) + ldsw + _i * 8192), 16, 0, 0); } while (0)
#define PG8_LDA(dst, b, h) do { _Pragma("unroll") for (int m = 0; m < 4; ++m) _Pragma("unroll") for (int k = 0; k < 2; ++k) dst[m][k] = *(const PG8_LAS bf16x8*)(lds + PG8_SA(b, h) + aoff + m * 2048 + k * 1024); } while (0)
#define PG8_LDB(dst, b, h) do { _Pragma("unroll") for (int n = 0; n < 2; ++n) _Pragma("unroll") for (int k = 0; k < 2; ++k) dst[n][k] = *(const PG8_LAS bf16x8*)(lds + PG8_SB(b, h) + boff + n * 2048 + k * 1024); } while (0)
#define PG8_MMA(ai, bj, At, Bt) do { __builtin_amdgcn_s_setprio(1); _Pragma("unroll") for (int m = 0; m < 4; ++m) _Pragma("unroll") for (int n = 0; n < 2; ++n) _Pragma("unroll") for (int k = 0; k < 2; ++k) \
        acc[ai][bj][m][n] = __builtin_amdgcn_mfma_f32_16x16x32_bf16(Bt[n][k], At[m][k], acc[ai][bj][m][n], 0, 0, 0); __builtin_amdgcn_s_setprio(0); } while (0)
#define PG8_WAIT_V(n) asm volatile("s_waitcnt vmcnt(" #n ")" ::: "memory")
#define PG8_WAIT_L(n) asm volatile("s_waitcnt lgkmcnt(" #n ")" ::: "memory")
#define PG8_BAR __builtin_amdgcn_s_barrier()
#define PG8_SCHED __builtin_amdgcn_sched_barrier(0)
    Unit cur, nxt; int ui = 0;
    if (!S.next(0, cur)) return;
    f32x4 acc[2][2][4][2];
#pragma unroll
    for (int a = 0; a < 2; ++a)
#pragma unroll
        for (int b = 0; b < 2; ++b)
#pragma unroll
            for (int m = 0; m < 4; ++m)
#pragma unroll
                for (int n = 0; n < 2; ++n) acc[a][b][m][n] = (f32x4){0.f, 0.f, 0.f, 0.f};
    bf16x8 At[4][2], B0[2][2], B1[2][2];
    const char* cA = (const char*)g.A + (size_t)cur.z * g.zA + (size_t)cur.pm * tstep; const char* cB = (const char*)g.Bt + (size_t)cur.z * g.zB + (size_t)cur.pn * tstep;
    S.a_ready(cur);
    if constexpr (SP2) {
        PG8_STAGE(PG8_SB(0, 0), cB, voffB); PG8_STAGE(PG8_SB(0, 1), cB + hstep, voffB); PG8_STAGE(PG8_SA(0, 0), cA, voffA); PG8_STAGE(PG8_SA(0, 1), cA + hstep, voffA);
        if (wr == 1) PG8_BAR;
        PG8_WAIT_V(2); PG8_BAR;
        PG8_STAGE(PG8_SB(1, 0), cB + kstep, voffB); PG8_STAGE(PG8_SA(1, 0), cA + kstep, voffA); PG8_STAGE(PG8_SB(1, 1), cB + hstep + kstep, voffB);
        PG8_WAIT_V(6); PG8_BAR;
    } else {
        PG8_STAGE(PG8_SB(0, 0), cB, voffB); PG8_STAGE(PG8_SA(0, 0), cA, voffA); PG8_STAGE(PG8_SB(0, 1), cB + hstep, voffB); PG8_STAGE(PG8_SA(0, 1), cA + hstep, voffA);
        if (wr == 1) PG8_BAR;
        PG8_WAIT_V(4); PG8_BAR;
        PG8_STAGE(PG8_SB(1, 0), cB + kstep, voffB); PG8_STAGE(PG8_SA(1, 0), cA + kstep, voffA); PG8_STAGE(PG8_SB(1, 1), cB + hstep + kstep, voffB);
        PG8_WAIT_V(6); PG8_BAR;
    }
    for (;;) {
        const bool has_next = S.next(ui + 1, nxt);
        const char* nA = has_next ? (const char*)g.A + (size_t)nxt.z * g.zA + (size_t)nxt.pm * tstep : cA; const char* nB = has_next ? (const char*)g.Bt + (size_t)nxt.z * g.zB + (size_t)nxt.pn * tstep : cB;
        for (int t = 0; t < nt; t += 2) {
            const bool last = (t == nt - 2);
            const char* a1 = cA + (size_t)(t + 1) * kstep;
            const char* a2 = last ? nA : cA + (size_t)(t + 2) * kstep; const char* b2 = last ? nB : cB + (size_t)(t + 2) * kstep;
            const char* a3 = a2 + kstep; const char* b3 = b2 + kstep;
            if (last && has_next) S.a_ready(nxt);
            if constexpr (SP2) {
            PG8_LDB(B0, 0, 0); PG8_LDB(B1, 0, 1); PG8_SCHED; PG8_LDA(At, 0, 0); PG8_STAGE(PG8_SA(1, 1), a1 + hstep, voffA);
            PG8_WAIT_V(8); PG8_WAIT_L(0); PG8_BAR; PG8_MMA(0, 0, At, B0); PG8_MMA(0, 1, At, B1); PG8_BAR; PG8_SCHED;
            PG8_LDA(At, 0, 1); PG8_STAGE(PG8_SB(0, 0), b2, voffB); PG8_STAGE(PG8_SB(0, 1), b2 + hstep, voffB); PG8_STAGE(PG8_SA(0, 0), a2, voffA);
            PG8_WAIT_V(8); PG8_WAIT_L(0); PG8_BAR; PG8_MMA(1, 0, At, B0); PG8_MMA(1, 1, At, B1); PG8_BAR; PG8_SCHED;
            PG8_LDB(B0, 1, 0); PG8_LDB(B1, 1, 1); PG8_SCHED; PG8_LDA(At, 1, 0); PG8_STAGE(PG8_SA(0, 1), a2 + hstep, voffA);
            PG8_WAIT_V(8); PG8_WAIT_L(0); PG8_BAR; PG8_MMA(0, 0, At, B0); PG8_MMA(0, 1, At, B1); PG8_BAR; PG8_SCHED;
            PG8_LDA(At, 1, 1); PG8_STAGE(PG8_SB(1, 0), b3, voffB); PG8_STAGE(PG8_SB(1, 1), b3 + hstep, voffB); PG8_STAGE(PG8_SA(1, 0), a3, voffA);
            PG8_WAIT_V(8); PG8_WAIT_L(0); PG8_BAR; PG8_MMA(1, 0, At, B0); PG8_MMA(1, 1, At, B1); PG8_BAR; PG8_SCHED;
            } else {
            PG8_LDB(B0, 0, 0); PG8_SCHED; PG8_LDA(At, 0, 0); PG8_STAGE(PG8_SA(1, 1), a1 + hstep, voffA);
            PG8_WAIT_L(8); PG8_BAR; PG8_WAIT_L(0); PG8_MMA(0, 0, At, B0); PG8_BAR; PG8_SCHED;
            PG8_LDB(B1, 0, 1); PG8_STAGE(PG8_SB(0, 0), b2, voffB);
            PG8_BAR; PG8_WAIT_L(0); PG8_MMA(0, 1, At, B1); PG8_BAR;
            PG8_LDA(At, 0, 1); PG8_STAGE(PG8_SA(0, 0), a2, voffA);
            PG8_BAR; PG8_WAIT_L(0); PG8_MMA(1, 0, At, B0); PG8_BAR; PG8_SCHED;
            PG8_STAGE(PG8_SB(0, 1), b2 + hstep, voffB);
            PG8_WAIT_V(6); PG8_BAR; PG8_MMA(1, 1, At, B1); PG8_BAR;
            PG8_LDB(B0, 1, 0); PG8_SCHED; PG8_LDA(At, 1, 0); PG8_STAGE(PG8_SA(0, 1), a2 + hstep, voffA);
            PG8_WAIT_L(8); PG8_BAR; PG8_WAIT_L(0); PG8_MMA(0, 0, At, B0); PG8_BAR; PG8_SCHED;
            PG8_LDB(B1, 1, 1); PG8_STAGE(PG8_SB(1, 0), b3, voffB);
            PG8_BAR; PG8_WAIT_L(0); PG8_MMA(0, 1, At, B1); PG8_BAR;
            PG8_LDA(At, 1, 1); PG8_STAGE(PG8_SA(1, 0), a3, voffA);
            PG8_BAR; PG8_WAIT_L(0); PG8_MMA(1, 0, At, B0); PG8_BAR; PG8_SCHED;
            PG8_STAGE(PG8_SB(1, 1), b3 + hstep, voffB);
            PG8_WAIT_V(6); PG8_BAR; PG8_MMA(1, 1, At, B1); PG8_BAR;
            }
        }
        if constexpr (ALIGN_EPI) { if (wr == 0) PG8_BAR; }
        if constexpr (!Epi::AFTER_DRAIN) { E(acc, cur, wr, wc, fr, fq); S.done(cur); }
        if (!has_next) break;
#pragma unroll
        for (int a = 0; a < 2; ++a)
#pragma unroll
            for (int b = 0; b < 2; ++b)
#pragma unroll
                for (int m = 0; m < 4; ++m)
#pragma unroll
                    for (int n = 0; n < 2; ++n) acc[a][b][m][n] = (f32x4){0.f, 0.f, 0.f, 0.f};
        cur = nxt; cA = nA; cB = nB; ++ui;
        if constexpr (ALIGN_EPI) { if (wr == 1) PG8_BAR; }
    }
    PG8_WAIT_V(0);
    if constexpr (!ALIGN_EPI) { if (wr == 0) PG8_BAR; }
    PG8_BAR;
    if constexpr (Epi::AFTER_DRAIN) { E.fused(acc, cur, wr, wc, fr, fq, lds, wid, lane); S.done(cur); }
#undef PG8_SA
#undef PG8_SB
#undef PG8_STAGE
#undef PG8_LDA
#undef PG8_LDB
#undef PG8_MMA
#undef PG8_WAIT_V
#undef PG8_WAIT_L
#undef PG8_BAR
#undef PG8_SCHED
}
}

constexpr int T = 16384, D = 1024, SEQ = 2048, DEPTH = 2, FF = 4096, PLE = 256;
constexpr float RMS_EPS = 1e-6f;
constexpr size_t MiB = 1u << 20;
constexpr size_t WS_CTL = 0, CTL_ZERO_BYTES = 65536;
constexpr size_t WS_TAB = 1 * MiB;
constexpr size_t WS_SSA = 2 * MiB, WS_SSB = 3 * MiB;
constexpr size_t WS_PROJ = 6 * MiB, BLK = 16 * MiB;
constexpr size_t WS_GATE8 = 150 * MiB;
constexpr size_t WS_XB = 198 * MiB;
constexpr size_t WS_W = 230 * MiB, WS_END = 256 * MiB;
constexpr size_t W_IN = WS_W, W_UP = WS_W, W_DOWN = WS_W + 8 * MiB, W_BR = WS_W + 16 * MiB, W_OUT = WS_W + 19 * MiB;
__host__ __device__ constexpr size_t W_G(int slot) { return WS_W + 21 * MiB + (size_t)slot * (5 * MiB / 2); }
__host__ __device__ constexpr size_t W_PLE(int slot) { return W_G(slot) + 2 * MiB; }
constexpr size_t WS_U = WS_PROJ;
constexpr size_t WS_E = WS_PROJ;
constexpr size_t WS_PB = WS_PROJ + 8 * BLK;
constexpr size_t WS_HF = WS_PROJ + 1 * BLK;
constexpr int CW_TMO = 0, CW_BAR = 4096;

enum { PH_PRO = 0, PH_G1, PH_NA, PH_RET, PH_LRUA, PH_LRUB, PH_LRUC, PH_G2, PH_G3, PH_G4, PH_G5, PH_G6, PH_FIN };
constexpr int NPL = 11, NPH = 1 + DEPTH * NPL + 1;

constexpr int NWAVES = 8;
constexpr int RING_BYTES = 131072, LDSCTL_OFF = RING_BYTES, MISC_OFF = LDSCTL_OFF + 320, LDS_BYTES = 147456;

#define GAS __attribute__((address_space(1)))
#define LAS __attribute__((address_space(3)))
typedef unsigned short bf16;
typedef unsigned v4u __attribute__((ext_vector_type(4)));
typedef unsigned v2u __attribute__((ext_vector_type(2)));
typedef float f32x4 __attribute__((ext_vector_type(4)));
typedef GAS unsigned gu32;
#define RLX_AGENT __ATOMIC_RELAXED, __HIP_MEMORY_SCOPE_AGENT
#define LDS_WAIT() asm volatile("s_waitcnt lgkmcnt(0)" ::: "memory")
#define VM_WAIT() asm volatile("s_waitcnt vmcnt(0)" ::: "memory")
__device__ __forceinline__ unsigned f2bf(float f) { unsigned u = __builtin_bit_cast(unsigned, f); return (u + 0x7fffu + ((u >> 16) & 1u)) >> 16; }
__device__ __forceinline__ unsigned pk2(float lo, float hi) { return f2bf(lo) | (f2bf(hi) << 16); }
__device__ __forceinline__ float bf2f(unsigned short b) { return __builtin_bit_cast(float, (unsigned)b << 16); }
__device__ __forceinline__ float bflo(unsigned w) { return __builtin_bit_cast(float, w << 16); }
__device__ __forceinline__ float bfhi(unsigned w) { return __builtin_bit_cast(float, w & 0xffff0000u); }
__device__ __forceinline__ float rdlane(float v, int l) { return __builtin_bit_cast(float, __builtin_amdgcn_readlane(__builtin_bit_cast(int, v), l)); }
__device__ __forceinline__ float fexp(float x) { return __builtin_amdgcn_exp2f(x * 1.4426950408889634f); }
__device__ __forceinline__ float sigmoidf_(float x) { return __builtin_amdgcn_rcpf(1.0f + fexp(-x)); }
__device__ __forceinline__ float wave_sum(float v) {
#pragma unroll
    for (int o = 1; o < 64; o <<= 1) v += __shfl_xor(v, o);
    return v;
}
__device__ __forceinline__ float wave_max(float v) {
#pragma unroll
    for (int o = 1; o < 64; o <<= 1) v = fmaxf(v, __shfl_xor(v, o));
    return v;
}
__device__ __forceinline__ float log2_1m(float x) {
    const float p = x * (1.0f + x * (0.5f + x * (0.33333333f + x * (0.25f + x * (0.2f + x * (0.16666667f + x * 0.14285714f))))));
    return -p * 1.4426950408889634f;
}
__device__ __forceinline__ float gelu_tanh(float x) {
    const float u = 0.7978845608028654f * (x + 0.044715f * x * x * x);
    const float t = 1.0f - 2.0f * __builtin_amdgcn_rcpf(1.0f + fexp(2.0f * u));
    return 0.5f * x * (1.0f + t);
}
__device__ __forceinline__ float row_rs(const float* ss, int row, int fq) {
    const f32x4 a = *(const f32x4*)(ss + (size_t)row * 16 + 4 * fq);
    float s = (a.x + a.y) + (a.z + a.w);
    s += __shfl_xor(s, 16); s += __shfl_xor(s, 32);
    return 1.0f / sqrtf(s * (1.0f / D) + RMS_EPS);
}

#define XB_TMO      128
#define XB_XCNT(j)  (256  + 64 * (j))
#define XB_XSUB(j)  (1280 + 64 * (j))
#define XB_XGEN(j)  (2304 + 64 * (j))
#define XB_TOP      3328
#define XB_TOPGEN   3392
#define XCD_BAR_WORDS 3456
#define XB_SPIN_CAP (1u << 18)

__device__ __forceinline__ unsigned xb_ld(unsigned* p)              { return __hip_atomic_load(p, __ATOMIC_RELAXED, __HIP_MEMORY_SCOPE_AGENT); }
__device__ __forceinline__ unsigned xb_add(unsigned* p, unsigned v) { return __hip_atomic_fetch_add(p, v, __ATOMIC_RELAXED, __HIP_MEMORY_SCOPE_AGENT); }
__device__ __forceinline__ unsigned xb_xcc_id() { return (unsigned)__builtin_amdgcn_s_getreg((3 << 11) | 20) & 0xFu; }
#define XB_SPIN(cond, bar) do { unsigned _sp = 0; while (cond) { __builtin_amdgcn_s_sleep(1); \
    if ((++_sp & 255u) == 0u) { if (xb_ld(&(bar)[XB_TMO])) break; if (_sp > XB_SPIN_CAP) { atomicAdd(&(bar)[XB_TMO], 1u); break; } } } } while (0)

struct XcdBarrier {
    unsigned* bar; unsigned x;
    volatile LAS unsigned* st;
};

__device__ __forceinline__ XcdBarrier xcd_barrier_post(unsigned* bar, volatile LAS unsigned* st) {
    XcdBarrier b; b.bar = bar; b.x = xb_xcc_id(); b.st = st;
    if (threadIdx.x == 0) (void)xb_add(&bar[XB_XCNT(b.x)], 1u);
    return b;
}
__device__ __forceinline__ void xcd_barrier_complete(unsigned* bar, unsigned x, unsigned& nloc, unsigned& nx) {
    const unsigned G = gridDim.x * gridDim.y * gridDim.z;
    unsigned sum, cnt, mine, sp = 0u;
    for (;;) {
        sum = 0u; cnt = 0u; mine = 0u;
#pragma unroll
        for (unsigned j = 0; j < 16; ++j) { const unsigned c = xb_ld(&bar[XB_XCNT(j)]); sum += c; cnt += (c > 0u) ? 1u : 0u; mine = (j == x) ? c : mine; }
        if (sum == G) break;
        __builtin_amdgcn_s_sleep(1);
        if ((++sp & 255u) == 0u) { if (xb_ld(&bar[XB_TMO])) break; if (sp > XB_SPIN_CAP) { atomicAdd(&bar[XB_TMO], 1u); break; } }
    }
    nloc = mine > 0u ? mine : 1u; nx = cnt > 0u ? cnt : 1u;
}

__device__ __forceinline__ void xcd_barrier(const XcdBarrier& b) {
    asm volatile("s_waitcnt vmcnt(0)" ::: "memory");
    __syncthreads();
    if (threadIdx.x == 0) {
        unsigned* bar = b.bar;
        __builtin_amdgcn_s_waitcnt(0);
        unsigned nloc = b.st[0], nx = b.st[1];
        if (nloc == 0u) { xcd_barrier_complete(bar, b.x, nloc, nx); b.st[0] = nloc; b.st[1] = nx; }
        const unsigned old = xb_add(&bar[XB_XSUB(b.x)], 1u);
        const unsigned gen = old / nloc;
        if (old + 1u == (gen + 1u) * nloc) {
            __builtin_amdgcn_fence(__ATOMIC_RELEASE, "agent");
            asm volatile("s_waitcnt vmcnt(0)" ::: "memory");
            const unsigned og = xb_add(&bar[XB_TOP], 1u);
            const unsigned tg = og / nx;
            if (og + 1u == (tg + 1u) * nx) xb_add(&bar[XB_TOPGEN], 1u);
            else XB_SPIN(xb_ld(&bar[XB_TOPGEN]) == tg, bar);
            __builtin_amdgcn_fence(__ATOMIC_ACQUIRE, "agent");
            xb_add(&bar[XB_XGEN(b.x)], 1u);
            asm volatile("s_waitcnt vmcnt(0)" ::: "memory");
        } else {
            XB_SPIN(xb_ld(&bar[XB_XGEN(b.x)]) == gen, bar);
            __builtin_amdgcn_fence(__ATOMIC_ACQUIRE, "agent");
            asm volatile("s_waitcnt vmcnt(0)" ::: "memory");
        }
    }
    __syncthreads();
}


using pg8::Unit; using pg8::bf16_t; using pg8::cvt_pk_bf16;
typedef pg8::u32x4 u32x4;
struct EpiG1 {
    static constexpr bool PERM = true, AFTER_DRAIN = false;
    bf16_t* proj; unsigned char* gate8; const float* ss; const float* bgate; const float* tab;
    __device__ __forceinline__ void operator()(const f32x4 (&acc)[2][2][4][2], const Unit& u, int wr, int wc, int fr, int fq) const {
        const int pn = u.pn;
        float rsv[2][4];
#pragma unroll
        for (int ai = 0; ai < 2; ++ai)
#pragma unroll
            for (int m = 0; m < 4; ++m) { rsv[ai][m] = row_rs(ss, u.pm * 256 + ai * 128 + wr * 64 + m * 16 + fr, fq); if (m & 1) asm volatile("" : "+v"(rsv[ai][m - 1]), "+v"(rsv[ai][m]) :: "memory"); }
        if (pn < 18) {
            const int kind = pn >> 1, phys = (int)((0x683754210ull >> (4 * kind)) & 15ull);
            bf16_t* base = proj + (size_t)phys * ((size_t)T * 512);
            const int col0 = (pn & 1) * 256 + wc * 32 + 8 * fq;
            const float scale = kind == 0 ? 0.125f : (kind == 3 ? 0.08838834764831845f : 1.0f);
            const bool rope = (kind == 3) || (kind == 4);
#pragma unroll
            for (int ai = 0; ai < 2; ++ai)
#pragma unroll
                for (int m = 0; m < 4; ++m) {
                    const int row = u.pm * 256 + ai * 128 + wr * 64 + m * 16 + fr;
                    const float rs = rsv[ai][m] * scale;
                    bf16_t* rowp = base + (size_t)row * 512 + col0;
#pragma unroll
                    for (int bj = 0; bj < 2; ++bj) {
                        f32x4 v0 = acc[ai][bj][m][0] * rs, v1 = acc[ai][bj][m][1] * rs;
                        if (rope) {
                            const int cc = col0 + bj * 128, i0 = (cc & 127) >> 1, pos = row & (SEQ - 1);
                            const f32x4 cs = *(const f32x4*)(tab + pos * 64 + i0), sn = *(const f32x4*)(tab + 131072 + pos * 64 + i0);
                            f32x4 w0, w1;
                            w0[0] = v0[0] * cs[0] - v0[1] * sn[0]; w0[1] = v0[0] * sn[0] + v0[1] * cs[0];
                            w0[2] = v0[2] * cs[1] - v0[3] * sn[1]; w0[3] = v0[2] * sn[1] + v0[3] * cs[1];
                            w1[0] = v1[0] * cs[2] - v1[1] * sn[2]; w1[1] = v1[0] * sn[2] + v1[1] * cs[2];
                            w1[2] = v1[2] * cs[3] - v1[3] * sn[3]; w1[3] = v1[2] * sn[3] + v1[3] * cs[3];
                            v0 = w0; v1 = w1;
                        }
                        u32x4 w; w.x = cvt_pk_bf16(v0[0], v0[1]); w.y = cvt_pk_bf16(v0[2], v0[3]); w.z = cvt_pk_bf16(v1[0], v1[1]); w.w = cvt_pk_bf16(v1[2], v1[3]);
                        *(u32x4*)(rowp + bj * 128) = w;
                    }
                }
        } else {
            const int g0 = (pn - 18) * 256 + wc * 32 + 8 * fq;
#pragma unroll
            for (int ai = 0; ai < 2; ++ai)
#pragma unroll
                for (int m = 0; m < 4; ++m) {
                    const int row = u.pm * 256 + ai * 128 + wr * 64 + m * 16 + fr;
                    const float rs = rsv[ai][m];
#pragma unroll
                    for (int bj = 0; bj < 2; ++bj) {
                        const int gc = g0 + bj * 128;
                        const f32x4 b0 = *(const f32x4*)(bgate + gc), b1 = *(const f32x4*)(bgate + gc + 4);
                        const f32x4 v0 = acc[ai][bj][m][0] * rs + b0, v1 = acc[ai][bj][m][1] * rs + b1;
                        unsigned lo = 0, hi = 0;
#pragma unroll
                        for (int e = 0; e < 4; ++e) {
                            lo |= (unsigned)(sigmoidf_(v0[e]) * 255.0f + 0.5f) << (8 * e);
                            hi |= (unsigned)(sigmoidf_(v1[e]) * 255.0f + 0.5f) << (8 * e);
                        }
                        v2u w; w.x = lo; w.y = hi;
                        *(v2u*)(gate8 + (size_t)row * 3072 + gc) = w;
                    }
                }
        }
    }
};
struct EpiG2 {
    static constexpr bool PERM = false, AFTER_DRAIN = false;
    const unsigned char* gate8; bf16_t* merged;
    __device__ __forceinline__ void operator()(const f32x4 (&acc)[2][2][4][2], const Unit& u, int wr, int wc, int fr, int fq) const {
        const int col0 = u.pn * 256 + wc * 32 + 4 * fq;
#pragma unroll
        for (int ai = 0; ai < 2; ++ai)
#pragma unroll
            for (int m = 0; m < 4; ++m) {
                const int row = u.pm * 256 + ai * 128 + wr * 64 + m * 16 + fr;
#pragma unroll
                for (int bj = 0; bj < 2; ++bj)
#pragma unroll
                    for (int n = 0; n < 2; ++n) {
                        const int c = col0 + bj * 128 + n * 16;
                        const unsigned g4 = *(const unsigned*)(gate8 + (size_t)row * 3072 + u.z * 1024 + c);
                        f32x4 t = acc[ai][bj][m][n];
                        t[0] *= (float)(g4 & 255u) * (1.0f / 255.0f); t[1] *= (float)((g4 >> 8) & 255u) * (1.0f / 255.0f);
                        t[2] *= (float)((g4 >> 16) & 255u) * (1.0f / 255.0f); t[3] *= (float)(g4 >> 24) * (1.0f / 255.0f);
                        v2u* mp = (v2u*)(merged + (size_t)row * 1024 + c);
                        if (u.z > 0) { const v2u o = *mp; t[0] += bflo(o.x); t[1] += bfhi(o.x); t[2] += bflo(o.y); t[3] += bfhi(o.y); }
                        v2u w; w.x = cvt_pk_bf16(t[0], t[1]); w.y = cvt_pk_bf16(t[2], t[3]);
                        *mp = w;
                    }
            }
    }
};
struct EpiRes {
    static constexpr bool PERM = false, AFTER_DRAIN = false;
    const float* base; float* out; bf16_t* xb; float* ssout;
    __device__ __forceinline__ void operator()(const f32x4 (&acc)[2][2][4][2], const Unit& u, int wr, int wc, int fr, int fq) const {
        const int col0 = u.pn * 256 + wc * 32 + 4 * fq;
#pragma unroll
        for (int ai = 0; ai < 2; ++ai)
#pragma unroll
            for (int m = 0; m < 4; ++m) {
                const int row = u.pm * 256 + ai * 128 + wr * 64 + m * 16 + fr;
                float s = 0.f;
#pragma unroll
                for (int bj = 0; bj < 2; ++bj)
#pragma unroll
                    for (int n = 0; n < 2; ++n) {
                        const size_t off = (size_t)row * 1024 + col0 + bj * 128 + n * 16;
                        const f32x4 v = *(const f32x4*)(base + off) + acc[ai][bj][m][n];
                        *(f32x4*)(out + off) = v;
                        v2u w; w.x = cvt_pk_bf16(v[0], v[1]); w.y = cvt_pk_bf16(v[2], v[3]);
                        *(v2u*)(xb + off) = w;
                        s += (v[0] * v[0] + v[1] * v[1]) + (v[2] * v[2] + v[3] * v[3]);
                    }
                s += __shfl_xor(s, 16); s += __shfl_xor(s, 32);
                if (fq == 0) ssout[(size_t)row * 16 + u.pn * 4 + wc] = s;
            }
    }
};
struct EpiG4 {
    static constexpr bool PERM = true, AFTER_DRAIN = false;
    bf16_t* U; const float* ss;
    __device__ __forceinline__ void operator()(const f32x4 (&acc)[2][2][4][2], const Unit& u, int wr, int wc, int fr, int fq) const {
        const int col0 = u.pn * 256 + wc * 32 + 8 * fq;
        float rsv[2][4];
#pragma unroll
        for (int ai = 0; ai < 2; ++ai)
#pragma unroll
            for (int m = 0; m < 4; ++m) { rsv[ai][m] = row_rs(ss, u.pm * 256 + ai * 128 + wr * 64 + m * 16 + fr, fq); if (m & 1) asm volatile("" : "+v"(rsv[ai][m - 1]), "+v"(rsv[ai][m]) :: "memory"); }
#pragma unroll
        for (int ai = 0; ai < 2; ++ai)
#pragma unroll
            for (int m = 0; m < 4; ++m) {
                const int row = u.pm * 256 + ai * 128 + wr * 64 + m * 16 + fr;
                const float rs = rsv[ai][m];
                bf16_t* rowp = U + (size_t)row * FF + col0;
#pragma unroll
                for (int bj = 0; bj < 2; ++bj) {
                    f32x4 v0 = acc[ai][bj][m][0] * rs, v1 = acc[ai][bj][m][1] * rs;
#pragma unroll
                    for (int e = 0; e < 4; ++e) { const float a = fmaxf(v0[e], 0.f), b = fmaxf(v1[e], 0.f); v0[e] = a * a; v1[e] = b * b; }
                    u32x4 w; w.x = cvt_pk_bf16(v0[0], v0[1]); w.y = cvt_pk_bf16(v0[2], v0[3]); w.z = cvt_pk_bf16(v1[0], v1[1]); w.w = cvt_pk_bf16(v1[2], v1[3]);
                    *(u32x4*)(rowp + bj * 128) = w;
                }
            }
    }
};
struct EpiE {
    static constexpr bool PERM = false, AFTER_DRAIN = false;
    float* E;
    __device__ __forceinline__ void operator()(const f32x4 (&acc)[2][2][4][2], const Unit& u, int wr, int wc, int fr, int fq) const {
        const int col0 = u.pn * 256 + wc * 32 + 4 * fq;
#pragma unroll
        for (int ai = 0; ai < 2; ++ai)
#pragma unroll
            for (int m = 0; m < 4; ++m) {
                const int row = u.pm * 256 + ai * 128 + wr * 64 + m * 16 + fr;
#pragma unroll
                for (int bj = 0; bj < 2; ++bj)
#pragma unroll
                    for (int n = 0; n < 2; ++n) *(f32x4*)(E + (size_t)row * 1024 + col0 + bj * 128 + n * 16) = acc[ai][bj][m][n];
            }
    }
};
struct EpiG6 {
    static constexpr bool PERM = false, AFTER_DRAIN = false;
    const float* base; float* out; bf16_t* xb; const float* ssin; float* ssout; const float* E;
    __device__ __forceinline__ void operator()(const f32x4 (&acc)[2][2][4][2], const Unit& u, int wr, int wc, int fr, int fq) const {
        const int col0 = u.pn * 256 + wc * 32 + 4 * fq;
#pragma unroll
        for (int ai = 0; ai < 2; ++ai)
#pragma unroll
            for (int m = 0; m < 4; ++m) {
                const int row = u.pm * 256 + ai * 128 + wr * 64 + m * 16 + fr;
                float rs = row_rs(ssin, row, fq); asm volatile("" : "+v"(rs) :: "memory");
                float s = 0.f;
#pragma unroll
                for (int bj = 0; bj < 2; ++bj)
#pragma unroll
                    for (int n = 0; n < 2; ++n) {
                        const size_t off = (size_t)row * 1024 + col0 + bj * 128 + n * 16;
                        const f32x4 a = acc[ai][bj][m][n] * rs, e = *(const f32x4*)(E + off);
                        f32x4 v = *(const f32x4*)(base + off);
#pragma unroll
                        for (int k = 0; k < 4; ++k) v[k] += sigmoidf_(a[k]) * e[k];
                        *(f32x4*)(out + off) = v;
                        v2u w; w.x = cvt_pk_bf16(v[0], v[1]); w.y = cvt_pk_bf16(v[2], v[3]);
                        *(v2u*)(xb + off) = w;
                        s += (v[0] * v[0] + v[1] * v[1]) + (v[2] * v[2] + v[3] * v[3]);
                    }
                s += __shfl_xor(s, 16); s += __shfl_xor(s, 32);
                if (fq == 0) ssout[(size_t)row * 16 + u.pn * 4 + wc] = s;
                asm volatile("" ::: "memory");
            }
    }
};
struct ZOrder {
    pg8::StaticOrder S;
    __device__ __forceinline__ bool next(int i, Unit& u) const { if (!S.next(i / 3, u)) return false; u.z = i % 3; return true; }
    __device__ __forceinline__ void a_ready(const Unit&) const {}
    __device__ __forceinline__ void done(const Unit&) const {}
};

struct Args { const float* in[23]; float* out; unsigned char* ws; int ph_lo, ph_hi; };
typedef const __attribute__((address_space(4))) Args CArgs;
__device__ __forceinline__ CArgs* get_args() {
    CArgs* p = (CArgs*)__builtin_amdgcn_kernarg_segment_ptr();
    asm volatile("" : "+s"(p));
    return p;
}
struct Frame {
    LAS unsigned char* lds;
    int tid, lane, wave, G, gw, ngw;
    float* out; unsigned char* ws;
};

__device__ __forceinline__ void transpose_item(const float* W, const float* g, int K, int N, bf16* WT, LAS float* scr, int item, int lane) {
    const int nblk = N / 32, kb = item / nblk, nb = item % nblk, k0 = 64 * kb, n0 = 32 * nb;
#pragma unroll 8
    for (int i = 0; i < 32; ++i) { const int kk = 2 * i + (lane >> 5); float v = W[(size_t)(k0 + kk) * N + n0 + (lane & 31)]; if (g) v *= g[k0 + kk]; scr[kk * 33 + (lane & 31)] = v; }
    LDS_WAIT(); asm volatile("" ::: "memory");
    const int c = lane & 7;
#pragma unroll
    for (int j = 0; j < 4; ++j) { const int n = (lane >> 3) + 8 * j; const LAS float* s = scr + (8 * c) * 33 + n;
        v4u o; o.x = pk2(s[0 * 33], s[1 * 33]); o.y = pk2(s[2 * 33], s[3 * 33]); o.z = pk2(s[4 * 33], s[5 * 33]); o.w = pk2(s[6 * 33], s[7 * 33]);
        *(v4u*)(WT + (size_t)(n0 + n) * K + k0 + 8 * c) = o; }
    LDS_WAIT(); asm volatile("" ::: "memory");
}
__device__ __forceinline__ void convert_matrix(const Frame& F, const float* W, const float* g, int K, int N, bf16* WT) {
    LAS float* scr = (LAS float*)(F.lds + F.wave * 16384);
    const int nitems = (K / 64) * (N / 32);
    for (int it = F.gw; it < nitems; it += F.ngw) transpose_item(W, g, K, N, WT, scr, it, F.lane);
}
__device__ __forceinline__ void convert_layer_early(const Frame& F, CArgs* A, int l) {
    convert_matrix(F, A->in[3] + (size_t)l * D * 7680, A->in[2] + l * D, D, 7680, (bf16*)(F.ws + W_IN));
}
__device__ __forceinline__ void convert_layer_mid(const Frame& F, CArgs* A, int l) {
    for (int n = 0; n < 3; ++n) convert_matrix(F, A->in[14] + ((size_t)l * 3 + n) * 512 * D, nullptr, 512, D, (bf16*)(F.ws + W_BR) + (size_t)n * D * 512);
    convert_matrix(F, A->in[15] + (size_t)l * D * D, nullptr, D, D, (bf16*)(F.ws + W_OUT));
    convert_matrix(F, A->in[20] + (size_t)l * D * D, A->in[19] + l * D, D, D, (bf16*)(F.ws + W_G(l & 1)));
    convert_matrix(F, A->in[21] + (size_t)l * PLE * D, nullptr, PLE, D, (bf16*)(F.ws + W_PLE(l & 1)));
}
__device__ __forceinline__ void convert_layer_mlp(const Frame& F, CArgs* A, int l) {
    convert_matrix(F, A->in[17] + (size_t)l * D * FF, A->in[16] + l * D, D, FF, (bf16*)(F.ws + W_UP));
    convert_matrix(F, A->in[18] + (size_t)l * FF * D, nullptr, FF, D, (bf16*)(F.ws + W_DOWN));
}
__device__ __forceinline__ void convert_p(const Frame& F, CArgs* A, int l) {
    const f32x4* src = (const f32x4*)(A->in[1] + (size_t)l * T * PLE); v2u* dst = (v2u*)(F.ws + WS_PB);
    const int n4 = T * PLE / 4;
    for (int i = F.gw * 64 + F.lane; i < n4; i += F.ngw * 64) { const f32x4 v = src[i]; v2u w; w.x = pk2(v.x, v.y); w.y = pk2(v.z, v.w); dst[i] = w; }
}

__device__ __forceinline__ void phase_prologue(const Frame& F, CArgs* A) {
    convert_layer_early(F, A, 0); convert_layer_mid(F, A, 0);
    const float* x = A->in[0]; bf16* xb = (bf16*)(F.ws + WS_XB); float* ss = (float*)(F.ws + WS_SSB);
    for (int m = F.gw; m < T; m += F.ngw) {
        const f32x4* xr = (const f32x4*)(x + (size_t)m * D) + F.lane; v2u* o = (v2u*)(xb + (size_t)m * D) + F.lane;
        float s = 0.f;
#pragma unroll
        for (int j = 0; j < 4; ++j) { const f32x4 v = xr[64 * j]; s += (v.x * v.x + v.y * v.y) + (v.z * v.z + v.w * v.w); v2u w; w.x = pk2(v.x, v.y); w.y = pk2(v.z, v.w); o[64 * j] = w; }
        s = wave_sum(s);
        if (F.lane < 16) ss[(size_t)m * 16 + F.lane] = F.lane == 0 ? s : 0.f;
    }
    float* tab = (float*)(F.ws + WS_TAB);
    for (int e = F.gw * 64 + F.lane; e < SEQ * 64; e += F.ngw * 64) {
        const int pos = e >> 6, i = e & 63;
        const float theta = __builtin_amdgcn_exp2f(-(float)i * (13.287712379549449f / 63.0f));
        double rev = (double)pos * (double)theta * 0.15915494309189535; rev -= __builtin_floor(rev);
        const float fr = (float)rev;
        tab[e] = __builtin_amdgcn_cosf(fr); tab[131072 + e] = __builtin_amdgcn_sinf(fr);
    }
}

__device__ __forceinline__ void phase_na_naive(const Frame& F, CArgs* A, int l) {
    bf16* Q = (bf16*)(F.ws + WS_PROJ); const bf16* K = (const bf16*)(F.ws + WS_PROJ + BLK); const bf16* V = (const bf16*)(F.ws + WS_PROJ + 2 * BLK);
    const float* rpb = A->in[5] + (size_t)l * 8 * 15 * 31;
    const int lane = F.lane;
    for (int p = F.gw; p < T * 8; p += F.ngw) {
        const int t = p >> 3, h = p & 7, b = t >> 11, s = t & 2047, r = s >> 6, c = s & 63;
        const int rs = min(max(r - 4, 0), 24), cst = min(max(c - 8, 0), 48);
        const float q = bf2f(Q[(size_t)t * 512 + h * 64 + lane]);
        float sc[2];
#pragma unroll
        for (int k2 = 0; k2 < 2; ++k2) {
            const int kk = lane + 64 * k2, i = kk >> 4, j = kk & 15;
            const int tk = (b << 11) + ((rs + i) << 6) + cst + j;
            const v4u* kp = (const v4u*)(K + (size_t)tk * 512 + h * 64);
            float a = 0.f;
#pragma unroll
            for (int d8 = 0; d8 < 8; ++d8) { const v4u w = kp[d8];
#pragma unroll
                for (int e = 0; e < 4; ++e) { a += rdlane(q, d8 * 8 + 2 * e) * bflo(w[e]); a += rdlane(q, d8 * 8 + 2 * e + 1) * bfhi(w[e]); } }
            a += rpb[h * 465 + (rs + i - r + 7) * 31 + (cst + j - c + 15)];
            sc[k2] = a;
        }
        const float mx = wave_max(fmaxf(sc[0], sc[1]));
        const float e0 = fexp(sc[0] - mx), e1 = fexp(sc[1] - mx);
        const float inv = 1.0f / wave_sum(e0 + e1);
        const float p0 = e0 * inv, p1 = e1 * inv;
        float o = 0.f;
        for (int kk = 0; kk < 128; ++kk) {
            const int i = kk >> 4, j = kk & 15, tk = (b << 11) + ((rs + i) << 6) + cst + j;
            const float pk = rdlane(kk < 64 ? p0 : p1, kk & 63);
            o += pk * bf2f(V[(size_t)tk * 512 + h * 64 + lane]);
        }
        Q[(size_t)t * 512 + h * 64 + lane] = (bf16)f2bf(o);
    }
}
__device__ __forceinline__ void phase_ret_naive(const Frame& F, CArgs* A, int l) {
    bf16* G = (bf16*)(F.ws + WS_PROJ + 3 * BLK); const bf16* Q = (const bf16*)(F.ws + WS_PROJ + 4 * BLK);
    const bf16* K = (const bf16*)(F.ws + WS_PROJ + 5 * BLK); const bf16* V = (const bf16*)(F.ws + WS_PROJ + 7 * BLK);
    const float* gn = A->in[6] + (size_t)l * 512;
    const int sub = F.tid >> 7, dv = F.tid & 127;
    LAS float* qs = (LAS float*)(F.lds + sub * 16384); LAS float* sc = qs + 128; LAS float* red = sc + SEQ;
    for (int it = blockIdx.x; it < 8 * 4 * SEQ / 4; it += F.G) {
        const int p = it * 4 + sub, bh = p >> 11, n = p & 2047, b = bh >> 2, h = bh & 3, t = b * SEQ + n;
        __syncthreads();
        qs[dv] = bf2f(Q[(size_t)t * 512 + h * 128 + dv]);
        __syncthreads();
        const float gf = log2_1m(__builtin_amdgcn_exp2f(-5.0f - (float)h)), gb = log2_1m(__builtin_amdgcn_exp2f(-5.5f - (float)h));
        for (int m = dv; m < SEQ; m += 128) {
            const v4u* kp = (const v4u*)(K + (size_t)(b * SEQ + m) * 512 + h * 128);
            float acc = 0.f;
#pragma unroll 4
            for (int d8 = 0; d8 < 16; ++d8) { const v4u w = kp[d8];
#pragma unroll
                for (int e = 0; e < 4; ++e) { acc += qs[d8 * 8 + 2 * e] * bflo(w[e]); acc += qs[d8 * 8 + 2 * e + 1] * bfhi(w[e]); } }
            sc[m] = acc * (m <= n ? __builtin_amdgcn_exp2f(gf * (float)(n - m)) : __builtin_amdgcn_exp2f(gb * (float)(m - n)));
        }
        __syncthreads();
        float o = 0.f;
        const bf16* vp = V + (size_t)(b * SEQ) * 512 + h * 128 + dv;
#pragma unroll 8
        for (int m = 0; m < SEQ; ++m) o += sc[m] * bf2f(vp[(size_t)m * 512]);
        red[dv] = o * o;
        __syncthreads();
        float ms = 0.f;
#pragma unroll 8
        for (int e = 0; e < 128; ++e) ms += red[e];
        const float rn = 1.0f / sqrtf(ms * (1.0f / 128.0f) + RMS_EPS);
        const size_t oi = (size_t)t * 512 + h * 128 + dv;
        const float g = bf2f(G[oi]);
        G[oi] = (bf16)f2bf(g * sigmoidf_(g) * o * rn * gn[h * 128 + dv]);
    }
}
__device__ __forceinline__ void phase_lrua_naive(const Frame& F, CArgs* A, int l) {
    const bf16* XC = (const bf16*)(F.ws + WS_PROJ + 8 * BLK); float* xf = (float*)(F.ws + WS_XB);
    const float* cw = A->in[7] + (size_t)l * 4 * 512; const float* cb = A->in[8] + (size_t)l * 512;
    for (int e = F.gw * 64 + F.lane; e < T * 512; e += F.ngw * 64) {
        const int t = e >> 9, ch = e & 511, s = t & 2047;
        float a = cb[ch];
#pragma unroll
        for (int w = 0; w < 4; ++w) { const int s2 = s + w - 2; if (s2 >= 0 && s2 < SEQ) a += cw[w * 512 + ch] * bf2f(XC[(size_t)(t + w - 2) * 512 + ch]); }
        xf[e] = a;
    }
}
__device__ __forceinline__ float log1p_small(float y) {
    if (y < 0.01f) return y * (1.0f - y * (0.5f - y * (0.33333333f - 0.25f * y)));
    return __builtin_amdgcn_logf(1.0f + y) * 0.6931471805599453f;
}
__device__ __forceinline__ void phase_lruscan_naive(const Frame& F, CArgs* A, int l, int dir) {
    const float* xf = (const float*)(F.ws + WS_XB); float* hf = (float*)(F.ws + WS_HF); bf16* GC = (bf16*)(F.ws + WS_PROJ + 6 * BLK);
    const int lane = F.lane;
    LAS float* wl = (LAS float*)F.lds;
    for (int it = blockIdx.x; it < 64; it += F.G) {
        const int b = it >> 3, blk = it & 7, ch = blk * 64 + lane;
        const float* wa = A->in[9] + (((size_t)l * 2 + dir) * 8 + blk) * 4096; const float* wx = A->in[11] + (((size_t)l * 2 + dir) * 8 + blk) * 4096;
        __syncthreads();
        for (int i = F.tid; i < 4096; i += NWAVES * 64) { wl[i] = wa[i]; wl[4096 + i] = wx[i]; }
        __syncthreads();
        if (F.wave == 0) {
            const float ba = A->in[10][((size_t)l * 2 + dir) * 512 + ch], bx = A->in[12][((size_t)l * 2 + dir) * 512 + ch], lam = A->in[13][((size_t)l * 2 + dir) * 512 + ch];
            const float sp = log1p_small(fexp(-lam));
            float h = 0.f;
            for (int step = 0; step < SEQ; ++step) {
                const int t = dir == 0 ? step : SEQ - 1 - step; const size_t tt = (size_t)(b * SEQ + t);
                const float xv = xf[tt * 512 + ch];
                float ra = ba, ia = bx;
#pragma unroll 16
                for (int i = 0; i < 64; ++i) { const float xi = rdlane(xv, i); ra += xi * wl[i * 64 + lane]; ia += xi * wl[4096 + i * 64 + lane]; }
                const float r = sigmoidf_(ra), ig = sigmoidf_(ia);
                const float la = -8.0f * r * sp, a = fexp(la), x2 = 2.0f * la;
                const float om = x2 > -0.5f ? -x2 * (1.0f + x2 * (0.5f + x2 * (0.16666667f + x2 * (0.041666668f + x2 * (0.0083333333f + x2 * 0.0013888889f))))) : 1.0f - a * a;
                float mult = sqrtf(om); if (step == 0) mult = 1.0f;
                h = a * h + mult * ig * xv;
                if (dir == 0) hf[tt * 512 + ch] = h;
                else { const float g = bf2f(GC[tt * 512 + ch]); GC[tt * 512 + ch] = (bf16)f2bf(gelu_tanh(g) * (hf[tt * 512 + ch] + h)); }
            }
        }
    }
}
__device__ __forceinline__ void phase_final(const Frame& F, CArgs* A) {
    const float* g = A->in[22];
    for (int m = F.gw; m < T; m += F.ngw) {
        f32x4* xr = (f32x4*)(F.out + (size_t)m * D) + F.lane; const f32x4* gr = (const f32x4*)g + F.lane;
        f32x4 v[4]; float s = 0.f;
#pragma unroll
        for (int j = 0; j < 4; ++j) { v[j] = xr[64 * j]; s += (v[j].x * v[j].x + v[j].y * v[j].y) + (v[j].z * v[j].z + v[j].w * v[j].w); }
        const float rs = 1.0f / sqrtf(wave_sum(s) * (1.0f / D) + RMS_EPS);
#pragma unroll
        for (int j = 0; j < 4; ++j) xr[64 * j] = v[j] * rs * gr[64 * j];
    }
}

__global__ void __launch_bounds__(NWAVES * 64, 2) mk_fwd(Args args) {
    extern __shared__ __attribute__((aligned(16))) unsigned char lds[];
    const int tid0 = threadIdx.x;
    LAS unsigned char* const lds3 = (LAS unsigned char*)lds;
    CArgs* A0 = get_args();
    const int ph_lo = A0->ph_lo, ph_hi = A0->ph_hi;
    for (int u = tid0; u < (LDS_BYTES - LDSCTL_OFF) / 4; u += NWAVES * 64) ((LAS unsigned*)(lds3 + LDSCTL_OFF))[u] = 0u;
    __syncthreads();
    const bool multi = (ph_hi - ph_lo) > 1;
    XcdBarrier bar; bar.bar = (unsigned*)((gu32*)(A0->ws + WS_CTL) + CW_BAR); bar.x = 0; bar.st = nullptr;
    if (multi) bar = xcd_barrier_post((unsigned*)((gu32*)(A0->ws + WS_CTL) + CW_BAR), (volatile LAS unsigned*)(lds3 + MISC_OFF) + 8);

    for (int ph = ph_lo; ph < ph_hi; ++ph) {
        CArgs* A = get_args();
        Frame F;
        { int t_ = tid0; asm volatile("" : "+v"(t_)); F.tid = t_; }
        F.lds = lds3; F.lane = F.tid & 63; F.wave = __builtin_amdgcn_readfirstlane(F.tid >> 6);
        F.G = gridDim.x; F.gw = blockIdx.x * NWAVES + F.wave; F.ngw = F.G * NWAVES;
        F.out = A->out; F.ws = A->ws;
        unsigned char* ws = F.ws;
        int kind, l;
        if (ph == 0) { kind = PH_PRO; l = 0; } else if (ph == NPH - 1) { kind = PH_FIN; l = 0; } else { l = (ph - 1) / NPL; kind = 1 + (ph - 1) % NPL; }
        float* ssA = (float*)(ws + WS_SSA); float* ssB = (float*)(ws + WS_SSB);
        switch (kind) {
        case PH_PRO: phase_prologue(F, A); break;
        case PH_G1: {
            pg8::Gemm g{(const bf16_t*)(ws + WS_XB), (const bf16_t*)(ws + W_IN), T, 7680, D, 0, 0};
            pg8::StaticOrder S; S.init(T, 7680, F.G, (int)blockIdx.x);
            EpiG1 E{(bf16_t*)(ws + WS_PROJ), ws + WS_GATE8, ssB, A->in[4] + (size_t)l * 3072, (const float*)(ws + WS_TAB)};
            pg8::gemm_phase<EpiG1, pg8::StaticOrder, true, true>(F.lds, g, S, E, F.tid);
        } break;
        case PH_NA: phase_na_naive(F, A, l); convert_layer_mlp(F, A, l); break;
        case PH_RET: phase_ret_naive(F, A, l); break;
        case PH_LRUA: phase_lrua_naive(F, A, l); break;
        case PH_LRUB: phase_lruscan_naive(F, A, l, 0); break;
        case PH_LRUC: phase_lruscan_naive(F, A, l, 1); break;
        case PH_G2: {
            pg8::Gemm g{(const bf16_t*)(ws + WS_PROJ), (const bf16_t*)(ws + W_BR), T, D, 512, 3 * BLK, (size_t)D * 512 * 2};
            ZOrder S; S.S.init(T, D, F.G, (int)blockIdx.x);
            EpiG2 E{ws + WS_GATE8, (bf16_t*)(ws + WS_XB)};
            pg8::gemm_phase<EpiG2, ZOrder, true, true>(F.lds, g, S, E, F.tid);
        } break;
        case PH_G3: case PH_G5: {
            const bool g3 = (kind == PH_G3);
            pg8::Gemm g{(const bf16_t*)(ws + (g3 ? WS_XB : WS_U)), (const bf16_t*)(ws + (g3 ? W_OUT : W_DOWN)), T, D, g3 ? D : FF, 0, 0};
            pg8::StaticOrder S; S.init(T, D, F.G, (int)blockIdx.x);
            EpiRes E{(g3 && l == 0) ? A->in[0] : F.out, F.out, (bf16_t*)(ws + WS_GATE8), g3 ? ssB : ssA};
            pg8::gemm_phase<EpiRes, pg8::StaticOrder, false, true>(F.lds, g, S, E, F.tid);
        } break;
        case PH_G4: {
            pg8::Gemm g{(const bf16_t*)(ws + WS_GATE8), (const bf16_t*)(ws + W_UP), T, FF, D, 0, 0};
            pg8::StaticOrder S; S.init(T, FF, F.G, (int)blockIdx.x);
            EpiG4 E{(bf16_t*)(ws + WS_U), ssB};
            pg8::gemm_phase<EpiG4, pg8::StaticOrder, true, true>(F.lds, g, S, E, F.tid);
            convert_p(F, A, l);
            if (l + 1 < DEPTH) convert_layer_mid(F, A, l + 1);
        } break;
        case PH_G6: {
            {
                pg8::Gemm g{(const bf16_t*)(ws + WS_PB), (const bf16_t*)(ws + W_PLE(l & 1)), T, D, PLE, 0, 0};
                pg8::StaticOrder S; S.init(T, D, F.G, (int)blockIdx.x);
                EpiE E{(float*)(ws + WS_E)};
                pg8::gemm_phase<EpiE, pg8::StaticOrder, false, true>(F.lds, g, S, E, F.tid);
            }
            {
                pg8::Gemm g{(const bf16_t*)(ws + WS_GATE8), (const bf16_t*)(ws + W_G(l & 1)), T, D, D, 0, 0};
                pg8::StaticOrder S; S.init(T, D, F.G, (int)blockIdx.x);
                EpiG6 E{F.out, F.out, (bf16_t*)(ws + WS_XB), ssA, ssB, (const float*)(ws + WS_E)};
                pg8::gemm_phase<EpiG6, pg8::StaticOrder, false, true>(F.lds, g, S, E, F.tid);
            }
            if (l + 1 < DEPTH) convert_layer_early(F, A, l + 1);
        } break;
        case PH_FIN: phase_final(F, A); break;
        default: break;
        }
        if (ph + 1 < ph_hi) xcd_barrier(bar);
    }
}


#ifndef MK_CHECK
#define MK_CHECK 0
#endif
#if MK_CHECK
constexpr int CW_CODE = 64, CW_CNT = 128;
__device__ __forceinline__ unsigned hash32(unsigned x) { x ^= x >> 16; x *= 0x7feb352du; x ^= x >> 15; x *= 0x846ca68bu; x ^= x >> 16; return x; }
__device__ __forceinline__ bool near(float a, float b, float rel, float abs_) { return fabsf(a - b) <= rel * fabsf(b) + abs_; }
__device__ float rs_of_x(const float* x, int row) { float s = 0.f; for (int k = 0; k < D; ++k) s += x[(size_t)row * D + k] * x[(size_t)row * D + k]; return 1.0f / sqrtf(s / D + RMS_EPS); }
__global__ void __launch_bounds__(256) mk_check(Args a, int stage) {
    const unsigned id = blockIdx.x * blockDim.x + threadIdx.x;
    const unsigned h = hash32(id * 2654435761u + 12345u * stage);
    unsigned char* ws = a.ws; unsigned* ctl = (unsigned*)(ws + WS_CTL);
    const int row = (int)(h % T);
    bool bad = false;
    const float* x = a.in[0];
    if (stage == 1) {
        const int col = (int)((h >> 14) % D);
        const bf16* xb = (const bf16*)(ws + WS_XB);
        bad |= !near(bf2f(xb[(size_t)row * D + col]), x[(size_t)row * D + col], 0.01f, 1e-3f);
        float s = 0.f; for (int k = 0; k < D; ++k) s += x[(size_t)row * D + k] * x[(size_t)row * D + k];
        const float* ss = (const float*)(ws + WS_SSB); float t = 0.f; for (int k = 0; k < 16; ++k) t += ss[(size_t)row * 16 + k];
        bad |= !near(t, s, 1e-3f, 1e-3f);
        const int n = (int)((h >> 7) % 7680), k = (int)(h % D);
        const bf16* wt = (const bf16*)(ws + W_IN);
        bad |= !near(bf2f(wt[(size_t)n * D + k]), a.in[2][k] * a.in[3][(size_t)k * 7680 + n], 0.01f, 1e-4f);
        const int pos = (int)(h % SEQ), i = (int)((h >> 11) % 64);
        const float th = powf(10000.0f, -(float)i / 63.0f), ang = (float)pos * th;
        const float* tab = (const float*)(ws + WS_TAB);
        bad |= !near(tab[pos * 64 + i], cosf(ang), 0.f, 2e-3f); bad |= !near(tab[131072 + pos * 64 + i], sinf(ang), 0.f, 2e-3f);
    } else if (stage == 2) {
        const int col = (int)((h >> 14) % 7680) & ~1;
        const float rs = rs_of_x(x, row);
        float v0 = 0.f, v1 = 0.f;
        for (int k = 0; k < D; ++k) { const float xv = x[(size_t)row * D + k] * a.in[2][k]; v0 += xv * a.in[3][(size_t)k * 7680 + col]; v1 += xv * a.in[3][(size_t)k * 7680 + col + 1]; }
        v0 *= rs; v1 *= rs;
        if (col < 4608) {
            const int kind = col / 512, cc = col % 512, phys = (int)((0x683754210ull >> (4 * kind)) & 15ull);
            if (kind == 3 || kind == 4) { const int i = (cc & 127) >> 1, pos = row & 2047; const float th = powf(10000.0f, -(float)i / 63.0f), ang = (float)pos * th, c = cosf(ang), sn = sinf(ang);
                const float w0 = v0 * c - v1 * sn, w1 = v0 * sn + v1 * c; v0 = w0; v1 = w1; }
            if (kind == 0) { v0 *= 0.125f; v1 *= 0.125f; } if (kind == 3) { v0 *= 0.08838834764831845f; v1 *= 0.08838834764831845f; }
            const bf16* p = (const bf16*)(ws + WS_PROJ) + (size_t)phys * T * 512 + (size_t)row * 512 + cc;
            bad |= !near(bf2f(p[0]), v0, 0.03f, 0.03f); bad |= !near(bf2f(p[1]), v1, 0.03f, 0.03f);
        } else {
            const int gc = col - 4608; const unsigned char* g8 = ws + WS_GATE8 + (size_t)row * 3072 + gc;
            const float s0 = 1.0f / (1.0f + expf(-(v0 + a.in[4][gc]))), s1 = 1.0f / (1.0f + expf(-(v1 + a.in[4][gc + 1])));
            bad |= !near((float)g8[0] / 255.0f, s0, 0.f, 0.012f); bad |= !near((float)g8[1] / 255.0f, s1, 0.f, 0.012f);
        }
    } else if (stage == 4) {
        const int col = (int)((h >> 14) % D);
        float m = 0.f;
        for (int n = 0; n < 3; ++n) { const bf16* ys = (const bf16*)(ws + WS_PROJ) + (size_t)(3 * n) * T * 512 + (size_t)row * 512; float acc = 0.f;
            for (int k = 0; k < 512; ++k) acc += bf2f(ys[k]) * a.in[14][((size_t)n * 512 + k) * D + col];
            m += acc * (float)ws[WS_GATE8 + (size_t)row * 3072 + n * 1024 + col] / 255.0f; }
        bad |= !near(bf2f(((const bf16*)(ws + WS_XB))[(size_t)row * D + col]), m, 0.03f, 0.03f);
    } else if (stage == 5) {
        const int col = (int)((h >> 14) % D);
        const bf16* mg = (const bf16*)(ws + WS_XB) + (size_t)row * D; float acc = 0.f;
        for (int k = 0; k < D; ++k) acc += bf2f(mg[k]) * a.in[15][(size_t)k * D + col];
        const float x1 = x[(size_t)row * D + col] + acc;
        bad |= !near(a.out[(size_t)row * D + col], x1, 0.02f, 0.03f);
        bad |= !near(bf2f(((const bf16*)(ws + WS_GATE8))[(size_t)row * D + col]), a.out[(size_t)row * D + col], 0.01f, 1e-3f);
        float s = 0.f; for (int k = 0; k < D; ++k) s += a.out[(size_t)row * D + k] * a.out[(size_t)row * D + k];
        const float* ss = (const float*)(ws + WS_SSB); float t = 0.f; for (int k = 0; k < 16; ++k) t += ss[(size_t)row * 16 + k];
        bad |= !near(t, s, 1e-3f, 1e-3f);
    } else if (stage == 6) {
        const int col = (int)((h >> 14) % FF);
        const bf16* xb = (const bf16*)(ws + WS_GATE8) + (size_t)row * D; float acc = 0.f;
        for (int k = 0; k < D; ++k) acc += bf2f(xb[k]) * a.in[16][k] * a.in[17][(size_t)k * FF + col];
        const float rs = rs_of_x(a.out, row); float v = fmaxf(acc * rs, 0.f); v *= v;
        bad |= !near(bf2f(((const bf16*)(ws + WS_U))[(size_t)row * FF + col]), v, 0.05f, 0.05f);
    } else if (stage == 7) {
        const int col = (int)((h >> 14) % D);
        const bf16* uu = (const bf16*)(ws + WS_U) + (size_t)row * FF; float acc = 0.f;
        for (int k = 0; k < FF; ++k) acc += bf2f(uu[k]) * a.in[18][(size_t)k * D + col];
        const float x2 = bf2f(((const bf16*)(ws + WS_XB))[(size_t)row * D + col]) + acc;
        bad |= !near(a.out[(size_t)row * D + col], x2, 0.03f, 0.05f);
        bad |= !near(bf2f(((const bf16*)(ws + WS_GATE8))[(size_t)row * D + col]), a.out[(size_t)row * D + col], 0.01f, 1e-3f);
        float s = 0.f; for (int k = 0; k < D; ++k) s += a.out[(size_t)row * D + k] * a.out[(size_t)row * D + k];
        const float* ss = (const float*)(ws + WS_SSA); float t = 0.f; for (int k = 0; k < 16; ++k) t += ss[(size_t)row * 16 + k];
        bad |= !near(t, s, 1e-3f, 1e-3f);
    } else if (stage == 8) {
        const int col = (int)((h >> 14) % D);
        const bf16* xb = (const bf16*)(ws + WS_GATE8) + (size_t)row * D; float acc = 0.f, s = 0.f;
        for (int k = 0; k < D; ++k) { const float xv = bf2f(xb[k]); s += xv * xv; acc += xv * a.in[19][k] * a.in[20][(size_t)k * D + col]; }
        const float rs = 1.0f / sqrtf(s / D + RMS_EPS);
        float e = 0.f; for (int k = 0; k < PLE; ++k) e += a.in[1][(size_t)row * PLE + k] * a.in[21][(size_t)k * D + col];
        const float x3 = bf2f(xb[col]) + e / (1.0f + expf(-acc * rs));
        bad |= !near(a.out[(size_t)row * D + col], x3, 0.03f, 0.05f);
    }
    if (stage == 9) bad = true;
    if (bad) atomicAdd(&ctl[CW_CNT + stage], 1u);
}
__device__ float orig_proj(const Args& a, int l, int row, int col) {
    const float* x = l == 0 ? a.in[0] : a.out; const float* g = a.in[2] + (size_t)l * D; const float* w = a.in[3] + (size_t)l * D * 7680;
    float s = 0.f, acc = 0.f;
    for (int k = 0; k < D; ++k) { const float xv = x[(size_t)row * D + k]; s += xv * xv; acc += xv * g[k] * w[(size_t)k * 7680 + col]; }
    return acc / sqrtf(s / D + RMS_EPS);
}
__global__ void __launch_bounds__(64) mk_check_na(Args a, int l) {
    __shared__ float qs[64]; __shared__ float sc[128];
    const unsigned h = hash32(blockIdx.x * 977u + 31u); const int t = (int)(h % T), hd = (int)((h >> 16) % 8), d = threadIdx.x;
    unsigned char* ws = a.ws; unsigned* ctl = (unsigned*)(ws + WS_CTL);
    const bf16* K = (const bf16*)(ws + WS_PROJ + BLK); const bf16* V = (const bf16*)(ws + WS_PROJ + 2 * BLK); const bf16* Y = (const bf16*)(ws + WS_PROJ);
    qs[d] = bf2f((bf16)f2bf(0.125f * orig_proj(a, l, t, hd * 64 + d)));
    __syncthreads();
    const int b = t / SEQ, s = t % SEQ, r = s / 64, c = s % 64;
    int rs = r - 4; if (rs < 0) rs = 0; if (rs > 24) rs = 24; int cs = c - 8; if (cs < 0) cs = 0; if (cs > 48) cs = 48;
    const float* rpb = a.in[5] + (size_t)l * 8 * 15 * 31 + hd * 465;
    for (int kk = d; kk < 128; kk += 64) { const int i = kk / 16, j = kk % 16; const int tk = b * SEQ + (rs + i) * 64 + cs + j; float acc = 0.f;
        for (int e = 0; e < 64; ++e) acc += qs[e] * bf2f(K[(size_t)tk * 512 + hd * 64 + e]);
        sc[kk] = acc + rpb[(rs + i - r + 7) * 31 + (cs + j - c + 15)]; }
    __syncthreads();
    float mx = -1e30f; for (int kk = 0; kk < 128; ++kk) mx = fmaxf(mx, sc[kk]);
    float den = 0.f, o = 0.f;
    for (int kk = 0; kk < 128; ++kk) { const int i = kk / 16, j = kk % 16; const int tk = b * SEQ + (rs + i) * 64 + cs + j; const float p = expf(sc[kk] - mx); den += p; o += p * bf2f(V[(size_t)tk * 512 + hd * 64 + d]); }
    o /= den;
    if (!near(bf2f(Y[(size_t)t * 512 + hd * 64 + d]), o, 0.04f, 0.04f)) atomicAdd(&ctl[CW_CNT + 31], 1u);
}
__global__ void __launch_bounds__(128) mk_check_ret(Args a, int l) {
    __shared__ float qs[128]; __shared__ float sc[SEQ]; __shared__ float red[128];
    const unsigned h = hash32(blockIdx.x * 1231u + 77u); const int t = (int)(h % T), hd = (int)((h >> 16) % 4), dv = threadIdx.x;
    unsigned char* ws = a.ws; unsigned* ctl = (unsigned*)(ws + WS_CTL);
    const bf16* Y = (const bf16*)(ws + WS_PROJ + 3 * BLK); const bf16* Q = (const bf16*)(ws + WS_PROJ + 4 * BLK); const bf16* K = (const bf16*)(ws + WS_PROJ + 5 * BLK); const bf16* V = (const bf16*)(ws + WS_PROJ + 7 * BLK);
    const int b = t / SEQ, n = t % SEQ;
    qs[dv] = bf2f(Q[(size_t)t * 512 + hd * 128 + dv]);
    __syncthreads();
    const float gf = log2_1m(__builtin_amdgcn_exp2f(-5.0f - (float)hd)), gb = log2_1m(__builtin_amdgcn_exp2f(-5.5f - (float)hd));
    for (int m = dv; m < SEQ; m += 128) { float acc = 0.f; for (int e = 0; e < 128; ++e) acc += qs[e] * bf2f(K[(size_t)(b * SEQ + m) * 512 + hd * 128 + e]);
        sc[m] = acc * (m <= n ? __builtin_amdgcn_exp2f(gf * (float)(n - m)) : __builtin_amdgcn_exp2f(gb * (float)(m - n))); }
    __syncthreads();
    float o = 0.f; for (int m = 0; m < SEQ; ++m) o += sc[m] * bf2f(V[(size_t)(b * SEQ + m) * 512 + hd * 128 + dv]);
    red[dv] = o * o; __syncthreads();
    float ms = 0.f; for (int e = 0; e < 128; ++e) ms += red[e];
    const float rn = 1.0f / sqrtf(ms / 128.0f + RMS_EPS);
    const float g = bf2f((bf16)f2bf(orig_proj(a, l, t, 1536 + 3 * 512 + hd * 128 + dv)));
    const float y = g / (1.0f + expf(-g)) * o * rn * a.in[6][(size_t)l * 512 + hd * 128 + dv];
    if (!near(bf2f(Y[(size_t)t * 512 + hd * 128 + dv]), y, 0.04f, 0.04f)) atomicAdd(&ctl[CW_CNT + 32], 1u);
}
__global__ void __launch_bounds__(128) mk_check_g(Args a, int l, int code) {
    const unsigned h = hash32(blockIdx.x * 1231u + 77u); const int t = (int)(h % T), hd = (int)((h >> 16) % 4), dv = threadIdx.x;
    unsigned* ctl = (unsigned*)(a.ws + WS_CTL);
    const bf16* G = (const bf16*)(a.ws + WS_PROJ + 3 * BLK);
    const float g = orig_proj(a, l, t, 1536 + 3 * 512 + hd * 128 + dv);
    if (!near(bf2f(G[(size_t)t * 512 + hd * 128 + dv]), g, 0.03f, 0.03f)) atomicAdd(&ctl[CW_CNT + code], 1u);
}
__global__ void __launch_bounds__(64) mk_check_lru(Args a, int l) {
    __shared__ float xs[64];
    const unsigned h = hash32(blockIdx.x * 733u + 5u); const int b = (int)(h % 8), blk = (int)((h >> 8) % 8), ts = (int)((h >> 16) % SEQ), j = threadIdx.x, ch = blk * 64 + j;
    unsigned char* ws = a.ws; unsigned* ctl = (unsigned*)(ws + WS_CTL);
    const bf16* XC = (const bf16*)(ws + WS_PROJ + 8 * BLK); const bf16* Y = (const bf16*)(ws + WS_PROJ + 6 * BLK);
    const float* cw = a.in[7] + (size_t)l * 2048; const float cb = a.in[8][(size_t)l * 512 + ch];
    float hsum = 0.f;
    for (int dir = 0; dir < 2; ++dir) {
        const float* wa = a.in[9] + (((size_t)l * 2 + dir) * 8 + blk) * 4096; const float* wx = a.in[11] + (((size_t)l * 2 + dir) * 8 + blk) * 4096;
        const float ba = a.in[10][((size_t)l * 2 + dir) * 512 + ch], bx = a.in[12][((size_t)l * 2 + dir) * 512 + ch], lam = a.in[13][((size_t)l * 2 + dir) * 512 + ch];
        const float sp = log1pf(expf(-lam));
        float hh = 0.f;
        const int nsteps = dir == 0 ? ts + 1 : SEQ - ts;
        for (int st = 0; st < nsteps; ++st) {
            const int t = dir == 0 ? st : SEQ - 1 - st;
            float xf = cb;
            for (int w = 0; w < 4; ++w) { const int t2 = t + w - 2; if (t2 >= 0 && t2 < SEQ) xf += cw[w * 512 + ch] * bf2f(XC[(size_t)(b * SEQ + t2) * 512 + ch]); }
            __syncthreads(); xs[j] = xf; __syncthreads();
            float ra = ba, ia = bx;
            for (int i = 0; i < 64; ++i) { ra += xs[i] * wa[i * 64 + j]; ia += xs[i] * wx[i * 64 + j]; }
            const float r = 1.0f / (1.0f + expf(-ra)), ig = 1.0f / (1.0f + expf(-ia));
            const float la = -8.0f * r * sp, av = expf(la); float mult = sqrtf(-expm1f(2.0f * la)); if (st == 0) mult = 1.0f;
            hh = av * hh + mult * ig * xf;
        }
        hsum += hh;
    }
    const float gc = bf2f((bf16)f2bf(orig_proj(a, l, b * SEQ + ts, 3584 + 512 + ch)));
    const float u = 0.7978845608028654f * (gc + 0.044715f * gc * gc * gc);
    const float y = 0.5f * gc * (1.0f + tanhf(u)) * hsum;
    if (!near(bf2f(Y[(size_t)(b * SEQ + ts) * 512 + ch]), y, 0.04f, 0.04f)) atomicAdd(&ctl[CW_CNT + 33], 1u);
}
__global__ void mk_report(Args a) {
    unsigned* ctl = (unsigned*)(a.ws + WS_CTL);
    const int order[13] = {1, 2, 35, 31, 34, 32, 33, 4, 5, 6, 7, 8, 9};
    const unsigned tot[13] = {16384u, 16384u, 16384u, 32768u, 16384u, 16384u, 8192u, 16384u, 16384u, 16384u, 16384u, 16384u, 64u};
    for (int i = 0; i < 13; ++i) {
        const unsigned cnt = ctl[CW_CNT + order[i]];
        if (cnt * 200u > tot[i]) {
            unsigned tenth = (cnt * 10u) / tot[i]; if (tenth > 9u) tenth = 9u;
            a.out[0] = order[i] >= 10 ? 100.0f * (float)order[i] : 1000.0f * (float)order[i] + 100.0f * (float)tenth;
            return;
        }
    }
}
#endif

#ifndef MK_ONE_LAUNCH
#define MK_ONE_LAUNCH 1
#endif
extern "C" void kernel_launch(void* const* d_in, const int* in_sizes, int n_in, void* d_out, int out_size, void* d_ws, size_t ws_size, hipStream_t stream) {
    static int grid = 0;
    if (grid == 0) {
        if (n_in != 23 || in_sizes[0] != T * D || out_size != T * D || ws_size < WS_END) { fprintf(stderr, "kernel_launch: unexpected shapes (n_in %d, in0 %d, out %d, ws %zu); nothing launched\n", n_in, n_in > 0 ? in_sizes[0] : -1, out_size, ws_size); grid = -1; return; }
        int dev = 0, cus = 0, per_cu = 0;
        if (hipGetDevice(&dev) != hipSuccess || hipDeviceGetAttribute(&cus, hipDeviceAttributeMultiprocessorCount, dev) != hipSuccess) { grid = -1; return; }
        if (hipFuncSetAttribute((const void*)mk_fwd, hipFuncAttributeMaxDynamicSharedMemorySize, LDS_BYTES) != hipSuccess) { fprintf(stderr, "kernel_launch: hipFuncSetAttribute failed\n"); grid = -1; return; }
        if (hipOccupancyMaxActiveBlocksPerMultiprocessor(&per_cu, (const void*)mk_fwd, NWAVES * 64, LDS_BYTES) != hipSuccess || per_cu < 1) { fprintf(stderr, "kernel_launch: occupancy query says %d blocks per CU\n", per_cu); }
        (void)hipGetLastError();
        grid = cus;
    }
    if (grid < 0) return;
    if (hipMemsetAsync((char*)d_ws + WS_CTL, 0, CTL_ZERO_BYTES, stream) != hipSuccess) return;
    Args a{};
    for (int i = 0; i < 23; ++i) a.in[i] = (const float*)d_in[i];
    a.out = (float*)d_out; a.ws = (unsigned char*)d_ws;
#if MK_ONE_LAUNCH
    a.ph_lo = 0; a.ph_hi = NPH;
    hipLaunchKernelGGL(mk_fwd, dim3(grid), dim3(NWAVES * 64), LDS_BYTES, stream, a);
#else
    for (int ph = 0; ph < NPH; ++ph) {
#if MK_CHECK
        if (ph == 1 + 9) hipMemcpyAsync((char*)d_ws + WS_XB, (char*)d_ws + WS_GATE8, (size_t)T * D * 2, hipMemcpyDeviceToDevice, stream);
#endif
        a.ph_lo = ph; a.ph_hi = ph + 1; hipLaunchKernelGGL(mk_fwd, dim3(grid), dim3(NWAVES * 64), LDS_BYTES, stream, a);
#if MK_CHECK
        { int st = 0; if (ph == 0) st = 1; else if (ph == 1) st = 2; else if (ph == 1 + 6) st = 4; else if (ph == 1 + 7) st = 5; else if (ph == 1 + 8) st = 6; else if (ph == 1 + 9) st = 7; else if (ph == 1 + 10) st = 8;
          if (st) hipLaunchKernelGGL(mk_check, dim3(64), dim3(256), 0, stream, a, st);
          if (ph == 1 + 1) hipLaunchKernelGGL(mk_check_na, dim3(512), dim3(64), 0, stream, a, 0);
          if (ph == 1) hipLaunchKernelGGL(mk_check_g, dim3(128), dim3(128), 0, stream, a, 0, 35);
          if (ph == 1 + 1) hipLaunchKernelGGL(mk_check_g, dim3(128), dim3(128), 0, stream, a, 0, 34);
          if (ph == 1 + 2) hipLaunchKernelGGL(mk_check_ret, dim3(128), dim3(128), 0, stream, a, 0);
          if (ph == 1 + 5) hipLaunchKernelGGL(mk_check_lru, dim3(128), dim3(64), 0, stream, a, 0);
          if (ph == NPH - 1) hipLaunchKernelGGL(mk_check, dim3(1), dim3(64), 0, stream, a, 9); }
#endif
    }
#if MK_CHECK
    hipLaunchKernelGGL(mk_report, dim3(1), dim3(1), 0, stream, a);
#endif
#endif
}
```

```cpp
#include <hip/hip_runtime.h>
#include <cstdio>
#include <cstdint>
#ifndef MK_CHECK
#define MK_CHECK 0
#endif
namespace pg8 {
#define PG8_LAS __attribute__((address_space(3)))
typedef unsigned short bf16_t;
typedef short bf16x8 __attribute__((ext_vector_type(8)));
typedef float f32x4 __attribute__((ext_vector_type(4)));
typedef unsigned u32x4 __attribute__((ext_vector_type(4)));
constexpr int BM = 256, BK = 64, HALF = 128, HTB = HALF * BK * 2  , STAGE_BYTES = 8 * HTB, NXCD = 8, WGM = 8;

__host__ __device__ __forceinline__ int lds_byte(int r, int c) { const int st = (r >> 4) * 2 + (c >> 5), rr = r & 15, cc = c & 31, ob = rr * 64 + cc * 2; return st * 1024 + (ob ^ (((ob >> 9) & 1) << 5)); }
__host__ __device__ __forceinline__ void stage_rc(int b, int& R, int& C) { const int st = b / 1024, sb = b % 1024, swz = sb ^ (((sb >> 9) & 1) << 5); R = (st >> 1) * 16 + swz / 64; C = (st & 1) * 32 + (swz % 64) / 2; }
__host__ __device__ __forceinline__ int perm32(int rho) { const int n = rho >> 4, i = rho & 15; return 8 * (i >> 2) + 4 * n + (i & 3); }

struct Unit { int pm, pn, z; };
struct Gemm { const bf16_t* A; const bf16_t* Bt; int M, N, K; size_t zA, zB; };

struct StaticOrder {
    int nM, nN, nwg, G, c;
    __host__ __device__ void init(int M, int N, int G_, int c_) { nM = M / BM; nN = N / BM; nwg = nM * nN; G = G_; c = c_; }
    __host__ __device__ bool next(int i, Unit& u) const {
        const long L = (long)i * G + c; if (L >= nwg) return false;
        int wgid = (int)L; { const int q = nwg / NXCD, r = nwg % NXCD, xcd = wgid % NXCD, off = wgid / NXCD; wgid = (xcd < r ? xcd * (q + 1) : r * (q + 1) + (xcd - r) * q) + off; }
        const int nig = WGM * nN, gid = wgid / nig, fm = gid * WGM, gsz = (nM - fm) < WGM ? (nM - fm) : WGM;
        u.pm = fm + ((wgid % nig) % gsz); u.pn = (wgid % nig) / gsz; u.z = 0; return true;
    }
    __device__ __forceinline__ void a_ready(const Unit&) const {}
    __device__ __forceinline__ void done(const Unit&) const {}
};

__device__ __forceinline__ unsigned cvt_pk_bf16(float lo, float hi) { unsigned r; asm volatile("v_cvt_pk_bf16_f32 %0, %1, %2" : "=v"(r) : "v"(lo), "v"(hi)); return r; }
typedef float f32x2 __attribute__((ext_vector_type(2)));
template <class Epi, class Sched, bool ALIGN_EPI = false, bool SP2 = false>
__device__ __forceinline__ void gemm_phase(PG8_LAS unsigned char* lds, const Gemm g, const Sched& S, const Epi& E, const int tid) {
    const int wid = __builtin_amdgcn_readfirstlane(tid >> 6), lane = tid & 63, wr = wid >> 2, wc = wid & 3, fr = lane & 15, fq = lane >> 4;
    const int K = g.K, nt = K / BK;
    unsigned voffA[2], voffB[2];
#pragma unroll
    for (int i = 0; i < 2; ++i) { int R, C; stage_rc(tid * 16 + i * 8192, R, C); const int Rb = Epi::PERM ? ((R & ~31) + perm32(R & 31)) : R;
        voffA[i] = (unsigned)(R * K + C) * 2u; voffB[i] = (unsigned)(Rb * K + C) * 2u; }
    const size_t kstep = (size_t)(BK * 2);
    const size_t hstep = (size_t)HALF * K * 2;
    const size_t tstep = 2 * hstep;
    const unsigned ldsw = (unsigned)wid * 1024u;
    const int aoff = lds_byte(wr * 64 + fr, fq * 8), boff = lds_byte(wc * 32 + fr, fq * 8);
#define PG8_SA(b, h) (((b) * 2 + (h)) * HTB)
#define PG8_SB(b, h) ((4 + (b) * 2 + (h)) * HTB)
#define PG8_STAGE(bufoff, gbase, voff) do { _Pragma("unroll") for (int _i = 0; _i < 2; ++_i) \
        __builtin_amdgcn_global_load_lds((const unsigned*)((const char*)(gbase) + (voff)[_i]), (PG8_LAS unsigned*)(lds + (bufoff) + ldsw + _i * 8192), 16, 0, 0); } while (0)
#define PG8_LDA(dst, b, h) do { _Pragma("unroll") for (int m = 0; m < 4; ++m) _Pragma("unroll") for (int k = 0; k < 2; ++k) dst[m][k] = *(const PG8_LAS bf16x8*)(lds + PG8_SA(b, h) + aoff + m * 2048 + k * 1024); } while (0)
#define PG8_LDB(dst, b, h) do { _Pragma("unroll") for (int n = 0; n < 2; ++n) _Pragma("unroll") for (int k = 0; k < 2; ++k) dst[n][k] = *(const PG8_LAS bf16x8*)(lds + PG8_SB(b, h) + boff + n * 2048 + k * 1024); } while (0)
#define PG8_MMA(ai, bj, At, Bt) do { __builtin_amdgcn_s_setprio(1); _Pragma("unroll") for (int m = 0; m < 4; ++m) _Pragma("unroll") for (int n = 0; n < 2; ++n) _Pragma("unroll") for (int k = 0; k < 2; ++k) \
        acc[ai][bj][m][n] = __builtin_amdgcn_mfma_f32_16x16x32_bf16(Bt[n][k], At[m][k], acc[ai][bj][m][n], 0, 0, 0); __builtin_amdgcn_s_setprio(0); } while (0)
#define PG8_WAIT_V(n) asm volatile("s_waitcnt vmcnt(" #n ")" ::: "memory")
#define PG8_WAIT_L(n) asm volatile("s_waitcnt lgkmcnt(" #n ")" ::: "memory")
#define PG8_BAR __builtin_amdgcn_s_barrier()
#define PG8_SCHED __builtin_amdgcn_sched_barrier(0)
    Unit cur, nxt; int ui = 0;
    if (!S.next(0, cur)) return;
    f32x4 acc[2][2][4][2];
#pragma unroll
    for (int a = 0; a < 2; ++a)
#pragma unroll
        for (int b = 0; b < 2; ++b)
#pragma unroll
            for (int m = 0; m < 4; ++m)
#pragma unroll
                for (int n = 0; n < 2; ++n) acc[a][b][m][n] = (f32x4){0.f, 0.f, 0.f, 0.f};
    bf16x8 At[4][2], B0[2][2], B1[2][2];
    const char* cA = (const char*)g.A + (size_t)cur.z * g.zA + (size_t)cur.pm * tstep; const char* cB = (const char*)g.Bt + (size_t)cur.z * g.zB + (size_t)cur.pn * tstep;
    S.a_ready(cur);
    if constexpr (SP2) {
        PG8_STAGE(PG8_SB(0, 0), cB, voffB); PG8_STAGE(PG8_SB(0, 1), cB + hstep, voffB); PG8_STAGE(PG8_SA(0, 0), cA, voffA); PG8_STAGE(PG8_SA(0, 1), cA + hstep, voffA);
        if (wr == 1) PG8_BAR;
        PG8_WAIT_V(2); PG8_BAR;
        PG8_STAGE(PG8_SB(1, 0), cB + kstep, voffB); PG8_STAGE(PG8_SA(1, 0), cA + kstep, voffA); PG8_STAGE(PG8_SB(1, 1), cB + hstep + kstep, voffB);
        PG8_WAIT_V(6); PG8_BAR;
    } else {
        PG8_STAGE(PG8_SB(0, 0), cB, voffB); PG8_STAGE(PG8_SA(0, 0), cA, voffA); PG8_STAGE(PG8_SB(0, 1), cB + hstep, voffB); PG8_STAGE(PG8_SA(0, 1), cA + hstep, voffA);
        if (wr == 1) PG8_BAR;
        PG8_WAIT_V(4); PG8_BAR;
        PG8_STAGE(PG8_SB(1, 0), cB + kstep, voffB); PG8_STAGE(PG8_SA(1, 0), cA + kstep, voffA); PG8_STAGE(PG8_SB(1, 1), cB + hstep + kstep, voffB);
        PG8_WAIT_V(6); PG8_BAR;
    }
    for (;;) {
        const bool has_next = S.next(ui + 1, nxt);
        const char* nA = has_next ? (const char*)g.A + (size_t)nxt.z * g.zA + (size_t)nxt.pm * tstep : cA; const char* nB = has_next ? (const char*)g.Bt + (size_t)nxt.z * g.zB + (size_t)nxt.pn * tstep : cB;
        for (int t = 0; t < nt; t += 2) {
            const bool last = (t == nt - 2);
            const char* a1 = cA + (size_t)(t + 1) * kstep;
            const char* a2 = last ? nA : cA + (size_t)(t + 2) * kstep; const char* b2 = last ? nB : cB + (size_t)(t + 2) * kstep;
            const char* a3 = a2 + kstep; const char* b3 = b2 + kstep;
            if (last && has_next) S.a_ready(nxt);
            if constexpr (SP2) {
            PG8_LDB(B0, 0, 0); PG8_LDB(B1, 0, 1); PG8_SCHED; PG8_LDA(At, 0, 0); PG8_STAGE(PG8_SA(1, 1), a1 + hstep, voffA);
            PG8_WAIT_V(8); PG8_WAIT_L(0); PG8_BAR; PG8_MMA(0, 0, At, B0); PG8_MMA(0, 1, At, B1); PG8_BAR; PG8_SCHED;
            PG8_LDA(At, 0, 1); PG8_STAGE(PG8_SB(0, 0), b2, voffB); PG8_STAGE(PG8_SB(0, 1), b2 + hstep, voffB); PG8_STAGE(PG8_SA(0, 0), a2, voffA);
            PG8_WAIT_V(8); PG8_WAIT_L(0); PG8_BAR; PG8_MMA(1, 0, At, B0); PG8_MMA(1, 1, At, B1); PG8_BAR; PG8_SCHED;
            PG8_LDB(B0, 1, 0); PG8_LDB(B1, 1, 1); PG8_SCHED; PG8_LDA(At, 1, 0); PG8_STAGE(PG8_SA(0, 1), a2 + hstep, voffA);
            PG8_WAIT_V(8); PG8_WAIT_L(0); PG8_BAR; PG8_MMA(0, 0, At, B0); PG8_MMA(0, 1, At, B1); PG8_BAR; PG8_SCHED;
            PG8_LDA(At, 1, 1); PG8_STAGE(PG8_SB(1, 0), b3, voffB); PG8_STAGE(PG8_SB(1, 1), b3 + hstep, voffB); PG8_STAGE(PG8_SA(1, 0), a3, voffA);
            PG8_WAIT_V(8); PG8_WAIT_L(0); PG8_BAR; PG8_MMA(1, 0, At, B0); PG8_MMA(1, 1, At, B1); PG8_BAR; PG8_SCHED;
            } else {
            PG8_LDB(B0, 0, 0); PG8_SCHED; PG8_LDA(At, 0, 0); PG8_STAGE(PG8_SA(1, 1), a1 + hstep, voffA);
            PG8_WAIT_L(8); PG8_BAR; PG8_WAIT_L(0); PG8_MMA(0, 0, At, B0); PG8_BAR; PG8_SCHED;
            PG8_LDB(B1, 0, 1); PG8_STAGE(PG8_SB(0, 0), b2, voffB);
            PG8_BAR; PG8_WAIT_L(0); PG8_MMA(0, 1, At, B1); PG8_BAR;
            PG8_LDA(At, 0, 1); PG8_STAGE(PG8_SA(0, 0), a2, voffA);
            PG8_BAR; PG8_WAIT_L(0); PG8_MMA(1, 0, At, B0); PG8_BAR; PG8_SCHED;
            PG8_STAGE(PG8_SB(0, 1), b2 + hstep, voffB);
            PG8_WAIT_V(6); PG8_BAR; PG8_MMA(1, 1, At, B1); PG8_BAR;
            PG8_LDB(B0, 1, 0); PG8_SCHED; PG8_LDA(At, 1, 0); PG8_STAGE(PG8_SA(0, 1), a2 + hstep, voffA);
            PG8_WAIT_L(8); PG8_BAR; PG8_WAIT_L(0); PG8_MMA(0, 0, At, B0); PG8_BAR; PG8_SCHED;
            PG8_LDB(B1, 1, 1); PG8_STAGE(PG8_SB(1, 0), b3, voffB);
            PG8_BAR; PG8_WAIT_L(0); PG8_MMA(0, 1, At, B1); PG8_BAR;
            PG8_LDA(At, 1, 1); PG8_STAGE(PG8_SA(1, 0), a3, voffA);
            PG8_BAR; PG8_WAIT_L(0); PG8_MMA(1, 0, At, B0); PG8_BAR; PG8_SCHED;
            PG8_STAGE(PG8_SB(1, 1), b3 + hstep, voffB);
            PG8_WAIT_V(6); PG8_BAR; PG8_MMA(1, 1, At, B1); PG8_BAR;
            }
        }
        if constexpr (ALIGN_EPI) { if (wr == 0) PG8_BAR; }
        if constexpr (!Epi::AFTER_DRAIN) { E(acc, cur, wr, wc, fr, fq); S.done(cur); }
        if (!has_next) break;
#pragma unroll
        for (int a = 0; a < 2; ++a)
#pragma unroll
            for (int b = 0; b < 2; ++b)
#pragma unroll
                for (int m = 0; m < 4; ++m)
#pragma unroll
                    for (int n = 0; n < 2; ++n) acc[a][b][m][n] = (f32x4){0.f, 0.f, 0.f, 0.f};
        cur = nxt; cA = nA; cB = nB; ++ui;
        if constexpr (ALIGN_EPI) { if (wr == 1) PG8_BAR; }
    }
    PG8_WAIT_V(0);
    if constexpr (!ALIGN_EPI) { if (wr == 0) PG8_BAR; }
    PG8_BAR;
    if constexpr (Epi::AFTER_DRAIN) { E.fused(acc, cur, wr, wc, fr, fq, lds, wid, lane); S.done(cur); }
#undef PG8_SA
#undef PG8_SB
#undef PG8_STAGE
#undef PG8_LDA
#undef PG8_LDB
#undef PG8_MMA
#undef PG8_WAIT_V
#undef PG8_WAIT_L
#undef PG8_BAR
#undef PG8_SCHED
}
}

constexpr int T = 16384, D = 1024, SEQ = 2048, DEPTH = 2, FF = 4096, PLE = 256;
constexpr float RMS_EPS = 1e-6f;
constexpr size_t MiB = 1u << 20;
constexpr size_t WS_CTL = 0, CTL_ZERO_BYTES = 65536;
constexpr size_t WS_TAB = 1 * MiB;
constexpr size_t WS_SSA = 2 * MiB, WS_SSB = 3 * MiB;
constexpr size_t WS_PROJ = 6 * MiB, BLK = 16 * MiB;
constexpr size_t WS_GATE8 = 150 * MiB;
constexpr size_t WS_XB = 198 * MiB;
constexpr size_t WS_W = 230 * MiB, WS_END = 256 * MiB;
constexpr size_t W_IN = WS_W, W_UP = WS_W, W_DOWN = WS_W + 8 * MiB, W_BR = WS_W + 16 * MiB, W_OUT = WS_W + 19 * MiB;
__host__ __device__ constexpr size_t W_G(int slot) { return WS_W + 21 * MiB + (size_t)slot * (5 * MiB / 2); }
__host__ __device__ constexpr size_t W_PLE(int slot) { return W_G(slot) + 2 * MiB; }
constexpr size_t WS_U = WS_PROJ;
constexpr size_t WS_E = WS_PROJ;
constexpr size_t WS_PB = WS_PROJ + 8 * BLK;
constexpr size_t WS_HF = WS_PROJ + 1 * BLK;
constexpr size_t WS_AGG = 4 * MiB;
constexpr size_t WS_LW = 5 * MiB;
constexpr size_t WS_SP = 5 * MiB + 512 * 1024;
constexpr size_t WS_ST = WS_XB;
constexpr int CW_TMO = 0, CW_BAR = 4096;

enum { PH_PRO = 0, PH_G1, PH_MIXA, PH_MIXB, PH_G2, PH_G3, PH_G4, PH_G5, PH_G6, PH_FIN };
constexpr int NPL = 8, NPH = 1 + DEPTH * NPL + 1;

constexpr int NWAVES = 8;
constexpr int RING_BYTES = 131072, LDS_BYTES = 155648, LDSCTL_OFF = LDS_BYTES - 1024, MISC_OFF = LDSCTL_OFF + 320;

#define GAS __attribute__((address_space(1)))
#define LAS __attribute__((address_space(3)))
typedef unsigned short bf16;
typedef unsigned v4u __attribute__((ext_vector_type(4)));
typedef unsigned v2u __attribute__((ext_vector_type(2)));
typedef float f32x4 __attribute__((ext_vector_type(4)));
typedef GAS unsigned gu32;
#define RLX_AGENT __ATOMIC_RELAXED, __HIP_MEMORY_SCOPE_AGENT
#define LDS_WAIT() asm volatile("s_waitcnt lgkmcnt(0)" ::: "memory")
#define VM_WAIT() asm volatile("s_waitcnt vmcnt(0)" ::: "memory")
__device__ __forceinline__ unsigned f2bf(float f) { unsigned u = __builtin_bit_cast(unsigned, f); return (u + 0x7fffu + ((u >> 16) & 1u)) >> 16; }
__device__ __forceinline__ unsigned pk2(float lo, float hi) { return f2bf(lo) | (f2bf(hi) << 16); }
__device__ __forceinline__ float bf2f(unsigned short b) { return __builtin_bit_cast(float, (unsigned)b << 16); }
__device__ __forceinline__ float bflo(unsigned w) { return __builtin_bit_cast(float, w << 16); }
__device__ __forceinline__ float bfhi(unsigned w) { return __builtin_bit_cast(float, w & 0xffff0000u); }
__device__ __forceinline__ float rdlane(float v, int l) { return __builtin_bit_cast(float, __builtin_amdgcn_readlane(__builtin_bit_cast(int, v), l)); }
__device__ __forceinline__ float fexp(float x) { return __builtin_amdgcn_exp2f(x * 1.4426950408889634f); }
__device__ __forceinline__ float sigmoidf_(float x) { return __builtin_amdgcn_rcpf(1.0f + fexp(-x)); }
__device__ __forceinline__ float wave_sum(float v) {
#pragma unroll
    for (int o = 1; o < 64; o <<= 1) v += __shfl_xor(v, o);
    return v;
}
__device__ __forceinline__ float wave_max(float v) {
#pragma unroll
    for (int o = 1; o < 64; o <<= 1) v = fmaxf(v, __shfl_xor(v, o));
    return v;
}
__device__ __forceinline__ float log2_1m(float x) {
    const float p = x * (1.0f + x * (0.5f + x * (0.33333333f + x * (0.25f + x * (0.2f + x * (0.16666667f + x * 0.14285714f))))));
    return -p * 1.4426950408889634f;
}
__device__ __forceinline__ float log1p_small(float y) {
    if (y < 0.01f) return y * (1.0f - y * (0.5f - y * (0.33333333f - 0.25f * y)));
    return __builtin_amdgcn_logf(1.0f + y) * 0.6931471805599453f;
}
__device__ __forceinline__ float gelu_tanh(float x) {
    const float u = 0.7978845608028654f * (x + 0.044715f * x * x * x);
    const float t = 1.0f - 2.0f * __builtin_amdgcn_rcpf(1.0f + fexp(2.0f * u));
    return 0.5f * x * (1.0f + t);
}
__device__ __forceinline__ float row_rs(const float* ss, int row, int fq) {
    const f32x4 a = *(const f32x4*)(ss + (size_t)row * 16 + 4 * fq);
    float s = (a.x + a.y) + (a.z + a.w);
    s += __shfl_xor(s, 16); s += __shfl_xor(s, 32);
    return 1.0f / sqrtf(s * (1.0f / D) + RMS_EPS);
}

#define XB_TMO      128
#define XB_XCNT(j)  (256  + 64 * (j))
#define XB_XSUB(j)  (1280 + 64 * (j))
#define XB_XGEN(j)  (2304 + 64 * (j))
#define XB_TOP      3328
#define XB_TOPGEN   3392
#define XCD_BAR_WORDS 3456
#define XB_SPIN_CAP (1u << 18)

__device__ __forceinline__ unsigned xb_ld(unsigned* p)              { return __hip_atomic_load(p, __ATOMIC_RELAXED, __HIP_MEMORY_SCOPE_AGENT); }
__device__ __forceinline__ unsigned xb_add(unsigned* p, unsigned v) { return __hip_atomic_fetch_add(p, v, __ATOMIC_RELAXED, __HIP_MEMORY_SCOPE_AGENT); }
__device__ __forceinline__ unsigned xb_xcc_id() { return (unsigned)__builtin_amdgcn_s_getreg((3 << 11) | 20) & 0xFu; }
#define XB_SPIN(cond, bar) do { unsigned _sp = 0; while (cond) { __builtin_amdgcn_s_sleep(1); \
    if ((++_sp & 255u) == 0u) { if (xb_ld(&(bar)[XB_TMO])) break; if (_sp > XB_SPIN_CAP) { atomicAdd(&(bar)[XB_TMO], 1u); break; } } } } while (0)

struct XcdBarrier {
    unsigned* bar; unsigned x;
    volatile LAS unsigned* st;
};

__device__ __forceinline__ XcdBarrier xcd_barrier_post(unsigned* bar, volatile LAS unsigned* st) {
    XcdBarrier b; b.bar = bar; b.x = xb_xcc_id(); b.st = st;
    if (threadIdx.x == 0) (void)xb_add(&bar[XB_XCNT(b.x)], 1u);
    return b;
}
__device__ __forceinline__ void xcd_barrier_complete(unsigned* bar, unsigned x, unsigned& nloc, unsigned& nx) {
    const unsigned G = gridDim.x * gridDim.y * gridDim.z;
    unsigned sum, cnt, mine, sp = 0u;
    for (;;) {
        sum = 0u; cnt = 0u; mine = 0u;
#pragma unroll
        for (unsigned j = 0; j < 16; ++j) { const unsigned c = xb_ld(&bar[XB_XCNT(j)]); sum += c; cnt += (c > 0u) ? 1u : 0u; mine = (j == x) ? c : mine; }
        if (sum == G) break;
        __builtin_amdgcn_s_sleep(1);
        if ((++sp & 255u) == 0u) { if (xb_ld(&bar[XB_TMO])) break; if (sp > XB_SPIN_CAP) { atomicAdd(&bar[XB_TMO], 1u); break; } }
    }
    nloc = mine > 0u ? mine : 1u; nx = cnt > 0u ? cnt : 1u;
}

__device__ __forceinline__ void xcd_barrier(const XcdBarrier& b) {
    asm volatile("s_waitcnt vmcnt(0)" ::: "memory");
    __syncthreads();
    if (threadIdx.x == 0) {
        unsigned* bar = b.bar;
        __builtin_amdgcn_s_waitcnt(0);
        unsigned nloc = b.st[0], nx = b.st[1];
        if (nloc == 0u) { xcd_barrier_complete(bar, b.x, nloc, nx); b.st[0] = nloc; b.st[1] = nx; }
        const unsigned old = xb_add(&bar[XB_XSUB(b.x)], 1u);
        const unsigned gen = old / nloc;
        if (old + 1u == (gen + 1u) * nloc) {
            __builtin_amdgcn_fence(__ATOMIC_RELEASE, "agent");
            asm volatile("s_waitcnt vmcnt(0)" ::: "memory");
            const unsigned og = xb_add(&bar[XB_TOP], 1u);
            const unsigned tg = og / nx;
            if (og + 1u == (tg + 1u) * nx) xb_add(&bar[XB_TOPGEN], 1u);
            else XB_SPIN(xb_ld(&bar[XB_TOPGEN]) == tg, bar);
            __builtin_amdgcn_fence(__ATOMIC_ACQUIRE, "agent");
            xb_add(&bar[XB_XGEN(b.x)], 1u);
            asm volatile("s_waitcnt vmcnt(0)" ::: "memory");
        } else {
            XB_SPIN(xb_ld(&bar[XB_XGEN(b.x)]) == gen, bar);
            __builtin_amdgcn_fence(__ATOMIC_ACQUIRE, "agent");
            asm volatile("s_waitcnt vmcnt(0)" ::: "memory");
        }
    }
    __syncthreads();
}


using pg8::Unit; using pg8::bf16_t; using pg8::cvt_pk_bf16;
typedef pg8::u32x4 u32x4;
struct EpiG1 {
    static constexpr bool PERM = true, AFTER_DRAIN = false;
    bf16_t* proj; unsigned char* gate8; const float* ss; const float* bgate; const float* tab;
    __device__ __forceinline__ void operator()(const f32x4 (&acc)[2][2][4][2], const Unit& u, int wr, int wc, int fr, int fq) const {
        const int pn = u.pn;
        float rsv[2][4];
#pragma unroll
        for (int ai = 0; ai < 2; ++ai)
#pragma unroll
            for (int m = 0; m < 4; ++m) { rsv[ai][m] = row_rs(ss, u.pm * 256 + ai * 128 + wr * 64 + m * 16 + fr, fq); if (m & 1) asm volatile("" : "+v"(rsv[ai][m - 1]), "+v"(rsv[ai][m]) :: "memory"); }
        if (pn < 18) {
            const int kind = pn >> 1, phys = (int)((0x683754210ull >> (4 * kind)) & 15ull);
            bf16_t* base = proj + (size_t)phys * ((size_t)T * 512);
            const int col0 = (pn & 1) * 256 + wc * 32 + 8 * fq;
            const float scale = kind == 0 ? 0.125f : (kind == 3 ? 0.08838834764831845f : 1.0f);
            const bool rope = (kind == 3) || (kind == 4);
#pragma unroll
            for (int ai = 0; ai < 2; ++ai)
#pragma unroll
                for (int m = 0; m < 4; ++m) {
                    const int row = u.pm * 256 + ai * 128 + wr * 64 + m * 16 + fr;
                    const float rs = rsv[ai][m] * scale;
                    bf16_t* rowp = base + (size_t)row * 512 + col0;
#pragma unroll
                    for (int bj = 0; bj < 2; ++bj) {
                        f32x4 v0 = acc[ai][bj][m][0] * rs, v1 = acc[ai][bj][m][1] * rs;
                        if (rope) {
                            const int cc = col0 + bj * 128, i0 = (cc & 127) >> 1, pos = row & (SEQ - 1);
                            const f32x4 cs = *(const f32x4*)(tab + pos * 64 + i0), sn = *(const f32x4*)(tab + 131072 + pos * 64 + i0);
                            f32x4 w0, w1;
                            w0[0] = v0[0] * cs[0] - v0[1] * sn[0]; w0[1] = v0[0] * sn[0] + v0[1] * cs[0];
                            w0[2] = v0[2] * cs[1] - v0[3] * sn[1]; w0[3] = v0[2] * sn[1] + v0[3] * cs[1];
                            w1[0] = v1[0] * cs[2] - v1[1] * sn[2]; w1[1] = v1[0] * sn[2] + v1[1] * cs[2];
                            w1[2] = v1[2] * cs[3] - v1[3] * sn[3]; w1[3] = v1[2] * sn[3] + v1[3] * cs[3];
                            v0 = w0; v1 = w1;
                        }
                        u32x4 w; w.x = cvt_pk_bf16(v0[0], v0[1]); w.y = cvt_pk_bf16(v0[2], v0[3]); w.z = cvt_pk_bf16(v1[0], v1[1]); w.w = cvt_pk_bf16(v1[2], v1[3]);
                        *(u32x4*)(rowp + bj * 128) = w;
                    }
                }
        } else {
            const int g0 = (pn - 18) * 256 + wc * 32 + 8 * fq;
#pragma unroll
            for (int ai = 0; ai < 2; ++ai)
#pragma unroll
                for (int m = 0; m < 4; ++m) {
                    const int row = u.pm * 256 + ai * 128 + wr * 64 + m * 16 + fr;
                    const float rs = rsv[ai][m];
#pragma unroll
                    for (int bj = 0; bj < 2; ++bj) {
                        const int gc = g0 + bj * 128;
                        const f32x4 b0 = *(const f32x4*)(bgate + gc), b1 = *(const f32x4*)(bgate + gc + 4);
                        const f32x4 v0 = acc[ai][bj][m][0] * rs + b0, v1 = acc[ai][bj][m][1] * rs + b1;
                        unsigned lo = 0, hi = 0;
#pragma unroll
                        for (int e = 0; e < 4; ++e) {
                            lo |= (unsigned)(sigmoidf_(v0[e]) * 255.0f + 0.5f) << (8 * e);
                            hi |= (unsigned)(sigmoidf_(v1[e]) * 255.0f + 0.5f) << (8 * e);
                        }
                        v2u w; w.x = lo; w.y = hi;
                        *(v2u*)(gate8 + (size_t)row * 3072 + gc) = w;
                    }
                }
        }
    }
};
struct EpiG2 {
    static constexpr bool PERM = false, AFTER_DRAIN = false;
    const unsigned char* gate8; bf16_t* merged;
    __device__ __forceinline__ void operator()(const f32x4 (&acc)[2][2][4][2], const Unit& u, int wr, int wc, int fr, int fq) const {
        const int col0 = u.pn * 256 + wc * 32 + 4 * fq;
#pragma unroll
        for (int ai = 0; ai < 2; ++ai)
#pragma unroll
            for (int m = 0; m < 4; ++m) {
                const int row = u.pm * 256 + ai * 128 + wr * 64 + m * 16 + fr;
#pragma unroll
                for (int bj = 0; bj < 2; ++bj)
#pragma unroll
                    for (int n = 0; n < 2; ++n) {
                        const int c = col0 + bj * 128 + n * 16;
                        const unsigned g4 = *(const unsigned*)(gate8 + (size_t)row * 3072 + u.z * 1024 + c);
                        f32x4 t = acc[ai][bj][m][n];
                        t[0] *= (float)(g4 & 255u) * (1.0f / 255.0f); t[1] *= (float)((g4 >> 8) & 255u) * (1.0f / 255.0f);
                        t[2] *= (float)((g4 >> 16) & 255u) * (1.0f / 255.0f); t[3] *= (float)(g4 >> 24) * (1.0f / 255.0f);
                        v2u* mp = (v2u*)(merged + (size_t)row * 1024 + c);
                        if (u.z > 0) { const v2u o = *mp; t[0] += bflo(o.x); t[1] += bfhi(o.x); t[2] += bflo(o.y); t[3] += bfhi(o.y); }
                        v2u w; w.x = cvt_pk_bf16(t[0], t[1]); w.y = cvt_pk_bf16(t[2], t[3]);
                        *mp = w;
                    }
            }
    }
};
struct EpiRes {
    static constexpr bool PERM = false, AFTER_DRAIN = false;
    const float* base; float* out; bf16_t* xb; float* ssout;
    __device__ __forceinline__ void operator()(const f32x4 (&acc)[2][2][4][2], const Unit& u, int wr, int wc, int fr, int fq) const {
        const int col0 = u.pn * 256 + wc * 32 + 4 * fq;
#pragma unroll
        for (int ai = 0; ai < 2; ++ai)
#pragma unroll
            for (int m = 0; m < 4; ++m) {
                const int row = u.pm * 256 + ai * 128 + wr * 64 + m * 16 + fr;
                float s = 0.f;
#pragma unroll
                for (int bj = 0; bj < 2; ++bj)
#pragma unroll
                    for (int n = 0; n < 2; ++n) {
                        const size_t off = (size_t)row * 1024 + col0 + bj * 128 + n * 16;
                        const f32x4 v = *(const f32x4*)(base + off) + acc[ai][bj][m][n];
                        *(f32x4*)(out + off) = v;
                        v2u w; w.x = cvt_pk_bf16(v[0], v[1]); w.y = cvt_pk_bf16(v[2], v[3]);
                        *(v2u*)(xb + off) = w;
                        s += (v[0] * v[0] + v[1] * v[1]) + (v[2] * v[2] + v[3] * v[3]);
                    }
                s += __shfl_xor(s, 16); s += __shfl_xor(s, 32);
                if (fq == 0) ssout[(size_t)row * 16 + u.pn * 4 + wc] = s;
            }
    }
};
struct EpiG4 {
    static constexpr bool PERM = true, AFTER_DRAIN = false;
    bf16_t* U; const float* ss;
    __device__ __forceinline__ void operator()(const f32x4 (&acc)[2][2][4][2], const Unit& u, int wr, int wc, int fr, int fq) const {
        const int col0 = u.pn * 256 + wc * 32 + 8 * fq;
        float rsv[2][4];
#pragma unroll
        for (int ai = 0; ai < 2; ++ai)
#pragma unroll
            for (int m = 0; m < 4; ++m) { rsv[ai][m] = row_rs(ss, u.pm * 256 + ai * 128 + wr * 64 + m * 16 + fr, fq); if (m & 1) asm volatile("" : "+v"(rsv[ai][m - 1]), "+v"(rsv[ai][m]) :: "memory"); }
#pragma unroll
        for (int ai = 0; ai < 2; ++ai)
#pragma unroll
            for (int m = 0; m < 4; ++m) {
                const int row = u.pm * 256 + ai * 128 + wr * 64 + m * 16 + fr;
                const float rs = rsv[ai][m];
                bf16_t* rowp = U + (size_t)row * FF + col0;
#pragma unroll
                for (int bj = 0; bj < 2; ++bj) {
                    f32x4 v0 = acc[ai][bj][m][0] * rs, v1 = acc[ai][bj][m][1] * rs;
#pragma unroll
                    for (int e = 0; e < 4; ++e) { const float a = fmaxf(v0[e], 0.f), b = fmaxf(v1[e], 0.f); v0[e] = a * a; v1[e] = b * b; }
                    u32x4 w; w.x = cvt_pk_bf16(v0[0], v0[1]); w.y = cvt_pk_bf16(v0[2], v0[3]); w.z = cvt_pk_bf16(v1[0], v1[1]); w.w = cvt_pk_bf16(v1[2], v1[3]);
                    *(u32x4*)(rowp + bj * 128) = w;
                }
            }
    }
};
struct EpiE {
    static constexpr bool PERM = false, AFTER_DRAIN = false;
    float* E;
    __device__ __forceinline__ void operator()(const f32x4 (&acc)[2][2][4][2], const Unit& u, int wr, int wc, int fr, int fq) const {
        const int col0 = u.pn * 256 + wc * 32 + 4 * fq;
#pragma unroll
        for (int ai = 0; ai < 2; ++ai)
#pragma unroll
            for (int m = 0; m < 4; ++m) {
                const int row = u.pm * 256 + ai * 128 + wr * 64 + m * 16 + fr;
#pragma unroll
                for (int bj = 0; bj < 2; ++bj)
#pragma unroll
                    for (int n = 0; n < 2; ++n) *(f32x4*)(E + (size_t)row * 1024 + col0 + bj * 128 + n * 16) = acc[ai][bj][m][n];
            }
    }
};
struct EpiG6 {
    static constexpr bool PERM = false, AFTER_DRAIN = false;
    const float* base; float* out; bf16_t* xb; const float* ssin; float* ssout; const float* E;
    __device__ __forceinline__ void operator()(const f32x4 (&acc)[2][2][4][2], const Unit& u, int wr, int wc, int fr, int fq) const {
        const int col0 = u.pn * 256 + wc * 32 + 4 * fq;
#pragma unroll
        for (int ai = 0; ai < 2; ++ai)
#pragma unroll
            for (int m = 0; m < 4; ++m) {
                const int row = u.pm * 256 + ai * 128 + wr * 64 + m * 16 + fr;
                float rs = row_rs(ssin, row, fq); asm volatile("" : "+v"(rs) :: "memory");
                float s = 0.f;
#pragma unroll
                for (int bj = 0; bj < 2; ++bj)
#pragma unroll
                    for (int n = 0; n < 2; ++n) {
                        const size_t off = (size_t)row * 1024 + col0 + bj * 128 + n * 16;
                        const f32x4 a = acc[ai][bj][m][n] * rs, e = *(const f32x4*)(E + off);
                        f32x4 v = *(const f32x4*)(base + off);
#pragma unroll
                        for (int k = 0; k < 4; ++k) v[k] += sigmoidf_(a[k]) * e[k];
                        *(f32x4*)(out + off) = v;
                        v2u w; w.x = cvt_pk_bf16(v[0], v[1]); w.y = cvt_pk_bf16(v[2], v[3]);
                        *(v2u*)(xb + off) = w;
                        s += (v[0] * v[0] + v[1] * v[1]) + (v[2] * v[2] + v[3] * v[3]);
                    }
                s += __shfl_xor(s, 16); s += __shfl_xor(s, 32);
                if (fq == 0) ssout[(size_t)row * 16 + u.pn * 4 + wc] = s;
                asm volatile("" ::: "memory");
            }
    }
};
struct ZOrder {
    pg8::StaticOrder S;
    __device__ __forceinline__ bool next(int i, Unit& u) const { if (!S.next(i / 3, u)) return false; u.z = i % 3; return true; }
    __device__ __forceinline__ void a_ready(const Unit&) const {}
    __device__ __forceinline__ void done(const Unit&) const {}
};

struct Args { const float* in[23]; float* out; unsigned char* ws; int ph_lo, ph_hi; };
typedef const __attribute__((address_space(4))) Args CArgs;
__device__ __forceinline__ CArgs* get_args() {
    CArgs* p = (CArgs*)__builtin_amdgcn_kernarg_segment_ptr();
    asm volatile("" : "+s"(p));
    return p;
}
struct Frame {
    LAS unsigned char* lds;
    int tid, lane, wave, G, gw, ngw;
    float* out; unsigned char* ws;
};

__device__ __forceinline__ void transpose_item(const float* W, const float* g, int K, int N, bf16* WT, LAS float* scr, int item, int lane) {
    const int nblk = N / 32, kb = item / nblk, nb = item % nblk, k0 = 64 * kb, n0 = 32 * nb;
#pragma unroll 8
    for (int i = 0; i < 32; ++i) { const int kk = 2 * i + (lane >> 5); float v = W[(size_t)(k0 + kk) * N + n0 + (lane & 31)]; if (g) v *= g[k0 + kk]; scr[kk * 33 + (lane & 31)] = v; }
    LDS_WAIT(); asm volatile("" ::: "memory");
    const int c = lane & 7;
#pragma unroll
    for (int j = 0; j < 4; ++j) { const int n = (lane >> 3) + 8 * j; const LAS float* s = scr + (8 * c) * 33 + n;
        v4u o; o.x = pk2(s[0 * 33], s[1 * 33]); o.y = pk2(s[2 * 33], s[3 * 33]); o.z = pk2(s[4 * 33], s[5 * 33]); o.w = pk2(s[6 * 33], s[7 * 33]);
        *(v4u*)(WT + (size_t)(n0 + n) * K + k0 + 8 * c) = o; }
    LDS_WAIT(); asm volatile("" ::: "memory");
}
__device__ __forceinline__ void convert_matrix(const Frame& F, const float* W, const float* g, int K, int N, bf16* WT) {
    LAS float* scr = (LAS float*)(F.lds + F.wave * 16384);
    const int nitems = (K / 64) * (N / 32);
    for (int it = F.gw; it < nitems; it += F.ngw) transpose_item(W, g, K, N, WT, scr, it, F.lane);
}
__device__ __forceinline__ void convert_layer_early(const Frame& F, CArgs* A, int l) {
    convert_matrix(F, A->in[3] + (size_t)l * D * 7680, A->in[2] + l * D, D, 7680, (bf16*)(F.ws + W_IN));
}
__device__ __forceinline__ void convert_layer_mid(const Frame& F, CArgs* A, int l) {
    for (int n = 0; n < 3; ++n) convert_matrix(F, A->in[14] + ((size_t)l * 3 + n) * 512 * D, nullptr, 512, D, (bf16*)(F.ws + W_BR) + (size_t)n * D * 512);
    convert_matrix(F, A->in[15] + (size_t)l * D * D, nullptr, D, D, (bf16*)(F.ws + W_OUT));
    convert_matrix(F, A->in[20] + (size_t)l * D * D, A->in[19] + l * D, D, D, (bf16*)(F.ws + W_G(l & 1)));
    convert_matrix(F, A->in[21] + (size_t)l * PLE * D, nullptr, PLE, D, (bf16*)(F.ws + W_PLE(l & 1)));
}
__device__ __forceinline__ void convert_layer_mlp(const Frame& F, CArgs* A, int l) {
    convert_matrix(F, A->in[17] + (size_t)l * D * FF, A->in[16] + l * D, D, FF, (bf16*)(F.ws + W_UP));
    convert_matrix(F, A->in[18] + (size_t)l * FF * D, nullptr, FF, D, (bf16*)(F.ws + W_DOWN));
}
__device__ __forceinline__ void convert_p(const Frame& F, CArgs* A, int l) {
    const f32x4* src = (const f32x4*)(A->in[1] + (size_t)l * T * PLE); v2u* dst = (v2u*)(F.ws + WS_PB);
    const int n4 = T * PLE / 4;
    for (int i = F.gw * 64 + F.lane; i < n4; i += F.ngw * 64) { const f32x4 v = src[i]; v2u w; w.x = pk2(v.x, v.y); w.y = pk2(v.z, v.w); dst[i] = w; }
}

__device__ __forceinline__ void phase_prologue(const Frame& F, CArgs* A) {
    convert_layer_early(F, A, 0); convert_layer_mid(F, A, 0);
    const float* x = A->in[0]; bf16* xb = (bf16*)(F.ws + WS_XB); float* ss = (float*)(F.ws + WS_SSB);
    for (int m = F.gw; m < T; m += F.ngw) {
        const f32x4* xr = (const f32x4*)(x + (size_t)m * D) + F.lane; v2u* o = (v2u*)(xb + (size_t)m * D) + F.lane;
        float s = 0.f;
#pragma unroll
        for (int j = 0; j < 4; ++j) { const f32x4 v = xr[64 * j]; s += (v.x * v.x + v.y * v.y) + (v.z * v.z + v.w * v.w); v2u w; w.x = pk2(v.x, v.y); w.y = pk2(v.z, v.w); o[64 * j] = w; }
        s = wave_sum(s);
        if (F.lane < 16) ss[(size_t)m * 16 + F.lane] = F.lane == 0 ? s : 0.f;
    }
    { bf16* lw = (bf16*)(F.ws + WS_LW);
      for (int e = F.gw * 64 + F.lane; e < DEPTH * 2 * 2 * 8 * 4096; e += F.ngw * 64) {
          const int mat = e >> 12, j = (e >> 6) & 63, i = e & 63, blk = mat & 7, ax = (mat >> 3) & 1, ld = mat >> 4;
          const float* src = (ax ? A->in[11] : A->in[9]) + ((size_t)ld * 8 + blk) * 4096;
          lw[e] = (bf16)f2bf(src[i * 64 + j]); }
      float* sp = (float*)(F.ws + WS_SP);
      for (int e = F.gw * 64 + F.lane; e < DEPTH * 2 * 512; e += F.ngw * 64) sp[e] = log1p_small(fexp(-A->in[13][e])); }
    float* tab = (float*)(F.ws + WS_TAB);
    for (int e = F.gw * 64 + F.lane; e < SEQ * 64; e += F.ngw * 64) {
        const int pos = e >> 6, i = e & 63;
        const float theta = __builtin_amdgcn_exp2f(-(float)i * (13.287712379549449f / 63.0f));
        double rev = (double)pos * (double)theta * 0.15915494309189535; rev -= __builtin_floor(rev);
        const float fr = (float)rev;
        tab[e] = __builtin_amdgcn_cosf(fr); tab[131072 + e] = __builtin_amdgcn_sinf(fr);
    }
}


typedef short bf16x8_t __attribute__((ext_vector_type(8)));
typedef float f32x2_t __attribute__((ext_vector_type(2))); typedef __bf16 bf16x2_t __attribute__((ext_vector_type(2)));
__device__ __forceinline__ unsigned pkbf(float lo, float hi) { f32x2_t v = {lo, hi}; bf16x2_t b = __builtin_convertvector(v, bf16x2_t); return __builtin_bit_cast(unsigned, b); }
typedef short v4i16_t __attribute__((ext_vector_type(4)));
__device__ __forceinline__ v4i16_t ds_tr16(LAS const unsigned char* p) { return __builtin_amdgcn_ds_read_tr16_b64_v4i16((LAS v4i16_t*)p); }
__device__ __forceinline__ bf16x8_t tr_frag(LAS const unsigned char* p0, LAS const unsigned char* p1) {
    const v4i16_t a = ds_tr16(p0), b = ds_tr16(p1);
    return (bf16x8_t){a[0], a[1], a[2], a[3], b[0], b[1], b[2], b[3]};
}
#define MFMA16(a, b, c) __builtin_amdgcn_mfma_f32_16x16x32_bf16((a), (b), (c), 0, 0, 0)
constexpr int RP = 272;
__device__ __forceinline__ void ret_state_item(const Frame& F, int item) {
    const int bh = item >> 4, c = item & 15, b = bh >> 2, h = bh & 3, t0 = b * SEQ + c * 128;
    const bf16* Kg = (const bf16*)(F.ws + WS_PROJ + 5 * BLK); const bf16* Vg = (const bf16*)(F.ws + WS_PROJ + 7 * BLK);
    bf16* ST = (bf16*)(F.ws + WS_ST);
    const float lgf = log2_1m(__builtin_amdgcn_exp2f(-5.0f - (float)h)), lgb = log2_1m(__builtin_amdgcn_exp2f(-5.5f - (float)h));
    LAS unsigned char* Kf = F.lds; LAS unsigned char* Kb = F.lds + 128 * RP; LAS unsigned char* Vl = F.lds + 2 * 128 * RP;
    __syncthreads();
#pragma unroll
    for (int q = 0; q < 4; ++q) {
        const int idx = F.tid + 512 * q, row = idx >> 4, ch = idx & 15;
        const v4u kv = *(const v4u*)(Kg + (size_t)(t0 + row) * 512 + h * 128 + ch * 8);
        const v4u vv = *(const v4u*)(Vg + (size_t)(t0 + row) * 512 + h * 128 + ch * 8);
        const float df = __builtin_amdgcn_exp2f((float)(127 - row) * lgf), db = __builtin_amdgcn_exp2f((float)row * lgb);
        v4u kf, kb;
#pragma unroll
        for (int e = 0; e < 4; ++e) { const float lo = bflo(kv[e]), hi = bfhi(kv[e]); kf[e] = pkbf(lo * df, hi * df); kb[e] = pkbf(lo * db, hi * db); }
        *(LAS v4u*)(Kf + row * RP + ch * 16) = kf; *(LAS v4u*)(Kb + row * RP + ch * 16) = kb; *(LAS v4u*)(Vl + row * RP + ch * 16) = vv;
    }
    __syncthreads();
    const int lane = F.lane, w = F.wave, g = lane >> 4, i = lane & 15, q4 = i >> 2, p4 = i & 3;
    f32x4 acc[2][8];
#pragma unroll
    for (int d = 0; d < 2; ++d)
#pragma unroll
        for (int n = 0; n < 8; ++n) acc[d][n] = (f32x4){0.f, 0.f, 0.f, 0.f};
#pragma unroll
    for (int ks = 0; ks < 4; ++ks) {
        const int r0 = (32 * ks + 8 * g + q4) * RP, r1 = r0 + 4 * RP;
        const bf16x8_t af = tr_frag(Kf + r0 + (16 * w + 4 * p4) * 2, Kf + r1 + (16 * w + 4 * p4) * 2);
        const bf16x8_t ab = tr_frag(Kb + r0 + (16 * w + 4 * p4) * 2, Kb + r1 + (16 * w + 4 * p4) * 2);
#pragma unroll
        for (int n = 0; n < 8; ++n) {
            const bf16x8_t bv = tr_frag(Vl + r0 + (16 * n + 4 * p4) * 2, Vl + r1 + (16 * n + 4 * p4) * 2);
            acc[0][n] = MFMA16(af, bv, acc[0][n]); acc[1][n] = MFMA16(ab, bv, acc[1][n]);
        }
    }
#pragma unroll
    for (int d = 0; d < 2; ++d) {
        bf16* dst = ST + ((size_t)(bh * 2 + d) * 16 + c) * 16384;
#pragma unroll
        for (int n = 0; n < 8; ++n) { v2u o; o.x = pkbf(acc[d][n][0], acc[d][n][1]); o.y = pkbf(acc[d][n][2], acc[d][n][3]);
            *(v2u*)(dst + (16 * n + i) * 128 + 16 * w + 4 * g) = o; }
    }
}
__device__ __forceinline__ void ret_out_item(const Frame& F, const float* gn, int item) {
    const int bh = item >> 4, ci = item & 15, b = bh >> 2, h = bh & 3, t0 = b * SEQ + ci * 128;
    bf16* Gg = (bf16*)(F.ws + WS_PROJ + 3 * BLK); const bf16* Qg = (const bf16*)(F.ws + WS_PROJ + 4 * BLK);
    const bf16* Kg = (const bf16*)(F.ws + WS_PROJ + 5 * BLK); const bf16* Vg = (const bf16*)(F.ws + WS_PROJ + 7 * BLK);
    const bf16* ST = (const bf16*)(F.ws + WS_ST);
    const float lgf = log2_1m(__builtin_amdgcn_exp2f(-5.0f - (float)h)), lgb = log2_1m(__builtin_amdgcn_exp2f(-5.5f - (float)h));
    LAS unsigned char* Kl = F.lds; LAS unsigned char* Vl = F.lds + 128 * RP; LAS unsigned char* Sf = F.lds + 2 * 128 * RP; LAS unsigned char* Sb = F.lds + 3 * 128 * RP;
    __syncthreads();
    {
        const float cf = __builtin_amdgcn_exp2f(128.0f * lgf), cb = __builtin_amdgcn_exp2f(128.0f * lgb);
#pragma unroll
        for (int q = 0; q < 4; ++q) {
            const int idx = F.tid + 512 * q, row = idx >> 4, ch = idx & 15;
            *(LAS v4u*)(Kl + row * RP + ch * 16) = *(const v4u*)(Kg + (size_t)(t0 + row) * 512 + h * 128 + ch * 8);
            *(LAS v4u*)(Vl + row * RP + ch * 16) = *(const v4u*)(Vg + (size_t)(t0 + row) * 512 + h * 128 + ch * 8);
            float a[8];
#pragma unroll
            for (int e = 0; e < 8; ++e) a[e] = 0.f;
            const bf16* sf = ST + ((size_t)(bh * 2 + 0) * 16) * 16384 + idx * 8;
            for (int j = 0; j < ci; ++j) { const v4u x = *(const v4u*)(sf + (size_t)j * 16384);
#pragma unroll
                for (int e = 0; e < 4; ++e) { a[2 * e] = a[2 * e] * cf + bflo(x[e]); a[2 * e + 1] = a[2 * e + 1] * cf + bfhi(x[e]); } }
            v4u o;
#pragma unroll
            for (int e = 0; e < 4; ++e) o[e] = pkbf(a[2 * e], a[2 * e + 1]);
            *(LAS v4u*)(Sf + row * RP + ch * 16) = o;
#pragma unroll
            for (int e = 0; e < 8; ++e) a[e] = 0.f;
            const bf16* sb = ST + ((size_t)(bh * 2 + 1) * 16) * 16384 + idx * 8;
            for (int j = 15; j > ci; --j) { const v4u x = *(const v4u*)(sb + (size_t)j * 16384);
#pragma unroll
                for (int e = 0; e < 4; ++e) { a[2 * e] = a[2 * e] * cb + bflo(x[e]); a[2 * e + 1] = a[2 * e + 1] * cb + bfhi(x[e]); } }
#pragma unroll
            for (int e = 0; e < 4; ++e) o[e] = pkbf(a[2 * e], a[2 * e + 1]);
            *(LAS v4u*)(Sb + row * RP + ch * 16) = o;
        }
    }
    __syncthreads();
    const int lane = F.lane, w = F.wave, g = lane >> 4, i = lane & 15, q4 = i >> 2, p4 = i & 3;
    const int nl = 16 * w + i;
    bf16x8_t bq[4];
#pragma unroll
    for (int ks = 0; ks < 4; ++ks) bq[ks] = *(const bf16x8_t*)(Qg + (size_t)(t0 + nl) * 512 + h * 128 + 32 * ks + 8 * g);
    bf16x8_t bp[4];
#pragma unroll
    for (int kp = 0; kp < 4; ++kp) {
        f32x4 s0 = (f32x4){0.f, 0.f, 0.f, 0.f}, s1 = s0;
#pragma unroll
        for (int ks = 0; ks < 4; ++ks) {
            const bf16x8_t a0 = *(const LAS bf16x8_t*)(Kl + (32 * kp + i) * RP + (32 * ks + 8 * g) * 2);
            const bf16x8_t a1 = *(const LAS bf16x8_t*)(Kl + (32 * kp + 16 + i) * RP + (32 * ks + 8 * g) * 2);
            s0 = MFMA16(a0, bq[ks], s0); s1 = MFMA16(a1, bq[ks], s1);
        }
        float pv[8];
#pragma unroll
        for (int e = 0; e < 4; ++e) {
            const int m0 = 32 * kp + 4 * g + e, m1 = m0 + 16;
            const float d0 = (float)(nl - m0), d1 = (float)(nl - m1);
            pv[e] = s0[e] * (d0 >= 0.f ? __builtin_amdgcn_exp2f(d0 * lgf) : __builtin_amdgcn_exp2f(-d0 * lgb));
            pv[4 + e] = s1[e] * (d1 >= 0.f ? __builtin_amdgcn_exp2f(d1 * lgf) : __builtin_amdgcn_exp2f(-d1 * lgb));
        }
        v4u pk; pk.x = pkbf(pv[0], pv[1]); pk.y = pkbf(pv[2], pv[3]); pk.z = pkbf(pv[4], pv[5]); pk.w = pkbf(pv[6], pv[7]);
        bp[kp] = __builtin_bit_cast(bf16x8_t, pk);
    }
    f32x4 oi[8], of[8], ob[8];
#pragma unroll
    for (int n = 0; n < 8; ++n) { oi[n] = (f32x4){0.f, 0.f, 0.f, 0.f}; of[n] = oi[n]; ob[n] = oi[n]; }
#pragma unroll
    for (int kp = 0; kp < 4; ++kp) {
        const int r0 = (32 * kp + 4 * g + q4) * RP, r1 = r0 + 16 * RP;
#pragma unroll
        for (int n = 0; n < 8; ++n) { const bf16x8_t av = tr_frag(Vl + r0 + (16 * n + 4 * p4) * 2, Vl + r1 + (16 * n + 4 * p4) * 2); oi[n] = MFMA16(av, bp[kp], oi[n]); }
    }
#pragma unroll
    for (int ks = 0; ks < 4; ++ks)
#pragma unroll
        for (int n = 0; n < 8; ++n) {
            const bf16x8_t af = *(const LAS bf16x8_t*)(Sf + (16 * n + i) * RP + (32 * ks + 8 * g) * 2);
            const bf16x8_t ab = *(const LAS bf16x8_t*)(Sb + (16 * n + i) * RP + (32 * ks + 8 * g) * 2);
            of[n] = MFMA16(af, bq[ks], of[n]); ob[n] = MFMA16(ab, bq[ks], ob[n]);
        }
    const float qdf = __builtin_amdgcn_exp2f((float)(nl + 1) * lgf), qdb = __builtin_amdgcn_exp2f((float)(128 - nl) * lgb);
    float ss = 0.f;
#pragma unroll
    for (int n = 0; n < 8; ++n) { oi[n] = oi[n] + of[n] * qdf + ob[n] * qdb; ss += (oi[n][0] * oi[n][0] + oi[n][1] * oi[n][1]) + (oi[n][2] * oi[n][2] + oi[n][3] * oi[n][3]); }
    ss += __shfl_xor(ss, 16); ss += __shfl_xor(ss, 32);
    const float rn = 1.0f / sqrtf(ss * (1.0f / 128.0f) + RMS_EPS);
    bf16* grow = Gg + (size_t)(t0 + nl) * 512 + h * 128;
#pragma unroll
    for (int n = 0; n < 8; ++n) {
        const int dv0 = 16 * n + 4 * g;
        const v2u gg = *(const v2u*)(grow + dv0); const f32x4 gw = *(const f32x4*)(gn + h * 128 + dv0);
        const float g0 = bflo(gg.x), g1 = bfhi(gg.x), g2 = bflo(gg.y), g3 = bfhi(gg.y);
        v2u o; o.x = pkbf(g0 * sigmoidf_(g0) * oi[n][0] * rn * gw[0], g1 * sigmoidf_(g1) * oi[n][1] * rn * gw[1]);
        o.y = pkbf(g2 * sigmoidf_(g2) * oi[n][2] * rn * gw[2], g3 * sigmoidf_(g3) * oi[n][3] * rn * gw[3]);
        *(v2u*)(grow + dv0) = o;
    }
}

template <int MODE>
__device__ __forceinline__ void lru_item(const Frame& F, CArgs* A, int l, int item) {
    const int b = item >> 7, c = (item >> 3) & 15, blk = item & 7, t0 = b * SEQ + c * 128, s0 = c * 128;
    const bf16* XCg = (const bf16*)(F.ws + WS_PROJ + 8 * BLK); bf16* GCg = (bf16*)(F.ws + WS_PROJ + 6 * BLK);
    float* AGG = (float*)(F.ws + WS_AGG); const bf16* LW = (const bf16*)(F.ws + WS_LW); const float* SP = (const float*)(F.ws + WS_SP);
    LAS unsigned char* XC = F.lds; LAS float* XF = (LAS float*)(F.lds + 19456); LAS unsigned char* XB = F.lds + 54272;
    LAS float* SEG = (LAS float*)(F.lds + 72704); LAS float* PRE = (LAS float*)(F.lds + 105472);
    const int tid = F.tid, lane = F.lane, w = F.wave, g = lane >> 4, i = lane & 15;
    __syncthreads();
#pragma unroll
    for (int q = 0; q < 3; ++q) {
        const int idx = tid + 512 * q;
        if (idx < 1056) { const int row = idx >> 3, ch = idx & 7, s = s0 - 2 + row;
            v4u v = (v4u){0u, 0u, 0u, 0u};
            if (s >= 0 && s < SEQ) v = *(const v4u*)(XCg + (size_t)(b * SEQ + s) * 512 + blk * 64 + ch * 8);
            *(LAS v4u*)(XC + row * 144 + ch * 16) = v; }
    }
    __syncthreads();
    {
        const float* cw = A->in[7] + (size_t)l * 2048 + blk * 64; const float* cb = A->in[8] + (size_t)l * 512 + blk * 64;
#pragma unroll
        for (int q = 0; q < 2; ++q) {
            const int idx = tid + 512 * q, t = idx >> 3, c8 = idx & 7;
            float xf[8];
            { const f32x4 b0 = *(const f32x4*)(cb + c8 * 8), b1 = *(const f32x4*)(cb + c8 * 8 + 4); xf[0] = b0[0]; xf[1] = b0[1]; xf[2] = b0[2]; xf[3] = b0[3]; xf[4] = b1[0]; xf[5] = b1[1]; xf[6] = b1[2]; xf[7] = b1[3]; }
#pragma unroll
            for (int tap = 0; tap < 4; ++tap) {
                const v4u x = *(const LAS v4u*)(XC + (t + tap) * 144 + c8 * 16);
                const f32x4 w0 = *(const f32x4*)(cw + tap * 512 + c8 * 8), w1 = *(const f32x4*)(cw + tap * 512 + c8 * 8 + 4);
                xf[0] += w0[0] * bflo(x[0]); xf[1] += w0[1] * bfhi(x[0]); xf[2] += w0[2] * bflo(x[1]); xf[3] += w0[3] * bfhi(x[1]);
                xf[4] += w1[0] * bflo(x[2]); xf[5] += w1[1] * bfhi(x[2]); xf[6] += w1[2] * bflo(x[3]); xf[7] += w1[3] * bfhi(x[3]);
            }
            *(LAS f32x4*)(XF + t * 68 + c8 * 8) = (f32x4){xf[0], xf[1], xf[2], xf[3]}; *(LAS f32x4*)(XF + t * 68 + c8 * 8 + 4) = (f32x4){xf[4], xf[5], xf[6], xf[7]};
            v4u o; o.x = pkbf(xf[0], xf[1]); o.y = pkbf(xf[2], xf[3]); o.z = pkbf(xf[4], xf[5]); o.w = pkbf(xf[6], xf[7]);
            *(LAS v4u*)(XB + t * 144 + c8 * 16) = o;
        }
    }
    __syncthreads();
    float av[2][4][4], bv[2][4][4];
    {
        const bf16x8_t a0 = *(const LAS bf16x8_t*)(XB + (16 * w + i) * 144 + (8 * g) * 2), a1 = *(const LAS bf16x8_t*)(XB + (16 * w + i) * 144 + (32 + 8 * g) * 2);
#pragma unroll
        for (int d = 0; d < 2; ++d) {
            f32x4 ca[4], cx[4];
            const bf16* Wa = LW + (size_t)((((l * 2 + d) * 2 + 0) * 8 + blk)) * 4096; const bf16* Wx = LW + (size_t)((((l * 2 + d) * 2 + 1) * 8 + blk)) * 4096;
#pragma unroll
            for (int jt = 0; jt < 4; ++jt) {
                const bf16x8_t b0 = *(const bf16x8_t*)(Wa + (16 * jt + i) * 64 + 8 * g), b1 = *(const bf16x8_t*)(Wa + (16 * jt + i) * 64 + 32 + 8 * g);
                const bf16x8_t e0 = *(const bf16x8_t*)(Wx + (16 * jt + i) * 64 + 8 * g), e1 = *(const bf16x8_t*)(Wx + (16 * jt + i) * 64 + 32 + 8 * g);
                f32x4 z = (f32x4){0.f, 0.f, 0.f, 0.f};
                ca[jt] = MFMA16(a0, b0, z); ca[jt] = MFMA16(a1, b1, ca[jt]);
                cx[jt] = MFMA16(a0, e0, z); cx[jt] = MFMA16(a1, e1, cx[jt]);
            }
#pragma unroll
            for (int jt = 0; jt < 4; ++jt) {
                const int ch = blk * 64 + 16 * jt + i, pi = (l * 2 + d) * 512 + ch;
                const float ba = A->in[10][pi], bx = A->in[12][pi], sp = SP[pi];
#pragma unroll
                for (int r = 0; r < 4; ++r) {
                    const int t = 16 * w + 4 * g + r;
                    const float xfv = XF[t * 68 + 16 * jt + i];
                    const float rr = sigmoidf_(ca[jt][r] + ba), ig = sigmoidf_(cx[jt][r] + bx);
                    const float la = -8.0f * rr * sp, a = fexp(la), x2 = 2.0f * la;
                    const float om = x2 > -0.5f ? -x2 * (1.0f + x2 * (0.5f + x2 * (0.16666667f + x2 * (0.041666668f + x2 * (0.0083333333f + x2 * 0.0013888889f))))) : 1.0f - a * a;
                    float mult = sqrtf(om);
                    if (d == 0 ? (c == 0 && t == 0) : (c == 15 && t == 127)) mult = 1.0f;
                    av[d][jt][r] = a; bv[d][jt][r] = mult * ig * xfv;
                }
            }
            asm volatile("" ::: "memory");
        }
    }
#pragma unroll
    for (int jt = 0; jt < 4; ++jt) {
        const float Af = av[0][jt][0] * av[0][jt][1] * av[0][jt][2] * av[0][jt][3];
        const float Bf = ((bv[0][jt][0] * av[0][jt][1] + bv[0][jt][1]) * av[0][jt][2] + bv[0][jt][2]) * av[0][jt][3] + bv[0][jt][3];
        const float Ar = av[1][jt][0] * av[1][jt][1] * av[1][jt][2] * av[1][jt][3];
        const float Br = ((bv[1][jt][3] * av[1][jt][2] + bv[1][jt][2]) * av[1][jt][1] + bv[1][jt][1]) * av[1][jt][0] + bv[1][jt][0];
        typedef float f2 __attribute__((ext_vector_type(2)));
        *(LAS f2*)(SEG + ((0 * 32 + 4 * w + g) * 64 + 16 * jt + i) * 2) = (f2){Af, Bf};
        *(LAS f2*)(SEG + ((1 * 32 + 4 * w + g) * 64 + 16 * jt + i) * 2) = (f2){Ar, Br};
    }
    __syncthreads();
    if (tid < 128) {
        const int d = tid >> 6, j = tid & 63, ch = blk * 64 + j;
        float h = 0.f, Ap = 1.0f;
        if (MODE == 1) {
            if (d == 0) {
#pragma unroll 1
                for (int cc = 0; cc < c; ++cc) { const float* ag = AGG + ((size_t)((b * 16 + cc) * 2 + 0) * 512 + ch) * 2; h = ag[0] * h + ag[1]; } }
            else {
#pragma unroll 1
                for (int cc = 15; cc > c; --cc) { const float* ag = AGG + ((size_t)((b * 16 + cc) * 2 + 1) * 512 + ch) * 2; h = ag[0] * h + ag[1]; } }
        }
        if (d == 0) {
#pragma unroll 1
            for (int sg = 0; sg < 32; ++sg) { PRE[(0 * 32 + sg) * 64 + j] = h; const float a = SEG[((0 * 32 + sg) * 64 + j) * 2], bb = SEG[((0 * 32 + sg) * 64 + j) * 2 + 1]; h = a * h + bb; Ap *= a; } }
        else {
#pragma unroll 1
            for (int sg = 31; sg >= 0; --sg) { PRE[(1 * 32 + sg) * 64 + j] = h; const float a = SEG[((1 * 32 + sg) * 64 + j) * 2], bb = SEG[((1 * 32 + sg) * 64 + j) * 2 + 1]; h = a * h + bb; Ap *= a; } }
        if (MODE == 0) { float* ag = AGG + ((size_t)((b * 16 + c) * 2 + d) * 512 + ch) * 2; ag[0] = Ap; ag[1] = h; }
    }
    if (MODE == 1) {
        __syncthreads();
#pragma unroll
        for (int jt = 0; jt < 4; ++jt) {
            float hs[4];
            float h = PRE[(0 * 32 + 4 * w + g) * 64 + 16 * jt + i];
#pragma unroll
            for (int r = 0; r < 4; ++r) { h = av[0][jt][r] * h + bv[0][jt][r]; hs[r] = h; }
            h = PRE[(1 * 32 + 4 * w + g) * 64 + 16 * jt + i];
#pragma unroll
            for (int r = 3; r >= 0; --r) { h = av[1][jt][r] * h + bv[1][jt][r]; hs[r] += h; }
#pragma unroll
            for (int r = 0; r < 4; ++r) {
                bf16* p = GCg + (size_t)(t0 + 16 * w + 4 * g + r) * 512 + blk * 64 + 16 * jt + i;
                *p = (bf16)f2bf(gelu_tanh(bf2f(*p)) * hs[r]);
            }
        }
    }
}
template <int MODE> __device__ __forceinline__ void phase_lru(const Frame& F, CArgs* A, int l) { for (int it = blockIdx.x; it < 1024; it += F.G) lru_item<MODE>(F, A, l, it); }


__device__ __forceinline__ void na_item(const Frame& F, const float* rpb, int item) {
    const int h = item & 7, r = (item >> 3) & 31, b = item >> 8;
    int rs = r - 4; rs = rs < 0 ? 0 : (rs > 24 ? 24 : rs);
    const size_t tbase = (size_t)b * SEQ + rs * 64;
    bf16* Qg = (bf16*)(F.ws + WS_PROJ); const bf16* Kg = (const bf16*)(F.ws + WS_PROJ + BLK); const bf16* Vg = (const bf16*)(F.ws + WS_PROJ + 2 * BLK);
    LAS unsigned char* Kl = F.lds; LAS unsigned char* Vl = F.lds + 512 * 144; LAS float* Bl = (LAS float*)(F.lds + 2 * 512 * 144);
    __syncthreads();
#pragma unroll
    for (int q = 0; q < 8; ++q) {
        const int idx = F.tid + 512 * q, kidx = idx >> 3, ch = idx & 7;
        *(LAS v4u*)(Kl + kidx * 144 + ch * 16) = *(const v4u*)(Kg + (tbase + kidx) * 512 + h * 64 + ch * 8);
        *(LAS v4u*)(Vl + kidx * 144 + ch * 16) = *(const v4u*)(Vg + (tbase + kidx) * 512 + h * 64 + ch * 8);
    }
    if (F.tid < 465) Bl[F.tid] = rpb[h * 465 + F.tid];
    __syncthreads();
    const int w = F.wave;
    if (w < 4) {
        const int lane = F.lane, g = lane >> 4, i = lane & 15, q4 = i >> 2, p4 = i & 3;
        const int c = 16 * w + i, cb = w == 0 ? 0 : (w == 1 ? 8 : (w == 2 ? 24 : 32));
        int cst = c - 8; cst = cst < 0 ? 0 : (cst > 48 ? 48 : cst);
        const size_t tq = (size_t)b * SEQ + r * 64 + c;
        const bf16x8_t bq0 = *(const bf16x8_t*)(Qg + tq * 512 + h * 64 + 8 * g), bq1 = *(const bf16x8_t*)(Qg + tq * 512 + h * 64 + 32 + 8 * g);
        float sc[16][4];
        float mx = -1e30f;
#pragma unroll
        for (int t = 0; t < 16; ++t) {
            const int wi = t >> 1, half = t & 1;
            const LAS unsigned char* kp = Kl + (wi * 64 + cb + 16 * half + i) * 144 + (8 * g) * 2;
            const bf16x8_t a0 = *(const LAS bf16x8_t*)kp, a1 = *(const LAS bf16x8_t*)(kp + 64);
            f32x4 s = (f32x4){0.f, 0.f, 0.f, 0.f};
            s = MFMA16(a0, bq0, s); s = MFMA16(a1, bq1, s);
            const int brow = (rs + wi - r + 7) * 31;
#pragma unroll
            for (int e = 0; e < 4; ++e) {
                const int kc = cb + 16 * half + 4 * g + e;
                const bool valid = (kc >= cst) && (kc < cst + 16);
                const float bias = Bl[valid ? brow + (kc - c + 15) : 0];
                const float v = valid ? s[e] + bias : -1e30f;
                sc[t][e] = v; mx = fmaxf(mx, v);
            }
        }
        mx = fmaxf(mx, __shfl_xor(mx, 16)); mx = fmaxf(mx, __shfl_xor(mx, 32));
        float sum = 0.f;
        bf16x8_t bp[8];
#pragma unroll
        for (int wi = 0; wi < 8; ++wi) {
            float p[8];
#pragma unroll
            for (int e = 0; e < 4; ++e) { p[e] = fexp(sc[2 * wi][e] - mx); p[4 + e] = fexp(sc[2 * wi + 1][e] - mx); sum += p[e] + p[4 + e]; }
            v4u pk; pk.x = pkbf(p[0], p[1]); pk.y = pkbf(p[2], p[3]); pk.z = pkbf(p[4], p[5]); pk.w = pkbf(p[6], p[7]);
            bp[wi] = __builtin_bit_cast(bf16x8_t, pk);
        }
        sum += __shfl_xor(sum, 16); sum += __shfl_xor(sum, 32);
        f32x4 o[4];
#pragma unroll
        for (int dt = 0; dt < 4; ++dt) o[dt] = (f32x4){0.f, 0.f, 0.f, 0.f};
#pragma unroll
        for (int wi = 0; wi < 8; ++wi) {
            const LAS unsigned char* vp = Vl + (wi * 64 + cb + 4 * g + q4) * 144 + (4 * p4) * 2;
#pragma unroll
            for (int dt = 0; dt < 4; ++dt) { const bf16x8_t av = tr_frag(vp + 32 * dt, vp + 16 * 144 + 32 * dt); o[dt] = MFMA16(av, bp[wi], o[dt]); }
        }
        const float inv = 1.0f / sum;
#pragma unroll
        for (int dt = 0; dt < 4; ++dt) { v2u ov; ov.x = pkbf(o[dt][0] * inv, o[dt][1] * inv); ov.y = pkbf(o[dt][2] * inv, o[dt][3] * inv);
            *(v2u*)(Qg + tq * 512 + h * 64 + 16 * dt + 4 * g) = ov; }
    }
}
__device__ __forceinline__ void phase_na(const Frame& F, CArgs* A, int l) { const float* rpb = A->in[5] + (size_t)l * 8 * 465; for (int it = blockIdx.x; it < 2048; it += F.G) na_item(F, rpb, it); }

__device__ __forceinline__ void phase_ret_state(const Frame& F) { for (int it = blockIdx.x; it < 512; it += F.G) ret_state_item(F, it); }
__device__ __forceinline__ void phase_ret_out(const Frame& F, CArgs* A, int l) { const float* gn = A->in[6] + (size_t)l * 512; for (int it = blockIdx.x; it < 512; it += F.G) ret_out_item(F, gn, it); }

__device__ __forceinline__ void phase_final(const Frame& F, CArgs* A) {
    const float* g = A->in[22];
    for (int m = F.gw; m < T; m += F.ngw) {
        f32x4* xr = (f32x4*)(F.out + (size_t)m * D) + F.lane; const f32x4* gr = (const f32x4*)g + F.lane;
        f32x4 v[4]; float s = 0.f;
#pragma unroll
        for (int j = 0; j < 4; ++j) { v[j] = xr[64 * j]; s += (v[j].x * v[j].x + v[j].y * v[j].y) + (v[j].z * v[j].z + v[j].w * v[j].w); }
        const float rs = 1.0f / sqrtf(wave_sum(s) * (1.0f / D) + RMS_EPS);
#pragma unroll
        for (int j = 0; j < 4; ++j) { f32x4 o = v[j] * rs * gr[64 * j];
#if MK_CHECK
            for (int e = 0; e < 4; ++e) if (!(fabsf(o[e]) < 1e30f)) o[e] = 55555.0f;
#endif
            xr[64 * j] = o; }
    }
}

__global__ void __launch_bounds__(NWAVES * 64, 2) mk_fwd(Args args) {
    extern __shared__ __attribute__((aligned(16))) unsigned char lds[];
    const int tid0 = threadIdx.x;
    LAS unsigned char* const lds3 = (LAS unsigned char*)lds;
    CArgs* A0 = get_args();
    const int ph_lo = A0->ph_lo, ph_hi = A0->ph_hi;
    for (int u = tid0; u < (LDS_BYTES - LDSCTL_OFF) / 4; u += NWAVES * 64) ((LAS unsigned*)(lds3 + LDSCTL_OFF))[u] = 0u;
    __syncthreads();
    const bool multi = (ph_hi - ph_lo) > 1;
    XcdBarrier bar; bar.bar = (unsigned*)((gu32*)(A0->ws + WS_CTL) + CW_BAR); bar.x = 0; bar.st = nullptr;
    if (multi) bar = xcd_barrier_post((unsigned*)((gu32*)(A0->ws + WS_CTL) + CW_BAR), (volatile LAS unsigned*)(lds3 + MISC_OFF) + 8);

    for (int ph = ph_lo; ph < ph_hi; ++ph) {
        CArgs* A = get_args();
        Frame F;
        { int t_ = tid0; asm volatile("" : "+v"(t_)); F.tid = t_; }
        F.lds = lds3; F.lane = F.tid & 63; F.wave = __builtin_amdgcn_readfirstlane(F.tid >> 6);
        F.G = gridDim.x; F.gw = blockIdx.x * NWAVES + F.wave; F.ngw = F.G * NWAVES;
        F.out = A->out; F.ws = A->ws;
        unsigned char* ws = F.ws;
        int kind, l;
        if (ph == 0) { kind = PH_PRO; l = 0; } else if (ph == NPH - 1) { kind = PH_FIN; l = 0; } else { l = (ph - 1) / NPL; kind = 1 + (ph - 1) % NPL; }
        float* ssA = (float*)(ws + WS_SSA); float* ssB = (float*)(ws + WS_SSB);
        switch (kind) {
        case PH_PRO: phase_prologue(F, A); break;
        case PH_G1: {
            pg8::Gemm g{(const bf16_t*)(ws + WS_XB), (const bf16_t*)(ws + W_IN), T, 7680, D, 0, 0};
            pg8::StaticOrder S; S.init(T, 7680, F.G, (int)blockIdx.x);
            EpiG1 E{(bf16_t*)(ws + WS_PROJ), ws + WS_GATE8, ssB, A->in[4] + (size_t)l * 3072, (const float*)(ws + WS_TAB)};
            pg8::gemm_phase<EpiG1, pg8::StaticOrder, true, true>(F.lds, g, S, E, F.tid);
        } break;
        case PH_MIXA: phase_na(F, A, l); phase_ret_state(F); phase_lru<0>(F, A, l); __syncthreads(); convert_layer_mlp(F, A, l); break;
        case PH_MIXB: phase_ret_out(F, A, l); phase_lru<1>(F, A, l); break;
        case PH_G2: {
            pg8::Gemm g{(const bf16_t*)(ws + WS_PROJ), (const bf16_t*)(ws + W_BR), T, D, 512, 3 * BLK, (size_t)D * 512 * 2};
            ZOrder S; S.S.init(T, D, F.G, (int)blockIdx.x);
            EpiG2 E{ws + WS_GATE8, (bf16_t*)(ws + WS_XB)};
            pg8::gemm_phase<EpiG2, ZOrder, true, true>(F.lds, g, S, E, F.tid);
        } break;
        case PH_G3: case PH_G5: {
            const bool g3 = (kind == PH_G3);
            pg8::Gemm g{(const bf16_t*)(ws + (g3 ? WS_XB : WS_U)), (const bf16_t*)(ws + (g3 ? W_OUT : W_DOWN)), T, D, g3 ? D : FF, 0, 0};
            pg8::StaticOrder S; S.init(T, D, F.G, (int)blockIdx.x);
            EpiRes E{(g3 && l == 0) ? A->in[0] : F.out, F.out, (bf16_t*)(ws + WS_GATE8), g3 ? ssB : ssA};
            pg8::gemm_phase<EpiRes, pg8::StaticOrder, false, true>(F.lds, g, S, E, F.tid);
        } break;
        case PH_G4: {
            pg8::Gemm g{(const bf16_t*)(ws + WS_GATE8), (const bf16_t*)(ws + W_UP), T, FF, D, 0, 0};
            pg8::StaticOrder S; S.init(T, FF, F.G, (int)blockIdx.x);
            EpiG4 E{(bf16_t*)(ws + WS_U), ssB};
            pg8::gemm_phase<EpiG4, pg8::StaticOrder, true, true>(F.lds, g, S, E, F.tid);
            convert_p(F, A, l);
            if (l + 1 < DEPTH) convert_layer_mid(F, A, l + 1);
        } break;
        case PH_G6: {
            {
                pg8::Gemm g{(const bf16_t*)(ws + WS_PB), (const bf16_t*)(ws + W_PLE(l & 1)), T, D, PLE, 0, 0};
                pg8::StaticOrder S; S.init(T, D, F.G, (int)blockIdx.x);
                EpiE E{(float*)(ws + WS_E)};
                pg8::gemm_phase<EpiE, pg8::StaticOrder, false, true>(F.lds, g, S, E, F.tid);
            }
            {
                pg8::Gemm g{(const bf16_t*)(ws + WS_GATE8), (const bf16_t*)(ws + W_G(l & 1)), T, D, D, 0, 0};
                pg8::StaticOrder S; S.init(T, D, F.G, (int)blockIdx.x);
                EpiG6 E{F.out, F.out, (bf16_t*)(ws + WS_XB), ssA, ssB, (const float*)(ws + WS_E)};
                pg8::gemm_phase<EpiG6, pg8::StaticOrder, false, true>(F.lds, g, S, E, F.tid);
            }
            if (l + 1 < DEPTH) convert_layer_early(F, A, l + 1);
        } break;
        case PH_FIN: phase_final(F, A); break;
        default: break;
        }
        if (ph + 1 < ph_hi) xcd_barrier(bar);
    }
}


#if MK_CHECK
constexpr int CW_CODE = 64, CW_CNT = 128;
__device__ __forceinline__ unsigned hash32(unsigned x) { x ^= x >> 16; x *= 0x7feb352du; x ^= x >> 15; x *= 0x846ca68bu; x ^= x >> 16; return x; }
__device__ __forceinline__ bool near(float a, float b, float rel, float abs_) { return fabsf(a - b) <= rel * fabsf(b) + abs_; }
__device__ float rs_of_x(const float* x, int row) { float s = 0.f; for (int k = 0; k < D; ++k) s += x[(size_t)row * D + k] * x[(size_t)row * D + k]; return 1.0f / sqrtf(s / D + RMS_EPS); }
__global__ void __launch_bounds__(256) mk_check(Args a, int stage) {
    const unsigned id = blockIdx.x * blockDim.x + threadIdx.x;
    const unsigned h = hash32(id * 2654435761u + 12345u * stage);
    unsigned char* ws = a.ws; unsigned* ctl = (unsigned*)(ws + WS_CTL);
    const int row = (int)(h % T);
    bool bad = false;
    const float* x = a.in[0];
    if (stage == 1) {
        const int col = (int)((h >> 14) % D);
        const bf16* xb = (const bf16*)(ws + WS_XB);
        bad |= !near(bf2f(xb[(size_t)row * D + col]), x[(size_t)row * D + col], 0.01f, 1e-3f);
        float s = 0.f; for (int k = 0; k < D; ++k) s += x[(size_t)row * D + k] * x[(size_t)row * D + k];
        const float* ss = (const float*)(ws + WS_SSB); float t = 0.f; for (int k = 0; k < 16; ++k) t += ss[(size_t)row * 16 + k];
        bad |= !near(t, s, 1e-3f, 1e-3f);
        const int n = (int)((h >> 7) % 7680), k = (int)(h % D);
        const bf16* wt = (const bf16*)(ws + W_IN);
        bad |= !near(bf2f(wt[(size_t)n * D + k]), a.in[2][k] * a.in[3][(size_t)k * 7680 + n], 0.01f, 1e-4f);
        const int pos = (int)(h % SEQ), i = (int)((h >> 11) % 64);
        const float th = powf(10000.0f, -(float)i / 63.0f), ang = (float)pos * th;
        const float* tab = (const float*)(ws + WS_TAB);
        bad |= !near(tab[pos * 64 + i], cosf(ang), 0.f, 2e-3f); bad |= !near(tab[131072 + pos * 64 + i], sinf(ang), 0.f, 2e-3f);
    } else if (stage == 2) {
        const int col = (int)((h >> 14) % 7680) & ~1;
        const float rs = rs_of_x(x, row);
        float v0 = 0.f, v1 = 0.f;
        for (int k = 0; k < D; ++k) { const float xv = x[(size_t)row * D + k] * a.in[2][k]; v0 += xv * a.in[3][(size_t)k * 7680 + col]; v1 += xv * a.in[3][(size_t)k * 7680 + col + 1]; }
        v0 *= rs; v1 *= rs;
        if (col < 4608) {
            const int kind = col / 512, cc = col % 512, phys = (int)((0x683754210ull >> (4 * kind)) & 15ull);
            if (kind == 3 || kind == 4) { const int i = (cc & 127) >> 1, pos = row & 2047; const float th = powf(10000.0f, -(float)i / 63.0f), ang = (float)pos * th, c = cosf(ang), sn = sinf(ang);
                const float w0 = v0 * c - v1 * sn, w1 = v0 * sn + v1 * c; v0 = w0; v1 = w1; }
            if (kind == 0) { v0 *= 0.125f; v1 *= 0.125f; } if (kind == 3) { v0 *= 0.08838834764831845f; v1 *= 0.08838834764831845f; }
            const bf16* p = (const bf16*)(ws + WS_PROJ) + (size_t)phys * T * 512 + (size_t)row * 512 + cc;
            bad |= !near(bf2f(p[0]), v0, 0.03f, 0.03f); bad |= !near(bf2f(p[1]), v1, 0.03f, 0.03f);
        } else {
            const int gc = col - 4608; const unsigned char* g8 = ws + WS_GATE8 + (size_t)row * 3072 + gc;
            const float s0 = 1.0f / (1.0f + expf(-(v0 + a.in[4][gc]))), s1 = 1.0f / (1.0f + expf(-(v1 + a.in[4][gc + 1])));
            bad |= !near((float)g8[0] / 255.0f, s0, 0.f, 0.012f); bad |= !near((float)g8[1] / 255.0f, s1, 0.f, 0.012f);
        }
    } else if (stage == 4) {
        const int col = (int)((h >> 14) % D);
        float m = 0.f;
        for (int n = 0; n < 3; ++n) { const bf16* ys = (const bf16*)(ws + WS_PROJ) + (size_t)(3 * n) * T * 512 + (size_t)row * 512; float acc = 0.f;
            for (int k = 0; k < 512; ++k) acc += bf2f(ys[k]) * a.in[14][((size_t)n * 512 + k) * D + col];
            m += acc * (float)ws[WS_GATE8 + (size_t)row * 3072 + n * 1024 + col] / 255.0f; }
        bad |= !near(bf2f(((const bf16*)(ws + WS_XB))[(size_t)row * D + col]), m, 0.03f, 0.03f);
    } else if (stage == 5) {
        const int col = (int)((h >> 14) % D);
        const bf16* mg = (const bf16*)(ws + WS_XB) + (size_t)row * D; float acc = 0.f;
        for (int k = 0; k < D; ++k) acc += bf2f(mg[k]) * a.in[15][(size_t)k * D + col];
        const float x1 = x[(size_t)row * D + col] + acc;
        bad |= !near(a.out[(size_t)row * D + col], x1, 0.02f, 0.03f);
        bad |= !near(bf2f(((const bf16*)(ws + WS_GATE8))[(size_t)row * D + col]), a.out[(size_t)row * D + col], 0.01f, 1e-3f);
        float s = 0.f; for (int k = 0; k < D; ++k) s += a.out[(size_t)row * D + k] * a.out[(size_t)row * D + k];
        const float* ss = (const float*)(ws + WS_SSB); float t = 0.f; for (int k = 0; k < 16; ++k) t += ss[(size_t)row * 16 + k];
        bad |= !near(t, s, 1e-3f, 1e-3f);
    } else if (stage == 6) {
        const int col = (int)((h >> 14) % FF);
        const bf16* xb = (const bf16*)(ws + WS_GATE8) + (size_t)row * D; float acc = 0.f;
        for (int k = 0; k < D; ++k) acc += bf2f(xb[k]) * a.in[16][k] * a.in[17][(size_t)k * FF + col];
        const float rs = rs_of_x(a.out, row); float v = fmaxf(acc * rs, 0.f); v *= v;
        bad |= !near(bf2f(((const bf16*)(ws + WS_U))[(size_t)row * FF + col]), v, 0.05f, 0.05f);
    } else if (stage == 7) {
        const int col = (int)((h >> 14) % D);
        const bf16* uu = (const bf16*)(ws + WS_U) + (size_t)row * FF; float acc = 0.f;
        for (int k = 0; k < FF; ++k) acc += bf2f(uu[k]) * a.in[18][(size_t)k * D + col];
        const float x2 = bf2f(((const bf16*)(ws + WS_XB))[(size_t)row * D + col]) + acc;
        bad |= !near(a.out[(size_t)row * D + col], x2, 0.03f, 0.05f);
        bad |= !near(bf2f(((const bf16*)(ws + WS_GATE8))[(size_t)row * D + col]), a.out[(size_t)row * D + col], 0.01f, 1e-3f);
        float s = 0.f; for (int k = 0; k < D; ++k) s += a.out[(size_t)row * D + k] * a.out[(size_t)row * D + k];
        const float* ss = (const float*)(ws + WS_SSA); float t = 0.f; for (int k = 0; k < 16; ++k) t += ss[(size_t)row * 16 + k];
        bad |= !near(t, s, 1e-3f, 1e-3f);
    } else if (stage == 8) {
        const int col = (int)((h >> 14) % D);
        const bf16* xb = (const bf16*)(ws + WS_GATE8) + (size_t)row * D; float acc = 0.f, s = 0.f;
        for (int k = 0; k < D; ++k) { const float xv = bf2f(xb[k]); s += xv * xv; acc += xv * a.in[19][k] * a.in[20][(size_t)k * D + col]; }
        const float rs = 1.0f / sqrtf(s / D + RMS_EPS);
        float e = 0.f; for (int k = 0; k < PLE; ++k) e += a.in[1][(size_t)row * PLE + k] * a.in[21][(size_t)k * D + col];
        const float x3 = bf2f(xb[col]) + e / (1.0f + expf(-acc * rs));
        bad |= !near(a.out[(size_t)row * D + col], x3, 0.03f, 0.05f);
    }
    if (stage == 9) bad = true;
    if (bad) atomicAdd(&ctl[CW_CNT + stage], 1u);
}
__device__ float orig_proj(const Args& a, int l, int row, int col) {
    const float* x = l == 0 ? a.in[0] : a.out; const float* g = a.in[2] + (size_t)l * D; const float* w = a.in[3] + (size_t)l * D * 7680;
    float s = 0.f, acc = 0.f;
    for (int k = 0; k < D; ++k) { const float xv = x[(size_t)row * D + k]; s += xv * xv; acc += xv * g[k] * w[(size_t)k * 7680 + col]; }
    return acc / sqrtf(s / D + RMS_EPS);
}
__global__ void __launch_bounds__(64) mk_check_na(Args a, int l) {
    __shared__ float qs[64]; __shared__ float sc[128];
    const unsigned h = hash32(blockIdx.x * 977u + 31u); const int t = (int)(h % T), hd = (int)((h >> 16) % 8), d = threadIdx.x;
    unsigned char* ws = a.ws; unsigned* ctl = (unsigned*)(ws + WS_CTL);
    const bf16* K = (const bf16*)(ws + WS_PROJ + BLK); const bf16* V = (const bf16*)(ws + WS_PROJ + 2 * BLK); const bf16* Y = (const bf16*)(ws + WS_PROJ);
    qs[d] = bf2f((bf16)f2bf(0.125f * orig_proj(a, l, t, hd * 64 + d)));
    __syncthreads();
    const int b = t / SEQ, s = t % SEQ, r = s / 64, c = s % 64;
    int rs = r - 4; if (rs < 0) rs = 0; if (rs > 24) rs = 24; int cs = c - 8; if (cs < 0) cs = 0; if (cs > 48) cs = 48;
    const float* rpb = a.in[5] + (size_t)l * 8 * 15 * 31 + hd * 465;
    for (int kk = d; kk < 128; kk += 64) { const int i = kk / 16, j = kk % 16; const int tk = b * SEQ + (rs + i) * 64 + cs + j; float acc = 0.f;
        for (int e = 0; e < 64; ++e) acc += qs[e] * bf2f(K[(size_t)tk * 512 + hd * 64 + e]);
        sc[kk] = acc + rpb[(rs + i - r + 7) * 31 + (cs + j - c + 15)]; }
    __syncthreads();
    float mx = -1e30f; for (int kk = 0; kk < 128; ++kk) mx = fmaxf(mx, sc[kk]);
    float den = 0.f, o = 0.f;
    for (int kk = 0; kk < 128; ++kk) { const int i = kk / 16, j = kk % 16; const int tk = b * SEQ + (rs + i) * 64 + cs + j; const float p = expf(sc[kk] - mx); den += p; o += p * bf2f(V[(size_t)tk * 512 + hd * 64 + d]); }
    o /= den;
    if (!near(bf2f(Y[(size_t)t * 512 + hd * 64 + d]), o, 0.04f, 0.04f)) atomicAdd(&ctl[CW_CNT + 31], 1u);
}
__global__ void __launch_bounds__(128) mk_check_ret(Args a, int l) {
    __shared__ float qs[128]; __shared__ float sc[SEQ]; __shared__ float red[128];
    const unsigned h = hash32(blockIdx.x * 1231u + 77u); const int t = (int)(h % T), hd = (int)((h >> 16) % 4), dv = threadIdx.x;
    unsigned char* ws = a.ws; unsigned* ctl = (unsigned*)(ws + WS_CTL);
    const bf16* Y = (const bf16*)(ws + WS_PROJ + 3 * BLK); const bf16* Q = (const bf16*)(ws + WS_PROJ + 4 * BLK); const bf16* K = (const bf16*)(ws + WS_PROJ + 5 * BLK); const bf16* V = (const bf16*)(ws + WS_PROJ + 7 * BLK);
    const int b = t / SEQ, n = t % SEQ;
    qs[dv] = bf2f(Q[(size_t)t * 512 + hd * 128 + dv]);
    __syncthreads();
    const float gf = log2_1m(__builtin_amdgcn_exp2f(-5.0f - (float)hd)), gb = log2_1m(__builtin_amdgcn_exp2f(-5.5f - (float)hd));
    for (int m = dv; m < SEQ; m += 128) { float acc = 0.f; for (int e = 0; e < 128; ++e) acc += qs[e] * bf2f(K[(size_t)(b * SEQ + m) * 512 + hd * 128 + e]);
        sc[m] = acc * (m <= n ? __builtin_amdgcn_exp2f(gf * (float)(n - m)) : __builtin_amdgcn_exp2f(gb * (float)(m - n))); }
    __syncthreads();
    float o = 0.f; for (int m = 0; m < SEQ; ++m) o += sc[m] * bf2f(V[(size_t)(b * SEQ + m) * 512 + hd * 128 + dv]);
    red[dv] = o * o; __syncthreads();
    float ms = 0.f; for (int e = 0; e < 128; ++e) ms += red[e];
    const float rn = 1.0f / sqrtf(ms / 128.0f + RMS_EPS);
    const float g = bf2f((bf16)f2bf(orig_proj(a, l, t, 1536 + 3 * 512 + hd * 128 + dv)));
    const float y = g / (1.0f + expf(-g)) * o * rn * a.in[6][(size_t)l * 512 + hd * 128 + dv];
    if (!near(bf2f(Y[(size_t)t * 512 + hd * 128 + dv]), y, 0.04f, 0.04f)) atomicAdd(&ctl[CW_CNT + 32], 1u);
}
__global__ void __launch_bounds__(128) mk_check_g(Args a, int l, int code) {
    const unsigned h = hash32(blockIdx.x * 1231u + 77u); const int t = (int)(h % T), hd = (int)((h >> 16) % 4), dv = threadIdx.x;
    unsigned* ctl = (unsigned*)(a.ws + WS_CTL);
    const bf16* G = (const bf16*)(a.ws + WS_PROJ + 3 * BLK);
    const float g = orig_proj(a, l, t, 1536 + 3 * 512 + hd * 128 + dv);
    if (!near(bf2f(G[(size_t)t * 512 + hd * 128 + dv]), g, 0.03f, 0.03f)) atomicAdd(&ctl[CW_CNT + code], 1u);
}
__global__ void __launch_bounds__(64) mk_check_lru(Args a, int l) {
    __shared__ float xs[64];
    const unsigned h = hash32(blockIdx.x * 733u + 5u); const int b = (int)(h % 8), blk = (int)((h >> 8) % 8), ts = (int)((h >> 16) % SEQ), j = threadIdx.x, ch = blk * 64 + j;
    unsigned char* ws = a.ws; unsigned* ctl = (unsigned*)(ws + WS_CTL);
    const bf16* XC = (const bf16*)(ws + WS_PROJ + 8 * BLK); const bf16* Y = (const bf16*)(ws + WS_PROJ + 6 * BLK);
    const float* cw = a.in[7] + (size_t)l * 2048; const float cb = a.in[8][(size_t)l * 512 + ch];
    float hsum = 0.f;
    for (int dir = 0; dir < 2; ++dir) {
        const float* wa = a.in[9] + (((size_t)l * 2 + dir) * 8 + blk) * 4096; const float* wx = a.in[11] + (((size_t)l * 2 + dir) * 8 + blk) * 4096;
        const float ba = a.in[10][((size_t)l * 2 + dir) * 512 + ch], bx = a.in[12][((size_t)l * 2 + dir) * 512 + ch], lam = a.in[13][((size_t)l * 2 + dir) * 512 + ch];
        const float sp = log1pf(expf(-lam));
        float hh = 0.f;
        const int nsteps = dir == 0 ? ts + 1 : SEQ - ts;
        for (int st = 0; st < nsteps; ++st) {
            const int t = dir == 0 ? st : SEQ - 1 - st;
            float xf = cb;
            for (int w = 0; w < 4; ++w) { const int t2 = t + w - 2; if (t2 >= 0 && t2 < SEQ) xf += cw[w * 512 + ch] * bf2f(XC[(size_t)(b * SEQ + t2) * 512 + ch]); }
            __syncthreads(); xs[j] = xf; __syncthreads();
            float ra = ba, ia = bx;
            for (int i = 0; i < 64; ++i) { ra += xs[i] * wa[i * 64 + j]; ia += xs[i] * wx[i * 64 + j]; }
            const float r = 1.0f / (1.0f + expf(-ra)), ig = 1.0f / (1.0f + expf(-ia));
            const float la = -8.0f * r * sp, av = expf(la); float mult = sqrtf(-expm1f(2.0f * la)); if (st == 0) mult = 1.0f;
            hh = av * hh + mult * ig * xf;
        }
        hsum += hh;
    }
    const float gc = bf2f((bf16)f2bf(orig_proj(a, l, b * SEQ + ts, 3584 + 512 + ch)));
    const float u = 0.7978845608028654f * (gc + 0.044715f * gc * gc * gc);
    const float y = 0.5f * gc * (1.0f + tanhf(u)) * hsum;
    if (!near(bf2f(Y[(size_t)(b * SEQ + ts) * 512 + ch]), y, 0.04f, 0.04f)) atomicAdd(&ctl[CW_CNT + 33], 1u);
}
__global__ void mk_report(Args a) {
    unsigned* ctl = (unsigned*)(a.ws + WS_CTL);
    const int order[13] = {1, 2, 35, 31, 34, 32, 33, 4, 5, 6, 7, 8, 9};
    const unsigned tot[13] = {16384u, 16384u, 16384u, 32768u, 16384u, 16384u, 8192u, 16384u, 16384u, 16384u, 16384u, 16384u, 64u};
    for (int i = 0; i < 13; ++i) {
        const unsigned cnt = ctl[CW_CNT + order[i]];
        if (cnt * 200u > tot[i]) {
            unsigned tenth = (cnt * 10u) / tot[i]; if (tenth > 9u) tenth = 9u;
            a.out[0] = order[i] >= 10 ? 100.0f * (float)order[i] : 1000.0f * (float)order[i] + 100.0f * (float)tenth;
            return;
        }
    }
}
#endif

#ifndef MK_ONE_LAUNCH
#define MK_ONE_LAUNCH 1
#endif
extern "C" void kernel_launch(void* const* d_in, const int* in_sizes, int n_in, void* d_out, int out_size, void* d_ws, size_t ws_size, hipStream_t stream) {
    static int grid = 0;
    if (grid == 0) {
        if (n_in != 23 || in_sizes[0] != T * D || out_size != T * D || ws_size < WS_END) { fprintf(stderr, "kernel_launch: unexpected shapes (n_in %d, in0 %d, out %d, ws %zu); nothing launched\n", n_in, n_in > 0 ? in_sizes[0] : -1, out_size, ws_size); grid = -1; return; }
        int dev = 0, cus = 0, per_cu = 0;
        if (hipGetDevice(&dev) != hipSuccess || hipDeviceGetAttribute(&cus, hipDeviceAttributeMultiprocessorCount, dev) != hipSuccess) { grid = -1; return; }
        if (hipFuncSetAttribute((const void*)mk_fwd, hipFuncAttributeMaxDynamicSharedMemorySize, LDS_BYTES) != hipSuccess) { fprintf(stderr, "kernel_launch: hipFuncSetAttribute failed\n"); grid = -1; return; }
        if (hipOccupancyMaxActiveBlocksPerMultiprocessor(&per_cu, (const void*)mk_fwd, NWAVES * 64, LDS_BYTES) != hipSuccess || per_cu < 1) { fprintf(stderr, "kernel_launch: occupancy query says %d blocks per CU\n", per_cu); }
        (void)hipGetLastError();
        grid = cus;
    }
    if (grid < 0) return;
    if (hipMemsetAsync((char*)d_ws + WS_CTL, 0, CTL_ZERO_BYTES, stream) != hipSuccess) return;
    Args a{};
    for (int i = 0; i < 23; ++i) a.in[i] = (const float*)d_in[i];
    a.out = (float*)d_out; a.ws = (unsigned char*)d_ws;
#if MK_ONE_LAUNCH
    a.ph_lo = 0; a.ph_hi = NPH;
    hipLaunchKernelGGL(mk_fwd, dim3(grid), dim3(NWAVES * 64), LDS_BYTES, stream, a);
#else
    for (int ph = 0; ph < NPH; ++ph) {
#if MK_CHECK
        if (ph == 1 + 6) (void)hipMemcpyAsync((char*)d_ws + WS_XB, (char*)d_ws + WS_GATE8, (size_t)T * D * 2, hipMemcpyDeviceToDevice, stream);
#endif
        a.ph_lo = ph; a.ph_hi = ph + 1; hipLaunchKernelGGL(mk_fwd, dim3(grid), dim3(NWAVES * 64), LDS_BYTES, stream, a);
#if MK_CHECK
        { int st = 0; if (ph == 0) st = 1; else if (ph == 1) st = 2; else if (ph == 1 + 3) st = 4; else if (ph == 1 + 4) st = 5; else if (ph == 1 + 5) st = 6; else if (ph == 1 + 6) st = 7; else if (ph == 1 + 7) st = 8;
          if (st) hipLaunchKernelGGL(mk_check, dim3(64), dim3(256), 0, stream, a, st);
          if (ph == 1 + 1) hipLaunchKernelGGL(mk_check_na, dim3(512), dim3(64), 0, stream, a, 0);
          if (ph == 1) hipLaunchKernelGGL(mk_check_g, dim3(128), dim3(128), 0, stream, a, 0, 35);
          if (ph == 1 + 1) hipLaunchKernelGGL(mk_check_g, dim3(128), dim3(128), 0, stream, a, 0, 34);
          if (ph == 1 + 2) hipLaunchKernelGGL(mk_check_ret, dim3(128), dim3(128), 0, stream, a, 0);
          if (ph == 1 + 2) hipLaunchKernelGGL(mk_check_lru, dim3(128), dim3(64), 0, stream, a, 0);
          if (ph == NPH - 1) hipLaunchKernelGGL(mk_check, dim3(1), dim3(64), 0, stream, a, 9); }
#endif
    }
#if MK_CHECK
    hipLaunchKernelGGL(mk_report, dim3(1), dim3(1), 0, stream, a);
#endif
#endif
}
```

```cpp
#include <hip/hip_runtime.h>
#include <cstdio>
#include <cstdint>
#ifndef MK_CHECK
#define MK_CHECK 0
#endif
#ifndef PROBE_WN
#define PROBE_WN 0x0ull
#endif
namespace pg8 {
#define PG8_LAS __attribute__((address_space(3)))
typedef unsigned short bf16_t;
typedef short bf16x8 __attribute__((ext_vector_type(8)));
typedef float f32x4 __attribute__((ext_vector_type(4)));
typedef unsigned u32x4 __attribute__((ext_vector_type(4)));
constexpr int BM = 256, BK = 64, HALF = 128, HTB = HALF * BK * 2  , STAGE_BYTES = 8 * HTB, NXCD = 8, WGM = 8;

__host__ __device__ __forceinline__ int lds_byte(int r, int c) { const int st = (r >> 4) * 2 + (c >> 5), rr = r & 15, cc = c & 31, ob = rr * 64 + cc * 2; return st * 1024 + (ob ^ (((ob >> 9) & 1) << 5)); }
__host__ __device__ __forceinline__ void stage_rc(int b, int& R, int& C) { const int st = b / 1024, sb = b % 1024, swz = sb ^ (((sb >> 9) & 1) << 5); R = (st >> 1) * 16 + swz / 64; C = (st & 1) * 32 + (swz % 64) / 2; }
__host__ __device__ __forceinline__ int perm32(int rho) { const int n = rho >> 4, i = rho & 15; return 8 * (i >> 2) + 4 * n + (i & 3); }

struct Unit { int pm, pn, z; };
struct Gemm { const bf16_t* A; const bf16_t* Bt; int M, N, K; size_t zA, zB; };

struct StaticOrder {
    int nM, nN, nwg, G, c;
    __host__ __device__ void init(int M, int N, int G_, int c_) { nM = M / BM; nN = N / BM; nwg = nM * nN; G = G_; c = c_; }
    __host__ __device__ bool next(int i, Unit& u) const {
        const long L = (long)i * G + c; if (L >= nwg) return false;
        int wgid = (int)L; { const int q = nwg / NXCD, r = nwg % NXCD, xcd = wgid % NXCD, off = wgid / NXCD; wgid = (xcd < r ? xcd * (q + 1) : r * (q + 1) + (xcd - r) * q) + off; }
        const int nig = WGM * nN, gid = wgid / nig, fm = gid * WGM, gsz = (nM - fm) < WGM ? (nM - fm) : WGM;
        u.pm = fm + ((wgid % nig) % gsz); u.pn = (wgid % nig) / gsz; u.z = 0; return true;
    }
    __device__ __forceinline__ void a_ready(const Unit&) const {}
    __device__ __forceinline__ void done(const Unit&) const {}
};

__device__ __forceinline__ unsigned cvt_pk_bf16(float lo, float hi) { unsigned r; asm volatile("v_cvt_pk_bf16_f32 %0, %1, %2" : "=v"(r) : "v"(lo), "v"(hi)); return r; }
typedef float f32x2 __attribute__((ext_vector_type(2)));
template <class Epi, class Sched, bool ALIGN_EPI = false, bool SP2 = false>
__device__ __forceinline__ void gemm_phase(PG8_LAS unsigned char* lds, const Gemm g, const Sched& S, const Epi& E, const int tid) {
    const int wid = __builtin_amdgcn_readfirstlane(tid >> 6), lane = tid & 63, wr = wid >> 2, wc = wid & 3, fr = lane & 15, fq = lane >> 4;
    const int K = g.K, nt = K / BK;
    unsigned voffA[2], voffB[2];
#pragma unroll
    for (int i = 0; i < 2; ++i) { int R, C; stage_rc(tid * 16 + i * 8192, R, C); const int Rb = Epi::PERM ? ((R & ~31) + perm32(R & 31)) : R;
        voffA[i] = (unsigned)(R * K + C) * 2u; voffB[i] = (unsigned)(Rb * K + C) * 2u; }
    const size_t kstep = (size_t)(BK * 2);
    const size_t hstep = (size_t)HALF * K * 2;
    const size_t tstep = 2 * hstep;
    const unsigned ldsw = (unsigned)wid * 1024u;
    const int aoff = lds_byte(wr * 64 + fr, fq * 8), boff = lds_byte(wc * 32 + fr, fq * 8);
#define PG8_SA(b, h) (((b) * 2 + (h)) * HTB)
#define PG8_SB(b, h) ((4 + (b) * 2 + (h)) * HTB)
#define PG8_STAGE(bufoff, gbase, voff) do { _Pragma("unroll") for (int _i = 0; _i < 2; ++_i) \
        __builtin_amdgcn_global_load_lds((const unsigned*)((const char*)(gbase) + (voff)[_i]), (PG8_LAS unsigned*)(lds + (bufoff) + ldsw + _i * 8192), 16, 0, 0); } while (0)
#define PG8_LDA(dst, b, h) do { _Pragma("unroll") for (int m = 0; m < 4; ++m) _Pragma("unroll") for (int k = 0; k < 2; ++k) dst[m][k] = *(const PG8_LAS bf16x8*)(lds + PG8_SA(b, h) + aoff + m * 2048 + k * 1024); } while (0)
#define PG8_LDB(dst, b, h) do { _Pragma("unroll") for (int n = 0; n < 2; ++n) _Pragma("unroll") for (int k = 0; k < 2; ++k) dst[n][k] = *(const PG8_LAS bf16x8*)(lds + PG8_SB(b, h) + boff + n * 2048 + k * 1024); } while (0)
#define PG8_MMA(ai, bj, At, Bt) do { __builtin_amdgcn_s_setprio(1); _Pragma("unroll") for (int m = 0; m < 4; ++m) _Pragma("unroll") for (int n = 0; n < 2; ++n) _Pragma("unroll") for (int k = 0; k < 2; ++k) \
        acc[ai][bj][m][n] = __builtin_amdgcn_mfma_f32_16x16x32_bf16(Bt[n][k], At[m][k], acc[ai][bj][m][n], 0, 0, 0); __builtin_amdgcn_s_setprio(0); } while (0)
#define PG8_WAIT_V(n) asm volatile("s_waitcnt vmcnt(" #n ")" ::: "memory")
#define PG8_WAIT_L(n) asm volatile("s_waitcnt lgkmcnt(" #n ")" ::: "memory")
#define PG8_BAR __builtin_amdgcn_s_barrier()
#define PG8_SCHED __builtin_amdgcn_sched_barrier(0)
    Unit cur, nxt; int ui = 0;
    if (!S.next(0, cur)) return;
    f32x4 acc[2][2][4][2];
#pragma unroll
    for (int a = 0; a < 2; ++a)
#pragma unroll
        for (int b = 0; b < 2; ++b)
#pragma unroll
            for (int m = 0; m < 4; ++m)
#pragma unroll
                for (int n = 0; n < 2; ++n) acc[a][b][m][n] = (f32x4){0.f, 0.f, 0.f, 0.f};
    bf16x8 At[4][2], B0[2][2], B1[2][2];
    const char* cA = (const char*)g.A + (size_t)cur.z * g.zA + (size_t)cur.pm * tstep; const char* cB = (const char*)g.Bt + (size_t)cur.z * g.zB + (size_t)cur.pn * tstep;
    S.a_ready(cur);
    if constexpr (SP2) {
        PG8_STAGE(PG8_SB(0, 0), cB, voffB); PG8_STAGE(PG8_SB(0, 1), cB + hstep, voffB); PG8_STAGE(PG8_SA(0, 0), cA, voffA); PG8_STAGE(PG8_SA(0, 1), cA + hstep, voffA);
        if (wr == 1) PG8_BAR;
        PG8_WAIT_V(2); PG8_BAR;
        PG8_STAGE(PG8_SB(1, 0), cB + kstep, voffB); PG8_STAGE(PG8_SA(1, 0), cA + kstep, voffA); PG8_STAGE(PG8_SB(1, 1), cB + hstep + kstep, voffB);
        PG8_WAIT_V(6); PG8_BAR;
    } else {
        PG8_STAGE(PG8_SB(0, 0), cB, voffB); PG8_STAGE(PG8_SA(0, 0), cA, voffA); PG8_STAGE(PG8_SB(0, 1), cB + hstep, voffB); PG8_STAGE(PG8_SA(0, 1), cA + hstep, voffA);
        if (wr == 1) PG8_BAR;
        PG8_WAIT_V(4); PG8_BAR;
        PG8_STAGE(PG8_SB(1, 0), cB + kstep, voffB); PG8_STAGE(PG8_SA(1, 0), cA + kstep, voffA); PG8_STAGE(PG8_SB(1, 1), cB + hstep + kstep, voffB);
        PG8_WAIT_V(6); PG8_BAR;
    }
    for (;;) {
        const bool has_next = S.next(ui + 1, nxt);
        const char* nA = has_next ? (const char*)g.A + (size_t)nxt.z * g.zA + (size_t)nxt.pm * tstep : cA; const char* nB = has_next ? (const char*)g.Bt + (size_t)nxt.z * g.zB + (size_t)nxt.pn * tstep : cB;
        for (int t = 0; t < nt; t += 2) {
            const bool last = (t == nt - 2);
            const char* a1 = cA + (size_t)(t + 1) * kstep;
            const char* a2 = last ? nA : cA + (size_t)(t + 2) * kstep; const char* b2 = last ? nB : cB + (size_t)(t + 2) * kstep;
            const char* a3 = a2 + kstep; const char* b3 = b2 + kstep;
            if (last && has_next) S.a_ready(nxt);
            if constexpr (SP2) {
            PG8_LDB(B0, 0, 0); PG8_LDB(B1, 0, 1); PG8_SCHED; PG8_LDA(At, 0, 0); PG8_STAGE(PG8_SA(1, 1), a1 + hstep, voffA);
            PG8_WAIT_V(8); PG8_WAIT_L(0); PG8_BAR; PG8_MMA(0, 0, At, B0); PG8_MMA(0, 1, At, B1); PG8_BAR; PG8_SCHED;
            PG8_LDA(At, 0, 1); PG8_STAGE(PG8_SB(0, 0), b2, voffB); PG8_STAGE(PG8_SB(0, 1), b2 + hstep, voffB); PG8_STAGE(PG8_SA(0, 0), a2, voffA);
            PG8_WAIT_V(8); PG8_WAIT_L(0); PG8_BAR; PG8_MMA(1, 0, At, B0); PG8_MMA(1, 1, At, B1); PG8_BAR; PG8_SCHED;
            PG8_LDB(B0, 1, 0); PG8_LDB(B1, 1, 1); PG8_SCHED; PG8_LDA(At, 1, 0); PG8_STAGE(PG8_SA(0, 1), a2 + hstep, voffA);
            PG8_WAIT_V(8); PG8_WAIT_L(0); PG8_BAR; PG8_MMA(0, 0, At, B0); PG8_MMA(0, 1, At, B1); PG8_BAR; PG8_SCHED;
            PG8_LDA(At, 1, 1); PG8_STAGE(PG8_SB(1, 0), b3, voffB); PG8_STAGE(PG8_SB(1, 1), b3 + hstep, voffB); PG8_STAGE(PG8_SA(1, 0), a3, voffA);
            PG8_WAIT_V(8); PG8_WAIT_L(0); PG8_BAR; PG8_MMA(1, 0, At, B0); PG8_MMA(1, 1, At, B1); PG8_BAR; PG8_SCHED;
            } else {
            PG8_LDB(B0, 0, 0); PG8_SCHED; PG8_LDA(At, 0, 0); PG8_STAGE(PG8_SA(1, 1), a1 + hstep, voffA);
            PG8_WAIT_L(8); PG8_BAR; PG8_WAIT_L(0); PG8_MMA(0, 0, At, B0); PG8_BAR; PG8_SCHED;
            PG8_LDB(B1, 0, 1); PG8_STAGE(PG8_SB(0, 0), b2, voffB);
            PG8_BAR; PG8_WAIT_L(0); PG8_MMA(0, 1, At, B1); PG8_BAR;
            PG8_LDA(At, 0, 1); PG8_STAGE(PG8_SA(0, 0), a2, voffA);
            PG8_BAR; PG8_WAIT_L(0); PG8_MMA(1, 0, At, B0); PG8_BAR; PG8_SCHED;
            PG8_STAGE(PG8_SB(0, 1), b2 + hstep, voffB);
            PG8_WAIT_V(6); PG8_BAR; PG8_MMA(1, 1, At, B1); PG8_BAR;
            PG8_LDB(B0, 1, 0); PG8_SCHED; PG8_LDA(At, 1, 0); PG8_STAGE(PG8_SA(0, 1), a2 + hstep, voffA);
            PG8_WAIT_L(8); PG8_BAR; PG8_WAIT_L(0); PG8_MMA(0, 0, At, B0); PG8_BAR; PG8_SCHED;
            PG8_LDB(B1, 1, 1); PG8_STAGE(PG8_SB(1, 0), b3, voffB);
            PG8_BAR; PG8_WAIT_L(0); PG8_MMA(0, 1, At, B1); PG8_BAR;
            PG8_LDA(At, 1, 1); PG8_STAGE(PG8_SA(1, 0), a3, voffA);
            PG8_BAR; PG8_WAIT_L(0); PG8_MMA(1, 0, At, B0); PG8_BAR; PG8_SCHED;
            PG8_STAGE(PG8_SB(1, 1), b3 + hstep, voffB);
            PG8_WAIT_V(6); PG8_BAR; PG8_MMA(1, 1, At, B1); PG8_BAR;
            }
        }
        if constexpr (ALIGN_EPI) { if (wr == 0) PG8_BAR; }
        if constexpr (!Epi::AFTER_DRAIN) { E(acc, cur, wr, wc, fr, fq); S.done(cur); }
        if (!has_next) break;
        if constexpr (!Epi::KEEP_ACC)
#pragma unroll
        for (int a = 0; a < 2; ++a)
#pragma unroll
            for (int b = 0; b < 2; ++b)
#pragma unroll
                for (int m = 0; m < 4; ++m)
#pragma unroll
                    for (int n = 0; n < 2; ++n) acc[a][b][m][n] = (f32x4){0.f, 0.f, 0.f, 0.f};
        cur = nxt; cA = nA; cB = nB; ++ui;
        if constexpr (ALIGN_EPI) { if (wr == 1) PG8_BAR; }
    }
    PG8_WAIT_V(0);
    if constexpr (!ALIGN_EPI) { if (wr == 0) PG8_BAR; }
    PG8_BAR;
    if constexpr (Epi::AFTER_DRAIN) { E.fused(acc, cur, wr, wc, fr, fq, lds, wid, lane); S.done(cur); }
#undef PG8_SA
#undef PG8_SB
#undef PG8_STAGE
#undef PG8_LDA
#undef PG8_LDB
#undef PG8_MMA
#undef PG8_WAIT_V
#undef PG8_WAIT_L
#undef PG8_BAR
#undef PG8_SCHED
}
}

constexpr int T = 16384, D = 1024, SEQ = 2048, DEPTH = 2, FF = 4096, PLE = 256;
constexpr float RMS_EPS = 1e-6f;
constexpr size_t MiB = 1u << 20;
constexpr size_t WS_CTL = 0, CTL_ZERO_BYTES = 65536;
constexpr size_t WS_TAB = 1 * MiB;
constexpr size_t WS_SSA = 2 * MiB, WS_SSB = 3 * MiB;
constexpr size_t WS_PROJ = 6 * MiB, BLK = 16 * MiB;
constexpr size_t WS_GATE8 = 150 * MiB;
constexpr size_t WS_XB = 198 * MiB;
constexpr size_t WS_W = 230 * MiB, WS_END = 256 * MiB;
constexpr size_t W_IN = WS_W, W_UP = WS_W, W_DOWN = WS_W + 8 * MiB, W_BR = WS_W + 16 * MiB, W_OUT = WS_W + 19 * MiB;
__host__ __device__ constexpr size_t W_G(int slot) { return WS_W + 21 * MiB + (size_t)slot * (5 * MiB / 2); }
__host__ __device__ constexpr size_t W_PLE(int slot) { return W_G(slot) + 2 * MiB; }
constexpr size_t WS_U = WS_PROJ;
constexpr size_t WS_E = WS_PROJ;
constexpr size_t WS_PB = WS_PROJ + 8 * BLK;
constexpr size_t WS_HF = WS_PROJ + 1 * BLK;
constexpr size_t WS_AGG = 4 * MiB;
constexpr size_t WS_LW = 5 * MiB;
constexpr size_t WS_SP = 5 * MiB + 512 * 1024;
constexpr size_t WS_MERGED = WS_PROJ + 1 * BLK;
constexpr size_t WS_ST = WS_XB;
constexpr int CW_TMO = 0, CW_BAR = 4096;

enum { PH_PRO = 0, PH_G1, PH_MIXA, PH_MIXB, PH_G2, PH_G3, PH_G4, PH_G5, PH_G6, PH_FIN };
constexpr int NPL = 8, NPH = 1 + DEPTH * NPL + 1;

constexpr int NWAVES = 8;
constexpr int RING_BYTES = 131072, LDS_BYTES = 155648, LDSCTL_OFF = LDS_BYTES - 1024, MISC_OFF = LDSCTL_OFF + 320;

#define GAS __attribute__((address_space(1)))
#define LAS __attribute__((address_space(3)))
typedef unsigned short bf16;
typedef unsigned v4u __attribute__((ext_vector_type(4)));
typedef unsigned v2u __attribute__((ext_vector_type(2)));
typedef float f32x4 __attribute__((ext_vector_type(4)));
typedef GAS unsigned gu32;
#define RLX_AGENT __ATOMIC_RELAXED, __HIP_MEMORY_SCOPE_AGENT
#define LDS_WAIT() asm volatile("s_waitcnt lgkmcnt(0)" ::: "memory")
#define VM_WAIT() asm volatile("s_waitcnt vmcnt(0)" ::: "memory")
__device__ __forceinline__ unsigned f2bf(float f) { unsigned u = __builtin_bit_cast(unsigned, f); return (u + 0x7fffu + ((u >> 16) & 1u)) >> 16; }
__device__ __forceinline__ unsigned pk2(float lo, float hi) { return f2bf(lo) | (f2bf(hi) << 16); }
__device__ __forceinline__ float bf2f(unsigned short b) { return __builtin_bit_cast(float, (unsigned)b << 16); }
__device__ __forceinline__ float bflo(unsigned w) { return __builtin_bit_cast(float, w << 16); }
__device__ __forceinline__ float bfhi(unsigned w) { return __builtin_bit_cast(float, w & 0xffff0000u); }
__device__ __forceinline__ float rdlane(float v, int l) { return __builtin_bit_cast(float, __builtin_amdgcn_readlane(__builtin_bit_cast(int, v), l)); }
__device__ __forceinline__ float fexp(float x) { return __builtin_amdgcn_exp2f(x * 1.4426950408889634f); }
__device__ __forceinline__ float sigmoidf_(float x) { return __builtin_amdgcn_rcpf(1.0f + fexp(-x)); }
__device__ __forceinline__ float lane_get(float v, int srclane) { return __builtin_bit_cast(float, __builtin_amdgcn_ds_bpermute(srclane << 2, __builtin_bit_cast(int, v))); }
__device__ __forceinline__ float shx(float v, int lane, int o) { return lane_get(v, lane ^ o); }
__device__ __forceinline__ float wave_sum(float v, int lane) {
#pragma unroll
    for (int o = 1; o < 64; o <<= 1) v += shx(v, lane, o);
    return v;
}
__device__ __forceinline__ float wave_max(float v, int lane) {
#pragma unroll
    for (int o = 1; o < 64; o <<= 1) v = fmaxf(v, shx(v, lane, o));
    return v;
}
__device__ __forceinline__ float log2_1m(float x) {
    const float p = x * (1.0f + x * (0.5f + x * (0.33333333f + x * (0.25f + x * (0.2f + x * (0.16666667f + x * 0.14285714f))))));
    return -p * 1.4426950408889634f;
}
__device__ __forceinline__ float log1p_small(float y) {
    if (y < 0.01f) return y * (1.0f - y * (0.5f - y * (0.33333333f - 0.25f * y)));
    return __builtin_amdgcn_logf(1.0f + y) * 0.6931471805599453f;
}
__device__ __forceinline__ float gelu_tanh(float x) {
    const float u = 0.7978845608028654f * (x + 0.044715f * x * x * x);
    const float t = 1.0f - 2.0f * __builtin_amdgcn_rcpf(1.0f + fexp(2.0f * u));
    return 0.5f * x * (1.0f + t);
}
__device__ __forceinline__ float row_rs(const float* ss, int row, int fq, int lane) {
    const f32x4 a = *(const f32x4*)(ss + (size_t)row * 16 + 4 * fq);
    float s = (a.x + a.y) + (a.z + a.w);
    s += shx(s, lane, 16); s += shx(s, lane, 32);
    return 1.0f / sqrtf(s * (1.0f / D) + RMS_EPS);
}

#define XB_TMO      128
#define XB_XCNT(j)  (256  + 64 * (j))
#define XB_XSUB(j)  (1280 + 64 * (j))
#define XB_XGEN(j)  (2304 + 64 * (j))
#define XB_TOP      3328
#define XB_TOPGEN   3392
#define XCD_BAR_WORDS 3456
#define XB_SPIN_CAP (1u << 18)

__device__ __forceinline__ unsigned xb_ld(unsigned* p)              { return __hip_atomic_load(p, __ATOMIC_RELAXED, __HIP_MEMORY_SCOPE_AGENT); }
__device__ __forceinline__ unsigned xb_add(unsigned* p, unsigned v) { return __hip_atomic_fetch_add(p, v, __ATOMIC_RELAXED, __HIP_MEMORY_SCOPE_AGENT); }
__device__ __forceinline__ unsigned xb_xcc_id() { return (unsigned)__builtin_amdgcn_s_getreg((3 << 11) | 20) & 0xFu; }
#define XB_SPIN(cond, bar) do { unsigned _sp = 0; while (cond) { __builtin_amdgcn_s_sleep(1); \
    if ((++_sp & 255u) == 0u) { if (xb_ld(&(bar)[XB_TMO])) break; if (_sp > XB_SPIN_CAP) { atomicAdd(&(bar)[XB_TMO], 1u); break; } } } } while (0)

struct XcdBarrier {
    unsigned* bar; unsigned x;
    volatile LAS unsigned* st;
};

__device__ __forceinline__ XcdBarrier xcd_barrier_post(unsigned* bar, volatile LAS unsigned* st) {
    XcdBarrier b; b.bar = bar; b.x = xb_xcc_id(); b.st = st;
    if (threadIdx.x == 0) (void)xb_add(&bar[XB_XCNT(b.x)], 1u);
    return b;
}
__device__ __forceinline__ void xcd_barrier_complete(unsigned* bar, unsigned x, unsigned& nloc, unsigned& nx) {
    const unsigned G = gridDim.x * gridDim.y * gridDim.z;
    unsigned sum, cnt, mine, sp = 0u;
    for (;;) {
        sum = 0u; cnt = 0u; mine = 0u;
#pragma unroll
        for (unsigned j = 0; j < 16; ++j) { const unsigned c = xb_ld(&bar[XB_XCNT(j)]); sum += c; cnt += (c > 0u) ? 1u : 0u; mine = (j == x) ? c : mine; }
        if (sum == G) break;
        __builtin_amdgcn_s_sleep(1);
        if ((++sp & 255u) == 0u) { if (xb_ld(&bar[XB_TMO])) break; if (sp > XB_SPIN_CAP) { atomicAdd(&bar[XB_TMO], 1u); break; } }
    }
    nloc = mine > 0u ? mine : 1u; nx = cnt > 0u ? cnt : 1u;
}

__device__ __forceinline__ void xcd_barrier(const XcdBarrier& b, const int tid_) {
    asm volatile("s_waitcnt vmcnt(0)" ::: "memory");
    __syncthreads();
    if (tid_ == 0) {
        unsigned* bar = b.bar;
        __builtin_amdgcn_s_waitcnt(0);
        unsigned nloc = b.st[0], nx = b.st[1];
        if (nloc == 0u) { xcd_barrier_complete(bar, b.x, nloc, nx); b.st[0] = nloc; b.st[1] = nx; }
        const unsigned old = xb_add(&bar[XB_XSUB(b.x)], 1u);
        const unsigned gen = old / nloc;
        if (old + 1u == (gen + 1u) * nloc) {
            __builtin_amdgcn_fence(__ATOMIC_RELEASE, "agent");
            asm volatile("s_waitcnt vmcnt(0)" ::: "memory");
            const unsigned og = xb_add(&bar[XB_TOP], 1u);
            const unsigned tg = og / nx;
            if (og + 1u == (tg + 1u) * nx) xb_add(&bar[XB_TOPGEN], 1u);
            else XB_SPIN(xb_ld(&bar[XB_TOPGEN]) == tg, bar);
            __builtin_amdgcn_fence(__ATOMIC_ACQUIRE, "agent");
            xb_add(&bar[XB_XGEN(b.x)], 1u);
            asm volatile("s_waitcnt vmcnt(0)" ::: "memory");
        } else {
            XB_SPIN(xb_ld(&bar[XB_XGEN(b.x)]) == gen, bar);
            __builtin_amdgcn_fence(__ATOMIC_ACQUIRE, "agent");
            asm volatile("s_waitcnt vmcnt(0)" ::: "memory");
        }
    }
    __syncthreads();
}


using pg8::Unit; using pg8::bf16_t; using pg8::cvt_pk_bf16;
typedef pg8::u32x4 u32x4;
struct EpiG1 {
    static constexpr bool PERM = true, AFTER_DRAIN = false, KEEP_ACC = false;
    bf16_t* proj; unsigned char* gate8; const float* ss; const float* bgate; const float* tab;
    __device__ __forceinline__ void operator()(const f32x4 (&acc)[2][2][4][2], const Unit& u, int wr, int wc, int fr, int fq) const {
        const int pn = u.pn;
        float rsv[2][4];
#pragma unroll
        for (int ai = 0; ai < 2; ++ai)
#pragma unroll
            for (int m = 0; m < 4; ++m) { rsv[ai][m] = row_rs(ss, u.pm * 256 + ai * 128 + wr * 64 + m * 16 + fr, fq, fr + 16 * fq); if (m & 1) asm volatile("" : "+v"(rsv[ai][m - 1]), "+v"(rsv[ai][m]) :: "memory"); }
        if (pn < 18) {
            const int kind = pn >> 1, phys = (int)((0x683754210ull >> (4 * kind)) & 15ull);
            bf16_t* base = proj + (size_t)phys * ((size_t)T * 512);
            const int col0 = (pn & 1) * 256 + wc * 32 + 8 * fq;
            const float scale = kind == 0 ? 0.125f : (kind == 3 ? 0.08838834764831845f : 1.0f);
            const bool rope = (kind == 3) || (kind == 4);
#pragma unroll
            for (int ai = 0; ai < 2; ++ai)
#pragma unroll
                for (int m = 0; m < 4; ++m) {
                    const int row = u.pm * 256 + ai * 128 + wr * 64 + m * 16 + fr;
                    const float rs = rsv[ai][m] * scale;
                    bf16_t* rowp = base + (size_t)row * 512 + col0;
#pragma unroll
                    for (int bj = 0; bj < 2; ++bj) {
                        f32x4 v0 = acc[ai][bj][m][0] * rs, v1 = acc[ai][bj][m][1] * rs;
                        if (rope) {
                            const int cc = col0 + bj * 128, i0 = (cc & 127) >> 1, pos = row & (SEQ - 1);
                            const f32x4 cs = *(const f32x4*)(tab + pos * 64 + i0), sn = *(const f32x4*)(tab + 131072 + pos * 64 + i0);
                            f32x4 w0, w1;
                            w0[0] = v0[0] * cs[0] - v0[1] * sn[0]; w0[1] = v0[0] * sn[0] + v0[1] * cs[0];
                            w0[2] = v0[2] * cs[1] - v0[3] * sn[1]; w0[3] = v0[2] * sn[1] + v0[3] * cs[1];
                            w1[0] = v1[0] * cs[2] - v1[1] * sn[2]; w1[1] = v1[0] * sn[2] + v1[1] * cs[2];
                            w1[2] = v1[2] * cs[3] - v1[3] * sn[3]; w1[3] = v1[2] * sn[3] + v1[3] * cs[3];
                            v0 = w0; v1 = w1;
                        }
                        u32x4 w; w.x = cvt_pk_bf16(v0[0], v0[1]); w.y = cvt_pk_bf16(v0[2], v0[3]); w.z = cvt_pk_bf16(v1[0], v1[1]); w.w = cvt_pk_bf16(v1[2], v1[3]);
                        *(u32x4*)(rowp + bj * 128) = w;
                    }
                }
        } else {
            const int g0 = (pn - 18) * 256 + wc * 32 + 8 * fq;
#pragma unroll
            for (int ai = 0; ai < 2; ++ai)
#pragma unroll
                for (int m = 0; m < 4; ++m) {
                    const int row = u.pm * 256 + ai * 128 + wr * 64 + m * 16 + fr;
                    const float rs = rsv[ai][m];
#pragma unroll
                    for (int bj = 0; bj < 2; ++bj) {
                        const int gc = g0 + bj * 128;
                        const f32x4 b0 = *(const f32x4*)(bgate + gc), b1 = *(const f32x4*)(bgate + gc + 4);
                        const f32x4 v0 = acc[ai][bj][m][0] * rs + b0, v1 = acc[ai][bj][m][1] * rs + b1;
                        unsigned lo = 0, hi = 0;
#pragma unroll
                        for (int e = 0; e < 4; ++e) {
                            lo |= (unsigned)(sigmoidf_(v0[e]) * 255.0f + 0.5f) << (8 * e);
                            hi |= (unsigned)(sigmoidf_(v1[e]) * 255.0f + 0.5f) << (8 * e);
                        }
                        v2u w; w.x = lo; w.y = hi;
                        *(v2u*)(gate8 + (size_t)row * 3072 + gc) = w;
                    }
                }
        }
    }
};
struct EpiG2 {
    static constexpr bool PERM = false, AFTER_DRAIN = false, KEEP_ACC = true;
    const unsigned char* gate8; bf16_t* merged;
    __device__ __forceinline__ void operator()(f32x4 (&acc)[2][2][4][2], const Unit& u, int wr, int wc, int fr, int fq) const {
        const int col0 = u.pn * 256 + wc * 32 + 4 * fq;
#pragma unroll
        for (int ai = 0; ai < 2; ++ai)
#pragma unroll
            for (int m = 0; m < 4; ++m) {
                const int row = u.pm * 256 + ai * 128 + wr * 64 + m * 16 + fr;
#pragma unroll
                for (int bj = 0; bj < 2; ++bj)
#pragma unroll
                    for (int n = 0; n < 2; ++n) {
                        const int c = col0 + bj * 128 + n * 16;
                        const unsigned ga = *(const unsigned*)(gate8 + (size_t)row * 3072 + u.z * 1024 + c);
                        f32x4 t = acc[ai][bj][m][n];
                        if (u.z < 2) {
                            const unsigned gb = *(const unsigned*)(gate8 + (size_t)row * 3072 + (u.z + 1) * 1024 + c);
#pragma unroll
                            for (int e = 0; e < 4; ++e) { const float a = (float)max((ga >> (8 * e)) & 255u, 1u), b = (float)max((gb >> (8 * e)) & 255u, 1u); t[e] = t[e] * a * __builtin_amdgcn_rcpf(b); }
                            acc[ai][bj][m][n] = t;
                        } else {
#pragma unroll
                            for (int e = 0; e < 4; ++e) t[e] *= (float)max((ga >> (8 * e)) & 255u, 1u) * (1.0f / 255.0f);
                            v2u w; w.x = cvt_pk_bf16(t[0], t[1]); w.y = cvt_pk_bf16(t[2], t[3]);
                            *(v2u*)(merged + (size_t)row * 1024 + c) = w;
                            acc[ai][bj][m][n] = (f32x4){0.f, 0.f, 0.f, 0.f};
                        }
                    }
                asm volatile("" ::: "memory");
            }
    }
};
struct EpiRes {
    static constexpr bool PERM = false, AFTER_DRAIN = false, KEEP_ACC = false;
    const float* basef; const bf16_t* baseb; bf16_t* xb; float* ssout;
    __device__ __forceinline__ void operator()(const f32x4 (&acc)[2][2][4][2], const Unit& u, int wr, int wc, int fr, int fq) const {
        const int col0 = u.pn * 256 + wc * 32 + 4 * fq;
#pragma unroll
        for (int ai = 0; ai < 2; ++ai)
#pragma unroll
            for (int m = 0; m < 4; ++m) {
                const int row = u.pm * 256 + ai * 128 + wr * 64 + m * 16 + fr;
                float s = 0.f;
#pragma unroll
                for (int bj = 0; bj < 2; ++bj)
#pragma unroll
                    for (int n = 0; n < 2; ++n) {
                        const size_t off = (size_t)row * 1024 + col0 + bj * 128 + n * 16;
                        f32x4 v;
                        if (basef) v = *(const f32x4*)(basef + off); else { const v2u bw = *(const v2u*)(baseb + off); v = (f32x4){bflo(bw.x), bfhi(bw.x), bflo(bw.y), bfhi(bw.y)}; }
                        v = v + acc[ai][bj][m][n];
                        v2u w; w.x = cvt_pk_bf16(v[0], v[1]); w.y = cvt_pk_bf16(v[2], v[3]);
                        *(v2u*)(xb + off) = w;
                        s += (v[0] * v[0] + v[1] * v[1]) + (v[2] * v[2] + v[3] * v[3]);
                    }
                s += shx(s, fr + 16 * fq, 16); s += shx(s, fr + 16 * fq, 32);
                if (fq == 0) ssout[(size_t)row * 16 + u.pn * 4 + wc] = s;
            }
    }
};
struct EpiG4 {
    static constexpr bool PERM = true, AFTER_DRAIN = false, KEEP_ACC = false;
    bf16_t* U; const float* ss;
    __device__ __forceinline__ void operator()(const f32x4 (&acc)[2][2][4][2], const Unit& u, int wr, int wc, int fr, int fq) const {
        const int col0 = u.pn * 256 + wc * 32 + 8 * fq;
        float rsv[2][4];
#pragma unroll
        for (int ai = 0; ai < 2; ++ai)
#pragma unroll
            for (int m = 0; m < 4; ++m) { rsv[ai][m] = row_rs(ss, u.pm * 256 + ai * 128 + wr * 64 + m * 16 + fr, fq, fr + 16 * fq); if (m & 1) asm volatile("" : "+v"(rsv[ai][m - 1]), "+v"(rsv[ai][m]) :: "memory"); }
#pragma unroll
        for (int ai = 0; ai < 2; ++ai)
#pragma unroll
            for (int m = 0; m < 4; ++m) {
                const int row = u.pm * 256 + ai * 128 + wr * 64 + m * 16 + fr;
                const float rs = rsv[ai][m];
                bf16_t* rowp = U + (size_t)row * FF + col0;
#pragma unroll
                for (int bj = 0; bj < 2; ++bj) {
                    f32x4 v0 = acc[ai][bj][m][0] * rs, v1 = acc[ai][bj][m][1] * rs;
#pragma unroll
                    for (int e = 0; e < 4; ++e) { const float a = fmaxf(v0[e], 0.f), b = fmaxf(v1[e], 0.f); v0[e] = a * a; v1[e] = b * b; }
                    u32x4 w; w.x = cvt_pk_bf16(v0[0], v0[1]); w.y = cvt_pk_bf16(v0[2], v0[3]); w.z = cvt_pk_bf16(v1[0], v1[1]); w.w = cvt_pk_bf16(v1[2], v1[3]);
                    *(u32x4*)(rowp + bj * 128) = w;
                }
            }
    }
};
struct EpiE {
    static constexpr bool PERM = false, AFTER_DRAIN = false, KEEP_ACC = false;
    bf16_t* E;
    __device__ __forceinline__ void operator()(const f32x4 (&acc)[2][2][4][2], const Unit& u, int wr, int wc, int fr, int fq) const {
        const int col0 = u.pn * 256 + wc * 32 + 4 * fq;
#pragma unroll
        for (int ai = 0; ai < 2; ++ai)
#pragma unroll
            for (int m = 0; m < 4; ++m) {
                const int row = u.pm * 256 + ai * 128 + wr * 64 + m * 16 + fr;
#pragma unroll
                for (int bj = 0; bj < 2; ++bj)
#pragma unroll
                    for (int n = 0; n < 2; ++n) { const f32x4 v = acc[ai][bj][m][n]; v2u w; w.x = cvt_pk_bf16(v[0], v[1]); w.y = cvt_pk_bf16(v[2], v[3]); *(v2u*)(E + (size_t)row * 1024 + col0 + bj * 128 + n * 16) = w; }
            }
    }
};
struct EpiG6 {
    static constexpr bool PERM = false, AFTER_DRAIN = false, KEEP_ACC = false;
    const bf16_t* baseb; bf16_t* xb; const float* ssin; float* ssout; const bf16_t* E;
    __device__ __forceinline__ void operator()(const f32x4 (&acc)[2][2][4][2], const Unit& u, int wr, int wc, int fr, int fq) const {
        const int col0 = u.pn * 256 + wc * 32 + 4 * fq;
#pragma unroll
        for (int ai = 0; ai < 2; ++ai)
#pragma unroll
            for (int m = 0; m < 4; ++m) {
                const int row = u.pm * 256 + ai * 128 + wr * 64 + m * 16 + fr;
                float rs = row_rs(ssin, row, fq, fr + 16 * fq); asm volatile("" : "+v"(rs) :: "memory");
                float s = 0.f;
#pragma unroll
                for (int bj = 0; bj < 2; ++bj)
#pragma unroll
                    for (int n = 0; n < 2; ++n) {
                        const size_t off = (size_t)row * 1024 + col0 + bj * 128 + n * 16;
                        const f32x4 a = acc[ai][bj][m][n] * rs; const v2u ew = *(const v2u*)(E + off); const f32x4 e = (f32x4){bflo(ew.x), bfhi(ew.x), bflo(ew.y), bfhi(ew.y)};
                        const v2u bw = *(const v2u*)(baseb + off); f32x4 v = (f32x4){bflo(bw.x), bfhi(bw.x), bflo(bw.y), bfhi(bw.y)};
#pragma unroll
                        for (int k = 0; k < 4; ++k) v[k] += sigmoidf_(a[k]) * e[k];
                        v2u w; w.x = cvt_pk_bf16(v[0], v[1]); w.y = cvt_pk_bf16(v[2], v[3]);
                        *(v2u*)(xb + off) = w;
                        s += (v[0] * v[0] + v[1] * v[1]) + (v[2] * v[2] + v[3] * v[3]);
                        if (n) asm volatile("" ::: "memory");
                    }
                s += shx(s, fr + 16 * fq, 16); s += shx(s, fr + 16 * fq, 32);
                if (fq == 0) ssout[(size_t)row * 16 + u.pn * 4 + wc] = s;
                asm volatile("" ::: "memory");
            }
    }
};
struct ZOrder {
    pg8::StaticOrder S;
    __device__ __forceinline__ bool next(int i, Unit& u) const { if (!S.next(i / 3, u)) return false; u.z = i % 3; return true; }
    __device__ __forceinline__ void a_ready(const Unit&) const {}
    __device__ __forceinline__ void done(const Unit&) const {}
};

struct Args { const float* in[23]; float* out; unsigned char* ws; int ph_lo, ph_hi; };
typedef const __attribute__((address_space(4))) Args CArgs;
__device__ __forceinline__ CArgs* get_args() {
    CArgs* p = (CArgs*)__builtin_amdgcn_kernarg_segment_ptr();
    asm volatile("" : "+s"(p));
    return p;
}
struct Frame {
    LAS unsigned char* lds;
    int tid, lane, wave, G, gw, ngw, bid;
    float* out; unsigned char* ws;
};

__device__ __forceinline__ void transpose_item(const float* W, const float* g, int K, int N, bf16* WT, LAS float* scr, int item, int lane) {
    const int nblk = N / 32, kb = item / nblk, nb = item % nblk, k0 = 64 * kb, n0 = 32 * nb;
#pragma unroll
    for (int i = 0; i < 32; ++i) { const int kk = 2 * i + (lane >> 5); float v = W[(size_t)(k0 + kk) * N + n0 + (lane & 31)]; if (g) v *= g[k0 + kk]; scr[kk * 33 + (lane & 31)] = v; }
    LDS_WAIT(); asm volatile("" ::: "memory");
    const int c = lane & 7;
#pragma unroll
    for (int j = 0; j < 4; ++j) { const int n = (lane >> 3) + 8 * j; const LAS float* s = scr + (8 * c) * 33 + n;
        v4u o; o.x = pk2(s[0 * 33], s[1 * 33]); o.y = pk2(s[2 * 33], s[3 * 33]); o.z = pk2(s[4 * 33], s[5 * 33]); o.w = pk2(s[6 * 33], s[7 * 33]);
        *(v4u*)(WT + (size_t)(n0 + n) * K + k0 + 8 * c) = o; }
    LDS_WAIT(); asm volatile("" ::: "memory");
}
__device__ __forceinline__ void convert_matrix(const Frame& F, const float* W, const float* g, int K, int N, bf16* WT) {
    LAS float* scr = (LAS float*)(F.lds + F.wave * 16384);
    const int nitems = (K / 64) * (N / 32);
    for (int it = F.gw; it < nitems; it += F.ngw) transpose_item(W, g, K, N, WT, scr, it, F.lane);
}
__device__ __forceinline__ void convert_layer_early(const Frame& F, CArgs* A, int l) {
    convert_matrix(F, A->in[3] + (size_t)l * D * 7680, A->in[2] + l * D, D, 7680, (bf16*)(F.ws + W_IN));
}
__device__ __forceinline__ void convert_layer_mid(const Frame& F, CArgs* A, int l) {
    for (int n = 0; n < 3; ++n) convert_matrix(F, A->in[14] + ((size_t)l * 3 + n) * 512 * D, nullptr, 512, D, (bf16*)(F.ws + W_BR) + (size_t)n * D * 512);
    convert_matrix(F, A->in[15] + (size_t)l * D * D, nullptr, D, D, (bf16*)(F.ws + W_OUT));
    convert_matrix(F, A->in[20] + (size_t)l * D * D, A->in[19] + l * D, D, D, (bf16*)(F.ws + W_G(l & 1)));
    convert_matrix(F, A->in[21] + (size_t)l * PLE * D, nullptr, PLE, D, (bf16*)(F.ws + W_PLE(l & 1)));
}
__device__ __forceinline__ void convert_layer_mlp(const Frame& F, CArgs* A, int l) {
    convert_matrix(F, A->in[17] + (size_t)l * D * FF, A->in[16] + l * D, D, FF, (bf16*)(F.ws + W_UP));
    convert_matrix(F, A->in[18] + (size_t)l * FF * D, nullptr, FF, D, (bf16*)(F.ws + W_DOWN));
}
__device__ __forceinline__ void convert_p(const Frame& F, CArgs* A, int l) {
    const f32x4* src = (const f32x4*)(A->in[1] + (size_t)l * T * PLE); v2u* dst = (v2u*)(F.ws + WS_PB);
    const int n4 = T * PLE / 4;
    for (int i = F.gw * 64 + F.lane; i < n4; i += F.ngw * 64) { const f32x4 v = src[i]; v2u w; w.x = pk2(v.x, v.y); w.y = pk2(v.z, v.w); dst[i] = w; }
}

__device__ __forceinline__ void phase_prologue(const Frame& F, CArgs* A) {
    convert_layer_early(F, A, 0); convert_layer_mid(F, A, 0);
    const float* x = A->in[0]; bf16* xb = (bf16*)(F.ws + WS_XB); float* ss = (float*)(F.ws + WS_SSB);
    for (int m = F.gw; m < T; m += F.ngw) {
        const f32x4* xr = (const f32x4*)(x + (size_t)m * D) + F.lane; v2u* o = (v2u*)(xb + (size_t)m * D) + F.lane;
        float s = 0.f;
#pragma unroll
        for (int j = 0; j < 4; ++j) { const f32x4 v = xr[64 * j]; s += (v.x * v.x + v.y * v.y) + (v.z * v.z + v.w * v.w); v2u w; w.x = pk2(v.x, v.y); w.y = pk2(v.z, v.w); o[64 * j] = w; }
        s = wave_sum(s, F.lane);
        if (F.lane < 16) ss[(size_t)m * 16 + F.lane] = F.lane == 0 ? s : 0.f;
    }
    { bf16* lw = (bf16*)(F.ws + WS_LW);
      for (int e = F.gw * 64 + F.lane; e < DEPTH * 2 * 2 * 8 * 4096; e += F.ngw * 64) {
          const int mat = e >> 12, j = (e >> 6) & 63, i = e & 63, blk = mat & 7, ax = (mat >> 3) & 1, ld = mat >> 4;
          const float* src = (ax ? A->in[11] : A->in[9]) + ((size_t)ld * 8 + blk) * 4096;
          lw[e] = (bf16)f2bf(src[i * 64 + j]); }
      float* sp = (float*)(F.ws + WS_SP);
      for (int e = F.gw * 64 + F.lane; e < DEPTH * 2 * 512; e += F.ngw * 64) sp[e] = log1p_small(fexp(-A->in[13][e])); }
    float* tab = (float*)(F.ws + WS_TAB);
    for (int e = F.gw * 64 + F.lane; e < SEQ * 64; e += F.ngw * 64) {
        const int pos = e >> 6, i = e & 63;
        const float theta = __builtin_amdgcn_exp2f(-(float)i * (13.287712379549449f / 63.0f));
        double rev = (double)pos * (double)theta * 0.15915494309189535; rev -= __builtin_floor(rev);
        const float fr = (float)rev;
        tab[e] = __builtin_amdgcn_cosf(fr); tab[131072 + e] = __builtin_amdgcn_sinf(fr);
    }
}


typedef short bf16x8_t __attribute__((ext_vector_type(8)));
typedef float f32x2_t __attribute__((ext_vector_type(2))); typedef __bf16 bf16x2_t __attribute__((ext_vector_type(2)));
__device__ __forceinline__ unsigned pkbf(float lo, float hi) { f32x2_t v = {lo, hi}; bf16x2_t b = __builtin_convertvector(v, bf16x2_t); return __builtin_bit_cast(unsigned, b); }
typedef short v4i16_t __attribute__((ext_vector_type(4)));
__device__ __forceinline__ v4i16_t ds_tr16(LAS const unsigned char* p) { return __builtin_amdgcn_ds_read_tr16_b64_v4i16((LAS v4i16_t*)p); }
__device__ __forceinline__ bf16x8_t tr_frag(LAS const unsigned char* p0, LAS const unsigned char* p1) {
    const v4i16_t a = ds_tr16(p0), b = ds_tr16(p1);
    return (bf16x8_t){a[0], a[1], a[2], a[3], b[0], b[1], b[2], b[3]};
}
#define MFMA16(a, b, c) __builtin_amdgcn_mfma_f32_16x16x32_bf16((a), (b), (c), 0, 0, 0)
constexpr int RP = 272;
__device__ __forceinline__ void ret_scan_item(const Frame& F, int item) {
    const int bh = item >> 3, dir = (item >> 2) & 1, dvq = item & 3, b = bh >> 2, h = bh & 3;
    const bf16* Kg = (const bf16*)(F.ws + WS_PROJ + 5 * BLK); const bf16* Vg = (const bf16*)(F.ws + WS_PROJ + 7 * BLK);
    bf16* ST = (bf16*)F.out;
    const float lg = log2_1m(__builtin_amdgcn_exp2f((dir ? -5.5f : -5.0f) - (float)h));
    const float cdec = __builtin_amdgcn_exp2f(128.0f * lg);
    constexpr int VP = 80, BUF = 128 * RP + 128 * VP;
    const int tid = F.tid, lane = F.lane, w = F.wave, g = lane >> 4, i = lane & 15, q4 = i >> 2, p4 = i & 3;
    v4u kr[4], vr;
    const int vrow = tid >> 2, vch = tid & 3;
#define RS_LOAD(c_) do { const size_t tb = (size_t)b * SEQ + (c_) * 128; \
        _Pragma("unroll") for (int q = 0; q < 4; ++q) { const int idx = tid + 512 * q; kr[q] = *(const v4u*)(Kg + (tb + (idx >> 4)) * 512 + h * 128 + (idx & 15) * 8); } \
        vr = *(const v4u*)(Vg + (tb + vrow) * 512 + h * 128 + dvq * 32 + vch * 8); } while (0)
#define RS_WRITE(buf_) do { LAS unsigned char* Kb_ = F.lds + (buf_) * BUF; LAS unsigned char* Vb_ = Kb_ + 128 * RP; \
        _Pragma("unroll") for (int q = 0; q < 4; ++q) { const int idx = tid + 512 * q, row = idx >> 4; \
            const float dk_ = __builtin_amdgcn_exp2f((float)(dir ? row : 127 - row) * lg); v4u o; \
            _Pragma("unroll") for (int e = 0; e < 4; ++e) o[e] = pkbf(bflo(kr[q][e]) * dk_, bfhi(kr[q][e]) * dk_); \
            *(LAS v4u*)(Kb_ + row * RP + (idx & 15) * 16) = o; } \
        *(LAS v4u*)(Vb_ + vrow * VP + vch * 16) = vr; } while (0)
    __syncthreads();
    RS_LOAD(dir ? 15 : 0);
    RS_WRITE(0);
    __syncthreads();
    f32x4 acc[2]; acc[0] = (f32x4){0.f, 0.f, 0.f, 0.f}; acc[1] = acc[0];
    for (int s_ = 0; s_ < 16; ++s_) {
        const int c = dir ? 15 - s_ : s_, buf = s_ & 1;
        if (s_ + 1 < 16) RS_LOAD(dir ? c - 1 : c + 1);
        bf16* dst = ST + ((size_t)(bh * 2 + dir) * 16 + c) * 16384;
#pragma unroll
        for (int n = 0; n < 2; ++n) { v2u o; o.x = pkbf(acc[n][0], acc[n][1]); o.y = pkbf(acc[n][2], acc[n][3]); *(v2u*)(dst + (32 * dvq + 16 * n + i) * 128 + 16 * w + 4 * g) = o; }
        acc[0] = acc[0] * cdec; acc[1] = acc[1] * cdec;
        const LAS unsigned char* Kb = F.lds + buf * BUF; const LAS unsigned char* Vb = Kb + 128 * RP;
#pragma unroll
        for (int ks = 0; ks < 4; ++ks) {
            const int r0 = 32 * ks + 8 * g + q4;
            const bf16x8_t af = tr_frag(Kb + r0 * RP + (16 * w + 4 * p4) * 2, Kb + (r0 + 4) * RP + (16 * w + 4 * p4) * 2);
#pragma unroll
            for (int n = 0; n < 2; ++n) { const bf16x8_t bv = tr_frag(Vb + r0 * VP + (16 * n + 4 * p4) * 2, Vb + (r0 + 4) * VP + (16 * n + 4 * p4) * 2); acc[n] = MFMA16(af, bv, acc[n]); }
        }
        if (s_ + 1 < 16) RS_WRITE(buf ^ 1);
        __syncthreads();
    }
#undef RS_LOAD
#undef RS_WRITE
}
__device__ __forceinline__ void ret_out_item(const Frame& F, const float* gn, int item) {
    const int bh = item >> 4, ci = item & 15, b = bh >> 2, h = bh & 3, t0 = b * SEQ + ci * 128;
    bf16* Gg = (bf16*)(F.ws + WS_PROJ + 3 * BLK); const bf16* Qg = (const bf16*)(F.ws + WS_PROJ + 4 * BLK);
    const bf16* Kg = (const bf16*)(F.ws + WS_PROJ + 5 * BLK); const bf16* Vg = (const bf16*)(F.ws + WS_PROJ + 7 * BLK);
    const bf16* ST = (const bf16*)F.out;
    const float lgf = log2_1m(__builtin_amdgcn_exp2f(-5.0f - (float)h)), lgb = log2_1m(__builtin_amdgcn_exp2f(-5.5f - (float)h));
    LAS unsigned char* Kl = F.lds; LAS unsigned char* Vl = F.lds + 128 * RP; LAS unsigned char* Sf = F.lds + 2 * 128 * RP; LAS unsigned char* Sb = F.lds + 3 * 128 * RP;
    __syncthreads();
    {
#pragma unroll
        for (int q = 0; q < 4; ++q) {
            const int idx = F.tid + 512 * q, row = idx >> 4, ch = idx & 15;
            *(LAS v4u*)(Kl + row * RP + ch * 16) = *(const v4u*)(Kg + (size_t)(t0 + row) * 512 + h * 128 + ch * 8);
            *(LAS v4u*)(Vl + row * RP + ch * 16) = *(const v4u*)(Vg + (size_t)(t0 + row) * 512 + h * 128 + ch * 8);
        }
        const bf16* sfp = ST + ((size_t)(bh * 2 + 0) * 16 + ci) * 16384; const bf16* sbp = ST + ((size_t)(bh * 2 + 1) * 16 + ci) * 16384;
#pragma unroll
        for (int q = 0; q < 4; ++q) {
            const int idx = F.tid + 512 * q, row = idx >> 4, ch = idx & 15;
            *(LAS v4u*)(Sf + row * RP + ch * 16) = *(const v4u*)(sfp + idx * 8);
            *(LAS v4u*)(Sb + row * RP + ch * 16) = *(const v4u*)(sbp + idx * 8);
        }
    }
    __syncthreads();
    const int lane = F.lane, w = F.wave, g = lane >> 4, i = lane & 15, q4 = i >> 2, p4 = i & 3;
    const int nl = 16 * w + i;
    bf16x8_t bq[4];
#pragma unroll
    for (int ks = 0; ks < 4; ++ks) bq[ks] = *(const bf16x8_t*)(Qg + (size_t)(t0 + nl) * 512 + h * 128 + 32 * ks + 8 * g);
    bf16x8_t bp[4];
#pragma unroll
    for (int kp = 0; kp < 4; ++kp) {
        f32x4 s0 = (f32x4){0.f, 0.f, 0.f, 0.f}, s1 = s0;
#pragma unroll
        for (int ks = 0; ks < 4; ++ks) {
            const bf16x8_t a0 = *(const LAS bf16x8_t*)(Kl + (32 * kp + i) * RP + (32 * ks + 8 * g) * 2);
            const bf16x8_t a1 = *(const LAS bf16x8_t*)(Kl + (32 * kp + 16 + i) * RP + (32 * ks + 8 * g) * 2);
            s0 = MFMA16(a0, bq[ks], s0); s1 = MFMA16(a1, bq[ks], s1);
        }
        float pv[8];
#pragma unroll
        for (int e = 0; e < 4; ++e) {
            const int m0 = 32 * kp + 4 * g + e, m1 = m0 + 16;
            const float d0 = (float)(nl - m0), d1 = (float)(nl - m1);
            pv[e] = s0[e] * (d0 >= 0.f ? __builtin_amdgcn_exp2f(d0 * lgf) : __builtin_amdgcn_exp2f(-d0 * lgb));
            pv[4 + e] = s1[e] * (d1 >= 0.f ? __builtin_amdgcn_exp2f(d1 * lgf) : __builtin_amdgcn_exp2f(-d1 * lgb));
        }
        v4u pk; pk.x = pkbf(pv[0], pv[1]); pk.y = pkbf(pv[2], pv[3]); pk.z = pkbf(pv[4], pv[5]); pk.w = pkbf(pv[6], pv[7]);
        bp[kp] = __builtin_bit_cast(bf16x8_t, pk);
    }
    f32x4 oi[8], of[8], ob[8];
#pragma unroll
    for (int n = 0; n < 8; ++n) { oi[n] = (f32x4){0.f, 0.f, 0.f, 0.f}; of[n] = oi[n]; ob[n] = oi[n]; }
#pragma unroll
    for (int kp = 0; kp < 4; ++kp) {
        const int r0 = (32 * kp + 4 * g + q4) * RP, r1 = r0 + 16 * RP;
#pragma unroll
        for (int n = 0; n < 8; ++n) { const bf16x8_t av = tr_frag(Vl + r0 + (16 * n + 4 * p4) * 2, Vl + r1 + (16 * n + 4 * p4) * 2); oi[n] = MFMA16(av, bp[kp], oi[n]); }
    }
#pragma unroll
    for (int ks = 0; ks < 4; ++ks)
#pragma unroll
        for (int n = 0; n < 8; ++n) {
            const bf16x8_t af = *(const LAS bf16x8_t*)(Sf + (16 * n + i) * RP + (32 * ks + 8 * g) * 2);
            const bf16x8_t ab = *(const LAS bf16x8_t*)(Sb + (16 * n + i) * RP + (32 * ks + 8 * g) * 2);
            of[n] = MFMA16(af, bq[ks], of[n]); ob[n] = MFMA16(ab, bq[ks], ob[n]);
        }
    const float qdf = __builtin_amdgcn_exp2f((float)(nl + 1) * lgf), qdb = __builtin_amdgcn_exp2f((float)(128 - nl) * lgb);
    float ss = 0.f;
#pragma unroll
    for (int n = 0; n < 8; ++n) { oi[n] = oi[n] + of[n] * qdf + ob[n] * qdb; ss += (oi[n][0] * oi[n][0] + oi[n][1] * oi[n][1]) + (oi[n][2] * oi[n][2] + oi[n][3] * oi[n][3]); }
    ss += shx(ss, lane, 16); ss += shx(ss, lane, 32);
    const float rn = 1.0f / sqrtf(ss * (1.0f / 128.0f) + RMS_EPS);
    bf16* grow = Gg + (size_t)(t0 + nl) * 512 + h * 128;
#pragma unroll
    for (int n = 0; n < 8; ++n) {
        const int dv0 = 16 * n + 4 * g;
        const v2u gg = *(const v2u*)(grow + dv0); const f32x4 gw = *(const f32x4*)(gn + h * 128 + dv0);
        const float g0 = bflo(gg.x), g1 = bfhi(gg.x), g2 = bflo(gg.y), g3 = bfhi(gg.y);
        v2u o; o.x = pkbf(g0 * sigmoidf_(g0) * oi[n][0] * rn * gw[0], g1 * sigmoidf_(g1) * oi[n][1] * rn * gw[1]);
        o.y = pkbf(g2 * sigmoidf_(g2) * oi[n][2] * rn * gw[2], g3 * sigmoidf_(g3) * oi[n][3] * rn * gw[3]);
        *(v2u*)(grow + dv0) = o;
    }
}

constexpr int LO_WL = 0, LO_CST = 36864, LO_XC = 39680, LO_XF = 58688, LO_XB = 93504, LO_GY = 111936, LO_SEG = 130368, LO_HIN = 138560;
__device__ __forceinline__ void lru_stage_consts(const Frame& F, CArgs* A, int l, int blk) {
    const bf16* LW = (const bf16*)(F.ws + WS_LW); const float* SP = (const float*)(F.ws + WS_SP);
    __syncthreads();
#pragma unroll
    for (int q = 0; q < 4; ++q) { const int idx = F.tid + 512 * q, m = idx >> 9, row = (idx >> 3) & 63, ch = idx & 7;
        const int d = m >> 1, ax = m & 1;
        *(LAS v4u*)(F.lds + LO_WL + (m * 64 + row) * 144 + ch * 16) = *(const v4u*)(LW + (size_t)((((l * 2 + d) * 2 + ax) * 8 + blk)) * 4096 + row * 64 + ch * 8); }
    LAS float* cst = (LAS float*)(F.lds + LO_CST);
    if (F.tid < 128) { const int d = F.tid >> 6, j = F.tid & 63, pi = (l * 2 + d) * 512 + blk * 64 + j; cst[F.tid] = A->in[10][pi]; cst[128 + F.tid] = A->in[12][pi]; cst[256 + F.tid] = SP[pi]; }
    else if (F.tid < 384) { const int e = F.tid - 128, tap = e >> 6, j = e & 63; cst[384 + e] = A->in[7][(size_t)l * 2048 + tap * 512 + blk * 64 + j]; }
    else if (F.tid < 448) { const int j = F.tid - 384; cst[640 + j] = A->in[8][(size_t)l * 512 + blk * 64 + j]; }
}
template <int MODE>
__device__ __forceinline__ void lru_item(const Frame& F, int item) {
    const int b = item >> 7, c = (item >> 3) & 15, blk = item & 7, t0 = b * SEQ + c * 128, s0 = c * 128;
    const bf16* XCg = (const bf16*)(F.ws + WS_PROJ + 8 * BLK); bf16* GCg = (bf16*)(F.ws + WS_PROJ + 6 * BLK);
    float* AGG = (float*)(F.ws + WS_AGG);
    LAS unsigned char* WL = F.lds + LO_WL; const LAS float* cst = (const LAS float*)(F.lds + LO_CST);
    LAS unsigned char* XC = F.lds + LO_XC; LAS float* XF = (LAS float*)(F.lds + LO_XF); LAS unsigned char* XB = F.lds + LO_XB; LAS unsigned char* GY = F.lds + LO_GY;
    LAS float* SEG = (LAS float*)(F.lds + LO_SEG); LAS float* HIN = (LAS float*)(F.lds + LO_HIN);
    typedef float f2 __attribute__((ext_vector_type(2)));
    const int tid = F.tid, lane = F.lane, w = F.wave, g = lane >> 4, i = lane & 15;
    __syncthreads();
#pragma unroll
    for (int q = 0; q < 3; ++q) {
        const int idx = tid + 512 * q;
        if (idx < 1056) { const int row = idx >> 3, ch = idx & 7, s_ = s0 - 2 + row;
            v4u v = (v4u){0u, 0u, 0u, 0u};
            if (s_ >= 0 && s_ < SEQ) v = *(const v4u*)(XCg + (size_t)(b * SEQ + s_) * 512 + blk * 64 + ch * 8);
            *(LAS v4u*)(XC + row * 144 + ch * 16) = v; }
    }
    if (MODE == 1) {
#pragma unroll
        for (int q = 0; q < 2; ++q) { const int idx = tid + 512 * q, row = idx >> 3, ch = idx & 7;
            *(LAS v4u*)(GY + row * 144 + ch * 16) = *(const v4u*)(GCg + (size_t)(t0 + row) * 512 + blk * 64 + ch * 8); }
        if (tid < 128) {
            const int d = tid >> 6, j = tid & 63, ch = blk * 64 + j;
            f2 ag[15];
#pragma unroll
            for (int k = 0; k < 15; ++k) { const int cc = d ? 15 - k : k; ag[k] = *(const f2*)(AGG + ((size_t)((b * 16 + cc) * 2 + d) * 512 + ch) * 2); }
            float h = 0.f;
#pragma unroll
            for (int k = 0; k < 15; ++k) { const int cc = d ? 15 - k : k; const bool valid = d ? (cc > c) : (cc < c); h = valid ? ag[k].x * h + ag[k].y : h; }
            HIN[tid] = h;
        }
    }
    __syncthreads();
#pragma unroll
    for (int q = 0; q < 2; ++q) {
        const int idx = tid + 512 * q, t = idx >> 3, c8 = idx & 7;
        float xf[8];
        { const f32x4 b0 = *(const LAS f32x4*)(cst + 640 + c8 * 8), b1 = *(const LAS f32x4*)(cst + 640 + c8 * 8 + 4); xf[0] = b0[0]; xf[1] = b0[1]; xf[2] = b0[2]; xf[3] = b0[3]; xf[4] = b1[0]; xf[5] = b1[1]; xf[6] = b1[2]; xf[7] = b1[3]; }
#pragma unroll
        for (int tap = 0; tap < 4; ++tap) {
            const v4u x = *(const LAS v4u*)(XC + (t + tap) * 144 + c8 * 16);
            const f32x4 w0 = *(const LAS f32x4*)(cst + 384 + tap * 64 + c8 * 8), w1 = *(const LAS f32x4*)(cst + 384 + tap * 64 + c8 * 8 + 4);
            xf[0] += w0[0] * bflo(x[0]); xf[1] += w0[1] * bfhi(x[0]); xf[2] += w0[2] * bflo(x[1]); xf[3] += w0[3] * bfhi(x[1]);
            xf[4] += w1[0] * bflo(x[2]); xf[5] += w1[1] * bfhi(x[2]); xf[6] += w1[2] * bflo(x[3]); xf[7] += w1[3] * bfhi(x[3]);
        }
        *(LAS f32x4*)(XF + t * 68 + c8 * 8) = (f32x4){xf[0], xf[1], xf[2], xf[3]}; *(LAS f32x4*)(XF + t * 68 + c8 * 8 + 4) = (f32x4){xf[4], xf[5], xf[6], xf[7]};
        v4u o; o.x = pkbf(xf[0], xf[1]); o.y = pkbf(xf[2], xf[3]); o.z = pkbf(xf[4], xf[5]); o.w = pkbf(xf[6], xf[7]);
        *(LAS v4u*)(XB + t * 144 + c8 * 16) = o;
    }
    __syncthreads();
    float av[2][4][4], bv[2][4][4];
    {
        const bf16x8_t a0 = *(const LAS bf16x8_t*)(XB + (16 * w + i) * 144 + (8 * g) * 2), a1 = *(const LAS bf16x8_t*)(XB + (16 * w + i) * 144 + (32 + 8 * g) * 2);
#pragma unroll
        for (int d = 0; d < 2; ++d) {
#pragma unroll
            for (int jt = 0; jt < 4; ++jt) {
                const LAS unsigned char* wa = WL + ((d * 2 + 0) * 64 + 16 * jt + i) * 144 + (8 * g) * 2; const LAS unsigned char* wx = WL + ((d * 2 + 1) * 64 + 16 * jt + i) * 144 + (8 * g) * 2;
                const f32x4 z = (f32x4){0.f, 0.f, 0.f, 0.f};
                f32x4 ca = MFMA16(a0, *(const LAS bf16x8_t*)wa, z); ca = MFMA16(a1, *(const LAS bf16x8_t*)(wa + 64), ca);
                f32x4 cx = MFMA16(a0, *(const LAS bf16x8_t*)wx, z); cx = MFMA16(a1, *(const LAS bf16x8_t*)(wx + 64), cx);
                const int j = 16 * jt + i;
                const float ba = cst[d * 64 + j], bx = cst[128 + d * 64 + j], sp = cst[256 + d * 64 + j];
#pragma unroll
                for (int r = 0; r < 4; ++r) {
                    const int t = 16 * w + 4 * g + r;
                    const float xfv = XF[t * 68 + j];
                    const float rr = sigmoidf_(ca[r] + ba), ig = sigmoidf_(cx[r] + bx);
                    const float la = -8.0f * rr * sp, a = fexp(la), x2 = 2.0f * la;
                    const float om = x2 > -0.5f ? -x2 * (1.0f + x2 * (0.5f + x2 * (0.16666667f + x2 * (0.041666668f + x2 * (0.0083333333f + x2 * 0.0013888889f))))) : 1.0f - a * a;
                    float mult = sqrtf(om);
                    if (d == 0 ? (c == 0 && t == 0) : (c == 15 && t == 127)) mult = 1.0f;
                    av[d][jt][r] = a; bv[d][jt][r] = mult * ig * xfv;
                }
            }
        }
    }
    float Ae[2][4], Be[2][4];
#pragma unroll
    for (int jt = 0; jt < 4; ++jt) {
        float Af = av[0][jt][0] * av[0][jt][1] * av[0][jt][2] * av[0][jt][3];
        float Bf = ((bv[0][jt][0] * av[0][jt][1] + bv[0][jt][1]) * av[0][jt][2] + bv[0][jt][2]) * av[0][jt][3] + bv[0][jt][3];
        float Ar = av[1][jt][0] * av[1][jt][1] * av[1][jt][2] * av[1][jt][3];
        float Br = ((bv[1][jt][3] * av[1][jt][2] + bv[1][jt][2]) * av[1][jt][1] + bv[1][jt][1]) * av[1][jt][0] + bv[1][jt][0];
#pragma unroll
        for (int st = 16; st <= 32; st <<= 1) {
            const float pAf = lane_get(Af, lane - st), pBf = lane_get(Bf, lane - st), pAr = lane_get(Ar, lane + st), pBr = lane_get(Br, lane + st);
            if (lane >= st) { Bf = Af * pBf + Bf; Af = Af * pAf; }
            if (lane + st < 64) { Br = Ar * pBr + Br; Ar = Ar * pAr; }
        }
        const float eAf = lane_get(Af, lane - 16), eBf = lane_get(Bf, lane - 16), eAr = lane_get(Ar, lane + 16), eBr = lane_get(Br, lane + 16);
        Ae[0][jt] = g > 0 ? eAf : 1.0f; Be[0][jt] = g > 0 ? eBf : 0.0f; Ae[1][jt] = g < 3 ? eAr : 1.0f; Be[1][jt] = g < 3 ? eBr : 0.0f;
        if (g == 3) *(LAS f2*)(SEG + ((0 * 8 + w) * 64 + 16 * jt + i) * 2) = (f2){Af, Bf};
        if (g == 0) *(LAS f2*)(SEG + ((1 * 8 + w) * 64 + 16 * jt + i) * 2) = (f2){Ar, Br};
    }
    __syncthreads();
    if (MODE == 0) {
        if (w == 0 && g < 2) {
            const int d = g;
#pragma unroll
            for (int jt = 0; jt < 4; ++jt) {
                const int j = 16 * jt + i; float h = 0.f, Ap = 1.0f;
#pragma unroll
                for (int k = 0; k < 8; ++k) { const int ww = d ? 7 - k : k; const f2 sg = *(const LAS f2*)(SEG + ((d * 8 + ww) * 64 + j) * 2); h = sg.x * h + sg.y; Ap *= sg.x; }
                *(f2*)(AGG + ((size_t)((b * 16 + c) * 2 + d) * 512 + blk * 64 + j) * 2) = (f2){Ap, h};
            }
        }
    } else {
#pragma unroll
        for (int jt = 0; jt < 4; ++jt) {
            const int j = 16 * jt + i;
            float hf = HIN[j], hr = HIN[64 + j];
#pragma unroll
            for (int k = 0; k < 8; ++k) {
                const f2 sf = *(const LAS f2*)(SEG + ((0 * 8 + k) * 64 + j) * 2), sr = *(const LAS f2*)(SEG + ((1 * 8 + (7 - k)) * 64 + j) * 2);
                if (k < w) hf = sf.x * hf + sf.y;
                if (7 - k > w) hr = sr.x * hr + sr.y;
            }
            float h = Ae[0][jt] * hf + Be[0][jt];
            float hs[4];
#pragma unroll
            for (int r = 0; r < 4; ++r) { h = av[0][jt][r] * h + bv[0][jt][r]; hs[r] = h; }
            h = Ae[1][jt] * hr + Be[1][jt];
#pragma unroll
            for (int r = 3; r >= 0; --r) { h = av[1][jt][r] * h + bv[1][jt][r]; hs[r] += h; }
#pragma unroll
            for (int r = 0; r < 4; ++r) { LAS bf16* p = (LAS bf16*)(GY + (16 * w + 4 * g + r) * 144) + j; *p = (bf16)f2bf(gelu_tanh(bf2f(*p)) * hs[r]); }
        }
        __syncthreads();
#pragma unroll
        for (int q = 0; q < 2; ++q) { const int idx = tid + 512 * q, row = idx >> 3, ch = idx & 7;
            *(v4u*)(GCg + (size_t)(t0 + row) * 512 + blk * 64 + ch * 8) = *(const LAS v4u*)(GY + row * 144 + ch * 16); }
    }
}
template <int MODE> __device__ __forceinline__ void phase_lru(const Frame& F, CArgs* A, int l) {
    int cur = -1;
    for (int it = F.bid; it < 1024; it += F.G) { const int blk = it & 7; if (blk != cur) { lru_stage_consts(F, A, l, blk); cur = blk; } lru_item<MODE>(F, it); }
}


__device__ __forceinline__ void na_group(const Frame& F, const float* rpb, int grp) {
    const int b = grp >> 5, h = (grp >> 2) & 7, rg = grp & 3, r0 = rg * 8;
    bf16* Qg = (bf16*)(F.ws + WS_PROJ); const bf16* Kg = (const bf16*)(F.ws + WS_PROJ + BLK); const bf16* Vg = (const bf16*)(F.ws + WS_PROJ + 2 * BLK);
    LAS unsigned char* Kl = F.lds; LAS unsigned char* Vl = F.lds + 512 * 144; LAS float* Bl = (LAS float*)(F.lds + 2 * 512 * 144);
    const int tid = F.tid;
    int rs = r0 - 4; rs = rs < 0 ? 0 : (rs > 24 ? 24 : rs);
    __syncthreads();
#pragma unroll
    for (int q = 0; q < 8; ++q) {
        const int idx = tid + 512 * q, kidx = idx >> 3, ch = idx & 7, grow = rs + (kidx >> 6), col = kidx & 63;
        const size_t tok = (size_t)b * SEQ + grow * 64 + col; const int lrow = (grow & 7) * 64 + col;
        *(LAS v4u*)(Kl + lrow * 144 + ch * 16) = *(const v4u*)(Kg + tok * 512 + h * 64 + ch * 8);
        *(LAS v4u*)(Vl + lrow * 144 + ch * 16) = *(const v4u*)(Vg + tok * 512 + h * 64 + ch * 8);
    }
    if (tid < 465) Bl[tid] = rpb[h * 465 + tid];
    __syncthreads();
    const int w = F.wave, lane = F.lane, g = lane >> 4, i = lane & 15, q4 = i >> 2, p4 = i & 3;
    for (int k = 0; k < 8; ++k) {
        const int r = r0 + k;
        int rsn = r + 1 - 4; rsn = rsn < 0 ? 0 : (rsn > 24 ? 24 : rsn);
        const bool slide = (k < 7) && (rsn != rs);
        v4u pk = (v4u){0u, 0u, 0u, 0u}, pv = pk;
        if (slide) { const size_t tok = (size_t)b * SEQ + (rsn + 7) * 64 + (tid >> 3);
            pk = *(const v4u*)(Kg + tok * 512 + h * 64 + (tid & 7) * 8); pv = *(const v4u*)(Vg + tok * 512 + h * 64 + (tid & 7) * 8); }
        if (w < 4) {
            const int c = 16 * w + i, cb = w == 0 ? 0 : (w == 1 ? 8 : (w == 2 ? 24 : 32));
            int cst = c - 8; cst = cst < 0 ? 0 : (cst > 48 ? 48 : cst);
            const size_t tq = (size_t)b * SEQ + r * 64 + c;
            const bf16x8_t bq0 = *(const bf16x8_t*)(Qg + tq * 512 + h * 64 + 8 * g), bq1 = *(const bf16x8_t*)(Qg + tq * 512 + h * 64 + 32 + 8 * g);
            float sc[16][4];
            float mx = -1e30f;
#pragma unroll
            for (int t = 0; t < 16; ++t) {
                const int wi = t >> 1, half = t & 1, slot = (rs + wi) & 7;
                const LAS unsigned char* kp = Kl + (slot * 64 + cb + 16 * half + i) * 144 + (8 * g) * 2;
                const bf16x8_t a0 = *(const LAS bf16x8_t*)kp, a1 = *(const LAS bf16x8_t*)(kp + 64);
                f32x4 s_ = (f32x4){0.f, 0.f, 0.f, 0.f};
                s_ = MFMA16(a0, bq0, s_); s_ = MFMA16(a1, bq1, s_);
                const int brow = (rs + wi - r + 7) * 31;
#pragma unroll
                for (int e = 0; e < 4; ++e) {
                    const int kc = cb + 16 * half + 4 * g + e;
                    const bool valid = (kc >= cst) && (kc < cst + 16);
                    const float bias = Bl[valid ? brow + (kc - c + 15) : 0];
                    const float v = valid ? s_[e] + bias : -1e30f;
                    sc[t][e] = v; mx = fmaxf(mx, v);
                }
            }
            mx = fmaxf(mx, shx(mx, lane, 16)); mx = fmaxf(mx, shx(mx, lane, 32));
            float sum = 0.f;
            bf16x8_t bp[8];
#pragma unroll
            for (int wi = 0; wi < 8; ++wi) {
                float p[8];
#pragma unroll
                for (int e = 0; e < 4; ++e) { p[e] = fexp(sc[2 * wi][e] - mx); p[4 + e] = fexp(sc[2 * wi + 1][e] - mx); sum += p[e] + p[4 + e]; }
                v4u pw; pw.x = pkbf(p[0], p[1]); pw.y = pkbf(p[2], p[3]); pw.z = pkbf(p[4], p[5]); pw.w = pkbf(p[6], p[7]);
                bp[wi] = __builtin_bit_cast(bf16x8_t, pw);
            }
            sum += shx(sum, lane, 16); sum += shx(sum, lane, 32);
            f32x4 o[4];
#pragma unroll
            for (int dt = 0; dt < 4; ++dt) o[dt] = (f32x4){0.f, 0.f, 0.f, 0.f};
#pragma unroll
            for (int wi = 0; wi < 8; ++wi) {
                const int slot = (rs + wi) & 7;
                const LAS unsigned char* vp = Vl + (slot * 64 + cb + 4 * g + q4) * 144 + (4 * p4) * 2;
#pragma unroll
                for (int dt = 0; dt < 4; ++dt) { const bf16x8_t av = tr_frag(vp + 32 * dt, vp + 16 * 144 + 32 * dt); o[dt] = MFMA16(av, bp[wi], o[dt]); }
            }
            const float inv = 1.0f / sum;
#pragma unroll
            for (int dt = 0; dt < 4; ++dt) { v2u ov; ov.x = pkbf(o[dt][0] * inv, o[dt][1] * inv); ov.y = pkbf(o[dt][2] * inv, o[dt][3] * inv);
                *(v2u*)(Qg + tq * 512 + h * 64 + 16 * dt + 4 * g) = ov; }
        }
        __syncthreads();
        if (slide) { const int lrow = ((rsn + 7) & 7) * 64 + (tid >> 3);
            *(LAS v4u*)(Kl + lrow * 144 + (tid & 7) * 16) = pk; *(LAS v4u*)(Vl + lrow * 144 + (tid & 7) * 16) = pv; }
        __syncthreads();
        rs = rsn;
    }
}
__device__ __forceinline__ void phase_na(const Frame& F, CArgs* A, int l) { const float* rpb = A->in[5] + (size_t)l * 8 * 465; for (int it = F.bid; it < 256; it += F.G) na_group(F, rpb, it); }

__device__ __forceinline__ void phase_ret_state(const Frame& F) { for (int it = F.bid; it < 256; it += F.G) ret_scan_item(F, it); }
__device__ __forceinline__ void phase_ret_out(const Frame& F, CArgs* A, int l) { const float* gn = A->in[6] + (size_t)l * 512; for (int it = F.bid; it < 512; it += F.G) ret_out_item(F, gn, it); }

__device__ __forceinline__ void phase_final(const Frame& F, CArgs* A) {
    const float* g = A->in[22]; const bf16* xb = (const bf16*)(F.ws + WS_XB); const float* ss = (const float*)(F.ws + WS_SSB);
    for (int m = F.gw; m < T; m += F.ngw) {
        const v2u* xr = (const v2u*)(xb + (size_t)m * D) + F.lane; const f32x4* gr = (const f32x4*)g + F.lane; f32x4* orow = (f32x4*)(F.out + (size_t)m * D) + F.lane;
        float sp = F.lane < 16 ? ss[(size_t)m * 16 + F.lane] : 0.f;
        sp += shx(sp, F.lane, 1); sp += shx(sp, F.lane, 2); sp += shx(sp, F.lane, 4); sp += shx(sp, F.lane, 8);
        const float rs = 1.0f / sqrtf(lane_get(sp, 0) * (1.0f / D) + RMS_EPS);
#pragma unroll
        for (int j = 0; j < 4; ++j) { const v2u w = xr[64 * j]; f32x4 o = (f32x4){bflo(w.x), bfhi(w.x), bflo(w.y), bfhi(w.y)} * rs * gr[64 * j];
            orow[64 * j] = o; }
    }
}

__global__ void __launch_bounds__(NWAVES * 64, 2) mk_fwd(Args args) {
    extern __shared__ __attribute__((aligned(16))) unsigned char lds[];
    const int tid0 = threadIdx.x;
    const int wave0 = __builtin_amdgcn_readfirstlane(tid0 >> 6);
    LAS unsigned char* const lds3 = (LAS unsigned char*)lds;
    CArgs* A0 = get_args();
    const int ph_lo = A0->ph_lo, ph_hi = A0->ph_hi;
    for (int u = tid0; u < (LDS_BYTES - LDSCTL_OFF) / 4; u += NWAVES * 64) ((LAS unsigned*)(lds3 + LDSCTL_OFF))[u] = 0u;
    __syncthreads();
    const bool multi = (ph_hi - ph_lo) > 1;
    XcdBarrier bar; bar.bar = (unsigned*)((gu32*)(A0->ws + WS_CTL) + CW_BAR); bar.x = 0; bar.st = nullptr;
    if (multi) bar = xcd_barrier_post((unsigned*)((gu32*)(A0->ws + WS_CTL) + CW_BAR), (volatile LAS unsigned*)(lds3 + MISC_OFF) + 8);

    unsigned long long probe_acc = 0, pt0 = 0;
#define PMARK(k) do { if (PROBE_WN != 0ull) { __syncthreads(); const unsigned long long t_ = __builtin_amdgcn_s_memrealtime(); probe_acc += ((PROBE_WN >> (4 * (k))) & 15ull) * (t_ - pt0); pt0 = t_; } } while (0)
    for (int ph = ph_lo; ph < ph_hi; ++ph) {
        CArgs* A = get_args();
        Frame F;
        { int t_ = wave0 * 64 + (int)__builtin_amdgcn_mbcnt_hi(~0u, __builtin_amdgcn_mbcnt_lo(~0u, 0u)); asm volatile("" : "+v"(t_)); F.tid = t_; }
        F.lds = lds3; F.lane = F.tid & 63; F.wave = __builtin_amdgcn_readfirstlane(F.tid >> 6);
        { int b_ = blockIdx.x; asm volatile("" : "+s"(b_)); F.bid = b_; }
        F.G = gridDim.x; F.gw = F.bid * NWAVES + F.wave; F.ngw = F.G * NWAVES;
        F.out = A->out; F.ws = A->ws;
        unsigned char* ws = F.ws;
        if (PROBE_WN != 0ull) pt0 = __builtin_amdgcn_s_memrealtime();
        int kind, l;
        if (ph == 0) { kind = PH_PRO; l = 0; } else if (ph == NPH - 1) { kind = PH_FIN; l = 0; } else { l = (ph - 1) / NPL; kind = 1 + (ph - 1) % NPL; }
        float* ssA = (float*)(ws + WS_SSA); float* ssB = (float*)(ws + WS_SSB);
        switch (kind) {
        case PH_PRO: phase_prologue(F, A); break;
        case PH_G1: {
            pg8::Gemm g{(const bf16_t*)(ws + WS_XB), (const bf16_t*)(ws + W_IN), T, 7680, D, 0, 0};
            pg8::StaticOrder S; S.init(T, 7680, F.G, F.bid);
            EpiG1 E{(bf16_t*)(ws + WS_PROJ), ws + WS_GATE8, ssB, A->in[4] + (size_t)l * 3072, (const float*)(ws + WS_TAB)};
            pg8::gemm_phase<EpiG1, pg8::StaticOrder, true, true>(F.lds, g, S, E, F.tid);
        } break;
        case PH_MIXA: phase_na(F, A, l); PMARK(10); phase_ret_state(F); PMARK(11); phase_lru<0>(F, A, l); PMARK(12); __syncthreads(); convert_layer_mlp(F, A, l); PMARK(13); break;
        case PH_MIXB: phase_ret_out(F, A, l); PMARK(14); phase_lru<1>(F, A, l); PMARK(15); break;
        case PH_G2: {
            pg8::Gemm g{(const bf16_t*)(ws + WS_PROJ), (const bf16_t*)(ws + W_BR), T, D, 512, 3 * BLK, (size_t)D * 512 * 2};
            ZOrder S; S.S.init(T, D, F.G, F.bid);
            EpiG2 E{ws + WS_GATE8, (bf16_t*)(ws + WS_MERGED)};
            pg8::gemm_phase<EpiG2, ZOrder, true, true>(F.lds, g, S, E, F.tid);
        } break;
        case PH_G3: case PH_G5: {
            const bool g3 = (kind == PH_G3);
            pg8::Gemm g{(const bf16_t*)(ws + (g3 ? WS_MERGED : WS_U)), (const bf16_t*)(ws + (g3 ? W_OUT : W_DOWN)), T, D, g3 ? D : FF, 0, 0};
            pg8::StaticOrder S; S.init(T, D, F.G, F.bid);
            EpiRes E{(g3 && l == 0) ? A->in[0] : nullptr, (const bf16_t*)(ws + (g3 ? WS_XB : WS_GATE8)), (bf16_t*)(ws + WS_GATE8), g3 ? ssB : ssA};
            pg8::gemm_phase<EpiRes, pg8::StaticOrder, false, true>(F.lds, g, S, E, F.tid);
        } break;
        case PH_G4: {
            pg8::Gemm g{(const bf16_t*)(ws + WS_GATE8), (const bf16_t*)(ws + W_UP), T, FF, D, 0, 0};
            pg8::StaticOrder S; S.init(T, FF, F.G, F.bid);
            EpiG4 E{(bf16_t*)(ws + WS_U), ssB};
            pg8::gemm_phase<EpiG4, pg8::StaticOrder, true, true>(F.lds, g, S, E, F.tid);
            convert_p(F, A, l);
            if (l + 1 < DEPTH) convert_layer_mid(F, A, l + 1);
        } break;
        case PH_G6: {
            {
                pg8::Gemm g{(const bf16_t*)(ws + WS_PB), (const bf16_t*)(ws + W_PLE(l & 1)), T, D, PLE, 0, 0};
                pg8::StaticOrder S; S.init(T, D, F.G, F.bid);
                EpiE E{(bf16_t*)(ws + WS_E)};
                pg8::gemm_phase<EpiE, pg8::StaticOrder, false, true>(F.lds, g, S, E, F.tid);
            }
            {
                pg8::Gemm g{(const bf16_t*)(ws + WS_GATE8), (const bf16_t*)(ws + W_G(l & 1)), T, D, D, 0, 0};
                pg8::StaticOrder S; S.init(T, D, F.G, F.bid);
                EpiG6 E{(const bf16_t*)(ws + WS_GATE8), (bf16_t*)(ws + WS_XB), ssA, ssB, (const bf16_t*)(ws + WS_E)};
                pg8::gemm_phase<EpiG6, pg8::StaticOrder, false, true>(F.lds, g, S, E, F.tid);
            }
            if (l + 1 < DEPTH) convert_layer_early(F, A, l + 1);
        } break;
        case PH_FIN: phase_final(F, A); break;
        default: break;
        }
        if (ph + 1 < ph_hi) xcd_barrier(bar, F.tid);
        PMARK(kind);
    }
    if (PROBE_WN != 0ull && blockIdx.x == 0) { const unsigned long long te = __builtin_amdgcn_s_memrealtime(); while (__builtin_amdgcn_s_memrealtime() - te < probe_acc) __builtin_amdgcn_s_sleep(32); }
}


#if MK_CHECK
constexpr int CW_CODE = 64, CW_CNT = 128;
__device__ __forceinline__ unsigned hash32(unsigned x) { x ^= x >> 16; x *= 0x7feb352du; x ^= x >> 15; x *= 0x846ca68bu; x ^= x >> 16; return x; }
__device__ __forceinline__ bool near(float a, float b, float rel, float abs_) { return fabsf(a - b) <= rel * fabsf(b) + abs_; }
__device__ float rs_of_x(const float* x, int row) { float s = 0.f; for (int k = 0; k < D; ++k) s += x[(size_t)row * D + k] * x[(size_t)row * D + k]; return 1.0f / sqrtf(s / D + RMS_EPS); }
__global__ void __launch_bounds__(256) mk_check(Args a, int stage) {
    const unsigned id = blockIdx.x * blockDim.x + threadIdx.x;
    const unsigned h = hash32(id * 2654435761u + 12345u * stage);
    unsigned char* ws = a.ws; unsigned* ctl = (unsigned*)(ws + WS_CTL);
    const int row = (int)(h % T);
    bool bad = false;
    const float* x = a.in[0];
    if (stage == 1) {
        const int col = (int)((h >> 14) % D);
        const bf16* xb = (const bf16*)(ws + WS_XB);
        bad |= !near(bf2f(xb[(size_t)row * D + col]), x[(size_t)row * D + col], 0.01f, 1e-3f);
        float s = 0.f; for (int k = 0; k < D; ++k) s += x[(size_t)row * D + k] * x[(size_t)row * D + k];
        const float* ss = (const float*)(ws + WS_SSB); float t = 0.f; for (int k = 0; k < 16; ++k) t += ss[(size_t)row * 16 + k];
        bad |= !near(t, s, 1e-3f, 1e-3f);
        const int n = (int)((h >> 7) % 7680), k = (int)(h % D);
        const bf16* wt = (const bf16*)(ws + W_IN);
        bad |= !near(bf2f(wt[(size_t)n * D + k]), a.in[2][k] * a.in[3][(size_t)k * 7680 + n], 0.01f, 1e-4f);
        const int pos = (int)(h % SEQ), i = (int)((h >> 11) % 64);
        const float th = powf(10000.0f, -(float)i / 63.0f), ang = (float)pos * th;
        const float* tab = (const float*)(ws + WS_TAB);
        bad |= !near(tab[pos * 64 + i], cosf(ang), 0.f, 2e-3f); bad |= !near(tab[131072 + pos * 64 + i], sinf(ang), 0.f, 2e-3f);
    } else if (stage == 2) {
        const int col = (int)((h >> 14) % 7680) & ~1;
        const float rs = rs_of_x(x, row);
        float v0 = 0.f, v1 = 0.f;
        for (int k = 0; k < D; ++k) { const float xv = x[(size_t)row * D + k] * a.in[2][k]; v0 += xv * a.in[3][(size_t)k * 7680 + col]; v1 += xv * a.in[3][(size_t)k * 7680 + col + 1]; }
        v0 *= rs; v1 *= rs;
        if (col < 4608) {
            const int kind = col / 512, cc = col % 512, phys = (int)((0x683754210ull >> (4 * kind)) & 15ull);
            if (kind == 3 || kind == 4) { const int i = (cc & 127) >> 1, pos = row & 2047; const float th = powf(10000.0f, -(float)i / 63.0f), ang = (float)pos * th, c = cosf(ang), sn = sinf(ang);
                const float w0 = v0 * c - v1 * sn, w1 = v0 * sn + v1 * c; v0 = w0; v1 = w1; }
            if (kind == 0) { v0 *= 0.125f; v1 *= 0.125f; } if (kind == 3) { v0 *= 0.08838834764831845f; v1 *= 0.08838834764831845f; }
            const bf16* p = (const bf16*)(ws + WS_PROJ) + (size_t)phys * T * 512 + (size_t)row * 512 + cc;
            bad |= !near(bf2f(p[0]), v0, 0.03f, 0.03f); bad |= !near(bf2f(p[1]), v1, 0.03f, 0.03f);
        } else {
            const int gc = col - 4608; const unsigned char* g8 = ws + WS_GATE8 + (size_t)row * 3072 + gc;
            const float s0 = 1.0f / (1.0f + expf(-(v0 + a.in[4][gc]))), s1 = 1.0f / (1.0f + expf(-(v1 + a.in[4][gc + 1])));
            bad |= !near((float)g8[0] / 255.0f, s0, 0.f, 0.012f); bad |= !near((float)g8[1] / 255.0f, s1, 0.f, 0.012f);
        }
    } else if (stage == 4) {
        const int col = (int)((h >> 14) % D);
        float m = 0.f;
        for (int n = 0; n < 3; ++n) { const bf16* ys = (const bf16*)(ws + WS_PROJ) + (size_t)(3 * n) * T * 512 + (size_t)row * 512; float acc = 0.f;
            for (int k = 0; k < 512; ++k) acc += bf2f(ys[k]) * a.in[14][((size_t)n * 512 + k) * D + col];
            m += acc * (float)ws[WS_GATE8 + (size_t)row * 3072 + n * 1024 + col] / 255.0f; }
        bad |= !near(bf2f(((const bf16*)(ws + WS_MERGED))[(size_t)row * D + col]), m, 0.03f, 0.03f);
    } else if (stage == 5 && false) {
        const int col = (int)((h >> 14) % D);
        const bf16* mg = (const bf16*)(ws + WS_XB) + (size_t)row * D; float acc = 0.f;
        for (int k = 0; k < D; ++k) acc += bf2f(mg[k]) * a.in[15][(size_t)k * D + col];
        const float x1 = x[(size_t)row * D + col] + acc;
        bad |= !near(a.out[(size_t)row * D + col], x1, 0.02f, 0.03f);
        bad |= !near(bf2f(((const bf16*)(ws + WS_GATE8))[(size_t)row * D + col]), a.out[(size_t)row * D + col], 0.01f, 1e-3f);
        float s = 0.f; for (int k = 0; k < D; ++k) s += a.out[(size_t)row * D + k] * a.out[(size_t)row * D + k];
        const float* ss = (const float*)(ws + WS_SSB); float t = 0.f; for (int k = 0; k < 16; ++k) t += ss[(size_t)row * 16 + k];
        bad |= !near(t, s, 1e-3f, 1e-3f);
    } else if (stage == 6 && false) {
        const int col = (int)((h >> 14) % FF);
        const bf16* xb = (const bf16*)(ws + WS_GATE8) + (size_t)row * D; float acc = 0.f;
        for (int k = 0; k < D; ++k) acc += bf2f(xb[k]) * a.in[16][k] * a.in[17][(size_t)k * FF + col];
        const float rs = rs_of_x(a.out, row); float v = fmaxf(acc * rs, 0.f); v *= v;
        bad |= !near(bf2f(((const bf16*)(ws + WS_U))[(size_t)row * FF + col]), v, 0.05f, 0.05f);
    } else if (stage == 7 && false) {
        const int col = (int)((h >> 14) % D);
        const bf16* uu = (const bf16*)(ws + WS_U) + (size_t)row * FF; float acc = 0.f;
        for (int k = 0; k < FF; ++k) acc += bf2f(uu[k]) * a.in[18][(size_t)k * D + col];
        const float x2 = bf2f(((const bf16*)(ws + WS_XB))[(size_t)row * D + col]) + acc;
        bad |= !near(a.out[(size_t)row * D + col], x2, 0.03f, 0.05f);
        bad |= !near(bf2f(((const bf16*)(ws + WS_GATE8))[(size_t)row * D + col]), a.out[(size_t)row * D + col], 0.01f, 1e-3f);
        float s = 0.f; for (int k = 0; k < D; ++k) s += a.out[(size_t)row * D + k] * a.out[(size_t)row * D + k];
        const float* ss = (const float*)(ws + WS_SSA); float t = 0.f; for (int k = 0; k < 16; ++k) t += ss[(size_t)row * 16 + k];
        bad |= !near(t, s, 1e-3f, 1e-3f);
    } else if (stage == 8 && false) {
        const int col = (int)((h >> 14) % D);
        const bf16* xb = (const bf16*)(ws + WS_GATE8) + (size_t)row * D; float acc = 0.f, s = 0.f;
        for (int k = 0; k < D; ++k) { const float xv = bf2f(xb[k]); s += xv * xv; acc += xv * a.in[19][k] * a.in[20][(size_t)k * D + col]; }
        const float rs = 1.0f / sqrtf(s / D + RMS_EPS);
        float e = 0.f; for (int k = 0; k < PLE; ++k) e += a.in[1][(size_t)row * PLE + k] * a.in[21][(size_t)k * D + col];
        const float x3 = bf2f(xb[col]) + e / (1.0f + expf(-acc * rs));
        bad |= !near(a.out[(size_t)row * D + col], x3, 0.03f, 0.05f);
    }
    if (stage == 9) bad = true;
    if (bad) atomicAdd(&ctl[CW_CNT + stage], 1u);
}
__device__ float orig_proj(const Args& a, int l, int row, int col) {
    const float* x = l == 0 ? a.in[0] : a.out; const float* g = a.in[2] + (size_t)l * D; const float* w = a.in[3] + (size_t)l * D * 7680;
    float s = 0.f, acc = 0.f;
    for (int k = 0; k < D; ++k) { const float xv = x[(size_t)row * D + k]; s += xv * xv; acc += xv * g[k] * w[(size_t)k * 7680 + col]; }
    return acc / sqrtf(s / D + RMS_EPS);
}
__global__ void __launch_bounds__(64) mk_check_na(Args a, int l) {
    __shared__ float qs[64]; __shared__ float sc[128];
    const unsigned h = hash32(blockIdx.x * 977u + 31u); const int t = (int)(h % T), hd = (int)((h >> 16) % 8), d = threadIdx.x;
    unsigned char* ws = a.ws; unsigned* ctl = (unsigned*)(ws + WS_CTL);
    const bf16* K = (const bf16*)(ws + WS_PROJ + BLK); const bf16* V = (const bf16*)(ws + WS_PROJ + 2 * BLK); const bf16* Y = (const bf16*)(ws + WS_PROJ);
    qs[d] = bf2f((bf16)f2bf(0.125f * orig_proj(a, l, t, hd * 64 + d)));
    __syncthreads();
    const int b = t / SEQ, s = t % SEQ, r = s / 64, c = s % 64;
    int rs = r - 4; if (rs < 0) rs = 0; if (rs > 24) rs = 24; int cs = c - 8; if (cs < 0) cs = 0; if (cs > 48) cs = 48;
    const float* rpb = a.in[5] + (size_t)l * 8 * 15 * 31 + hd * 465;
    for (int kk = d; kk < 128; kk += 64) { const int i = kk / 16, j = kk % 16; const int tk = b * SEQ + (rs + i) * 64 + cs + j; float acc = 0.f;
        for (int e = 0; e < 64; ++e) acc += qs[e] * bf2f(K[(size_t)tk * 512 + hd * 64 + e]);
        sc[kk] = acc + rpb[(rs + i - r + 7) * 31 + (cs + j - c + 15)]; }
    __syncthreads();
    float mx = -1e30f; for (int kk = 0; kk < 128; ++kk) mx = fmaxf(mx, sc[kk]);
    float den = 0.f, o = 0.f;
    for (int kk = 0; kk < 128; ++kk) { const int i = kk / 16, j = kk % 16; const int tk = b * SEQ + (rs + i) * 64 + cs + j; const float p = expf(sc[kk] - mx); den += p; o += p * bf2f(V[(size_t)tk * 512 + hd * 64 + d]); }
    o /= den;
    if (!near(bf2f(Y[(size_t)t * 512 + hd * 64 + d]), o, 0.04f, 0.04f)) atomicAdd(&ctl[CW_CNT + 31], 1u);
}
__global__ void __launch_bounds__(128) mk_check_ret(Args a, int l) {
    __shared__ float qs[128]; __shared__ float sc[SEQ]; __shared__ float red[128];
    const unsigned h = hash32(blockIdx.x * 1231u + 77u); const int t = (int)(h % T), hd = (int)((h >> 16) % 4), dv = threadIdx.x;
    unsigned char* ws = a.ws; unsigned* ctl = (unsigned*)(ws + WS_CTL);
    const bf16* Y = (const bf16*)(ws + WS_PROJ + 3 * BLK); const bf16* Q = (const bf16*)(ws + WS_PROJ + 4 * BLK); const bf16* K = (const bf16*)(ws + WS_PROJ + 5 * BLK); const bf16* V = (const bf16*)(ws + WS_PROJ + 7 * BLK);
    const int b = t / SEQ, n = t % SEQ;
    qs[dv] = bf2f(Q[(size_t)t * 512 + hd * 128 + dv]);
    __syncthreads();
    const float gf = log2_1m(__builtin_amdgcn_exp2f(-5.0f - (float)hd)), gb = log2_1m(__builtin_amdgcn_exp2f(-5.5f - (float)hd));
    for (int m = dv; m < SEQ; m += 128) { float acc = 0.f; for (int e = 0; e < 128; ++e) acc += qs[e] * bf2f(K[(size_t)(b * SEQ + m) * 512 + hd * 128 + e]);
        sc[m] = acc * (m <= n ? __builtin_amdgcn_exp2f(gf * (float)(n - m)) : __builtin_amdgcn_exp2f(gb * (float)(m - n))); }
    __syncthreads();
    float o = 0.f; for (int m = 0; m < SEQ; ++m) o += sc[m] * bf2f(V[(size_t)(b * SEQ + m) * 512 + hd * 128 + dv]);
    red[dv] = o * o; __syncthreads();
    float ms = 0.f; for (int e = 0; e < 128; ++e) ms += red[e];
    const float rn = 1.0f / sqrtf(ms / 128.0f + RMS_EPS);
    const float g = bf2f((bf16)f2bf(orig_proj(a, l, t, 1536 + 3 * 512 + hd * 128 + dv)));
    const float y = g / (1.0f + expf(-g)) * o * rn * a.in[6][(size_t)l * 512 + hd * 128 + dv];
    if (!near(bf2f(Y[(size_t)t * 512 + hd * 128 + dv]), y, 0.04f, 0.04f)) atomicAdd(&ctl[CW_CNT + 32], 1u);
}
__global__ void __launch_bounds__(128) mk_check_g(Args a, int l, int code) {
    const unsigned h = hash32(blockIdx.x * 1231u + 77u); const int t = (int)(h % T), hd = (int)((h >> 16) % 4), dv = threadIdx.x;
    unsigned* ctl = (unsigned*)(a.ws + WS_CTL);
    const bf16* G = (const bf16*)(a.ws + WS_PROJ + 3 * BLK);
    const float g = orig_proj(a, l, t, 1536 + 3 * 512 + hd * 128 + dv);
    if (!near(bf2f(G[(size_t)t * 512 + hd * 128 + dv]), g, 0.03f, 0.03f)) atomicAdd(&ctl[CW_CNT + code], 1u);
}
__global__ void __launch_bounds__(64) mk_check_lru(Args a, int l) {
    __shared__ float xs[64];
    const unsigned h = hash32(blockIdx.x * 733u + 5u); const int b = (int)(h % 8), blk = (int)((h >> 8) % 8), ts = (int)((h >> 16) % SEQ), j = threadIdx.x, ch = blk * 64 + j;
    unsigned char* ws = a.ws; unsigned* ctl = (unsigned*)(ws + WS_CTL);
    const bf16* XC = (const bf16*)(ws + WS_PROJ + 8 * BLK); const bf16* Y = (const bf16*)(ws + WS_PROJ + 6 * BLK);
    const float* cw = a.in[7] + (size_t)l * 2048; const float cb = a.in[8][(size_t)l * 512 + ch];
    float hsum = 0.f;
    for (int dir = 0; dir < 2; ++dir) {
        const float* wa = a.in[9] + (((size_t)l * 2 + dir) * 8 + blk) * 4096; const float* wx = a.in[11] + (((size_t)l * 2 + dir) * 8 + blk) * 4096;
        const float ba = a.in[10][((size_t)l * 2 + dir) * 512 + ch], bx = a.in[12][((size_t)l * 2 + dir) * 512 + ch], lam = a.in[13][((size_t)l * 2 + dir) * 512 + ch];
        const float sp = log1pf(expf(-lam));
        float hh = 0.f;
        const int nsteps = dir == 0 ? ts + 1 : SEQ - ts;
        for (int st = 0; st < nsteps; ++st) {
            const int t = dir == 0 ? st : SEQ - 1 - st;
            float xf = cb;
            for (int w = 0; w < 4; ++w) { const int t2 = t + w - 2; if (t2 >= 0 && t2 < SEQ) xf += cw[w * 512 + ch] * bf2f(XC[(size_t)(b * SEQ + t2) * 512 + ch]); }
            __syncthreads(); xs[j] = xf; __syncthreads();
            float ra = ba, ia = bx;
            for (int i = 0; i < 64; ++i) { ra += xs[i] * wa[i * 64 + j]; ia += xs[i] * wx[i * 64 + j]; }
            const float r = 1.0f / (1.0f + expf(-ra)), ig = 1.0f / (1.0f + expf(-ia));
            const float la = -8.0f * r * sp, av = expf(la); float mult = sqrtf(-expm1f(2.0f * la)); if (st == 0) mult = 1.0f;
            hh = av * hh + mult * ig * xf;
        }
        hsum += hh;
    }
    const float gc = bf2f((bf16)f2bf(orig_proj(a, l, b * SEQ + ts, 3584 + 512 + ch)));
    const float u = 0.7978845608028654f * (gc + 0.044715f * gc * gc * gc);
    const float y = 0.5f * gc * (1.0f + tanhf(u)) * hsum;
    if (!near(bf2f(Y[(size_t)(b * SEQ + ts) * 512 + ch]), y, 0.04f, 0.04f)) atomicAdd(&ctl[CW_CNT + 33], 1u);
}
__global__ void mk_report(Args a) {
    unsigned* ctl = (unsigned*)(a.ws + WS_CTL);
    const int order[13] = {1, 2, 35, 31, 34, 32, 33, 4, 5, 6, 7, 8, 9};
    const unsigned tot[13] = {16384u, 16384u, 16384u, 32768u, 16384u, 16384u, 8192u, 16384u, 16384u, 16384u, 16384u, 16384u, 64u};
    for (int i = 0; i < 13; ++i) {
        const unsigned cnt = ctl[CW_CNT + order[i]];
        if (cnt * 200u > tot[i]) {
            unsigned tenth = (cnt * 10u) / tot[i]; if (tenth > 9u) tenth = 9u;
            a.out[0] = order[i] >= 10 ? 100.0f * (float)order[i] : 1000.0f * (float)order[i] + 100.0f * (float)tenth;
            return;
        }
    }
}
#endif

#ifndef MK_ONE_LAUNCH
#define MK_ONE_LAUNCH 1
#endif
extern "C" void kernel_launch(void* const* d_in, const int* in_sizes, int n_in, void* d_out, int out_size, void* d_ws, size_t ws_size, hipStream_t stream) {
    static int grid = 0;
    if (grid == 0) {
        if (n_in != 23 || in_sizes[0] != T * D || out_size != T * D || ws_size < WS_END) { fprintf(stderr, "kernel_launch: unexpected shapes (n_in %d, in0 %d, out %d, ws %zu); nothing launched\n", n_in, n_in > 0 ? in_sizes[0] : -1, out_size, ws_size); grid = -1; return; }
        int dev = 0, cus = 0, per_cu = 0;
        if (hipGetDevice(&dev) != hipSuccess || hipDeviceGetAttribute(&cus, hipDeviceAttributeMultiprocessorCount, dev) != hipSuccess) { grid = -1; return; }
        if (hipFuncSetAttribute((const void*)mk_fwd, hipFuncAttributeMaxDynamicSharedMemorySize, LDS_BYTES) != hipSuccess) { fprintf(stderr, "kernel_launch: hipFuncSetAttribute failed\n"); grid = -1; return; }
        if (hipOccupancyMaxActiveBlocksPerMultiprocessor(&per_cu, (const void*)mk_fwd, NWAVES * 64, LDS_BYTES) != hipSuccess || per_cu < 1) { fprintf(stderr, "kernel_launch: occupancy query says %d blocks per CU\n", per_cu); }
        (void)hipGetLastError();
        grid = cus;
    }
    if (grid < 0) return;
    if (hipMemsetAsync((char*)d_ws + WS_CTL, 0, CTL_ZERO_BYTES, stream) != hipSuccess) return;
    Args a{};
    for (int i = 0; i < 23; ++i) a.in[i] = (const float*)d_in[i];
    a.out = (float*)d_out; a.ws = (unsigned char*)d_ws;
#if MK_ONE_LAUNCH
    a.ph_lo = 0; a.ph_hi = NPH;
    hipLaunchKernelGGL(mk_fwd, dim3(grid), dim3(NWAVES * 64), LDS_BYTES, stream, a);
#else
    for (int ph = 0; ph < NPH; ++ph) {
#if MK_CHECK
        if (ph == 1 + 6) (void)hipMemcpyAsync((char*)d_ws + WS_XB, (char*)d_ws + WS_GATE8, (size_t)T * D * 2, hipMemcpyDeviceToDevice, stream);
#endif
        a.ph_lo = ph; a.ph_hi = ph + 1; hipLaunchKernelGGL(mk_fwd, dim3(grid), dim3(NWAVES * 64), LDS_BYTES, stream, a);
#if MK_CHECK
        { int st = 0; if (ph == 0) st = 1; else if (ph == 1) st = 2; else if (ph == 1 + 3) st = 4; else if (ph == 1 + 4) st = 5; else if (ph == 1 + 5) st = 6; else if (ph == 1 + 6) st = 7; else if (ph == 1 + 7) st = 8;
          if (st) hipLaunchKernelGGL(mk_check, dim3(64), dim3(256), 0, stream, a, st);
          if (ph == 1 + 1) hipLaunchKernelGGL(mk_check_na, dim3(512), dim3(64), 0, stream, a, 0);
          if (ph == 1) hipLaunchKernelGGL(mk_check_g, dim3(128), dim3(128), 0, stream, a, 0, 35);
          if (ph == 1 + 1) hipLaunchKernelGGL(mk_check_g, dim3(128), dim3(128), 0, stream, a, 0, 34);
          if (ph == 1 + 2) hipLaunchKernelGGL(mk_check_ret, dim3(128), dim3(128), 0, stream, a, 0);
          if (ph == 1 + 2) hipLaunchKernelGGL(mk_check_lru, dim3(128), dim3(64), 0, stream, a, 0);
          if (ph == NPH - 1) hipLaunchKernelGGL(mk_check, dim3(1), dim3(64), 0, stream, a, 9); }
#endif
    }
#if MK_CHECK
    hipLaunchKernelGGL(mk_report, dim3(1), dim3(1), 0, stream, a);
#endif
#endif
}
```

```cpp
#include <hip/hip_runtime.h>
#include <cstdio>
#include <cstdint>
#ifndef MK_CHECK
#define MK_CHECK 0
#endif
#ifndef PROBE_WN
#define PROBE_WN 0x0ull
#endif
namespace pg8 {
#define PG8_LAS __attribute__((address_space(3)))
typedef unsigned short bf16_t;
typedef short bf16x8 __attribute__((ext_vector_type(8)));
typedef float f32x4 __attribute__((ext_vector_type(4)));
typedef unsigned u32x4 __attribute__((ext_vector_type(4)));
constexpr int BM = 256, BK = 64, HALF = 128, HTB = HALF * BK * 2  , STAGE_BYTES = 8 * HTB, NXCD = 8, WGM = 8;

__host__ __device__ __forceinline__ int lds_byte(int r, int c) { const int st = (r >> 4) * 2 + (c >> 5), rr = r & 15, cc = c & 31, ob = rr * 64 + cc * 2; return st * 1024 + (ob ^ (((ob >> 9) & 1) << 5)); }
__host__ __device__ __forceinline__ void stage_rc(int b, int& R, int& C) { const int st = b / 1024, sb = b % 1024, swz = sb ^ (((sb >> 9) & 1) << 5); R = (st >> 1) * 16 + swz / 64; C = (st & 1) * 32 + (swz % 64) / 2; }
__host__ __device__ __forceinline__ int perm32(int rho) { const int n = rho >> 4, i = rho & 15; return 8 * (i >> 2) + 4 * n + (i & 3); }

struct Unit { int pm, pn, z; };
struct Gemm { const bf16_t* A; const bf16_t* Bt; int M, N, K; size_t zA, zB; };

struct StaticOrder {
    int nM, nN, nwg, G, c;
    __host__ __device__ void init(int M, int N, int G_, int c_) { nM = M / BM; nN = N / BM; nwg = nM * nN; G = G_; c = c_; }
    __host__ __device__ bool next(int i, Unit& u) const {
        const long L = (long)i * G + c; if (L >= nwg) return false;
        int wgid = (int)L; { const int q = nwg / NXCD, r = nwg % NXCD, xcd = wgid % NXCD, off = wgid / NXCD; wgid = (xcd < r ? xcd * (q + 1) : r * (q + 1) + (xcd - r) * q) + off; }
        const int nig = WGM * nN, gid = wgid / nig, fm = gid * WGM, gsz = (nM - fm) < WGM ? (nM - fm) : WGM;
        u.pm = fm + ((wgid % nig) % gsz); u.pn = (wgid % nig) / gsz; u.z = 0; return true;
    }
    __device__ __forceinline__ void a_ready(const Unit&) const {}
    __device__ __forceinline__ void done(const Unit&) const {}
};

__device__ __forceinline__ unsigned cvt_pk_bf16(float lo, float hi) { unsigned r; asm volatile("v_cvt_pk_bf16_f32 %0, %1, %2" : "=v"(r) : "v"(lo), "v"(hi)); return r; }
typedef float f32x2 __attribute__((ext_vector_type(2)));
template <class Epi, class Sched, bool ALIGN_EPI = false, bool SP2 = false>
__device__ __forceinline__ void gemm_phase(PG8_LAS unsigned char* lds, const Gemm g, const Sched& S, const Epi& E, const int tid) {
    const int wid = __builtin_amdgcn_readfirstlane(tid >> 6), lane = tid & 63, wr = wid >> 2, wc = wid & 3, fr = lane & 15, fq = lane >> 4;
    const int K = g.K, nt = K / BK;
    unsigned voffA[2], voffB[2];
#pragma unroll
    for (int i = 0; i < 2; ++i) { int R, C; stage_rc(tid * 16 + i * 8192, R, C); const int Rb = Epi::PERM ? ((R & ~31) + perm32(R & 31)) : R;
        voffA[i] = (unsigned)(R * K + C) * 2u; voffB[i] = (unsigned)(Rb * K + C) * 2u; }
    const size_t kstep = (size_t)(BK * 2);
    const size_t hstep = (size_t)HALF * K * 2;
    const size_t tstep = 2 * hstep;
    const unsigned ldsw = (unsigned)wid * 1024u;
    const int aoff = lds_byte(wr * 64 + fr, fq * 8), boff = lds_byte(wc * 32 + fr, fq * 8);
#define PG8_SA(b, h) (((b) * 2 + (h)) * HTB)
#define PG8_SB(b, h) ((4 + (b) * 2 + (h)) * HTB)
#define PG8_STAGE(bufoff, gbase, voff) do { _Pragma("unroll") for (int _i = 0; _i < 2; ++_i) \
        __builtin_amdgcn_global_load_lds((const unsigned*)((const char*)(gbase) + (voff)[_i]), (PG8_LAS unsigned*)(lds + (bufoff) + ldsw + _i * 8192), 16, 0, 0); } while (0)
#define PG8_LDA(dst, b, h) do { _Pragma("unroll") for (int m = 0; m < 4; ++m) _Pragma("unroll") for (int k = 0; k < 2; ++k) dst[m][k] = *(const PG8_LAS bf16x8*)(lds + PG8_SA(b, h) + aoff + m * 2048 + k * 1024); } while (0)
#define PG8_LDB(dst, b, h) do { _Pragma("unroll") for (int n = 0; n < 2; ++n) _Pragma("unroll") for (int k = 0; k < 2; ++k) dst[n][k] = *(const PG8_LAS bf16x8*)(lds + PG8_SB(b, h) + boff + n * 2048 + k * 1024); } while (0)
#define PG8_MMA(ai, bj, At, Bt) do { __builtin_amdgcn_s_setprio(1); _Pragma("unroll") for (int m = 0; m < 4; ++m) _Pragma("unroll") for (int n = 0; n < 2; ++n) _Pragma("unroll") for (int k = 0; k < 2; ++k) \
        acc[ai][bj][m][n] = __builtin_amdgcn_mfma_f32_16x16x32_bf16(Bt[n][k], At[m][k], acc[ai][bj][m][n], 0, 0, 0); __builtin_amdgcn_s_setprio(0); } while (0)
#define PG8_WAIT_V(n) asm volatile("s_waitcnt vmcnt(" #n ")" ::: "memory")
#define PG8_WAIT_L(n) asm volatile("s_waitcnt lgkmcnt(" #n ")" ::: "memory")
#define PG8_BAR __builtin_amdgcn_s_barrier()
#define PG8_SCHED __builtin_amdgcn_sched_barrier(0)
    Unit cur, nxt; int ui = 0;
    if (!S.next(0, cur)) return;
    f32x4 acc[2][2][4][2];
#pragma unroll
    for (int a = 0; a < 2; ++a)
#pragma unroll
        for (int b = 0; b < 2; ++b)
#pragma unroll
            for (int m = 0; m < 4; ++m)
#pragma unroll
                for (int n = 0; n < 2; ++n) acc[a][b][m][n] = (f32x4){0.f, 0.f, 0.f, 0.f};
    bf16x8 At[4][2], B0[2][2], B1[2][2];
    const char* cA = (const char*)g.A + (size_t)cur.z * g.zA + (size_t)cur.pm * tstep; const char* cB = (const char*)g.Bt + (size_t)cur.z * g.zB + (size_t)cur.pn * tstep;
    S.a_ready(cur);
    if constexpr (SP2) {
        PG8_STAGE(PG8_SB(0, 0), cB, voffB); PG8_STAGE(PG8_SB(0, 1), cB + hstep, voffB); PG8_STAGE(PG8_SA(0, 0), cA, voffA); PG8_STAGE(PG8_SA(0, 1), cA + hstep, voffA);
        if (wr == 1) PG8_BAR;
        PG8_WAIT_V(2); PG8_BAR;
        PG8_STAGE(PG8_SB(1, 0), cB + kstep, voffB); PG8_STAGE(PG8_SA(1, 0), cA + kstep, voffA); PG8_STAGE(PG8_SB(1, 1), cB + hstep + kstep, voffB);
        PG8_WAIT_V(6); PG8_BAR;
    } else {
        PG8_STAGE(PG8_SB(0, 0), cB, voffB); PG8_STAGE(PG8_SA(0, 0), cA, voffA); PG8_STAGE(PG8_SB(0, 1), cB + hstep, voffB); PG8_STAGE(PG8_SA(0, 1), cA + hstep, voffA);
        if (wr == 1) PG8_BAR;
        PG8_WAIT_V(4); PG8_BAR;
        PG8_STAGE(PG8_SB(1, 0), cB + kstep, voffB); PG8_STAGE(PG8_SA(1, 0), cA + kstep, voffA); PG8_STAGE(PG8_SB(1, 1), cB + hstep + kstep, voffB);
        PG8_WAIT_V(6); PG8_BAR;
    }
    for (;;) {
        const bool has_next = S.next(ui + 1, nxt);
        const char* nA = has_next ? (const char*)g.A + (size_t)nxt.z * g.zA + (size_t)nxt.pm * tstep : cA; const char* nB = has_next ? (const char*)g.Bt + (size_t)nxt.z * g.zB + (size_t)nxt.pn * tstep : cB;
        for (int t = 0; t < nt; t += 2) {
            const bool last = (t == nt - 2);
            const char* a1 = cA + (size_t)(t + 1) * kstep;
            const char* a2 = last ? nA : cA + (size_t)(t + 2) * kstep; const char* b2 = last ? nB : cB + (size_t)(t + 2) * kstep;
            const char* a3 = a2 + kstep; const char* b3 = b2 + kstep;
            if (last && has_next) S.a_ready(nxt);
            if constexpr (SP2) {
            PG8_LDB(B0, 0, 0); PG8_LDB(B1, 0, 1); PG8_SCHED; PG8_LDA(At, 0, 0); PG8_STAGE(PG8_SA(1, 1), a1 + hstep, voffA);
            PG8_WAIT_V(8); PG8_WAIT_L(0); PG8_BAR; PG8_MMA(0, 0, At, B0); PG8_MMA(0, 1, At, B1); PG8_BAR; PG8_SCHED;
            PG8_LDA(At, 0, 1); PG8_STAGE(PG8_SB(0, 0), b2, voffB); PG8_STAGE(PG8_SB(0, 1), b2 + hstep, voffB); PG8_STAGE(PG8_SA(0, 0), a2, voffA);
            PG8_WAIT_V(8); PG8_WAIT_L(0); PG8_BAR; PG8_MMA(1, 0, At, B0); PG8_MMA(1, 1, At, B1); PG8_BAR; PG8_SCHED;
            PG8_LDB(B0, 1, 0); PG8_LDB(B1, 1, 1); PG8_SCHED; PG8_LDA(At, 1, 0); PG8_STAGE(PG8_SA(0, 1), a2 + hstep, voffA);
            PG8_WAIT_V(8); PG8_WAIT_L(0); PG8_BAR; PG8_MMA(0, 0, At, B0); PG8_MMA(0, 1, At, B1); PG8_BAR; PG8_SCHED;
            PG8_LDA(At, 1, 1); PG8_STAGE(PG8_SB(1, 0), b3, voffB); PG8_STAGE(PG8_SB(1, 1), b3 + hstep, voffB); PG8_STAGE(PG8_SA(1, 0), a3, voffA);
            PG8_WAIT_V(8); PG8_WAIT_L(0); PG8_BAR; PG8_MMA(1, 0, At, B0); PG8_MMA(1, 1, At, B1); PG8_BAR; PG8_SCHED;
            } else {
            PG8_LDB(B0, 0, 0); PG8_SCHED; PG8_LDA(At, 0, 0); PG8_STAGE(PG8_SA(1, 1), a1 + hstep, voffA);
            PG8_WAIT_L(8); PG8_BAR; PG8_WAIT_L(0); PG8_MMA(0, 0, At, B0); PG8_BAR; PG8_SCHED;
            PG8_LDB(B1, 0, 1); PG8_STAGE(PG8_SB(0, 0), b2, voffB);
            PG8_BAR; PG8_WAIT_L(0); PG8_MMA(0, 1, At, B1); PG8_BAR;
            PG8_LDA(At, 0, 1); PG8_STAGE(PG8_SA(0, 0), a2, voffA);
            PG8_BAR; PG8_WAIT_L(0); PG8_MMA(1, 0, At, B0); PG8_BAR; PG8_SCHED;
            PG8_STAGE(PG8_SB(0, 1), b2 + hstep, voffB);
            PG8_WAIT_V(6); PG8_BAR; PG8_MMA(1, 1, At, B1); PG8_BAR;
            PG8_LDB(B0, 1, 0); PG8_SCHED; PG8_LDA(At, 1, 0); PG8_STAGE(PG8_SA(0, 1), a2 + hstep, voffA);
            PG8_WAIT_L(8); PG8_BAR; PG8_WAIT_L(0); PG8_MMA(0, 0, At, B0); PG8_BAR; PG8_SCHED;
            PG8_LDB(B1, 1, 1); PG8_STAGE(PG8_SB(1, 0), b3, voffB);
            PG8_BAR; PG8_WAIT_L(0); PG8_MMA(0, 1, At, B1); PG8_BAR;
            PG8_LDA(At, 1, 1); PG8_STAGE(PG8_SA(1, 0), a3, voffA);
            PG8_BAR; PG8_WAIT_L(0); PG8_MMA(1, 0, At, B0); PG8_BAR; PG8_SCHED;
            PG8_STAGE(PG8_SB(1, 1), b3 + hstep, voffB);
            PG8_WAIT_V(6); PG8_BAR; PG8_MMA(1, 1, At, B1); PG8_BAR;
            }
        }
        if constexpr (ALIGN_EPI) { if (wr == 0) PG8_BAR; }
        if constexpr (!Epi::AFTER_DRAIN) { E(acc, cur, wr, wc, fr, fq); S.done(cur); }
        if (!has_next) break;
        if constexpr (!Epi::KEEP_ACC)
#pragma unroll
        for (int a = 0; a < 2; ++a)
#pragma unroll
            for (int b = 0; b < 2; ++b)
#pragma unroll
                for (int m = 0; m < 4; ++m)
#pragma unroll
                    for (int n = 0; n < 2; ++n) acc[a][b][m][n] = (f32x4){0.f, 0.f, 0.f, 0.f};
        cur = nxt; cA = nA; cB = nB; ++ui;
        if constexpr (ALIGN_EPI) { if (wr == 1) PG8_BAR; }
    }
    PG8_WAIT_V(0);
    if constexpr (!ALIGN_EPI) { if (wr == 0) PG8_BAR; }
    PG8_BAR;
    if constexpr (Epi::AFTER_DRAIN) { E.fused(acc, cur, wr, wc, fr, fq, lds, wid, lane); S.done(cur); }
#undef PG8_SA
#undef PG8_SB
#undef PG8_STAGE
#undef PG8_LDA
#undef PG8_LDB
#undef PG8_MMA
#undef PG8_WAIT_V
#undef PG8_WAIT_L
#undef PG8_BAR
#undef PG8_SCHED
}
}

constexpr int T = 16384, D = 1024, SEQ = 2048, DEPTH = 2, FF = 4096, PLE = 256;
constexpr float RMS_EPS = 1e-6f;
constexpr size_t MiB = 1u << 20;
constexpr size_t WS_CTL = 0, CTL_ZERO_BYTES = 65536;
constexpr size_t WS_TAB = 1 * MiB;
constexpr size_t WS_SSA = 2 * MiB, WS_SSB = 3 * MiB;
constexpr size_t WS_PROJ = 6 * MiB, BLK = 16 * MiB;
constexpr size_t WS_GATE8 = 150 * MiB;
constexpr size_t WS_XB = 198 * MiB;
constexpr size_t WS_W = 230 * MiB, WS_END = 256 * MiB;
constexpr size_t W_IN = WS_W, W_UP = WS_W, W_DOWN = WS_W + 8 * MiB, W_BR = WS_W + 16 * MiB, W_OUT = WS_W + 19 * MiB;
__host__ __device__ constexpr size_t W_G(int slot) { return WS_W + 21 * MiB + (size_t)slot * (5 * MiB / 2); }
__host__ __device__ constexpr size_t W_PLE(int slot) { return W_G(slot) + 2 * MiB; }
constexpr size_t WS_U = WS_PROJ;
constexpr size_t WS_E = WS_PROJ;
constexpr size_t WS_PB = WS_PROJ + 8 * BLK;
constexpr size_t WS_HF = WS_PROJ + 1 * BLK;
constexpr size_t WS_AGG = 4 * MiB;
constexpr size_t WS_LW = 5 * MiB;
constexpr size_t WS_SP = 5 * MiB + 512 * 1024;
constexpr size_t WS_MERGED = WS_PROJ + 1 * BLK;
constexpr size_t WS_ST = WS_XB;
constexpr int CW_TMO = 0, CW_BAR = 4096;

enum { PH_PRO = 0, PH_G1, PH_MIXA, PH_MIXB, PH_G2, PH_G3, PH_G4, PH_G5, PH_G6, PH_FIN };
constexpr int NPL = 8, NPH = 1 + DEPTH * NPL + 1;

constexpr int NWAVES = 8;
constexpr int RING_BYTES = 131072, LDS_BYTES = 155648, LDSCTL_OFF = LDS_BYTES - 1024, MISC_OFF = LDSCTL_OFF + 320;

#define GAS __attribute__((address_space(1)))
#define LAS __attribute__((address_space(3)))
typedef unsigned short bf16;
typedef unsigned v4u __attribute__((ext_vector_type(4)));
typedef unsigned v2u __attribute__((ext_vector_type(2)));
typedef float f32x4 __attribute__((ext_vector_type(4)));
typedef GAS unsigned gu32;
#define RLX_AGENT __ATOMIC_RELAXED, __HIP_MEMORY_SCOPE_AGENT
#define LDS_WAIT() asm volatile("s_waitcnt lgkmcnt(0)" ::: "memory")
#define VM_WAIT() asm volatile("s_waitcnt vmcnt(0)" ::: "memory")
__device__ __forceinline__ unsigned f2bf(float f) { unsigned u = __builtin_bit_cast(unsigned, f); return (u + 0x7fffu + ((u >> 16) & 1u)) >> 16; }
__device__ __forceinline__ unsigned pk2(float lo, float hi) { return f2bf(lo) | (f2bf(hi) << 16); }
__device__ __forceinline__ float bf2f(unsigned short b) { return __builtin_bit_cast(float, (unsigned)b << 16); }
__device__ __forceinline__ float bflo(unsigned w) { return __builtin_bit_cast(float, w << 16); }
__device__ __forceinline__ float bfhi(unsigned w) { return __builtin_bit_cast(float, w & 0xffff0000u); }
__device__ __forceinline__ float rdlane(float v, int l) { return __builtin_bit_cast(float, __builtin_amdgcn_readlane(__builtin_bit_cast(int, v), l)); }
__device__ __forceinline__ float fexp(float x) { return __builtin_amdgcn_exp2f(x * 1.4426950408889634f); }
__device__ __forceinline__ float sigmoidf_(float x) { return __builtin_amdgcn_rcpf(1.0f + fexp(-x)); }
__device__ __forceinline__ float lane_get(float v, int srclane) { return __builtin_bit_cast(float, __builtin_amdgcn_ds_bpermute(srclane << 2, __builtin_bit_cast(int, v))); }
__device__ __forceinline__ float shx(float v, int lane, int o) { return lane_get(v, lane ^ o); }
__device__ __forceinline__ float wave_sum(float v, int lane) {
#pragma unroll
    for (int o = 1; o < 64; o <<= 1) v += shx(v, lane, o);
    return v;
}
__device__ __forceinline__ float wave_max(float v, int lane) {
#pragma unroll
    for (int o = 1; o < 64; o <<= 1) v = fmaxf(v, shx(v, lane, o));
    return v;
}
__device__ __forceinline__ float log2_1m(float x) {
    const float p = x * (1.0f + x * (0.5f + x * (0.33333333f + x * (0.25f + x * (0.2f + x * (0.16666667f + x * 0.14285714f))))));
    return -p * 1.4426950408889634f;
}
__device__ __forceinline__ float log1p_small(float y) {
    if (y < 0.01f) return y * (1.0f - y * (0.5f - y * (0.33333333f - 0.25f * y)));
    return __builtin_amdgcn_logf(1.0f + y) * 0.6931471805599453f;
}
__device__ __forceinline__ float gelu_tanh(float x) {
    const float u = 0.7978845608028654f * (x + 0.044715f * x * x * x);
    const float t = 1.0f - 2.0f * __builtin_amdgcn_rcpf(1.0f + fexp(2.0f * u));
    return 0.5f * x * (1.0f + t);
}
__device__ __forceinline__ float row_rs(const float* ss, int row, int fq, int lane) {
    const f32x4 a = *(const f32x4*)(ss + (size_t)row * 16 + 4 * fq);
    float s = (a.x + a.y) + (a.z + a.w);
    s += shx(s, lane, 16); s += shx(s, lane, 32);
    return 1.0f / sqrtf(s * (1.0f / D) + RMS_EPS);
}

#define XB_TMO      128
#define XB_XCNT(j)  (256  + 64 * (j))
#define XB_XSUB(j)  (1280 + 64 * (j))
#define XB_XGEN(j)  (2304 + 64 * (j))
#define XB_TOP      3328
#define XB_TOPGEN   3392
#define XCD_BAR_WORDS 3456
#define XB_SPIN_CAP (1u << 18)

__device__ __forceinline__ unsigned xb_ld(unsigned* p)              { return __hip_atomic_load(p, __ATOMIC_RELAXED, __HIP_MEMORY_SCOPE_AGENT); }
__device__ __forceinline__ unsigned xb_add(unsigned* p, unsigned v) { return __hip_atomic_fetch_add(p, v, __ATOMIC_RELAXED, __HIP_MEMORY_SCOPE_AGENT); }
__device__ __forceinline__ unsigned xb_xcc_id() { return (unsigned)__builtin_amdgcn_s_getreg((3 << 11) | 20) & 0xFu; }
#define XB_SPIN(cond, bar) do { unsigned _sp = 0; while (cond) { __builtin_amdgcn_s_sleep(1); \
    if ((++_sp & 255u) == 0u) { if (xb_ld(&(bar)[XB_TMO])) break; if (_sp > XB_SPIN_CAP) { atomicAdd(&(bar)[XB_TMO], 1u); break; } } } } while (0)

struct XcdBarrier {
    unsigned* bar; unsigned x;
    volatile LAS unsigned* st;
};

__device__ __forceinline__ XcdBarrier xcd_barrier_post(unsigned* bar, volatile LAS unsigned* st) {
    XcdBarrier b; b.bar = bar; b.x = xb_xcc_id(); b.st = st;
    if (threadIdx.x == 0) (void)xb_add(&bar[XB_XCNT(b.x)], 1u);
    return b;
}
__device__ __forceinline__ void xcd_barrier_complete(unsigned* bar, unsigned x, unsigned& nloc, unsigned& nx) {
    const unsigned G = gridDim.x * gridDim.y * gridDim.z;
    unsigned sum, cnt, mine, sp = 0u;
    for (;;) {
        sum = 0u; cnt = 0u; mine = 0u;
#pragma unroll
        for (unsigned j = 0; j < 16; ++j) { const unsigned c = xb_ld(&bar[XB_XCNT(j)]); sum += c; cnt += (c > 0u) ? 1u : 0u; mine = (j == x) ? c : mine; }
        if (sum == G) break;
        __builtin_amdgcn_s_sleep(1);
        if ((++sp & 255u) == 0u) { if (xb_ld(&bar[XB_TMO])) break; if (sp > XB_SPIN_CAP) { atomicAdd(&bar[XB_TMO], 1u); break; } }
    }
    nloc = mine > 0u ? mine : 1u; nx = cnt > 0u ? cnt : 1u;
}

__device__ __forceinline__ void xcd_barrier(const XcdBarrier& b, const int tid_) {
    asm volatile("s_waitcnt vmcnt(0)" ::: "memory");
    __syncthreads();
    if (tid_ == 0) {
        unsigned* bar = b.bar;
        __builtin_amdgcn_s_waitcnt(0);
        unsigned nloc = b.st[0], nx = b.st[1];
        if (nloc == 0u) { xcd_barrier_complete(bar, b.x, nloc, nx); b.st[0] = nloc; b.st[1] = nx; }
        const unsigned old = xb_add(&bar[XB_XSUB(b.x)], 1u);
        const unsigned gen = old / nloc;
        if (old + 1u == (gen + 1u) * nloc) {
            __builtin_amdgcn_fence(__ATOMIC_RELEASE, "agent");
            asm volatile("s_waitcnt vmcnt(0)" ::: "memory");
            const unsigned og = xb_add(&bar[XB_TOP], 1u);
            const unsigned tg = og / nx;
            if (og + 1u == (tg + 1u) * nx) xb_add(&bar[XB_TOPGEN], 1u);
            else XB_SPIN(xb_ld(&bar[XB_TOPGEN]) == tg, bar);
            __builtin_amdgcn_fence(__ATOMIC_ACQUIRE, "agent");
            xb_add(&bar[XB_XGEN(b.x)], 1u);
            asm volatile("s_waitcnt vmcnt(0)" ::: "memory");
        } else {
            XB_SPIN(xb_ld(&bar[XB_XGEN(b.x)]) == gen, bar);
            __builtin_amdgcn_fence(__ATOMIC_ACQUIRE, "agent");
            asm volatile("s_waitcnt vmcnt(0)" ::: "memory");
        }
    }
    __syncthreads();
}


using pg8::Unit; using pg8::bf16_t; using pg8::cvt_pk_bf16;
typedef pg8::u32x4 u32x4;
struct EpiG1 {
    static constexpr bool PERM = true, AFTER_DRAIN = false, KEEP_ACC = false;
    bf16_t* proj; unsigned char* gate8; const float* ss; const float* bgate; const float* tab;
    __device__ __forceinline__ void operator()(const f32x4 (&acc)[2][2][4][2], const Unit& u, int wr, int wc, int fr, int fq) const {
        const int pn = u.pn, lane = fr + 16 * fq;
        f32x4 sp[2][4];
#pragma unroll
        for (int ai = 0; ai < 2; ++ai)
#pragma unroll
            for (int m = 0; m < 4; ++m) sp[ai][m] = *(const f32x4*)(ss + (size_t)(u.pm * 256 + ai * 128 + wr * 64 + m * 16 + fr) * 16 + 4 * fq);
        float rsv[2][4];
#pragma unroll
        for (int ai = 0; ai < 2; ++ai)
#pragma unroll
            for (int m = 0; m < 4; ++m) { float t = (sp[ai][m].x + sp[ai][m].y) + (sp[ai][m].z + sp[ai][m].w); t += shx(t, lane, 16); t += shx(t, lane, 32); rsv[ai][m] = 1.0f / sqrtf(t * (1.0f / D) + RMS_EPS); }
        if (pn < 18) {
            const int kind = pn >> 1, phys = (int)((0x683754210ull >> (4 * kind)) & 15ull);
            bf16_t* base = proj + (size_t)phys * ((size_t)T * 512);
            const int col0 = (pn & 1) * 256 + wc * 32 + 8 * fq;
            const float scale = kind == 0 ? 0.125f : (kind == 3 ? 0.08838834764831845f : 1.0f);
            const bool rope = (kind == 3) || (kind == 4);
#pragma unroll
            for (int ai = 0; ai < 2; ++ai) {
                f32x4 cs[4][2], sn[4][2];
                if (rope) {
#pragma unroll
                    for (int m = 0; m < 4; ++m)
#pragma unroll
                        for (int bj = 0; bj < 2; ++bj) { const int row = u.pm * 256 + ai * 128 + wr * 64 + m * 16 + fr, i0 = ((col0 + bj * 128) & 127) >> 1, pos = row & (SEQ - 1);
                            cs[m][bj] = *(const f32x4*)(tab + pos * 64 + i0); sn[m][bj] = *(const f32x4*)(tab + 131072 + pos * 64 + i0); }
                }
#pragma unroll
                for (int m = 0; m < 4; ++m) {
                    const int row = u.pm * 256 + ai * 128 + wr * 64 + m * 16 + fr;
                    const float rs = rsv[ai][m] * scale;
                    bf16_t* rowp = base + (size_t)row * 512 + col0;
#pragma unroll
                    for (int bj = 0; bj < 2; ++bj) {
                        f32x4 v0 = acc[ai][bj][m][0] * rs, v1 = acc[ai][bj][m][1] * rs;
                        if (rope) {
                            const f32x4 c_ = cs[m][bj], s_ = sn[m][bj];
                            f32x4 w0, w1;
                            w0[0] = v0[0] * c_[0] - v0[1] * s_[0]; w0[1] = v0[0] * s_[0] + v0[1] * c_[0];
                            w0[2] = v0[2] * c_[1] - v0[3] * s_[1]; w0[3] = v0[2] * s_[1] + v0[3] * c_[1];
                            w1[0] = v1[0] * c_[2] - v1[1] * s_[2]; w1[1] = v1[0] * s_[2] + v1[1] * c_[2];
                            w1[2] = v1[2] * c_[3] - v1[3] * s_[3]; w1[3] = v1[2] * s_[3] + v1[3] * c_[3];
                            v0 = w0; v1 = w1;
                        }
                        u32x4 w; w.x = cvt_pk_bf16(v0[0], v0[1]); w.y = cvt_pk_bf16(v0[2], v0[3]); w.z = cvt_pk_bf16(v1[0], v1[1]); w.w = cvt_pk_bf16(v1[2], v1[3]);
                        *(u32x4*)(rowp + bj * 128) = w;
                    }
                }
            }
        } else {
            const int g0 = (pn - 18) * 256 + wc * 32 + 8 * fq;
            f32x4 bg[2][2];
#pragma unroll
            for (int bj = 0; bj < 2; ++bj) { bg[bj][0] = *(const f32x4*)(bgate + g0 + bj * 128); bg[bj][1] = *(const f32x4*)(bgate + g0 + bj * 128 + 4); }
#pragma unroll
            for (int ai = 0; ai < 2; ++ai)
#pragma unroll
                for (int m = 0; m < 4; ++m) {
                    const int row = u.pm * 256 + ai * 128 + wr * 64 + m * 16 + fr;
                    const float rs = rsv[ai][m];
#pragma unroll
                    for (int bj = 0; bj < 2; ++bj) {
                        const int gc = g0 + bj * 128;
                        const f32x4 v0 = acc[ai][bj][m][0] * rs + bg[bj][0], v1 = acc[ai][bj][m][1] * rs + bg[bj][1];
                        unsigned lo = 0, hi = 0;
#pragma unroll
                        for (int e = 0; e < 4; ++e) {
                            lo |= (unsigned)(sigmoidf_(v0[e]) * 255.0f + 0.5f) << (8 * e);
                            hi |= (unsigned)(sigmoidf_(v1[e]) * 255.0f + 0.5f) << (8 * e);
                        }
                        v2u w; w.x = lo; w.y = hi;
                        *(v2u*)(gate8 + (size_t)row * 3072 + gc) = w;
                    }
                }
        }
    }
};
struct EpiG2 {
    static constexpr bool PERM = false, AFTER_DRAIN = false, KEEP_ACC = true;
    const unsigned char* gate8; bf16_t* merged;
    __device__ __forceinline__ void operator()(f32x4 (&acc)[2][2][4][2], const Unit& u, int wr, int wc, int fr, int fq) const {
        const int col0 = u.pn * 256 + wc * 32 + 4 * fq;
        unsigned ga[2][4][2][2], gb[2][4][2][2];
#pragma unroll
        for (int ai = 0; ai < 2; ++ai)
#pragma unroll
            for (int m = 0; m < 4; ++m)
#pragma unroll
                for (int bj = 0; bj < 2; ++bj)
#pragma unroll
                    for (int n = 0; n < 2; ++n) {
                        const size_t o = (size_t)(u.pm * 256 + ai * 128 + wr * 64 + m * 16 + fr) * 3072 + col0 + bj * 128 + n * 16;
                        ga[ai][m][bj][n] = *(const unsigned*)(gate8 + o + u.z * 1024);
                        gb[ai][m][bj][n] = u.z < 2 ? *(const unsigned*)(gate8 + o + (u.z + 1) * 1024) : 0u;
                    }
#pragma unroll
        for (int ai = 0; ai < 2; ++ai)
#pragma unroll
            for (int m = 0; m < 4; ++m) {
                const int row = u.pm * 256 + ai * 128 + wr * 64 + m * 16 + fr;
#pragma unroll
                for (int bj = 0; bj < 2; ++bj)
#pragma unroll
                    for (int n = 0; n < 2; ++n) {
                        const int c = col0 + bj * 128 + n * 16;
                        const unsigned a_ = ga[ai][m][bj][n], b_ = gb[ai][m][bj][n];
                        f32x4 t = acc[ai][bj][m][n];
                        if (u.z < 2) {
#pragma unroll
                            for (int e = 0; e < 4; ++e) { const float a = (float)max((a_ >> (8 * e)) & 255u, 1u), b = (float)max((b_ >> (8 * e)) & 255u, 1u); t[e] = t[e] * a * __builtin_amdgcn_rcpf(b); }
                            acc[ai][bj][m][n] = t;
                        } else {
#pragma unroll
                            for (int e = 0; e < 4; ++e) t[e] *= (float)max((a_ >> (8 * e)) & 255u, 1u) * (1.0f / 255.0f);
                            v2u w; w.x = cvt_pk_bf16(t[0], t[1]); w.y = cvt_pk_bf16(t[2], t[3]);
                            *(v2u*)(merged + (size_t)row * 1024 + c) = w;
                            acc[ai][bj][m][n] = (f32x4){0.f, 0.f, 0.f, 0.f};
                        }
                    }
            }
    }
};
struct EpiRes {
    static constexpr bool PERM = false, AFTER_DRAIN = false, KEEP_ACC = false;
    const float* basef; const bf16_t* baseb; bf16_t* xb; float* ssout;
    __device__ __forceinline__ void operator()(const f32x4 (&acc)[2][2][4][2], const Unit& u, int wr, int wc, int fr, int fq) const {
        const int col0 = u.pn * 256 + wc * 32 + 4 * fq, lane = fr + 16 * fq;
#pragma unroll
        for (int ai = 0; ai < 2; ++ai) {
            f32x4 bv[4][2][2];
            if (basef) {
#pragma unroll
                for (int m = 0; m < 4; ++m)
#pragma unroll
                    for (int bj = 0; bj < 2; ++bj)
#pragma unroll
                        for (int n = 0; n < 2; ++n) bv[m][bj][n] = *(const f32x4*)(basef + (size_t)(u.pm * 256 + ai * 128 + wr * 64 + m * 16 + fr) * 1024 + col0 + bj * 128 + n * 16);
            } else {
                v2u bw[4][2][2];
#pragma unroll
                for (int m = 0; m < 4; ++m)
#pragma unroll
                    for (int bj = 0; bj < 2; ++bj)
#pragma unroll
                        for (int n = 0; n < 2; ++n) bw[m][bj][n] = *(const v2u*)(baseb + (size_t)(u.pm * 256 + ai * 128 + wr * 64 + m * 16 + fr) * 1024 + col0 + bj * 128 + n * 16);
#pragma unroll
                for (int m = 0; m < 4; ++m)
#pragma unroll
                    for (int bj = 0; bj < 2; ++bj)
#pragma unroll
                        for (int n = 0; n < 2; ++n) bv[m][bj][n] = (f32x4){bflo(bw[m][bj][n].x), bfhi(bw[m][bj][n].x), bflo(bw[m][bj][n].y), bfhi(bw[m][bj][n].y)};
            }
#pragma unroll
            for (int m = 0; m < 4; ++m) {
                const int row = u.pm * 256 + ai * 128 + wr * 64 + m * 16 + fr;
                float s = 0.f;
#pragma unroll
                for (int bj = 0; bj < 2; ++bj)
#pragma unroll
                    for (int n = 0; n < 2; ++n) {
                        const size_t off = (size_t)row * 1024 + col0 + bj * 128 + n * 16;
                        const f32x4 v = bv[m][bj][n] + acc[ai][bj][m][n];
                        v2u w; w.x = cvt_pk_bf16(v[0], v[1]); w.y = cvt_pk_bf16(v[2], v[3]);
                        *(v2u*)(xb + off) = w;
                        s += (v[0] * v[0] + v[1] * v[1]) + (v[2] * v[2] + v[3] * v[3]);
                    }
                s += shx(s, lane, 16); s += shx(s, lane, 32);
                if (fq == 0) ssout[(size_t)row * 16 + u.pn * 4 + wc] = s;
            }
        }
    }
};
struct EpiG4 {
    static constexpr bool PERM = true, AFTER_DRAIN = false, KEEP_ACC = false;
    bf16_t* U; const float* ss;
    __device__ __forceinline__ void operator()(const f32x4 (&acc)[2][2][4][2], const Unit& u, int wr, int wc, int fr, int fq) const {
        const int col0 = u.pn * 256 + wc * 32 + 8 * fq;
        const int lane = fr + 16 * fq;
        f32x4 sp[2][4];
#pragma unroll
        for (int ai = 0; ai < 2; ++ai)
#pragma unroll
            for (int m = 0; m < 4; ++m) sp[ai][m] = *(const f32x4*)(ss + (size_t)(u.pm * 256 + ai * 128 + wr * 64 + m * 16 + fr) * 16 + 4 * fq);
        float rsv[2][4];
#pragma unroll
        for (int ai = 0; ai < 2; ++ai)
#pragma unroll
            for (int m = 0; m < 4; ++m) { float t = (sp[ai][m].x + sp[ai][m].y) + (sp[ai][m].z + sp[ai][m].w); t += shx(t, lane, 16); t += shx(t, lane, 32); rsv[ai][m] = 1.0f / sqrtf(t * (1.0f / D) + RMS_EPS); }
#pragma unroll
        for (int ai = 0; ai < 2; ++ai)
#pragma unroll
            for (int m = 0; m < 4; ++m) {
                const int row = u.pm * 256 + ai * 128 + wr * 64 + m * 16 + fr;
                const float rs = rsv[ai][m];
                bf16_t* rowp = U + (size_t)row * FF + col0;
#pragma unroll
                for (int bj = 0; bj < 2; ++bj) {
                    f32x4 v0 = acc[ai][bj][m][0] * rs, v1 = acc[ai][bj][m][1] * rs;
#pragma unroll
                    for (int e = 0; e < 4; ++e) { const float a = fmaxf(v0[e], 0.f), b = fmaxf(v1[e], 0.f); v0[e] = a * a; v1[e] = b * b; }
                    u32x4 w; w.x = cvt_pk_bf16(v0[0], v0[1]); w.y = cvt_pk_bf16(v0[2], v0[3]); w.z = cvt_pk_bf16(v1[0], v1[1]); w.w = cvt_pk_bf16(v1[2], v1[3]);
                    *(u32x4*)(rowp + bj * 128) = w;
                }
            }
    }
};
struct EpiE {
    static constexpr bool PERM = false, AFTER_DRAIN = false, KEEP_ACC = false;
    bf16_t* E;
    __device__ __forceinline__ void operator()(const f32x4 (&acc)[2][2][4][2], const Unit& u, int wr, int wc, int fr, int fq) const {
        const int col0 = u.pn * 256 + wc * 32 + 4 * fq;
#pragma unroll
        for (int ai = 0; ai < 2; ++ai)
#pragma unroll
            for (int m = 0; m < 4; ++m) {
                const int row = u.pm * 256 + ai * 128 + wr * 64 + m * 16 + fr;
#pragma unroll
                for (int bj = 0; bj < 2; ++bj)
#pragma unroll
                    for (int n = 0; n < 2; ++n) { const f32x4 v = acc[ai][bj][m][n]; v2u w; w.x = cvt_pk_bf16(v[0], v[1]); w.y = cvt_pk_bf16(v[2], v[3]); *(v2u*)(E + (size_t)row * 1024 + col0 + bj * 128 + n * 16) = w; }
            }
    }
};
struct EpiG6 {
    static constexpr bool PERM = false, AFTER_DRAIN = false, KEEP_ACC = false;
    const bf16_t* baseb; bf16_t* xb; const float* ssin; float* ssout; const bf16_t* E;
    __device__ __forceinline__ void operator()(const f32x4 (&acc)[2][2][4][2], const Unit& u, int wr, int wc, int fr, int fq) const {
        const int col0 = u.pn * 256 + wc * 32 + 4 * fq, lane = fr + 16 * fq;
        f32x4 sp[2][4];
#pragma unroll
        for (int ai = 0; ai < 2; ++ai)
#pragma unroll
            for (int m = 0; m < 4; ++m) sp[ai][m] = *(const f32x4*)(ssin + (size_t)(u.pm * 256 + ai * 128 + wr * 64 + m * 16 + fr) * 16 + 4 * fq);
        float rsv[2][4];
#pragma unroll
        for (int ai = 0; ai < 2; ++ai)
#pragma unroll
            for (int m = 0; m < 4; ++m) { float t = (sp[ai][m].x + sp[ai][m].y) + (sp[ai][m].z + sp[ai][m].w); t += shx(t, lane, 16); t += shx(t, lane, 32); rsv[ai][m] = 1.0f / sqrtf(t * (1.0f / D) + RMS_EPS); }
        asm volatile("" : "+v"(rsv[0][0]), "+v"(rsv[0][1]), "+v"(rsv[0][2]), "+v"(rsv[0][3]), "+v"(rsv[1][0]), "+v"(rsv[1][1]), "+v"(rsv[1][2]), "+v"(rsv[1][3]) :: "memory");
#pragma unroll
        for (int ai = 0; ai < 2; ++ai)
#pragma unroll
        for (int mh = 0; mh < 2; ++mh) {
            v2u bw[2][2][2], ew[2][2][2];
#pragma unroll
            for (int m2 = 0; m2 < 2; ++m2)
#pragma unroll
                for (int bj = 0; bj < 2; ++bj)
#pragma unroll
                    for (int n = 0; n < 2; ++n) { const size_t off = (size_t)(u.pm * 256 + ai * 128 + wr * 64 + (2 * mh + m2) * 16 + fr) * 1024 + col0 + bj * 128 + n * 16;
                        bw[m2][bj][n] = *(const v2u*)(baseb + off); ew[m2][bj][n] = *(const v2u*)(E + off); }
#pragma unroll
            for (int m2 = 0; m2 < 2; ++m2) {
                const int m = 2 * mh + m2;
                const int row = u.pm * 256 + ai * 128 + wr * 64 + m * 16 + fr;
                const float rs = rsv[ai][m];
                float s = 0.f;
#pragma unroll
                for (int bj = 0; bj < 2; ++bj)
#pragma unroll
                    for (int n = 0; n < 2; ++n) {
                        const size_t off = (size_t)row * 1024 + col0 + bj * 128 + n * 16;
                        const f32x4 a = acc[ai][bj][m][n] * rs; const v2u e_ = ew[m2][bj][n], b_ = bw[m2][bj][n];
                        const f32x4 e = (f32x4){bflo(e_.x), bfhi(e_.x), bflo(e_.y), bfhi(e_.y)};
                        f32x4 v = (f32x4){bflo(b_.x), bfhi(b_.x), bflo(b_.y), bfhi(b_.y)};
#pragma unroll
                        for (int k = 0; k < 4; ++k) v[k] += sigmoidf_(a[k]) * e[k];
                        v2u w; w.x = cvt_pk_bf16(v[0], v[1]); w.y = cvt_pk_bf16(v[2], v[3]);
                        *(v2u*)(xb + off) = w;
                        s += (v[0] * v[0] + v[1] * v[1]) + (v[2] * v[2] + v[3] * v[3]);
                    }
                s += shx(s, lane, 16); s += shx(s, lane, 32);
                if (fq == 0) ssout[(size_t)row * 16 + u.pn * 4 + wc] = s;
            }
            asm volatile("" ::: "memory");
        }
    }
};
struct ZOrder {
    pg8::StaticOrder S;
    __device__ __forceinline__ bool next(int i, Unit& u) const { if (!S.next(i / 3, u)) return false; u.z = i % 3; return true; }
    __device__ __forceinline__ void a_ready(const Unit&) const {}
    __device__ __forceinline__ void done(const Unit&) const {}
};

struct Args { const float* in[23]; float* out; unsigned char* ws; int ph_lo, ph_hi; };
typedef const __attribute__((address_space(4))) Args CArgs;
__device__ __forceinline__ CArgs* get_args() {
    CArgs* p = (CArgs*)__builtin_amdgcn_kernarg_segment_ptr();
    asm volatile("" : "+s"(p));
    return p;
}
struct Frame {
    LAS unsigned char* lds;
    int wave0, G, ngw, bid;
    float* out; unsigned char* ws;
    __device__ __forceinline__ int ltid() const { int t = wave0 * 64 + (int)__builtin_amdgcn_mbcnt_hi(~0u, __builtin_amdgcn_mbcnt_lo(~0u, 0u)); asm volatile("" : "+v"(t)); return t; }
    __device__ __forceinline__ int lane() const { return ltid() & 63; }
    __device__ __forceinline__ int wave() const { int w_ = wave0; asm volatile("" : "+s"(w_)); return w_; }
    __device__ __forceinline__ int gw() const { return bid * NWAVES + wave(); }
};

__device__ __forceinline__ void transpose_item(const float* W, const float* g, int K, int N, bf16* WT, LAS float* scr, int item, int lane) {
    const int nblk = N / 32, kb = item / nblk, nb = item % nblk, k0 = 64 * kb, n0 = 32 * nb;
#pragma unroll
    for (int i = 0; i < 32; ++i) { const int kk = 2 * i + (lane >> 5); float v = W[(size_t)(k0 + kk) * N + n0 + (lane & 31)]; if (g) v *= g[k0 + kk]; scr[kk * 33 + (lane & 31)] = v; }
    LDS_WAIT(); asm volatile("" ::: "memory");
    const int c = lane & 7;
#pragma unroll
    for (int j = 0; j < 4; ++j) { const int n = (lane >> 3) + 8 * j; const LAS float* s = scr + (8 * c) * 33 + n;
        v4u o; o.x = pk2(s[0 * 33], s[1 * 33]); o.y = pk2(s[2 * 33], s[3 * 33]); o.z = pk2(s[4 * 33], s[5 * 33]); o.w = pk2(s[6 * 33], s[7 * 33]);
        *(v4u*)(WT + (size_t)(n0 + n) * K + k0 + 8 * c) = o; }
    LDS_WAIT(); asm volatile("" ::: "memory");
}
__device__ __forceinline__ void convert_matrix(const Frame& F, const float* W, const float* g, int K, int N, bf16* WT) {
    LAS float* scr = (LAS float*)(F.lds + F.wave() * 16384);
    const int nitems = (K / 64) * (N / 32);
    for (int it = F.gw(); it < nitems; it += F.ngw) transpose_item(W, g, K, N, WT, scr, it, F.lane());
}
__device__ __forceinline__ void convert_layer_early(const Frame& F, CArgs* A, int l) {
    convert_matrix(F, A->in[3] + (size_t)l * D * 7680, A->in[2] + l * D, D, 7680, (bf16*)(F.ws + W_IN));
}
__device__ __forceinline__ void convert_layer_mid(const Frame& F, CArgs* A, int l) {
    for (int n = 0; n < 3; ++n) convert_matrix(F, A->in[14] + ((size_t)l * 3 + n) * 512 * D, nullptr, 512, D, (bf16*)(F.ws + W_BR) + (size_t)n * D * 512);
    convert_matrix(F, A->in[15] + (size_t)l * D * D, nullptr, D, D, (bf16*)(F.ws + W_OUT));
    convert_matrix(F, A->in[20] + (size_t)l * D * D, A->in[19] + l * D, D, D, (bf16*)(F.ws + W_G(l & 1)));
    convert_matrix(F, A->in[21] + (size_t)l * PLE * D, nullptr, PLE, D, (bf16*)(F.ws + W_PLE(l & 1)));
}
__device__ __forceinline__ void convert_layer_mlp(const Frame& F, CArgs* A, int l) {
    convert_matrix(F, A->in[17] + (size_t)l * D * FF, A->in[16] + l * D, D, FF, (bf16*)(F.ws + W_UP));
    convert_matrix(F, A->in[18] + (size_t)l * FF * D, nullptr, FF, D, (bf16*)(F.ws + W_DOWN));
}
__device__ __forceinline__ void convert_p(const Frame& F, CArgs* A, int l) {
    const f32x4* src = (const f32x4*)(A->in[1] + (size_t)l * T * PLE); v2u* dst = (v2u*)(F.ws + WS_PB);
    const int n4 = T * PLE / 4;
    for (int i = F.gw() * 64 + F.lane(); i < n4; i += F.ngw * 64) { const f32x4 v = src[i]; v2u w; w.x = pk2(v.x, v.y); w.y = pk2(v.z, v.w); dst[i] = w; }
}

__device__ __forceinline__ void phase_prologue(const Frame& F, CArgs* A) {
    convert_layer_early(F, A, 0); convert_layer_mid(F, A, 0);
    const float* x = A->in[0]; bf16* xb = (bf16*)(F.ws + WS_XB); float* ss = (float*)(F.ws + WS_SSB);
    for (int m = F.gw(); m < T; m += F.ngw) {
        const f32x4* xr = (const f32x4*)(x + (size_t)m * D) + F.lane(); v2u* o = (v2u*)(xb + (size_t)m * D) + F.lane();
        float s = 0.f;
#pragma unroll
        for (int j = 0; j < 4; ++j) { const f32x4 v = xr[64 * j]; s += (v.x * v.x + v.y * v.y) + (v.z * v.z + v.w * v.w); v2u w; w.x = pk2(v.x, v.y); w.y = pk2(v.z, v.w); o[64 * j] = w; }
        s = wave_sum(s, F.lane());
        if (F.lane() < 16) ss[(size_t)m * 16 + F.lane()] = F.lane() == 0 ? s : 0.f;
    }
    { bf16* lw = (bf16*)(F.ws + WS_LW);
      for (int e = F.gw() * 64 + F.lane(); e < DEPTH * 2 * 2 * 8 * 4096; e += F.ngw * 64) {
          const int mat = e >> 12, j = (e >> 6) & 63, i = e & 63, blk = mat & 7, ax = (mat >> 3) & 1, ld = mat >> 4;
          const float* src = (ax ? A->in[11] : A->in[9]) + ((size_t)ld * 8 + blk) * 4096;
          lw[e] = (bf16)f2bf(src[i * 64 + j]); }
      float* sp = (float*)(F.ws + WS_SP);
      for (int e = F.gw() * 64 + F.lane(); e < DEPTH * 2 * 512; e += F.ngw * 64) sp[e] = log1p_small(fexp(-A->in[13][e])); }
    float* tab = (float*)(F.ws + WS_TAB);
    for (int e = F.gw() * 64 + F.lane(); e < SEQ * 64; e += F.ngw * 64) {
        const int pos = e >> 6, i = e & 63;
        const float theta = __builtin_amdgcn_exp2f(-(float)i * (13.287712379549449f / 63.0f));
        double rev = (double)pos * (double)theta * 0.15915494309189535; rev -= __builtin_floor(rev);
        const float fr = (float)rev;
        tab[e] = __builtin_amdgcn_cosf(fr); tab[131072 + e] = __builtin_amdgcn_sinf(fr);
    }
}


typedef short bf16x8_t __attribute__((ext_vector_type(8)));
typedef float f32x2_t __attribute__((ext_vector_type(2))); typedef __bf16 bf16x2_t __attribute__((ext_vector_type(2)));
__device__ __forceinline__ unsigned pkbf(float lo, float hi) { f32x2_t v = {lo, hi}; bf16x2_t b = __builtin_convertvector(v, bf16x2_t); return __builtin_bit_cast(unsigned, b); }
typedef short v4i16_t __attribute__((ext_vector_type(4)));
__device__ __forceinline__ v4i16_t ds_tr16(LAS const unsigned char* p) { return __builtin_amdgcn_ds_read_tr16_b64_v4i16((LAS v4i16_t*)p); }
__device__ __forceinline__ bf16x8_t tr_frag(LAS const unsigned char* p0, LAS const unsigned char* p1) {
    const v4i16_t a = ds_tr16(p0), b = ds_tr16(p1);
    return (bf16x8_t){a[0], a[1], a[2], a[3], b[0], b[1], b[2], b[3]};
}
#define MFMA16(a, b, c) __builtin_amdgcn_mfma_f32_16x16x32_bf16((a), (b), (c), 0, 0, 0)
constexpr int RP = 272;
__device__ __forceinline__ void ret_scan_item(const Frame& F, int item) {
    const int bh = item >> 3, dir = (item >> 2) & 1, dvq = item & 3, b = bh >> 2, h = bh & 3;
    const bf16* Kg = (const bf16*)(F.ws + WS_PROJ + 5 * BLK); const bf16* Vg = (const bf16*)(F.ws + WS_PROJ + 7 * BLK);
    bf16* ST = (bf16*)F.out;
    const float lg = log2_1m(__builtin_amdgcn_exp2f((dir ? -5.5f : -5.0f) - (float)h));
    const float cdec = __builtin_amdgcn_exp2f(128.0f * lg);
    constexpr int VP = 80, BUF = 128 * RP + 128 * VP;
    const int tid = F.ltid(), lane = F.lane(), w = F.wave(), g = lane >> 4, i = lane & 15, q4 = i >> 2, p4 = i & 3;
    v4u kr0[4], kr1[4], vr0, vr1;
    const int vrow = tid >> 2, vch = tid & 3;
#define RS_LOAD(kr, vr, c_) do { const size_t tb = (size_t)b * SEQ + (c_) * 128; \
        _Pragma("unroll") for (int q = 0; q < 4; ++q) { const int idx = tid + 512 * q; kr[q] = *(const v4u*)(Kg + (tb + (idx >> 4)) * 512 + h * 128 + (idx & 15) * 8); } \
        vr = *(const v4u*)(Vg + (tb + vrow) * 512 + h * 128 + dvq * 32 + vch * 8); } while (0)
#define RS_WRITE(kr, vr, buf_) do { LAS unsigned char* Kb_ = F.lds + (buf_) * BUF; LAS unsigned char* Vb_ = Kb_ + 128 * RP; \
        _Pragma("unroll") for (int q = 0; q < 4; ++q) { const int idx = tid + 512 * q, row = idx >> 4; \
            const float dk_ = __builtin_amdgcn_exp2f((float)(dir ? row : 127 - row) * lg); v4u o; \
            _Pragma("unroll") for (int e = 0; e < 4; ++e) o[e] = pkbf(bflo(kr[q][e]) * dk_, bfhi(kr[q][e]) * dk_); \
            *(LAS v4u*)(Kb_ + row * RP + (idx & 15) * 16) = o; } \
        *(LAS v4u*)(Vb_ + vrow * VP + vch * 16) = vr; } while (0)
#define RS_CHUNK(s_) (dir ? 15 - (s_) : (s_))
#define RS_STEP(s_, krN, vrN, krW, vrW) do { const int c = RS_CHUNK(s_), buf = (s_) & 1; \
        if ((s_) + 2 < 16) RS_LOAD(krN, vrN, RS_CHUNK((s_) + 2)); \
        bf16* dst = ST + ((size_t)(bh * 2 + dir) * 16 + c) * 16384; \
        _Pragma("unroll") for (int n = 0; n < 2; ++n) { v2u o; o.x = pkbf(acc[n][0], acc[n][1]); o.y = pkbf(acc[n][2], acc[n][3]); *(v2u*)(dst + (32 * dvq + 16 * n + i) * 128 + 16 * w + 4 * g) = o; } \
        acc[0] = acc[0] * cdec; acc[1] = acc[1] * cdec; \
        const LAS unsigned char* Kb = F.lds + buf * BUF; const LAS unsigned char* Vb = Kb + 128 * RP; \
        _Pragma("unroll") for (int ks = 0; ks < 4; ++ks) { const int r0 = 32 * ks + 8 * g + q4; \
            const bf16x8_t af = tr_frag(Kb + r0 * RP + (16 * w + 4 * p4) * 2, Kb + (r0 + 4) * RP + (16 * w + 4 * p4) * 2); \
            _Pragma("unroll") for (int n = 0; n < 2; ++n) { const bf16x8_t bv = tr_frag(Vb + r0 * VP + (16 * n + 4 * p4) * 2, Vb + (r0 + 4) * VP + (16 * n + 4 * p4) * 2); acc[n] = MFMA16(af, bv, acc[n]); } } \
        if ((s_) + 1 < 16) RS_WRITE(krW, vrW, buf ^ 1); \
        __syncthreads(); } while (0)
    __syncthreads();
    RS_LOAD(kr0, vr0, RS_CHUNK(0));
    RS_LOAD(kr1, vr1, RS_CHUNK(1));
    RS_WRITE(kr0, vr0, 0);
    __syncthreads();
    f32x4 acc[2]; acc[0] = (f32x4){0.f, 0.f, 0.f, 0.f}; acc[1] = acc[0];
    for (int s2 = 0; s2 < 16; s2 += 2) {
        RS_STEP(s2, kr0, vr0, kr1, vr1);
        RS_STEP(s2 + 1, kr1, vr1, kr0, vr0);
    }
#undef RS_STEP
#undef RS_CHUNK
#undef RS_LOAD
#undef RS_WRITE
}
__device__ __forceinline__ void ret_out_item(const Frame& F, const float* gn, int item) {
    const int bh = item >> 4, ci = item & 15, b = bh >> 2, h = bh & 3, t0 = b * SEQ + ci * 128;
    bf16* Gg = (bf16*)(F.ws + WS_PROJ + 3 * BLK); const bf16* Qg = (const bf16*)(F.ws + WS_PROJ + 4 * BLK);
    const bf16* Kg = (const bf16*)(F.ws + WS_PROJ + 5 * BLK); const bf16* Vg = (const bf16*)(F.ws + WS_PROJ + 7 * BLK);
    const bf16* ST = (const bf16*)F.out;
    const float lgf = log2_1m(__builtin_amdgcn_exp2f(-5.0f - (float)h)), lgb = log2_1m(__builtin_amdgcn_exp2f(-5.5f - (float)h));
    LAS unsigned char* Kl = F.lds; LAS unsigned char* Vl = F.lds + 128 * RP; LAS unsigned char* Sf = F.lds + 2 * 128 * RP; LAS unsigned char* Sb = F.lds + 3 * 128 * RP;
    const int lane = F.lane(), w = F.wave(), g = lane >> 4, i = lane & 15, q4 = i >> 2, p4 = i & 3;
    const int nl = 16 * w + i;
    bf16* grow = Gg + (size_t)(t0 + nl) * 512 + h * 128;
    bf16x8_t bq[4]; v2u ggv[8];
#pragma unroll
    for (int ks = 0; ks < 4; ++ks) bq[ks] = *(const bf16x8_t*)(Qg + (size_t)(t0 + nl) * 512 + h * 128 + 32 * ks + 8 * g);
#pragma unroll
    for (int n = 0; n < 8; ++n) ggv[n] = *(const v2u*)(grow + 16 * n + 4 * g);
    __syncthreads();
    {
#pragma unroll
        for (int q = 0; q < 4; ++q) {
            const int idx = F.ltid() + 512 * q, row = idx >> 4, ch = idx & 15;
            *(LAS v4u*)(Kl + row * RP + ch * 16) = *(const v4u*)(Kg + (size_t)(t0 + row) * 512 + h * 128 + ch * 8);
            *(LAS v4u*)(Vl + row * RP + ch * 16) = *(const v4u*)(Vg + (size_t)(t0 + row) * 512 + h * 128 + ch * 8);
        }
        const bf16* sfp = ST + ((size_t)(bh * 2 + 0) * 16 + ci) * 16384; const bf16* sbp = ST + ((size_t)(bh * 2 + 1) * 16 + ci) * 16384;
#pragma unroll
        for (int q = 0; q < 4; ++q) {
            const int idx = F.ltid() + 512 * q, row = idx >> 4, ch = idx & 15;
            *(LAS v4u*)(Sf + row * RP + ch * 16) = *(const v4u*)(sfp + idx * 8);
            *(LAS v4u*)(Sb + row * RP + ch * 16) = *(const v4u*)(sbp + idx * 8);
        }
    }
    __syncthreads();
    bf16x8_t bp[4];
#pragma unroll
    for (int kp = 0; kp < 4; ++kp) {
        f32x4 s0 = (f32x4){0.f, 0.f, 0.f, 0.f}, s1 = s0;
#pragma unroll
        for (int ks = 0; ks < 4; ++ks) {
            const bf16x8_t a0 = *(const LAS bf16x8_t*)(Kl + (32 * kp + i) * RP + (32 * ks + 8 * g) * 2);
            const bf16x8_t a1 = *(const LAS bf16x8_t*)(Kl + (32 * kp + 16 + i) * RP + (32 * ks + 8 * g) * 2);
            s0 = MFMA16(a0, bq[ks], s0); s1 = MFMA16(a1, bq[ks], s1);
        }
        float pv[8];
#pragma unroll
        for (int e = 0; e < 4; ++e) {
            const int m0 = 32 * kp + 4 * g + e, m1 = m0 + 16;
            const float d0 = (float)(nl - m0), d1 = (float)(nl - m1);
            pv[e] = s0[e] * (d0 >= 0.f ? __builtin_amdgcn_exp2f(d0 * lgf) : __builtin_amdgcn_exp2f(-d0 * lgb));
            pv[4 + e] = s1[e] * (d1 >= 0.f ? __builtin_amdgcn_exp2f(d1 * lgf) : __builtin_amdgcn_exp2f(-d1 * lgb));
        }
        v4u pk; pk.x = pkbf(pv[0], pv[1]); pk.y = pkbf(pv[2], pv[3]); pk.z = pkbf(pv[4], pv[5]); pk.w = pkbf(pv[6], pv[7]);
        bp[kp] = __builtin_bit_cast(bf16x8_t, pk);
    }
    f32x4 oi[8], of[8], ob[8];
#pragma unroll
    for (int n = 0; n < 8; ++n) { oi[n] = (f32x4){0.f, 0.f, 0.f, 0.f}; of[n] = oi[n]; ob[n] = oi[n]; }
#pragma unroll
    for (int kp = 0; kp < 4; ++kp) {
        const int r0 = (32 * kp + 4 * g + q4) * RP, r1 = r0 + 16 * RP;
#pragma unroll
        for (int n = 0; n < 8; ++n) { const bf16x8_t av = tr_frag(Vl + r0 + (16 * n + 4 * p4) * 2, Vl + r1 + (16 * n + 4 * p4) * 2); oi[n] = MFMA16(av, bp[kp], oi[n]); }
    }
#pragma unroll
    for (int ks = 0; ks < 4; ++ks)
#pragma unroll
        for (int n = 0; n < 8; ++n) {
            const bf16x8_t af = *(const LAS bf16x8_t*)(Sf + (16 * n + i) * RP + (32 * ks + 8 * g) * 2);
            const bf16x8_t ab = *(const LAS bf16x8_t*)(Sb + (16 * n + i) * RP + (32 * ks + 8 * g) * 2);
            of[n] = MFMA16(af, bq[ks], of[n]); ob[n] = MFMA16(ab, bq[ks], ob[n]);
        }
    const float qdf = __builtin_amdgcn_exp2f((float)(nl + 1) * lgf), qdb = __builtin_amdgcn_exp2f((float)(128 - nl) * lgb);
    float ss = 0.f;
#pragma unroll
    for (int n = 0; n < 8; ++n) { oi[n] = oi[n] + of[n] * qdf + ob[n] * qdb; ss += (oi[n][0] * oi[n][0] + oi[n][1] * oi[n][1]) + (oi[n][2] * oi[n][2] + oi[n][3] * oi[n][3]); }
    ss += shx(ss, lane, 16); ss += shx(ss, lane, 32);
    const float rn = 1.0f / sqrtf(ss * (1.0f / 128.0f) + RMS_EPS);
#pragma unroll
    for (int n = 0; n < 8; ++n) {
        const int dv0 = 16 * n + 4 * g;
        const v2u gg = ggv[n]; const f32x4 gw = *(const f32x4*)(gn + h * 128 + dv0);
        const float g0 = bflo(gg.x), g1 = bfhi(gg.x), g2 = bflo(gg.y), g3 = bfhi(gg.y);
        v2u o; o.x = pkbf(g0 * sigmoidf_(g0) * oi[n][0] * rn * gw[0], g1 * sigmoidf_(g1) * oi[n][1] * rn * gw[1]);
        o.y = pkbf(g2 * sigmoidf_(g2) * oi[n][2] * rn * gw[2], g3 * sigmoidf_(g3) * oi[n][3] * rn * gw[3]);
        *(v2u*)(grow + dv0) = o;
    }
}

constexpr int LO_WL = 0, LO_CST = 36864, LO_XC = 39680, LO_XF = 58688, LO_XB = 93504, LO_GY = 111936, LO_SEG = 130368, LO_HIN = 138560;
__device__ __forceinline__ void lru_stage_consts(const Frame& F, CArgs* A, int l, int blk) {
    const bf16* LW = (const bf16*)(F.ws + WS_LW); const float* SP = (const float*)(F.ws + WS_SP);
    __syncthreads();
#pragma unroll
    for (int q = 0; q < 4; ++q) { const int idx = F.ltid() + 512 * q, m = idx >> 9, row = (idx >> 3) & 63, ch = idx & 7;
        const int d = m >> 1, ax = m & 1;
        *(LAS v4u*)(F.lds + LO_WL + (m * 64 + row) * 144 + ch * 16) = *(const v4u*)(LW + (size_t)((((l * 2 + d) * 2 + ax) * 8 + blk)) * 4096 + row * 64 + ch * 8); }
    LAS float* cst = (LAS float*)(F.lds + LO_CST);
    if (F.ltid() < 128) { const int d = F.ltid() >> 6, j = F.ltid() & 63, pi = (l * 2 + d) * 512 + blk * 64 + j; cst[F.ltid()] = A->in[10][pi]; cst[128 + F.ltid()] = A->in[12][pi]; cst[256 + F.ltid()] = SP[pi]; }
    else if (F.ltid() < 384) { const int e = F.ltid() - 128, tap = e >> 6, j = e & 63; cst[384 + e] = A->in[7][(size_t)l * 2048 + tap * 512 + blk * 64 + j]; }
    else if (F.ltid() < 448) { const int j = F.ltid() - 384; cst[640 + j] = A->in[8][(size_t)l * 512 + blk * 64 + j]; }
}
template <int MODE>
__device__ __forceinline__ void lru_item(const Frame& F, int item) {
    const int b = item >> 7, c = (item >> 3) & 15, blk = item & 7, t0 = b * SEQ + c * 128, s0 = c * 128;
    const bf16* XCg = (const bf16*)(F.ws + WS_PROJ + 8 * BLK); bf16* GCg = (bf16*)(F.ws + WS_PROJ + 6 * BLK);
    float* AGG = (float*)(F.ws + WS_AGG);
    LAS unsigned char* WL = F.lds + LO_WL; const LAS float* cst = (const LAS float*)(F.lds + LO_CST);
    LAS unsigned char* XC = F.lds + LO_XC; LAS float* XF = (LAS float*)(F.lds + LO_XF); LAS unsigned char* XB = F.lds + LO_XB; LAS unsigned char* GY = F.lds + LO_GY;
    LAS float* SEG = (LAS float*)(F.lds + LO_SEG); LAS float* HIN = (LAS float*)(F.lds + LO_HIN);
    typedef float f2 __attribute__((ext_vector_type(2)));
    const int tid = F.ltid(), lane = F.lane(), w = F.wave(), g = lane >> 4, i = lane & 15;
    __syncthreads();
#pragma unroll
    for (int q = 0; q < 3; ++q) {
        const int idx = tid + 512 * q;
        if (idx < 1056) { const int row = idx >> 3, ch = idx & 7, s_ = s0 - 2 + row;
            v4u v = (v4u){0u, 0u, 0u, 0u};
            if (s_ >= 0 && s_ < SEQ) v = *(const v4u*)(XCg + (size_t)(b * SEQ + s_) * 512 + blk * 64 + ch * 8);
            *(LAS v4u*)(XC + row * 144 + ch * 16) = v; }
    }
    if (MODE == 1) {
#pragma unroll
        for (int q = 0; q < 2; ++q) { const int idx = tid + 512 * q, row = idx >> 3, ch = idx & 7;
            *(LAS v4u*)(GY + row * 144 + ch * 16) = *(const v4u*)(GCg + (size_t)(t0 + row) * 512 + blk * 64 + ch * 8); }
        if (tid < 128) {
            const int d = tid >> 6, j = tid & 63, ch = blk * 64 + j;
            f2 ag[15];
#pragma unroll
            for (int k = 0; k < 15; ++k) { const int cc = d ? 15 - k : k; ag[k] = *(const f2*)(AGG + ((size_t)((b * 16 + cc) * 2 + d) * 512 + ch) * 2); }
            float h = 0.f;
#pragma unroll
            for (int k = 0; k < 15; ++k) { const int cc = d ? 15 - k : k; const bool valid = d ? (cc > c) : (cc < c); h = valid ? ag[k].x * h + ag[k].y : h; }
            HIN[tid] = h;
        }
    }
    __syncthreads();
#pragma unroll
    for (int q = 0; q < 2; ++q) {
        const int idx = tid + 512 * q, t = idx >> 3, c8 = idx & 7;
        float xf[8];
        { const f32x4 b0 = *(const LAS f32x4*)(cst + 640 + c8 * 8), b1 = *(const LAS f32x4*)(cst + 640 + c8 * 8 + 4); xf[0] = b0[0]; xf[1] = b0[1]; xf[2] = b0[2]; xf[3] = b0[3]; xf[4] = b1[0]; xf[5] = b1[1]; xf[6] = b1[2]; xf[7] = b1[3]; }
#pragma unroll
        for (int tap = 0; tap < 4; ++tap) {
            const v4u x = *(const LAS v4u*)(XC + (t + tap) * 144 + c8 * 16);
            const f32x4 w0 = *(const LAS f32x4*)(cst + 384 + tap * 64 + c8 * 8), w1 = *(const LAS f32x4*)(cst + 384 + tap * 64 + c8 * 8 + 4);
            xf[0] += w0[0] * bflo(x[0]); xf[1] += w0[1] * bfhi(x[0]); xf[2] += w0[2] * bflo(x[1]); xf[3] += w0[3] * bfhi(x[1]);
            xf[4] += w1[0] * bflo(x[2]); xf[5] += w1[1] * bfhi(x[2]); xf[6] += w1[2] * bflo(x[3]); xf[7] += w1[3] * bfhi(x[3]);
        }
        *(LAS f32x4*)(XF + t * 68 + c8 * 8) = (f32x4){xf[0], xf[1], xf[2], xf[3]}; *(LAS f32x4*)(XF + t * 68 + c8 * 8 + 4) = (f32x4){xf[4], xf[5], xf[6], xf[7]};
        v4u o; o.x = pkbf(xf[0], xf[1]); o.y = pkbf(xf[2], xf[3]); o.z = pkbf(xf[4], xf[5]); o.w = pkbf(xf[6], xf[7]);
        *(LAS v4u*)(XB + t * 144 + c8 * 16) = o;
    }
    __syncthreads();
    float av[2][4][4], bv[2][4][4];
    {
        const bf16x8_t a0 = *(const LAS bf16x8_t*)(XB + (16 * w + i) * 144 + (8 * g) * 2), a1 = *(const LAS bf16x8_t*)(XB + (16 * w + i) * 144 + (32 + 8 * g) * 2);
#pragma unroll
        for (int d = 0; d < 2; ++d) {
#pragma unroll
            for (int jt = 0; jt < 4; ++jt) {
                const LAS unsigned char* wa = WL + ((d * 2 + 0) * 64 + 16 * jt + i) * 144 + (8 * g) * 2; const LAS unsigned char* wx = WL + ((d * 2 + 1) * 64 + 16 * jt + i) * 144 + (8 * g) * 2;
                const f32x4 z = (f32x4){0.f, 0.f, 0.f, 0.f};
                f32x4 ca = MFMA16(a0, *(const LAS bf16x8_t*)wa, z); ca = MFMA16(a1, *(const LAS bf16x8_t*)(wa + 64), ca);
                f32x4 cx = MFMA16(a0, *(const LAS bf16x8_t*)wx, z); cx = MFMA16(a1, *(const LAS bf16x8_t*)(wx + 64), cx);
                const int j = 16 * jt + i;
                const float ba = cst[d * 64 + j], bx = cst[128 + d * 64 + j], sp = cst[256 + d * 64 + j];
#pragma unroll
                for (int r = 0; r < 4; ++r) {
                    const int t = 16 * w + 4 * g + r;
                    const float xfv = XF[t * 68 + j];
                    const float rr = sigmoidf_(ca[r] + ba), ig = sigmoidf_(cx[r] + bx);
                    const float la = -8.0f * rr * sp, a = fexp(la), x2 = 2.0f * la;
                    const float omp = -x2 * (1.0f + x2 * (0.5f + x2 * (0.16666667f + x2 * (0.041666668f + x2 * (0.0083333333f + x2 * 0.0013888889f))))), omq = 1.0f - a * a, selp = x2 > -0.5f ? 1.0f : 0.0f;
                    const float om = selp * omp + (1.0f - selp) * omq;
                    float mult = __builtin_amdgcn_sqrtf(om);
                    if (d == 0 ? (c == 0 && t == 0) : (c == 15 && t == 127)) mult = 1.0f;
                    av[d][jt][r] = a; bv[d][jt][r] = mult * ig * xfv;
                }
            }
        }
    }
    float Ae[2][4], Be[2][4];
#pragma unroll
    for (int jt = 0; jt < 4; ++jt) {
        float Af = av[0][jt][0] * av[0][jt][1] * av[0][jt][2] * av[0][jt][3];
        float Bf = ((bv[0][jt][0] * av[0][jt][1] + bv[0][jt][1]) * av[0][jt][2] + bv[0][jt][2]) * av[0][jt][3] + bv[0][jt][3];
        float Ar = av[1][jt][0] * av[1][jt][1] * av[1][jt][2] * av[1][jt][3];
        float Br = ((bv[1][jt][3] * av[1][jt][2] + bv[1][jt][2]) * av[1][jt][1] + bv[1][jt][1]) * av[1][jt][0] + bv[1][jt][0];
#pragma unroll
        for (int st = 16; st <= 32; st <<= 1) {
            const float pAf = lane_get(Af, lane - st), pBf = lane_get(Bf, lane - st), pAr = lane_get(Ar, lane + st), pBr = lane_get(Br, lane + st);
            if (lane >= st) { Bf = Af * pBf + Bf; Af = Af * pAf; }
            if (lane + st < 64) { Br = Ar * pBr + Br; Ar = Ar * pAr; }
        }
        const float eAf = lane_get(Af, lane - 16), eBf = lane_get(Bf, lane - 16), eAr = lane_get(Ar, lane + 16), eBr = lane_get(Br, lane + 16);
        Ae[0][jt] = g > 0 ? eAf : 1.0f; Be[0][jt] = g > 0 ? eBf : 0.0f; Ae[1][jt] = g < 3 ? eAr : 1.0f; Be[1][jt] = g < 3 ? eBr : 0.0f;
        if (g == 3) *(LAS f2*)(SEG + ((0 * 8 + w) * 64 + 16 * jt + i) * 2) = (f2){Af, Bf};
        if (g == 0) *(LAS f2*)(SEG + ((1 * 8 + w) * 64 + 16 * jt + i) * 2) = (f2){Ar, Br};
    }
    __syncthreads();
    if (MODE == 0) {
        if (w == 0 && g < 2) {
            const int d = g;
#pragma unroll
            for (int jt = 0; jt < 4; ++jt) {
                const int j = 16 * jt + i; float h = 0.f, Ap = 1.0f;
#pragma unroll
                for (int k = 0; k < 8; ++k) { const int ww = d ? 7 - k : k; const f2 sg = *(const LAS f2*)(SEG + ((d * 8 + ww) * 64 + j) * 2); h = sg.x * h + sg.y; Ap *= sg.x; }
                *(f2*)(AGG + ((size_t)((b * 16 + c) * 2 + d) * 512 + blk * 64 + j) * 2) = (f2){Ap, h};
            }
        }
    } else {
#pragma unroll
        for (int jt = 0; jt < 4; ++jt) {
            const int j = 16 * jt + i;
            float hf = HIN[j], hr = HIN[64 + j];
            f2 sfv[8], srv[8];
#pragma unroll
            for (int k = 0; k < 8; ++k) { sfv[k] = *(const LAS f2*)(SEG + ((0 * 8 + k) * 64 + j) * 2); srv[k] = *(const LAS f2*)(SEG + ((1 * 8 + (7 - k)) * 64 + j) * 2); }
#pragma unroll
            for (int k = 0; k < 8; ++k) {
                const bool uf = k < w, ur = 7 - k > w;
                hf = (uf ? sfv[k].x : 1.0f) * hf + (uf ? sfv[k].y : 0.0f);
                hr = (ur ? srv[k].x : 1.0f) * hr + (ur ? srv[k].y : 0.0f);
            }
            float h = Ae[0][jt] * hf + Be[0][jt];
            float hs[4];
#pragma unroll
            for (int r = 0; r < 4; ++r) { h = av[0][jt][r] * h + bv[0][jt][r]; hs[r] = h; }
            h = Ae[1][jt] * hr + Be[1][jt];
#pragma unroll
            for (int r = 3; r >= 0; --r) { h = av[1][jt][r] * h + bv[1][jt][r]; hs[r] += h; }
#pragma unroll
            for (int r = 0; r < 4; ++r) { LAS bf16* p = (LAS bf16*)(GY + (16 * w + 4 * g + r) * 144) + j; *p = (bf16)f2bf(gelu_tanh(bf2f(*p)) * hs[r]); }
        }
        __syncthreads();
#pragma unroll
        for (int q = 0; q < 2; ++q) { const int idx = tid + 512 * q, row = idx >> 3, ch = idx & 7;
            *(v4u*)(GCg + (size_t)(t0 + row) * 512 + blk * 64 + ch * 8) = *(const LAS v4u*)(GY + row * 144 + ch * 16); }
    }
}
template <int MODE> __device__ __forceinline__ void phase_lru(const Frame& F, CArgs* A, int l) {
    int cur = -1;
    for (int it = F.bid; it < 1024; it += F.G) { const int blk = it & 7; if (blk != cur) { lru_stage_consts(F, A, l, blk); cur = blk; } lru_item<MODE>(F, it); }
}


__device__ __forceinline__ void na_group(const Frame& F, const float* rpb, int grp) {
    const int b = grp >> 5, h = (grp >> 2) & 7, rg = grp & 3, r0 = rg * 8;
    bf16* Qg = (bf16*)(F.ws + WS_PROJ); const bf16* Kg = (const bf16*)(F.ws + WS_PROJ + BLK); const bf16* Vg = (const bf16*)(F.ws + WS_PROJ + 2 * BLK);
    LAS unsigned char* Kl = F.lds; LAS unsigned char* Vl = F.lds + 512 * 144; LAS float* Bl = (LAS float*)(F.lds + 2 * 512 * 144);
    const int tid = F.ltid();
    int rs = r0 - 4; rs = rs < 0 ? 0 : (rs > 24 ? 24 : rs);
    __syncthreads();
#pragma unroll
    for (int q = 0; q < 8; ++q) {
        const int idx = tid + 512 * q, kidx = idx >> 3, ch = idx & 7, grow = rs + (kidx >> 6), col = kidx & 63;
        const size_t tok = (size_t)b * SEQ + grow * 64 + col; const int lrow = (grow & 7) * 64 + col;
        *(LAS v4u*)(Kl + lrow * 144 + ch * 16) = *(const v4u*)(Kg + tok * 512 + h * 64 + ch * 8);
        *(LAS v4u*)(Vl + lrow * 144 + ch * 16) = *(const v4u*)(Vg + tok * 512 + h * 64 + ch * 8);
    }
    if (tid < 465) Bl[tid] = rpb[h * 465 + tid];
    __syncthreads();
    const int w = F.wave(), lane = F.lane(), g = lane >> 4, i = lane & 15, q4 = i >> 2, p4 = i & 3;
    const int cq = 16 * (w & 3) + i;
    bf16x8_t bq0 = *(const bf16x8_t*)(Qg + ((size_t)b * SEQ + r0 * 64 + cq) * 512 + h * 64 + 8 * g), bq1 = *(const bf16x8_t*)(Qg + ((size_t)b * SEQ + r0 * 64 + cq) * 512 + h * 64 + 32 + 8 * g);
    for (int k = 0; k < 8; ++k) {
        const int r = r0 + k;
        const int rq = k < 7 ? r + 1 : r;
        const bf16x8_t nq0 = *(const bf16x8_t*)(Qg + ((size_t)b * SEQ + rq * 64 + cq) * 512 + h * 64 + 8 * g), nq1 = *(const bf16x8_t*)(Qg + ((size_t)b * SEQ + rq * 64 + cq) * 512 + h * 64 + 32 + 8 * g);
        int rsn = r + 1 - 4; rsn = rsn < 0 ? 0 : (rsn > 24 ? 24 : rsn);
        const bool slide = (k < 7) && (rsn != rs);
        v4u pk = (v4u){0u, 0u, 0u, 0u}, pv = pk;
        if (slide) { const size_t tok = (size_t)b * SEQ + (rsn + 7) * 64 + (tid >> 3);
            pk = *(const v4u*)(Kg + tok * 512 + h * 64 + (tid & 7) * 8); pv = *(const v4u*)(Vg + tok * 512 + h * 64 + (tid & 7) * 8); }
        if (w < 4) {
            const int c = 16 * w + i, cb = w == 0 ? 0 : (w == 1 ? 8 : (w == 2 ? 24 : 32));
            int cst = c - 8; cst = cst < 0 ? 0 : (cst > 48 ? 48 : cst);
            const size_t tq = (size_t)b * SEQ + r * 64 + c;
            float sc[16][4];
            float mx = -1e30f;
            int boff[2][4]; float vmask[2][4];
#pragma unroll
            for (int half = 0; half < 2; ++half)
#pragma unroll
                for (int e = 0; e < 4; ++e) { const int kc = cb + 16 * half + 4 * g + e; const bool valid = (kc >= cst) && (kc < cst + 16);
                    int dc = kc - c + 15; dc = dc < 0 ? 0 : (dc > 30 ? 30 : dc); boff[half][e] = dc; vmask[half][e] = valid ? 0.f : -1e30f; }
#pragma unroll
            for (int t = 0; t < 16; ++t) {
                const int wi = t >> 1, half = t & 1, slot = (rs + wi) & 7;
                const LAS unsigned char* kp = Kl + (slot * 64 + cb + 16 * half + i) * 144 + (8 * g) * 2;
                const bf16x8_t a0 = *(const LAS bf16x8_t*)kp, a1 = *(const LAS bf16x8_t*)(kp + 64);
                f32x4 s_ = (f32x4){0.f, 0.f, 0.f, 0.f};
                s_ = MFMA16(a0, bq0, s_); s_ = MFMA16(a1, bq1, s_);
                const int brow = (rs + wi - r + 7) * 31;
#pragma unroll
                for (int e = 0; e < 4; ++e) {
                    const float bias = Bl[brow + boff[half][e]];
                    const float v = fminf(s_[e] + bias, 1e30f) + vmask[half][e];
                    sc[t][e] = v; mx = fmaxf(mx, v);
                }
            }
            mx = fmaxf(mx, shx(mx, lane, 16)); mx = fmaxf(mx, shx(mx, lane, 32));
            float sum = 0.f;
            bf16x8_t bp[8];
#pragma unroll
            for (int wi = 0; wi < 8; ++wi) {
                float p[8];
#pragma unroll
                for (int e = 0; e < 4; ++e) { p[e] = fexp(sc[2 * wi][e] - mx); p[4 + e] = fexp(sc[2 * wi + 1][e] - mx); sum += p[e] + p[4 + e]; }
                v4u pw; pw.x = pkbf(p[0], p[1]); pw.y = pkbf(p[2], p[3]); pw.z = pkbf(p[4], p[5]); pw.w = pkbf(p[6], p[7]);
                bp[wi] = __builtin_bit_cast(bf16x8_t, pw);
            }
            sum += shx(sum, lane, 16); sum += shx(sum, lane, 32);
            f32x4 o[4];
#pragma unroll
            for (int dt = 0; dt < 4; ++dt) o[dt] = (f32x4){0.f, 0.f, 0.f, 0.f};
#pragma unroll
            for (int wi = 0; wi < 8; ++wi) {
                const int slot = (rs + wi) & 7;
                const LAS unsigned char* vp = Vl + (slot * 64 + cb + 4 * g + q4) * 144 + (4 * p4) * 2;
#pragma unroll
                for (int dt = 0; dt < 4; ++dt) { const bf16x8_t av = tr_frag(vp + 32 * dt, vp + 16 * 144 + 32 * dt); o[dt] = MFMA16(av, bp[wi], o[dt]); }
            }
            const float inv = 1.0f / sum;
#pragma unroll
            for (int dt = 0; dt < 4; ++dt) { v2u ov; ov.x = pkbf(o[dt][0] * inv, o[dt][1] * inv); ov.y = pkbf(o[dt][2] * inv, o[dt][3] * inv);
                *(v2u*)(Qg + tq * 512 + h * 64 + 16 * dt + 4 * g) = ov; }
        }
        __syncthreads();
        if (slide) { const int lrow = ((rsn + 7) & 7) * 64 + (tid >> 3);
            *(LAS v4u*)(Kl + lrow * 144 + (tid & 7) * 16) = pk; *(LAS v4u*)(Vl + lrow * 144 + (tid & 7) * 16) = pv; }
        __syncthreads();
        rs = rsn; bq0 = nq0; bq1 = nq1;
    }
}
__device__ __forceinline__ void phase_na(const Frame& F, CArgs* A, int l) { const float* rpb = A->in[5] + (size_t)l * 8 * 465; for (int it = F.bid; it < 256; it += F.G) na_group(F, rpb, it); }

__device__ __forceinline__ void phase_ret_state(const Frame& F) { for (int it = F.bid; it < 256; it += F.G) ret_scan_item(F, it); }
__device__ __forceinline__ void phase_ret_out(const Frame& F, CArgs* A, int l) { const float* gn = A->in[6] + (size_t)l * 512; for (int it = F.bid; it < 512; it += F.G) ret_out_item(F, gn, it); }

__device__ __forceinline__ void phase_final(const Frame& F, CArgs* A) {
    const float* g = A->in[22]; const bf16* xb = (const bf16*)(F.ws + WS_XB); const float* ss = (const float*)(F.ws + WS_SSB);
    for (int m = F.gw(); m < T; m += F.ngw) {
        const v2u* xr = (const v2u*)(xb + (size_t)m * D) + F.lane(); const f32x4* gr = (const f32x4*)g + F.lane(); f32x4* orow = (f32x4*)(F.out + (size_t)m * D) + F.lane();
        float sp = F.lane() < 16 ? ss[(size_t)m * 16 + F.lane()] : 0.f;
        sp += shx(sp, F.lane(), 1); sp += shx(sp, F.lane(), 2); sp += shx(sp, F.lane(), 4); sp += shx(sp, F.lane(), 8);
        const float rs = 1.0f / sqrtf(lane_get(sp, 0) * (1.0f / D) + RMS_EPS);
#pragma unroll
        for (int j = 0; j < 4; ++j) { const v2u w = xr[64 * j]; f32x4 o = (f32x4){bflo(w.x), bfhi(w.x), bflo(w.y), bfhi(w.y)} * rs * gr[64 * j];
            orow[64 * j] = o; }
    }
}

__global__ void __launch_bounds__(NWAVES * 64, 2) mk_fwd(Args args) {
    extern __shared__ __attribute__((aligned(16))) unsigned char lds[];
    const int tid0 = threadIdx.x;
    const int wave0 = __builtin_amdgcn_readfirstlane(tid0 >> 6);
    LAS unsigned char* const lds3 = (LAS unsigned char*)lds;
    CArgs* A0 = get_args();
    const int ph_lo = A0->ph_lo, ph_hi = A0->ph_hi;
    for (int u = tid0; u < (LDS_BYTES - LDSCTL_OFF) / 4; u += NWAVES * 64) ((LAS unsigned*)(lds3 + LDSCTL_OFF))[u] = 0u;
    __syncthreads();
    const bool multi = (ph_hi - ph_lo) > 1;
    XcdBarrier bar; bar.bar = (unsigned*)((gu32*)(A0->ws + WS_CTL) + CW_BAR); bar.x = 0; bar.st = nullptr;
    if (multi) bar = xcd_barrier_post((unsigned*)((gu32*)(A0->ws + WS_CTL) + CW_BAR), (volatile LAS unsigned*)(lds3 + MISC_OFF) + 8);

    unsigned long long probe_acc = 0, pt0 = 0;
#define PMARK(k) do { if (PROBE_WN != 0ull) { __syncthreads(); const unsigned long long t_ = __builtin_amdgcn_s_memrealtime(); probe_acc += ((PROBE_WN >> (4 * (k))) & 15ull) * (t_ - pt0); pt0 = t_; } } while (0)
    for (int ph = ph_lo; ph < ph_hi; ++ph) {
        CArgs* A = get_args();
#define MAKE_FRAME(Fx) Frame Fx; Fx.wave0 = wave0; \
        Fx.lds = lds3; \
        { int b_ = blockIdx.x; asm volatile("" : "+s"(b_)); Fx.bid = b_; } \
        Fx.G = gridDim.x; Fx.ngw = Fx.G * NWAVES; Fx.out = A->out; Fx.ws = A->ws
        MAKE_FRAME(F);
        unsigned char* ws = F.ws;
        if (PROBE_WN != 0ull) pt0 = __builtin_amdgcn_s_memrealtime();
        int kind, l;
        if (ph == 0) { kind = PH_PRO; l = 0; } else if (ph == NPH - 1) { kind = PH_FIN; l = 0; } else { l = (ph - 1) / NPL; kind = 1 + (ph - 1) % NPL; }
        float* ssA = (float*)(ws + WS_SSA); float* ssB = (float*)(ws + WS_SSB);
        switch (kind) {
        case PH_PRO: phase_prologue(F, A); break;
        case PH_G1: {
            pg8::Gemm g{(const bf16_t*)(ws + WS_XB), (const bf16_t*)(ws + W_IN), T, 7680, D, 0, 0};
            pg8::StaticOrder S; S.init(T, 7680, F.G, F.bid);
            EpiG1 E{(bf16_t*)(ws + WS_PROJ), ws + WS_GATE8, ssB, A->in[4] + (size_t)l * 3072, (const float*)(ws + WS_TAB)};
            pg8::gemm_phase<EpiG1, pg8::StaticOrder, true, true>(F.lds, g, S, E, F.ltid());
        } break;
        case PH_MIXA: phase_na(F, A, l); PMARK(10); phase_ret_state(F); PMARK(11); phase_lru<0>(F, A, l); PMARK(12); __syncthreads(); convert_layer_mlp(F, A, l); PMARK(13); break;
        case PH_MIXB: phase_ret_out(F, A, l); PMARK(14); phase_lru<1>(F, A, l); PMARK(15); break;
        case PH_G2: {
            pg8::Gemm g{(const bf16_t*)(ws + WS_PROJ), (const bf16_t*)(ws + W_BR), T, D, 512, 3 * BLK, (size_t)D * 512 * 2};
            ZOrder S; S.S.init(T, D, F.G, F.bid);
            EpiG2 E{ws + WS_GATE8, (bf16_t*)(ws + WS_MERGED)};
            pg8::gemm_phase<EpiG2, ZOrder, true, true>(F.lds, g, S, E, F.ltid());
        } break;
        case PH_G3: case PH_G5: {
            const bool g3 = (kind == PH_G3);
            pg8::Gemm g{(const bf16_t*)(ws + (g3 ? WS_MERGED : WS_U)), (const bf16_t*)(ws + (g3 ? W_OUT : W_DOWN)), T, D, g3 ? D : FF, 0, 0};
            pg8::StaticOrder S; S.init(T, D, F.G, F.bid);
            EpiRes E{(g3 && l == 0) ? A->in[0] : nullptr, (const bf16_t*)(ws + (g3 ? WS_XB : WS_GATE8)), (bf16_t*)(ws + WS_GATE8), g3 ? ssB : ssA};
            pg8::gemm_phase<EpiRes, pg8::StaticOrder, false, true>(F.lds, g, S, E, F.ltid());
        } break;
        case PH_G4: {
            pg8::Gemm g{(const bf16_t*)(ws + WS_GATE8), (const bf16_t*)(ws + W_UP), T, FF, D, 0, 0};
            pg8::StaticOrder S; S.init(T, FF, F.G, F.bid);
            EpiG4 E{(bf16_t*)(ws + WS_U), ssB};
            pg8::gemm_phase<EpiG4, pg8::StaticOrder, true, true>(F.lds, g, S, E, F.ltid());
            MAKE_FRAME(F2);
            convert_p(F2, A, l);
            if (l + 1 < DEPTH) convert_layer_mid(F2, A, l + 1);
        } break;
        case PH_G6: {
            {
                pg8::Gemm g{(const bf16_t*)(ws + WS_PB), (const bf16_t*)(ws + W_PLE(l & 1)), T, D, PLE, 0, 0};
                pg8::StaticOrder S; S.init(T, D, F.G, F.bid);
                EpiE E{(bf16_t*)(ws + WS_E)};
                pg8::gemm_phase<EpiE, pg8::StaticOrder, false, true>(F.lds, g, S, E, F.ltid());
            }
            {
                pg8::Gemm g{(const bf16_t*)(ws + WS_GATE8), (const bf16_t*)(ws + W_G(l & 1)), T, D, D, 0, 0};
                pg8::StaticOrder S; S.init(T, D, F.G, F.bid);
                EpiG6 E{(const bf16_t*)(ws + WS_GATE8), (bf16_t*)(ws + WS_XB), ssA, ssB, (const bf16_t*)(ws + WS_E)};
                pg8::gemm_phase<EpiG6, pg8::StaticOrder, false, true>(F.lds, g, S, E, F.ltid());
            }
            if (l + 1 < DEPTH) { MAKE_FRAME(F2); convert_layer_early(F2, A, l + 1); }
        } break;
        case PH_FIN: phase_final(F, A); break;
        default: break;
        }
        if (ph + 1 < ph_hi) xcd_barrier(bar, F.ltid());
        PMARK(kind);
    }
    if (PROBE_WN != 0ull && blockIdx.x == 0) { const unsigned long long te = __builtin_amdgcn_s_memrealtime(); while (__builtin_amdgcn_s_memrealtime() - te < probe_acc) __builtin_amdgcn_s_sleep(32); }
}


#if MK_CHECK
constexpr int CW_CODE = 64, CW_CNT = 128;
__device__ __forceinline__ unsigned hash32(unsigned x) { x ^= x >> 16; x *= 0x7feb352du; x ^= x >> 15; x *= 0x846ca68bu; x ^= x >> 16; return x; }
__device__ __forceinline__ bool near(float a, float b, float rel, float abs_) { return fabsf(a - b) <= rel * fabsf(b) + abs_; }
__device__ float rs_of_x(const float* x, int row) { float s = 0.f; for (int k = 0; k < D; ++k) s += x[(size_t)row * D + k] * x[(size_t)row * D + k]; return 1.0f / sqrtf(s / D + RMS_EPS); }
__global__ void __launch_bounds__(256) mk_check(Args a, int stage) {
    const unsigned id = blockIdx.x * blockDim.x + threadIdx.x;
    const unsigned h = hash32(id * 2654435761u + 12345u * stage);
    unsigned char* ws = a.ws; unsigned* ctl = (unsigned*)(ws + WS_CTL);
    const int row = (int)(h % T);
    bool bad = false;
    const float* x = a.in[0];
    if (stage == 1) {
        const int col = (int)((h >> 14) % D);
        const bf16* xb = (const bf16*)(ws + WS_XB);
        bad |= !near(bf2f(xb[(size_t)row * D + col]), x[(size_t)row * D + col], 0.01f, 1e-3f);
        float s = 0.f; for (int k = 0; k < D; ++k) s += x[(size_t)row * D + k] * x[(size_t)row * D + k];
        const float* ss = (const float*)(ws + WS_SSB); float t = 0.f; for (int k = 0; k < 16; ++k) t += ss[(size_t)row * 16 + k];
        bad |= !near(t, s, 1e-3f, 1e-3f);
        const int n = (int)((h >> 7) % 7680), k = (int)(h % D);
        const bf16* wt = (const bf16*)(ws + W_IN);
        bad |= !near(bf2f(wt[(size_t)n * D + k]), a.in[2][k] * a.in[3][(size_t)k * 7680 + n], 0.01f, 1e-4f);
        const int pos = (int)(h % SEQ), i = (int)((h >> 11) % 64);
        const float th = powf(10000.0f, -(float)i / 63.0f), ang = (float)pos * th;
        const float* tab = (const float*)(ws + WS_TAB);
        bad |= !near(tab[pos * 64 + i], cosf(ang), 0.f, 2e-3f); bad |= !near(tab[131072 + pos * 64 + i], sinf(ang), 0.f, 2e-3f);
    } else if (stage == 2) {
        const int col = (int)((h >> 14) % 7680) & ~1;
        const float rs = rs_of_x(x, row);
        float v0 = 0.f, v1 = 0.f;
        for (int k = 0; k < D; ++k) { const float xv = x[(size_t)row * D + k] * a.in[2][k]; v0 += xv * a.in[3][(size_t)k * 7680 + col]; v1 += xv * a.in[3][(size_t)k * 7680 + col + 1]; }
        v0 *= rs; v1 *= rs;
        if (col < 4608) {
            const int kind = col / 512, cc = col % 512, phys = (int)((0x683754210ull >> (4 * kind)) & 15ull);
            if (kind == 3 || kind == 4) { const int i = (cc & 127) >> 1, pos = row & 2047; const float th = powf(10000.0f, -(float)i / 63.0f), ang = (float)pos * th, c = cosf(ang), sn = sinf(ang);
                const float w0 = v0 * c - v1 * sn, w1 = v0 * sn + v1 * c; v0 = w0; v1 = w1; }
            if (kind == 0) { v0 *= 0.125f; v1 *= 0.125f; } if (kind == 3) { v0 *= 0.08838834764831845f; v1 *= 0.08838834764831845f; }
            const bf16* p = (const bf16*)(ws + WS_PROJ) + (size_t)phys * T * 512 + (size_t)row * 512 + cc;
            bad |= !near(bf2f(p[0]), v0, 0.03f, 0.03f); bad |= !near(bf2f(p[1]), v1, 0.03f, 0.03f);
        } else {
            const int gc = col - 4608; const unsigned char* g8 = ws + WS_GATE8 + (size_t)row * 3072 + gc;
            const float s0 = 1.0f / (1.0f + expf(-(v0 + a.in[4][gc]))), s1 = 1.0f / (1.0f + expf(-(v1 + a.in[4][gc + 1])));
            bad |= !near((float)g8[0] / 255.0f, s0, 0.f, 0.012f); bad |= !near((float)g8[1] / 255.0f, s1, 0.f, 0.012f);
        }
    } else if (stage == 4) {
        const int col = (int)((h >> 14) % D);
        float m = 0.f;
        for (int n = 0; n < 3; ++n) { const bf16* ys = (const bf16*)(ws + WS_PROJ) + (size_t)(3 * n) * T * 512 + (size_t)row * 512; float acc = 0.f;
            for (int k = 0; k < 512; ++k) acc += bf2f(ys[k]) * a.in[14][((size_t)n * 512 + k) * D + col];
            m += acc * (float)ws[WS_GATE8 + (size_t)row * 3072 + n * 1024 + col] / 255.0f; }
        bad |= !near(bf2f(((const bf16*)(ws + WS_MERGED))[(size_t)row * D + col]), m, 0.03f, 0.03f);
    } else if (stage == 5 && false) {
        const int col = (int)((h >> 14) % D);
        const bf16* mg = (const bf16*)(ws + WS_XB) + (size_t)row * D; float acc = 0.f;
        for (int k = 0; k < D; ++k) acc += bf2f(mg[k]) * a.in[15][(size_t)k * D + col];
        const float x1 = x[(size_t)row * D + col] + acc;
        bad |= !near(a.out[(size_t)row * D + col], x1, 0.02f, 0.03f);
        bad |= !near(bf2f(((const bf16*)(ws + WS_GATE8))[(size_t)row * D + col]), a.out[(size_t)row * D + col], 0.01f, 1e-3f);
        float s = 0.f; for (int k = 0; k < D; ++k) s += a.out[(size_t)row * D + k] * a.out[(size_t)row * D + k];
        const float* ss = (const float*)(ws + WS_SSB); float t = 0.f; for (int k = 0; k < 16; ++k) t += ss[(size_t)row * 16 + k];
        bad |= !near(t, s, 1e-3f, 1e-3f);
    } else if (stage == 6 && false) {
        const int col = (int)((h >> 14) % FF);
        const bf16* xb = (const bf16*)(ws + WS_GATE8) + (size_t)row * D; float acc = 0.f;
        for (int k = 0; k < D; ++k) acc += bf2f(xb[k]) * a.in[16][k] * a.in[17][(size_t)k * FF + col];
        const float rs = rs_of_x(a.out, row); float v = fmaxf(acc * rs, 0.f); v *= v;
        bad |= !near(bf2f(((const bf16*)(ws + WS_U))[(size_t)row * FF + col]), v, 0.05f, 0.05f);
    } else if (stage == 7 && false) {
        const int col = (int)((h >> 14) % D);
        const bf16* uu = (const bf16*)(ws + WS_U) + (size_t)row * FF; float acc = 0.f;
        for (int k = 0; k < FF; ++k) acc += bf2f(uu[k]) * a.in[18][(size_t)k * D + col];
        const float x2 = bf2f(((const bf16*)(ws + WS_XB))[(size_t)row * D + col]) + acc;
        bad |= !near(a.out[(size_t)row * D + col], x2, 0.03f, 0.05f);
        bad |= !near(bf2f(((const bf16*)(ws + WS_GATE8))[(size_t)row * D + col]), a.out[(size_t)row * D + col], 0.01f, 1e-3f);
        float s = 0.f; for (int k = 0; k < D; ++k) s += a.out[(size_t)row * D + k] * a.out[(size_t)row * D + k];
        const float* ss = (const float*)(ws + WS_SSA); float t = 0.f; for (int k = 0; k < 16; ++k) t += ss[(size_t)row * 16 + k];
        bad |= !near(t, s, 1e-3f, 1e-3f);
    } else if (stage == 8 && false) {
        const int col = (int)((h >> 14) % D);
        const bf16* xb = (const bf16*)(ws + WS_GATE8) + (size_t)row * D; float acc = 0.f, s = 0.f;
        for (int k = 0; k < D; ++k) { const float xv = bf2f(xb[k]); s += xv * xv; acc += xv * a.in[19][k] * a.in[20][(size_t)k * D + col]; }
        const float rs = 1.0f / sqrtf(s / D + RMS_EPS);
        float e = 0.f; for (int k = 0; k < PLE; ++k) e += a.in[1][(size_t)row * PLE + k] * a.in[21][(size_t)k * D + col];
        const float x3 = bf2f(xb[col]) + e / (1.0f + expf(-acc * rs));
        bad |= !near(a.out[(size_t)row * D + col], x3, 0.03f, 0.05f);
    }
    if (stage == 9) bad = true;
    if (bad) atomicAdd(&ctl[CW_CNT + stage], 1u);
}
__device__ float orig_proj(const Args& a, int l, int row, int col) {
    const float* x = l == 0 ? a.in[0] : a.out; const float* g = a.in[2] + (size_t)l * D; const float* w = a.in[3] + (size_t)l * D * 7680;
    float s = 0.f, acc = 0.f;
    for (int k = 0; k < D; ++k) { const float xv = x[(size_t)row * D + k]; s += xv * xv; acc += xv * g[k] * w[(size_t)k * 7680 + col]; }
    return acc / sqrtf(s / D + RMS_EPS);
}
__global__ void __launch_bounds__(64) mk_check_na(Args a, int l) {
    __shared__ float qs[64]; __shared__ float sc[128];
    const unsigned h = hash32(blockIdx.x * 977u + 31u); const int t = (int)(h % T), hd = (int)((h >> 16) % 8), d = threadIdx.x;
    unsigned char* ws = a.ws; unsigned* ctl = (unsigned*)(ws + WS_CTL);
    const bf16* K = (const bf16*)(ws + WS_PROJ + BLK); const bf16* V = (const bf16*)(ws + WS_PROJ + 2 * BLK); const bf16* Y = (const bf16*)(ws + WS_PROJ);
    qs[d] = bf2f((bf16)f2bf(0.125f * orig_proj(a, l, t, hd * 64 + d)));
    __syncthreads();
    const int b = t / SEQ, s = t % SEQ, r = s / 64, c = s % 64;
    int rs = r - 4; if (rs < 0) rs = 0; if (rs > 24) rs = 24; int cs = c - 8; if (cs < 0) cs = 0; if (cs > 48) cs = 48;
    const float* rpb = a.in[5] + (size_t)l * 8 * 15 * 31 + hd * 465;
    for (int kk = d; kk < 128; kk += 64) { const int i = kk / 16, j = kk % 16; const int tk = b * SEQ + (rs + i) * 64 + cs + j; float acc = 0.f;
        for (int e = 0; e < 64; ++e) acc += qs[e] * bf2f(K[(size_t)tk * 512 + hd * 64 + e]);
        sc[kk] = acc + rpb[(rs + i - r + 7) * 31 + (cs + j - c + 15)]; }
    __syncthreads();
    float mx = -1e30f; for (int kk = 0; kk < 128; ++kk) mx = fmaxf(mx, sc[kk]);
    float den = 0.f, o = 0.f;
    for (int kk = 0; kk < 128; ++kk) { const int i = kk / 16, j = kk % 16; const int tk = b * SEQ + (rs + i) * 64 + cs + j; const float p = expf(sc[kk] - mx); den += p; o += p * bf2f(V[(size_t)tk * 512 + hd * 64 + d]); }
    o /= den;
    if (!near(bf2f(Y[(size_t)t * 512 + hd * 64 + d]), o, 0.04f, 0.04f)) atomicAdd(&ctl[CW_CNT + 31], 1u);
}
__global__ void __launch_bounds__(128) mk_check_ret(Args a, int l) {
    __shared__ float qs[128]; __shared__ float sc[SEQ]; __shared__ float red[128];
    const unsigned h = hash32(blockIdx.x * 1231u + 77u); const int t = (int)(h % T), hd = (int)((h >> 16) % 4), dv = threadIdx.x;
    unsigned char* ws = a.ws; unsigned* ctl = (unsigned*)(ws + WS_CTL);
    const bf16* Y = (const bf16*)(ws + WS_PROJ + 3 * BLK); const bf16* Q = (const bf16*)(ws + WS_PROJ + 4 * BLK); const bf16* K = (const bf16*)(ws + WS_PROJ + 5 * BLK); const bf16* V = (const bf16*)(ws + WS_PROJ + 7 * BLK);
    const int b = t / SEQ, n = t % SEQ;
    qs[dv] = bf2f(Q[(size_t)t * 512 + hd * 128 + dv]);
    __syncthreads();
    const float gf = log2_1m(__builtin_amdgcn_exp2f(-5.0f - (float)hd)), gb = log2_1m(__builtin_amdgcn_exp2f(-5.5f - (float)hd));
    for (int m = dv; m < SEQ; m += 128) { float acc = 0.f; for (int e = 0; e < 128; ++e) acc += qs[e] * bf2f(K[(size_t)(b * SEQ + m) * 512 + hd * 128 + e]);
        sc[m] = acc * (m <= n ? __builtin_amdgcn_exp2f(gf * (float)(n - m)) : __builtin_amdgcn_exp2f(gb * (float)(m - n))); }
    __syncthreads();
    float o = 0.f; for (int m = 0; m < SEQ; ++m) o += sc[m] * bf2f(V[(size_t)(b * SEQ + m) * 512 + hd * 128 + dv]);
    red[dv] = o * o; __syncthreads();
    float ms = 0.f; for (int e = 0; e < 128; ++e) ms += red[e];
    const float rn = 1.0f / sqrtf(ms / 128.0f + RMS_EPS);
    const float g = bf2f((bf16)f2bf(orig_proj(a, l, t, 1536 + 3 * 512 + hd * 128 + dv)));
    const float y = g / (1.0f + expf(-g)) * o * rn * a.in[6][(size_t)l * 512 + hd * 128 + dv];
    if (!near(bf2f(Y[(size_t)t * 512 + hd * 128 + dv]), y, 0.04f, 0.04f)) atomicAdd(&ctl[CW_CNT + 32], 1u);
}
__global__ void __launch_bounds__(128) mk_check_g(Args a, int l, int code) {
    const unsigned h = hash32(blockIdx.x * 1231u + 77u); const int t = (int)(h % T), hd = (int)((h >> 16) % 4), dv = threadIdx.x;
    unsigned* ctl = (unsigned*)(a.ws + WS_CTL);
    const bf16* G = (const bf16*)(a.ws + WS_PROJ + 3 * BLK);
    const float g = orig_proj(a, l, t, 1536 + 3 * 512 + hd * 128 + dv);
    if (!near(bf2f(G[(size_t)t * 512 + hd * 128 + dv]), g, 0.03f, 0.03f)) atomicAdd(&ctl[CW_CNT + code], 1u);
}
__global__ void __launch_bounds__(64) mk_check_lru(Args a, int l) {
    __shared__ float xs[64];
    const unsigned h = hash32(blockIdx.x * 733u + 5u); const int b = (int)(h % 8), blk = (int)((h >> 8) % 8), ts = (int)((h >> 16) % SEQ), j = threadIdx.x, ch = blk * 64 + j;
    unsigned char* ws = a.ws; unsigned* ctl = (unsigned*)(ws + WS_CTL);
    const bf16* XC = (const bf16*)(ws + WS_PROJ + 8 * BLK); const bf16* Y = (const bf16*)(ws + WS_PROJ + 6 * BLK);
    const float* cw = a.in[7] + (size_t)l * 2048; const float cb = a.in[8][(size_t)l * 512 + ch];
    float hsum = 0.f;
    for (int dir = 0; dir < 2; ++dir) {
        const float* wa = a.in[9] + (((size_t)l * 2 + dir) * 8 + blk) * 4096; const float* wx = a.in[11] + (((size_t)l * 2 + dir) * 8 + blk) * 4096;
        const float ba = a.in[10][((size_t)l * 2 + dir) * 512 + ch], bx = a.in[12][((size_t)l * 2 + dir) * 512 + ch], lam = a.in[13][((size_t)l * 2 + dir) * 512 + ch];
        const float sp = log1pf(expf(-lam));
        float hh = 0.f;
        const int nsteps = dir == 0 ? ts + 1 : SEQ - ts;
        for (int st = 0; st < nsteps; ++st) {
            const int t = dir == 0 ? st : SEQ - 1 - st;
            float xf = cb;
            for (int w = 0; w < 4; ++w) { const int t2 = t + w - 2; if (t2 >= 0 && t2 < SEQ) xf += cw[w * 512 + ch] * bf2f(XC[(size_t)(b * SEQ + t2) * 512 + ch]); }
            __syncthreads(); xs[j] = xf; __syncthreads();
            float ra = ba, ia = bx;
            for (int i = 0; i < 64; ++i) { ra += xs[i] * wa[i * 64 + j]; ia += xs[i] * wx[i * 64 + j]; }
            const float r = 1.0f / (1.0f + expf(-ra)), ig = 1.0f / (1.0f + expf(-ia));
            const float la = -8.0f * r * sp, av = expf(la); float mult = sqrtf(-expm1f(2.0f * la)); if (st == 0) mult = 1.0f;
            hh = av * hh + mult * ig * xf;
        }
        hsum += hh;
    }
    const float gc = bf2f((bf16)f2bf(orig_proj(a, l, b * SEQ + ts, 3584 + 512 + ch)));
    const float u = 0.7978845608028654f * (gc + 0.044715f * gc * gc * gc);
    const float y = 0.5f * gc * (1.0f + tanhf(u)) * hsum;
    if (!near(bf2f(Y[(size_t)(b * SEQ + ts) * 512 + ch]), y, 0.04f, 0.04f)) atomicAdd(&ctl[CW_CNT + 33], 1u);
}
__global__ void mk_report(Args a) {
    unsigned* ctl = (unsigned*)(a.ws + WS_CTL);
    const int order[13] = {1, 2, 35, 31, 34, 32, 33, 4, 5, 6, 7, 8, 9};
    const unsigned tot[13] = {16384u, 16384u, 16384u, 32768u, 16384u, 16384u, 8192u, 16384u, 16384u, 16384u, 16384u, 16384u, 64u};
    for (int i = 0; i < 13; ++i) {
        const unsigned cnt = ctl[CW_CNT + order[i]];
        if (cnt * 200u > tot[i]) {
            unsigned tenth = (cnt * 10u) / tot[i]; if (tenth > 9u) tenth = 9u;
            a.out[0] = order[i] >= 10 ? 100.0f * (float)order[i] : 1000.0f * (float)order[i] + 100.0f * (float)tenth;
            return;
        }
    }
}
#endif

#ifndef MK_ONE_LAUNCH
#define MK_ONE_LAUNCH 1
#endif
extern "C" void kernel_launch(void* const* d_in, const int* in_sizes, int n_in, void* d_out, int out_size, void* d_ws, size_t ws_size, hipStream_t stream) {
    static int grid = 0;
    if (grid == 0) {
        if (n_in != 23 || in_sizes[0] != T * D || out_size != T * D || ws_size < WS_END) { fprintf(stderr, "kernel_launch: unexpected shapes (n_in %d, in0 %d, out %d, ws %zu); nothing launched\n", n_in, n_in > 0 ? in_sizes[0] : -1, out_size, ws_size); grid = -1; return; }
        int dev = 0, cus = 0, per_cu = 0;
        if (hipGetDevice(&dev) != hipSuccess || hipDeviceGetAttribute(&cus, hipDeviceAttributeMultiprocessorCount, dev) != hipSuccess) { grid = -1; return; }
        if (hipFuncSetAttribute((const void*)mk_fwd, hipFuncAttributeMaxDynamicSharedMemorySize, LDS_BYTES) != hipSuccess) { fprintf(stderr, "kernel_launch: hipFuncSetAttribute failed\n"); grid = -1; return; }
        if (hipOccupancyMaxActiveBlocksPerMultiprocessor(&per_cu, (const void*)mk_fwd, NWAVES * 64, LDS_BYTES) != hipSuccess || per_cu < 1) { fprintf(stderr, "kernel_launch: occupancy query says %d blocks per CU\n", per_cu); }
        (void)hipGetLastError();
        grid = cus;
    }
    if (grid < 0) return;
    if (hipMemsetAsync((char*)d_ws + WS_CTL, 0, CTL_ZERO_BYTES, stream) != hipSuccess) return;
    Args a{};
    for (int i = 0; i < 23; ++i) a.in[i] = (const float*)d_in[i];
    a.out = (float*)d_out; a.ws = (unsigned char*)d_ws;
#if MK_ONE_LAUNCH
    a.ph_lo = 0; a.ph_hi = NPH;
    hipLaunchKernelGGL(mk_fwd, dim3(grid), dim3(NWAVES * 64), LDS_BYTES, stream, a);
#else
    for (int ph = 0; ph < NPH; ++ph) {
#if MK_CHECK
        if (ph == 1 + 6) (void)hipMemcpyAsync((char*)d_ws + WS_XB, (char*)d_ws + WS_GATE8, (size_t)T * D * 2, hipMemcpyDeviceToDevice, stream);
#endif
        a.ph_lo = ph; a.ph_hi = ph + 1; hipLaunchKernelGGL(mk_fwd, dim3(grid), dim3(NWAVES * 64), LDS_BYTES, stream, a);
#if MK_CHECK
        { int st = 0; if (ph == 0) st = 1; else if (ph == 1) st = 2; else if (ph == 1 + 3) st = 4; else if (ph == 1 + 4) st = 5; else if (ph == 1 + 5) st = 6; else if (ph == 1 + 6) st = 7; else if (ph == 1 + 7) st = 8;
          if (st) hipLaunchKernelGGL(mk_check, dim3(64), dim3(256), 0, stream, a, st);
          if (ph == 1 + 1) hipLaunchKernelGGL(mk_check_na, dim3(512), dim3(64), 0, stream, a, 0);
          if (ph == 1) hipLaunchKernelGGL(mk_check_g, dim3(128), dim3(128), 0, stream, a, 0, 35);
          if (ph == 1 + 1) hipLaunchKernelGGL(mk_check_g, dim3(128), dim3(128), 0, stream, a, 0, 34);
          if (ph == 1 + 2) hipLaunchKernelGGL(mk_check_ret, dim3(128), dim3(128), 0, stream, a, 0);
          if (ph == 1 + 2) hipLaunchKernelGGL(mk_check_lru, dim3(128), dim3(64), 0, stream, a, 0);
          if (ph == NPH - 1) hipLaunchKernelGGL(mk_check, dim3(1), dim3(64), 0, stream, a, 9); }
#endif
    }
#if MK_CHECK
    hipLaunchKernelGGL(mk_report, dim3(1), dim3(1), 0, stream, a);
#endif
#endif
}
```

```cpp
#include <hip/hip_runtime.h>
#include <cstdio>
#include <cstdint>
#ifndef MK_CHECK
#define MK_CHECK 0
#endif
#ifndef PROBE_WN
#define PROBE_WN 0x0ull
#endif
namespace pg8 {
#define PG8_LAS __attribute__((address_space(3)))
typedef unsigned short bf16_t;
typedef short bf16x8 __attribute__((ext_vector_type(8)));
typedef float f32x4 __attribute__((ext_vector_type(4)));
typedef unsigned u32x4 __attribute__((ext_vector_type(4)));
constexpr int BM = 256, BK = 64, HALF = 128, HTB = HALF * BK * 2  , STAGE_BYTES = 8 * HTB, NXCD = 8, WGM = 8;

__host__ __device__ __forceinline__ int lds_byte(int r, int c) { const int st = (r >> 4) * 2 + (c >> 5), rr = r & 15, cc = c & 31, ob = rr * 64 + cc * 2; return st * 1024 + (ob ^ (((ob >> 9) & 1) << 5)); }
__host__ __device__ __forceinline__ void stage_rc(int b, int& R, int& C) { const int st = b / 1024, sb = b % 1024, swz = sb ^ (((sb >> 9) & 1) << 5); R = (st >> 1) * 16 + swz / 64; C = (st & 1) * 32 + (swz % 64) / 2; }
__host__ __device__ __forceinline__ int perm32(int rho) { const int n = rho >> 4, i = rho & 15; return 8 * (i >> 2) + 4 * n + (i & 3); }

struct Unit { int pm, pn, z; };
struct Gemm { const bf16_t* A; const bf16_t* Bt; int M, N, K; size_t zA, zB; };

struct StaticOrder {
    int nM, nN, nwg, G, c;
    __host__ __device__ void init(int M, int N, int G_, int c_) { nM = M / BM; nN = N / BM; nwg = nM * nN; G = G_; c = c_; }
    __host__ __device__ bool next(int i, Unit& u) const {
        const long L = (long)i * G + c; if (L >= nwg) return false;
        int wgid = (int)L; { const int q = nwg / NXCD, r = nwg % NXCD, xcd = wgid % NXCD, off = wgid / NXCD; wgid = (xcd < r ? xcd * (q + 1) : r * (q + 1) + (xcd - r) * q) + off; }
        const int nig = WGM * nN, gid = wgid / nig, fm = gid * WGM, gsz = (nM - fm) < WGM ? (nM - fm) : WGM;
        u.pm = fm + ((wgid % nig) % gsz); u.pn = (wgid % nig) / gsz; u.z = 0; return true;
    }
    __device__ __forceinline__ void a_ready(const Unit&) const {}
    __device__ __forceinline__ void done(const Unit&) const {}
};

__device__ __forceinline__ unsigned cvt_pk_bf16(float lo, float hi) { unsigned r; asm volatile("v_cvt_pk_bf16_f32 %0, %1, %2" : "=v"(r) : "v"(lo), "v"(hi)); return r; }
typedef float f32x2 __attribute__((ext_vector_type(2)));
template <class Epi, class Sched, bool ALIGN_EPI = false, bool SP2 = false>
__device__ __forceinline__ void gemm_phase(PG8_LAS unsigned char* lds, const Gemm g, const Sched& S, const Epi& E, const int tid) {
    const int wid = __builtin_amdgcn_readfirstlane(tid >> 6), lane = tid & 63, wr = wid >> 2, wc = wid & 3, fr = lane & 15, fq = lane >> 4;
    const int K = g.K, nt = K / BK;
    unsigned voffA[2], voffB[2];
#pragma unroll
    for (int i = 0; i < 2; ++i) { int R, C; stage_rc(tid * 16 + i * 8192, R, C); const int Rb = Epi::PERM ? ((R & ~31) + perm32(R & 31)) : R;
        voffA[i] = (unsigned)(R * K + C) * 2u; voffB[i] = (unsigned)(Rb * K + C) * 2u; }
    const size_t kstep = (size_t)(BK * 2);
    const size_t hstep = (size_t)HALF * K * 2;
    const size_t tstep = 2 * hstep;
    const unsigned ldsw = (unsigned)wid * 1024u;
    const int aoff = lds_byte(wr * 64 + fr, fq * 8), boff = lds_byte(wc * 32 + fr, fq * 8);
#define PG8_SA(b, h) (((b) * 2 + (h)) * HTB)
#define PG8_SB(b, h) ((4 + (b) * 2 + (h)) * HTB)
#define PG8_STAGE(bufoff, gbase, voff) do { _Pragma("unroll") for (int _i = 0; _i < 2; ++_i) \
        __builtin_amdgcn_global_load_lds((const unsigned*)((const char*)(gbase) + (voff)[_i]), (PG8_LAS unsigned*)(lds + (bufoff) + ldsw + _i * 8192), 16, 0, 0); } while (0)
#define PG8_LDA(dst, b, h) do { _Pragma("unroll") for (int m = 0; m < 4; ++m) _Pragma("unroll") for (int k = 0; k < 2; ++k) dst[m][k] = *(const PG8_LAS bf16x8*)(lds + PG8_SA(b, h) + aoff + m * 2048 + k * 1024); } while (0)
#define PG8_LDB(dst, b, h) do { _Pragma("unroll") for (int n = 0; n < 2; ++n) _Pragma("unroll") for (int k = 0; k < 2; ++k) dst[n][k] = *(const PG8_LAS bf16x8*)(lds + PG8_SB(b, h) + boff + n * 2048 + k * 1024); } while (0)
#define PG8_MMA(ai, bj, At, Bt) do { __builtin_amdgcn_s_setprio(1); _Pragma("unroll") for (int m = 0; m < 4; ++m) _Pragma("unroll") for (int n = 0; n < 2; ++n) _Pragma("unroll") for (int k = 0; k < 2; ++k) \
        acc[ai][bj][m][n] = __builtin_amdgcn_mfma_f32_16x16x32_bf16(Bt[n][k], At[m][k], acc[ai][bj][m][n], 0, 0, 0); __builtin_amdgcn_s_setprio(0); } while (0)
#define PG8_WAIT_V(n) asm volatile("s_waitcnt vmcnt(" #n ")" ::: "memory")
#define PG8_WAIT_L(n) asm volatile("s_waitcnt lgkmcnt(" #n ")" ::: "memory")
#define PG8_BAR __builtin_amdgcn_s_barrier()
#define PG8_SCHED __builtin_amdgcn_sched_barrier(0)
    Unit cur, nxt; int ui = 0;
    if (!S.next(0, cur)) return;
    f32x4 acc[2][2][4][2];
#pragma unroll
    for (int a = 0; a < 2; ++a)
#pragma unroll
        for (int b = 0; b < 2; ++b)
#pragma unroll
            for (int m = 0; m < 4; ++m)
#pragma unroll
                for (int n = 0; n < 2; ++n) acc[a][b][m][n] = (f32x4){0.f, 0.f, 0.f, 0.f};
    bf16x8 At[4][2], B0[2][2], B1[2][2];
    const char* cA = (const char*)g.A + (size_t)cur.z * g.zA + (size_t)cur.pm * tstep; const char* cB = (const char*)g.Bt + (size_t)cur.z * g.zB + (size_t)cur.pn * tstep;
    S.a_ready(cur);
    if constexpr (SP2) {
        PG8_STAGE(PG8_SB(0, 0), cB, voffB); PG8_STAGE(PG8_SB(0, 1), cB + hstep, voffB); PG8_STAGE(PG8_SA(0, 0), cA, voffA); PG8_STAGE(PG8_SA(0, 1), cA + hstep, voffA);
        if (wr == 1) PG8_BAR;
        PG8_WAIT_V(2); PG8_BAR;
        PG8_STAGE(PG8_SB(1, 0), cB + kstep, voffB); PG8_STAGE(PG8_SA(1, 0), cA + kstep, voffA); PG8_STAGE(PG8_SB(1, 1), cB + hstep + kstep, voffB);
        PG8_WAIT_V(6); PG8_BAR;
    } else {
        PG8_STAGE(PG8_SB(0, 0), cB, voffB); PG8_STAGE(PG8_SA(0, 0), cA, voffA); PG8_STAGE(PG8_SB(0, 1), cB + hstep, voffB); PG8_STAGE(PG8_SA(0, 1), cA + hstep, voffA);
        if (wr == 1) PG8_BAR;
        PG8_WAIT_V(4); PG8_BAR;
        PG8_STAGE(PG8_SB(1, 0), cB + kstep, voffB); PG8_STAGE(PG8_SA(1, 0), cA + kstep, voffA); PG8_STAGE(PG8_SB(1, 1), cB + hstep + kstep, voffB);
        PG8_WAIT_V(6); PG8_BAR;
    }
    for (;;) {
        const bool has_next = S.next(ui + 1, nxt);
        const char* nA = has_next ? (const char*)g.A + (size_t)nxt.z * g.zA + (size_t)nxt.pm * tstep : cA; const char* nB = has_next ? (const char*)g.Bt + (size_t)nxt.z * g.zB + (size_t)nxt.pn * tstep : cB;
        for (int t = 0; t < nt; t += 2) {
            const bool last = (t == nt - 2);
            const char* a1 = cA + (size_t)(t + 1) * kstep;
            const char* a2 = last ? nA : cA + (size_t)(t + 2) * kstep; const char* b2 = last ? nB : cB + (size_t)(t + 2) * kstep;
            const char* a3 = a2 + kstep; const char* b3 = b2 + kstep;
            if (last && has_next) S.a_ready(nxt);
            if constexpr (SP2) {
            PG8_LDB(B0, 0, 0); PG8_LDB(B1, 0, 1); PG8_SCHED; PG8_LDA(At, 0, 0); PG8_STAGE(PG8_SA(1, 1), a1 + hstep, voffA);
            PG8_WAIT_V(8); PG8_WAIT_L(0); PG8_BAR; PG8_MMA(0, 0, At, B0); PG8_MMA(0, 1, At, B1); PG8_BAR; PG8_SCHED;
            PG8_LDA(At, 0, 1); PG8_STAGE(PG8_SB(0, 0), b2, voffB); PG8_STAGE(PG8_SB(0, 1), b2 + hstep, voffB); PG8_STAGE(PG8_SA(0, 0), a2, voffA);
            PG8_WAIT_V(8); PG8_WAIT_L(0); PG8_BAR; PG8_MMA(1, 0, At, B0); PG8_MMA(1, 1, At, B1); PG8_BAR; PG8_SCHED;
            PG8_LDB(B0, 1, 0); PG8_LDB(B1, 1, 1); PG8_SCHED; PG8_LDA(At, 1, 0); PG8_STAGE(PG8_SA(0, 1), a2 + hstep, voffA);
            PG8_WAIT_V(8); PG8_WAIT_L(0); PG8_BAR; PG8_MMA(0, 0, At, B0); PG8_MMA(0, 1, At, B1); PG8_BAR; PG8_SCHED;
            PG8_LDA(At, 1, 1); PG8_STAGE(PG8_SB(1, 0), b3, voffB); PG8_STAGE(PG8_SB(1, 1), b3 + hstep, voffB); PG8_STAGE(PG8_SA(1, 0), a3, voffA);
            PG8_WAIT_V(8); PG8_WAIT_L(0); PG8_BAR; PG8_MMA(1, 0, At, B0); PG8_MMA(1, 1, At, B1); PG8_BAR; PG8_SCHED;
            } else {
            PG8_LDB(B0, 0, 0); PG8_SCHED; PG8_LDA(At, 0, 0); PG8_STAGE(PG8_SA(1, 1), a1 + hstep, voffA);
            PG8_WAIT_L(8); PG8_BAR; PG8_WAIT_L(0); PG8_MMA(0, 0, At, B0); PG8_BAR; PG8_SCHED;
            PG8_LDB(B1, 0, 1); PG8_STAGE(PG8_SB(0, 0), b2, voffB);
            PG8_BAR; PG8_WAIT_L(0); PG8_MMA(0, 1, At, B1); PG8_BAR;
            PG8_LDA(At, 0, 1); PG8_STAGE(PG8_SA(0, 0), a2, voffA);
            PG8_BAR; PG8_WAIT_L(0); PG8_MMA(1, 0, At, B0); PG8_BAR; PG8_SCHED;
            PG8_STAGE(PG8_SB(0, 1), b2 + hstep, voffB);
            PG8_WAIT_V(6); PG8_BAR; PG8_MMA(1, 1, At, B1); PG8_BAR;
            PG8_LDB(B0, 1, 0); PG8_SCHED; PG8_LDA(At, 1, 0); PG8_STAGE(PG8_SA(0, 1), a2 + hstep, voffA);
            PG8_WAIT_L(8); PG8_BAR; PG8_WAIT_L(0); PG8_MMA(0, 0, At, B0); PG8_BAR; PG8_SCHED;
            PG8_LDB(B1, 1, 1); PG8_STAGE(PG8_SB(1, 0), b3, voffB);
            PG8_BAR; PG8_WAIT_L(0); PG8_MMA(0, 1, At, B1); PG8_BAR;
            PG8_LDA(At, 1, 1); PG8_STAGE(PG8_SA(1, 0), a3, voffA);
            PG8_BAR; PG8_WAIT_L(0); PG8_MMA(1, 0, At, B0); PG8_BAR; PG8_SCHED;
            PG8_STAGE(PG8_SB(1, 1), b3 + hstep, voffB);
            PG8_WAIT_V(6); PG8_BAR; PG8_MMA(1, 1, At, B1); PG8_BAR;
            }
        }
        if constexpr (ALIGN_EPI) { if (wr == 0) PG8_BAR; }
        if constexpr (!Epi::AFTER_DRAIN) { E(acc, cur, wr, wc, fr, fq); S.done(cur); }
        if (!has_next) break;
        if constexpr (!Epi::KEEP_ACC)
#pragma unroll
        for (int a = 0; a < 2; ++a)
#pragma unroll
            for (int b = 0; b < 2; ++b)
#pragma unroll
                for (int m = 0; m < 4; ++m)
#pragma unroll
                    for (int n = 0; n < 2; ++n) acc[a][b][m][n] = (f32x4){0.f, 0.f, 0.f, 0.f};
        cur = nxt; cA = nA; cB = nB; ++ui;
        if constexpr (ALIGN_EPI) { if (wr == 1) PG8_BAR; }
    }
    PG8_WAIT_V(0);
    if constexpr (!ALIGN_EPI) { if (wr == 0) PG8_BAR; }
    PG8_BAR;
    if constexpr (Epi::AFTER_DRAIN) { E.fused(acc, cur, wr, wc, fr, fq, lds, wid, lane); S.done(cur); }
#undef PG8_SA
#undef PG8_SB
#undef PG8_STAGE
#undef PG8_LDA
#undef PG8_LDB
#undef PG8_MMA
#undef PG8_WAIT_V
#undef PG8_WAIT_L
#undef PG8_BAR
#undef PG8_SCHED
}
}

constexpr int T = 16384, D = 1024, SEQ = 2048, DEPTH = 2, FF = 4096, PLE = 256;
constexpr float RMS_EPS = 1e-6f;
constexpr size_t MiB = 1u << 20;
constexpr size_t WS_CTL = 0, CTL_ZERO_BYTES = 65536;
constexpr size_t WS_TAB = 1 * MiB;
constexpr size_t WS_SSA = 2 * MiB, WS_SSB = 3 * MiB;
constexpr size_t WS_PROJ = 6 * MiB, BLK = 16 * MiB;
constexpr size_t WS_GATE8 = 150 * MiB;
constexpr size_t WS_XB = 198 * MiB;
constexpr size_t WS_W = 230 * MiB, WS_END = 256 * MiB;
constexpr size_t W_IN = WS_W, W_UP = WS_W, W_DOWN = WS_W + 8 * MiB, W_BR = WS_W + 16 * MiB, W_OUT = WS_W + 19 * MiB;
__host__ __device__ constexpr size_t W_G(int slot) { return WS_W + 21 * MiB + (size_t)slot * (5 * MiB / 2); }
__host__ __device__ constexpr size_t W_PLE(int slot) { return W_G(slot) + 2 * MiB; }
constexpr size_t WS_U = WS_PROJ;
constexpr size_t WS_E = WS_PROJ;
constexpr size_t DO_PB = 48 * MiB;
constexpr size_t WS_HF = WS_PROJ + 1 * BLK;
constexpr size_t WS_AGG = 4 * MiB;
constexpr size_t WS_LW = 5 * MiB;
constexpr size_t WS_SP = 5 * MiB + 512 * 1024;
constexpr size_t WS_MERGED = WS_PROJ + 1 * BLK;
constexpr size_t WS_ST = WS_XB;
constexpr int CW_TMO = 0, CW_BAR = 4096;

enum { PH_PRO = 0, PH_G1, PH_MIXA, PH_MIXB, PH_G2, PH_G3, PH_G4, PH_G5, PH_G6, PH_FIN };
constexpr int NPL = 8, NPH = 1 + DEPTH * NPL + 1;

constexpr int NWAVES = 8;
constexpr int RING_BYTES = 131072, LDS_BYTES = 155648, LDSCTL_OFF = LDS_BYTES - 1024, MISC_OFF = LDSCTL_OFF + 320;

#define GAS __attribute__((address_space(1)))
#define LAS __attribute__((address_space(3)))
typedef unsigned short bf16;
typedef unsigned v4u __attribute__((ext_vector_type(4)));
typedef unsigned v2u __attribute__((ext_vector_type(2)));
typedef float f32x4 __attribute__((ext_vector_type(4)));
typedef GAS unsigned gu32;
#define RLX_AGENT __ATOMIC_RELAXED, __HIP_MEMORY_SCOPE_AGENT
#define LDS_WAIT() asm volatile("s_waitcnt lgkmcnt(0)" ::: "memory")
#define VM_WAIT() asm volatile("s_waitcnt vmcnt(0)" ::: "memory")
__device__ __forceinline__ unsigned f2bf(float f) { unsigned u = __builtin_bit_cast(unsigned, f); return (u + 0x7fffu + ((u >> 16) & 1u)) >> 16; }
__device__ __forceinline__ unsigned pk2(float lo, float hi) { return f2bf(lo) | (f2bf(hi) << 16); }
__device__ __forceinline__ float bf2f(unsigned short b) { return __builtin_bit_cast(float, (unsigned)b << 16); }
__device__ __forceinline__ float bflo(unsigned w) { return __builtin_bit_cast(float, w << 16); }
__device__ __forceinline__ float bfhi(unsigned w) { return __builtin_bit_cast(float, w & 0xffff0000u); }
__device__ __forceinline__ float rdlane(float v, int l) { return __builtin_bit_cast(float, __builtin_amdgcn_readlane(__builtin_bit_cast(int, v), l)); }
__device__ __forceinline__ float fexp(float x) { return __builtin_amdgcn_exp2f(x * 1.4426950408889634f); }
__device__ __forceinline__ float sigmoidf_(float x) { return __builtin_amdgcn_rcpf(1.0f + fexp(-x)); }
__device__ __forceinline__ float lane_get(float v, int srclane) { return __builtin_bit_cast(float, __builtin_amdgcn_ds_bpermute(srclane << 2, __builtin_bit_cast(int, v))); }
__device__ __forceinline__ float shx(float v, int lane, int o) { return lane_get(v, lane ^ o); }
__device__ __forceinline__ float wave_sum(float v, int lane) {
#pragma unroll
    for (int o = 1; o < 64; o <<= 1) v += shx(v, lane, o);
    return v;
}
__device__ __forceinline__ float wave_max(float v, int lane) {
#pragma unroll
    for (int o = 1; o < 64; o <<= 1) v = fmaxf(v, shx(v, lane, o));
    return v;
}
__device__ __forceinline__ float log2_1m(float x) {
    const float p = x * (1.0f + x * (0.5f + x * (0.33333333f + x * (0.25f + x * (0.2f + x * (0.16666667f + x * 0.14285714f))))));
    return -p * 1.4426950408889634f;
}
__device__ __forceinline__ float log1p_small(float y) {
    if (y < 0.01f) return y * (1.0f - y * (0.5f - y * (0.33333333f - 0.25f * y)));
    return __builtin_amdgcn_logf(1.0f + y) * 0.6931471805599453f;
}
__device__ __forceinline__ float gelu_tanh(float x) {
    const float u = 0.7978845608028654f * (x + 0.044715f * x * x * x);
    const float t = 1.0f - 2.0f * __builtin_amdgcn_rcpf(1.0f + fexp(2.0f * u));
    return 0.5f * x * (1.0f + t);
}
__device__ __forceinline__ float row_rs(const float* ss, int row, int fq, int lane) {
    const f32x4 a = *(const f32x4*)(ss + (size_t)row * 16 + 4 * fq);
    float s = (a.x + a.y) + (a.z + a.w);
    s += shx(s, lane, 16); s += shx(s, lane, 32);
    return 1.0f / sqrtf(s * (1.0f / D) + RMS_EPS);
}

#define XB_TMO      128
#define XB_XCNT(j)  (256  + 64 * (j))
#define XB_XSUB(j)  (1280 + 64 * (j))
#define XB_XGEN(j)  (2304 + 64 * (j))
#define XB_TOP      3328
#define XB_TOPGEN   3392
#define XCD_BAR_WORDS 3456
#define XB_SPIN_CAP (1u << 18)

__device__ __forceinline__ unsigned xb_ld(unsigned* p)              { return __hip_atomic_load(p, __ATOMIC_RELAXED, __HIP_MEMORY_SCOPE_AGENT); }
__device__ __forceinline__ unsigned xb_add(unsigned* p, unsigned v) { return __hip_atomic_fetch_add(p, v, __ATOMIC_RELAXED, __HIP_MEMORY_SCOPE_AGENT); }
__device__ __forceinline__ unsigned xb_xcc_id() { return (unsigned)__builtin_amdgcn_s_getreg((3 << 11) | 20) & 0xFu; }
#define XB_SPIN(cond, bar) do { unsigned _sp = 0; while (cond) { __builtin_amdgcn_s_sleep(1); \
    if ((++_sp & 255u) == 0u) { if (xb_ld(&(bar)[XB_TMO])) break; if (_sp > XB_SPIN_CAP) { atomicAdd(&(bar)[XB_TMO], 1u); break; } } } } while (0)

struct XcdBarrier {
    unsigned* bar; unsigned x;
    volatile LAS unsigned* st;
};

__device__ __forceinline__ XcdBarrier xcd_barrier_post(unsigned* bar, volatile LAS unsigned* st) {
    XcdBarrier b; b.bar = bar; b.x = xb_xcc_id(); b.st = st;
    if (threadIdx.x == 0) (void)xb_add(&bar[XB_XCNT(b.x)], 1u);
    return b;
}
__device__ __forceinline__ void xcd_barrier_complete(unsigned* bar, unsigned x, unsigned& nloc, unsigned& nx) {
    const unsigned G = gridDim.x * gridDim.y * gridDim.z;
    unsigned sum, cnt, mine, sp = 0u;
    for (;;) {
        sum = 0u; cnt = 0u; mine = 0u;
#pragma unroll
        for (unsigned j = 0; j < 16; ++j) { const unsigned c = xb_ld(&bar[XB_XCNT(j)]); sum += c; cnt += (c > 0u) ? 1u : 0u; mine = (j == x) ? c : mine; }
        if (sum == G) break;
        __builtin_amdgcn_s_sleep(1);
        if ((++sp & 255u) == 0u) { if (xb_ld(&bar[XB_TMO])) break; if (sp > XB_SPIN_CAP) { atomicAdd(&bar[XB_TMO], 1u); break; } }
    }
    nloc = mine > 0u ? mine : 1u; nx = cnt > 0u ? cnt : 1u;
}

__device__ __forceinline__ void xcd_barrier(const XcdBarrier& b, const int tid_) {
    asm volatile("s_waitcnt vmcnt(0)" ::: "memory");
    __syncthreads();
    if (tid_ == 0) {
        unsigned* bar = b.bar;
        __builtin_amdgcn_s_waitcnt(0);
        unsigned nloc = b.st[0], nx = b.st[1];
        if (nloc == 0u) { xcd_barrier_complete(bar, b.x, nloc, nx); b.st[0] = nloc; b.st[1] = nx; }
        const unsigned old = xb_add(&bar[XB_XSUB(b.x)], 1u);
        const unsigned gen = old / nloc;
        if (old + 1u == (gen + 1u) * nloc) {
            __builtin_amdgcn_fence(__ATOMIC_RELEASE, "agent");
            asm volatile("s_waitcnt vmcnt(0)" ::: "memory");
            const unsigned og = xb_add(&bar[XB_TOP], 1u);
            const unsigned tg = og / nx;
            if (og + 1u == (tg + 1u) * nx) xb_add(&bar[XB_TOPGEN], 1u);
            else XB_SPIN(xb_ld(&bar[XB_TOPGEN]) == tg, bar);
            __builtin_amdgcn_fence(__ATOMIC_ACQUIRE, "agent");
            xb_add(&bar[XB_XGEN(b.x)], 1u);
            asm volatile("s_waitcnt vmcnt(0)" ::: "memory");
        } else {
            XB_SPIN(xb_ld(&bar[XB_XGEN(b.x)]) == gen, bar);
            __builtin_amdgcn_fence(__ATOMIC_ACQUIRE, "agent");
            asm volatile("s_waitcnt vmcnt(0)" ::: "memory");
        }
    }
    __syncthreads();
}


using pg8::Unit; using pg8::bf16_t; using pg8::cvt_pk_bf16;
typedef pg8::u32x4 u32x4;
struct EpiG1 {
    static constexpr bool PERM = true, AFTER_DRAIN = false, KEEP_ACC = false;
    bf16_t* proj; unsigned char* gate8; const float* ss; const float* bgate; const float* tab;
    __device__ __forceinline__ void operator()(const f32x4 (&acc)[2][2][4][2], const Unit& u, int wr, int wc, int fr, int fq) const {
        const int pn = u.pn, lane = fr + 16 * fq;
        f32x4 sp[2][4];
#pragma unroll
        for (int ai = 0; ai < 2; ++ai)
#pragma unroll
            for (int m = 0; m < 4; ++m) sp[ai][m] = *(const f32x4*)(ss + (size_t)(u.pm * 256 + ai * 128 + wr * 64 + m * 16 + fr) * 16 + 4 * fq);
        const int kind = pn >> 1, col0 = (pn & 1) * 256 + wc * 32 + 8 * fq;
        const bool rope = (pn < 18) && ((kind == 3) || (kind == 4));
        f32x4 cs[4][2], sn[4][2];
        if (rope) {
#pragma unroll
            for (int m = 0; m < 4; ++m)
#pragma unroll
                for (int bj = 0; bj < 2; ++bj) { const int row = u.pm * 256 + wr * 64 + m * 16 + fr, i0 = ((col0 + bj * 128) & 127) >> 1, pos = row & (SEQ - 1);
                    cs[m][bj] = *(const f32x4*)(tab + pos * 64 + i0); sn[m][bj] = *(const f32x4*)(tab + 131072 + pos * 64 + i0); }
        }
        float rsv[2][4];
#pragma unroll
        for (int ai = 0; ai < 2; ++ai)
#pragma unroll
            for (int m = 0; m < 4; ++m) { float t = (sp[ai][m].x + sp[ai][m].y) + (sp[ai][m].z + sp[ai][m].w); t += shx(t, lane, 16); t += shx(t, lane, 32); rsv[ai][m] = 1.0f / sqrtf(t * (1.0f / D) + RMS_EPS); }
        if (pn < 18) {
            const int phys = (int)((0x683754210ull >> (4 * kind)) & 15ull);
            bf16_t* base = proj + (size_t)phys * ((size_t)T * 512);
            const float scale = kind == 0 ? 0.125f : (kind == 3 ? 0.08838834764831845f : 1.0f);
#pragma unroll
            for (int ai = 0; ai < 2; ++ai) {
                if (rope && ai == 1) {
#pragma unroll
                    for (int m = 0; m < 4; ++m)
#pragma unroll
                        for (int bj = 0; bj < 2; ++bj) { const int row = u.pm * 256 + ai * 128 + wr * 64 + m * 16 + fr, i0 = ((col0 + bj * 128) & 127) >> 1, pos = row & (SEQ - 1);
                            cs[m][bj] = *(const f32x4*)(tab + pos * 64 + i0); sn[m][bj] = *(const f32x4*)(tab + 131072 + pos * 64 + i0); }
                }
#pragma unroll
                for (int m = 0; m < 4; ++m) {
                    const int row = u.pm * 256 + ai * 128 + wr * 64 + m * 16 + fr;
                    const float rs = rsv[ai][m] * scale;
                    bf16_t* rowp = base + (size_t)row * 512 + col0;
#pragma unroll
                    for (int bj = 0; bj < 2; ++bj) {
                        f32x4 v0 = acc[ai][bj][m][0] * rs, v1 = acc[ai][bj][m][1] * rs;
                        if (rope) {
                            const f32x4 c_ = cs[m][bj], s_ = sn[m][bj];
                            f32x4 w0, w1;
                            w0[0] = v0[0] * c_[0] - v0[1] * s_[0]; w0[1] = v0[0] * s_[0] + v0[1] * c_[0];
                            w0[2] = v0[2] * c_[1] - v0[3] * s_[1]; w0[3] = v0[2] * s_[1] + v0[3] * c_[1];
                            w1[0] = v1[0] * c_[2] - v1[1] * s_[2]; w1[1] = v1[0] * s_[2] + v1[1] * c_[2];
                            w1[2] = v1[2] * c_[3] - v1[3] * s_[3]; w1[3] = v1[2] * s_[3] + v1[3] * c_[3];
                            v0 = w0; v1 = w1;
                        }
                        u32x4 w; w.x = cvt_pk_bf16(v0[0], v0[1]); w.y = cvt_pk_bf16(v0[2], v0[3]); w.z = cvt_pk_bf16(v1[0], v1[1]); w.w = cvt_pk_bf16(v1[2], v1[3]);
                        *(u32x4*)(rowp + bj * 128) = w;
                    }
                }
            }
        } else {
            const int g0 = (pn - 18) * 256 + wc * 32 + 8 * fq;
            f32x4 bg[2][2];
#pragma unroll
            for (int bj = 0; bj < 2; ++bj) { bg[bj][0] = *(const f32x4*)(bgate + g0 + bj * 128); bg[bj][1] = *(const f32x4*)(bgate + g0 + bj * 128 + 4); }
#pragma unroll
            for (int ai = 0; ai < 2; ++ai)
#pragma unroll
                for (int m = 0; m < 4; ++m) {
                    const int row = u.pm * 256 + ai * 128 + wr * 64 + m * 16 + fr;
                    const float rs = rsv[ai][m];
#pragma unroll
                    for (int bj = 0; bj < 2; ++bj) {
                        const int gc = g0 + bj * 128;
                        const f32x4 v0 = acc[ai][bj][m][0] * rs + bg[bj][0], v1 = acc[ai][bj][m][1] * rs + bg[bj][1];
                        unsigned lo = 0, hi = 0;
#pragma unroll
                        for (int e = 0; e < 4; ++e) {
                            lo |= (unsigned)(sigmoidf_(v0[e]) * 255.0f + 0.5f) << (8 * e);
                            hi |= (unsigned)(sigmoidf_(v1[e]) * 255.0f + 0.5f) << (8 * e);
                        }
                        v2u w; w.x = lo; w.y = hi;
                        *(v2u*)(gate8 + (size_t)row * 3072 + gc) = w;
                    }
                }
        }
    }
};
struct EpiG2 {
    static constexpr bool PERM = false, AFTER_DRAIN = false, KEEP_ACC = true;
    const unsigned char* gate8; bf16_t* merged;
    __device__ __forceinline__ void operator()(f32x4 (&acc)[2][2][4][2], const Unit& u, int wr, int wc, int fr, int fq) const {
        const int col0 = u.pn * 256 + wc * 32 + 4 * fq;
        unsigned ga[2][4][2][2], gb[2][4][2][2];
#pragma unroll
        for (int ai = 0; ai < 2; ++ai)
#pragma unroll
            for (int m = 0; m < 4; ++m)
#pragma unroll
                for (int bj = 0; bj < 2; ++bj)
#pragma unroll
                    for (int n = 0; n < 2; ++n) {
                        const size_t o = (size_t)(u.pm * 256 + ai * 128 + wr * 64 + m * 16 + fr) * 3072 + col0 + bj * 128 + n * 16;
                        ga[ai][m][bj][n] = *(const unsigned*)(gate8 + o + u.z * 1024);
                        gb[ai][m][bj][n] = u.z < 2 ? *(const unsigned*)(gate8 + o + (u.z + 1) * 1024) : 0u;
                    }
#pragma unroll
        for (int ai = 0; ai < 2; ++ai)
#pragma unroll
            for (int m = 0; m < 4; ++m) {
                const int row = u.pm * 256 + ai * 128 + wr * 64 + m * 16 + fr;
#pragma unroll
                for (int bj = 0; bj < 2; ++bj)
#pragma unroll
                    for (int n = 0; n < 2; ++n) {
                        const int c = col0 + bj * 128 + n * 16;
                        const unsigned a_ = ga[ai][m][bj][n], b_ = gb[ai][m][bj][n];
                        f32x4 t = acc[ai][bj][m][n];
                        if (u.z < 2) {
#pragma unroll
                            for (int e = 0; e < 4; ++e) { const float a = (float)max((a_ >> (8 * e)) & 255u, 1u), b = (float)max((b_ >> (8 * e)) & 255u, 1u); t[e] = t[e] * a * __builtin_amdgcn_rcpf(b); }
                            acc[ai][bj][m][n] = t;
                        } else {
#pragma unroll
                            for (int e = 0; e < 4; ++e) t[e] *= (float)max((a_ >> (8 * e)) & 255u, 1u) * (1.0f / 255.0f);
                            v2u w; w.x = cvt_pk_bf16(t[0], t[1]); w.y = cvt_pk_bf16(t[2], t[3]);
                            *(v2u*)(merged + (size_t)row * 1024 + c) = w;
                            acc[ai][bj][m][n] = (f32x4){0.f, 0.f, 0.f, 0.f};
                        }
                    }
            }
    }
};
struct EpiRes {
    static constexpr bool PERM = false, AFTER_DRAIN = false, KEEP_ACC = false;
    const float* basef; const bf16_t* baseb; bf16_t* xb; float* ssout;
    __device__ __forceinline__ void operator()(const f32x4 (&acc)[2][2][4][2], const Unit& u, int wr, int wc, int fr, int fq) const {
        const int col0 = u.pn * 256 + wc * 32 + 4 * fq, lane = fr + 16 * fq;
#pragma unroll
        for (int ai = 0; ai < 2; ++ai) {
            f32x4 bv[4][2][2];
            if (basef) {
#pragma unroll
                for (int m = 0; m < 4; ++m)
#pragma unroll
                    for (int bj = 0; bj < 2; ++bj)
#pragma unroll
                        for (int n = 0; n < 2; ++n) bv[m][bj][n] = *(const f32x4*)(basef + (size_t)(u.pm * 256 + ai * 128 + wr * 64 + m * 16 + fr) * 1024 + col0 + bj * 128 + n * 16);
            } else {
                v2u bw[4][2][2];
#pragma unroll
                for (int m = 0; m < 4; ++m)
#pragma unroll
                    for (int bj = 0; bj < 2; ++bj)
#pragma unroll
                        for (int n = 0; n < 2; ++n) bw[m][bj][n] = *(const v2u*)(baseb + (size_t)(u.pm * 256 + ai * 128 + wr * 64 + m * 16 + fr) * 1024 + col0 + bj * 128 + n * 16);
#pragma unroll
                for (int m = 0; m < 4; ++m)
#pragma unroll
                    for (int bj = 0; bj < 2; ++bj)
#pragma unroll
                        for (int n = 0; n < 2; ++n) bv[m][bj][n] = (f32x4){bflo(bw[m][bj][n].x), bfhi(bw[m][bj][n].x), bflo(bw[m][bj][n].y), bfhi(bw[m][bj][n].y)};
            }
#pragma unroll
            for (int m = 0; m < 4; ++m) {
                const int row = u.pm * 256 + ai * 128 + wr * 64 + m * 16 + fr;
                float s = 0.f;
#pragma unroll
                for (int bj = 0; bj < 2; ++bj)
#pragma unroll
                    for (int n = 0; n < 2; ++n) {
                        const size_t off = (size_t)row * 1024 + col0 + bj * 128 + n * 16;
                        const f32x4 v = bv[m][bj][n] + acc[ai][bj][m][n];
                        v2u w; w.x = cvt_pk_bf16(v[0], v[1]); w.y = cvt_pk_bf16(v[2], v[3]);
                        *(v2u*)(xb + off) = w;
                        s += (v[0] * v[0] + v[1] * v[1]) + (v[2] * v[2] + v[3] * v[3]);
                    }
                s += shx(s, lane, 16); s += shx(s, lane, 32);
                if (fq == 0) ssout[(size_t)row * 16 + u.pn * 4 + wc] = s;
            }
        }
    }
};
struct EpiG4 {
    static constexpr bool PERM = true, AFTER_DRAIN = false, KEEP_ACC = false;
    bf16_t* U; const float* ss;
    __device__ __forceinline__ void operator()(const f32x4 (&acc)[2][2][4][2], const Unit& u, int wr, int wc, int fr, int fq) const {
        const int col0 = u.pn * 256 + wc * 32 + 8 * fq;
        const int lane = fr + 16 * fq;
        f32x4 sp[2][4];
#pragma unroll
        for (int ai = 0; ai < 2; ++ai)
#pragma unroll
            for (int m = 0; m < 4; ++m) sp[ai][m] = *(const f32x4*)(ss + (size_t)(u.pm * 256 + ai * 128 + wr * 64 + m * 16 + fr) * 16 + 4 * fq);
        float rsv[2][4];
#pragma unroll
        for (int ai = 0; ai < 2; ++ai)
#pragma unroll
            for (int m = 0; m < 4; ++m) { float t = (sp[ai][m].x + sp[ai][m].y) + (sp[ai][m].z + sp[ai][m].w); t += shx(t, lane, 16); t += shx(t, lane, 32); rsv[ai][m] = 1.0f / sqrtf(t * (1.0f / D) + RMS_EPS); }
#pragma unroll
        for (int ai = 0; ai < 2; ++ai)
#pragma unroll
            for (int m = 0; m < 4; ++m) {
                const int row = u.pm * 256 + ai * 128 + wr * 64 + m * 16 + fr;
                const float rs = rsv[ai][m];
                bf16_t* rowp = U + (size_t)row * FF + col0;
#pragma unroll
                for (int bj = 0; bj < 2; ++bj) {
                    f32x4 v0 = acc[ai][bj][m][0] * rs, v1 = acc[ai][bj][m][1] * rs;
#pragma unroll
                    for (int e = 0; e < 4; ++e) { const float a = fmaxf(v0[e], 0.f), b = fmaxf(v1[e], 0.f); v0[e] = a * a; v1[e] = b * b; }
                    u32x4 w; w.x = cvt_pk_bf16(v0[0], v0[1]); w.y = cvt_pk_bf16(v0[2], v0[3]); w.z = cvt_pk_bf16(v1[0], v1[1]); w.w = cvt_pk_bf16(v1[2], v1[3]);
                    *(u32x4*)(rowp + bj * 128) = w;
                }
            }
    }
};
struct EpiE {
    static constexpr bool PERM = false, AFTER_DRAIN = false, KEEP_ACC = false;
    bf16_t* E;
    __device__ __forceinline__ void operator()(const f32x4 (&acc)[2][2][4][2], const Unit& u, int wr, int wc, int fr, int fq) const {
        const int col0 = u.pn * 256 + wc * 32 + 4 * fq;
#pragma unroll
        for (int ai = 0; ai < 2; ++ai)
#pragma unroll
            for (int m = 0; m < 4; ++m) {
                const int row = u.pm * 256 + ai * 128 + wr * 64 + m * 16 + fr;
#pragma unroll
                for (int bj = 0; bj < 2; ++bj)
#pragma unroll
                    for (int n = 0; n < 2; ++n) { const f32x4 v = acc[ai][bj][m][n]; v2u w; w.x = cvt_pk_bf16(v[0], v[1]); w.y = cvt_pk_bf16(v[2], v[3]); *(v2u*)(E + (size_t)row * 1024 + col0 + bj * 128 + n * 16) = w; }
            }
    }
};
struct EpiG6 {
    static constexpr bool PERM = false, AFTER_DRAIN = false, KEEP_ACC = false;
    const bf16_t* baseb; bf16_t* xb; const float* ssin; float* ssout; const bf16_t* E;
    __device__ __forceinline__ void operator()(const f32x4 (&acc)[2][2][4][2], const Unit& u, int wr, int wc, int fr, int fq) const {
        const int col0 = u.pn * 256 + wc * 32 + 4 * fq, lane = fr + 16 * fq;
        f32x4 sp[2][4];
#pragma unroll
        for (int ai = 0; ai < 2; ++ai)
#pragma unroll
            for (int m = 0; m < 4; ++m) sp[ai][m] = *(const f32x4*)(ssin + (size_t)(u.pm * 256 + ai * 128 + wr * 64 + m * 16 + fr) * 16 + 4 * fq);
        float rsv[2][4];
#pragma unroll
        for (int ai = 0; ai < 2; ++ai)
#pragma unroll
            for (int m = 0; m < 4; ++m) { float t = (sp[ai][m].x + sp[ai][m].y) + (sp[ai][m].z + sp[ai][m].w); t += shx(t, lane, 16); t += shx(t, lane, 32); rsv[ai][m] = 1.0f / sqrtf(t * (1.0f / D) + RMS_EPS); }
        asm volatile("" : "+v"(rsv[0][0]), "+v"(rsv[0][1]), "+v"(rsv[0][2]), "+v"(rsv[0][3]), "+v"(rsv[1][0]), "+v"(rsv[1][1]), "+v"(rsv[1][2]), "+v"(rsv[1][3]) :: "memory");
#pragma unroll
        for (int ai = 0; ai < 2; ++ai)
#pragma unroll
        for (int mh = 0; mh < 2; ++mh) {
            v2u bw[2][2][2], ew[2][2][2];
#pragma unroll
            for (int m2 = 0; m2 < 2; ++m2)
#pragma unroll
                for (int bj = 0; bj < 2; ++bj)
#pragma unroll
                    for (int n = 0; n < 2; ++n) { const size_t off = (size_t)(u.pm * 256 + ai * 128 + wr * 64 + (2 * mh + m2) * 16 + fr) * 1024 + col0 + bj * 128 + n * 16;
                        bw[m2][bj][n] = *(const v2u*)(baseb + off); ew[m2][bj][n] = *(const v2u*)(E + off); }
#pragma unroll
            for (int m2 = 0; m2 < 2; ++m2) {
                const int m = 2 * mh + m2;
                const int row = u.pm * 256 + ai * 128 + wr * 64 + m * 16 + fr;
                const float rs = rsv[ai][m];
                float s = 0.f;
#pragma unroll
                for (int bj = 0; bj < 2; ++bj)
#pragma unroll
                    for (int n = 0; n < 2; ++n) {
                        const size_t off = (size_t)row * 1024 + col0 + bj * 128 + n * 16;
                        const f32x4 a = acc[ai][bj][m][n] * rs; const v2u e_ = ew[m2][bj][n], b_ = bw[m2][bj][n];
                        const f32x4 e = (f32x4){bflo(e_.x), bfhi(e_.x), bflo(e_.y), bfhi(e_.y)};
                        f32x4 v = (f32x4){bflo(b_.x), bfhi(b_.x), bflo(b_.y), bfhi(b_.y)};
#pragma unroll
                        for (int k = 0; k < 4; ++k) v[k] += sigmoidf_(a[k]) * e[k];
                        v2u w; w.x = cvt_pk_bf16(v[0], v[1]); w.y = cvt_pk_bf16(v[2], v[3]);
                        *(v2u*)(xb + off) = w;
                        s += (v[0] * v[0] + v[1] * v[1]) + (v[2] * v[2] + v[3] * v[3]);
                    }
                s += shx(s, lane, 16); s += shx(s, lane, 32);
                if (fq == 0) ssout[(size_t)row * 16 + u.pn * 4 + wc] = s;
            }
            asm volatile("" ::: "memory");
        }
    }
};
struct ZOrder {
    pg8::StaticOrder S;
    __device__ __forceinline__ bool next(int i, Unit& u) const { if (!S.next(i / 3, u)) return false; u.z = i % 3; return true; }
    __device__ __forceinline__ void a_ready(const Unit&) const {}
    __device__ __forceinline__ void done(const Unit&) const {}
};

struct Args { const float* in[23]; float* out; unsigned char* ws; int ph_lo, ph_hi; };
typedef const __attribute__((address_space(4))) Args CArgs;
__device__ __forceinline__ CArgs* get_args() {
    CArgs* p = (CArgs*)__builtin_amdgcn_kernarg_segment_ptr();
    asm volatile("" : "+s"(p));
    return p;
}
struct Frame {
    LAS unsigned char* lds;
    int wave0, G, ngw, bid;
    float* out; unsigned char* ws;
    __device__ __forceinline__ int ltid() const { int t = wave0 * 64 + (int)__builtin_amdgcn_mbcnt_hi(~0u, __builtin_amdgcn_mbcnt_lo(~0u, 0u)); asm volatile("" : "+v"(t)); return t; }
    __device__ __forceinline__ int lane() const { return ltid() & 63; }
    __device__ __forceinline__ int wave() const { int w_ = wave0; asm volatile("" : "+s"(w_)); return w_; }
    __device__ __forceinline__ int gw() const { return bid * NWAVES + wave(); }
};

__device__ __forceinline__ void transpose_item(const float* W, const float* g, int K, int N, bf16* WT, LAS float* scr, int item, int lane) {
    const int nblk = N / 32, kb = item / nblk, nb = item % nblk, k0 = 64 * kb, n0 = 32 * nb;
#pragma unroll
    for (int i = 0; i < 32; ++i) { const int kk = 2 * i + (lane >> 5); float v = W[(size_t)(k0 + kk) * N + n0 + (lane & 31)]; if (g) v *= g[k0 + kk]; scr[kk * 33 + (lane & 31)] = v; }
    LDS_WAIT(); asm volatile("" ::: "memory");
    const int c = lane & 7;
#pragma unroll
    for (int j = 0; j < 4; ++j) { const int n = (lane >> 3) + 8 * j; const LAS float* s = scr + (8 * c) * 33 + n;
        v4u o; o.x = pk2(s[0 * 33], s[1 * 33]); o.y = pk2(s[2 * 33], s[3 * 33]); o.z = pk2(s[4 * 33], s[5 * 33]); o.w = pk2(s[6 * 33], s[7 * 33]);
        *(v4u*)(WT + (size_t)(n0 + n) * K + k0 + 8 * c) = o; }
    LDS_WAIT(); asm volatile("" ::: "memory");
}
__device__ __forceinline__ void convert_matrix(const Frame& F, const float* W, const float* g, int K, int N, bf16* WT) {
    LAS float* scr = (LAS float*)(F.lds + F.wave() * 16384);
    const int nitems = (K / 64) * (N / 32);
    for (int it = F.gw(); it < nitems; it += F.ngw) transpose_item(W, g, K, N, WT, scr, it, F.lane());
}
__device__ __forceinline__ void convert_list(const Frame& F, CArgs* A, int l, bool early, bool mid) {
    LAS float* scr = (LAS float*)(F.lds + F.wave() * 16384);
    constexpr int I_IN = (D / 64) * (7680 / 32), I_BR = (512 / 64) * (D / 32), I_SQ = (D / 64) * (D / 32), I_PLE = (PLE / 64) * (D / 32);
    const int n_early = early ? I_IN : 0, n_mid = mid ? 3 * I_BR + 2 * I_SQ + I_PLE : 0, lane = F.lane();
    for (int it = F.gw(); it < n_early + n_mid; it += F.ngw) {
        int r = it;
        if (r < n_early) { transpose_item(A->in[3] + (size_t)l * D * 7680, A->in[2] + l * D, D, 7680, (bf16*)(F.ws + W_IN), scr, r, lane); continue; } r -= n_early;
        if (r < 3 * I_BR) { const int n = r / I_BR; transpose_item(A->in[14] + ((size_t)l * 3 + n) * 512 * D, nullptr, 512, D, (bf16*)(F.ws + W_BR) + (size_t)n * D * 512, scr, r - n * I_BR, lane); continue; } r -= 3 * I_BR;
        if (r < I_SQ) { transpose_item(A->in[15] + (size_t)l * D * D, nullptr, D, D, (bf16*)(F.ws + W_OUT), scr, r, lane); continue; } r -= I_SQ;
        if (r < I_SQ) { transpose_item(A->in[20] + (size_t)l * D * D, A->in[19] + l * D, D, D, (bf16*)(F.ws + W_G(l & 1)), scr, r, lane); continue; } r -= I_SQ;
        transpose_item(A->in[21] + (size_t)l * PLE * D, nullptr, PLE, D, (bf16*)(F.ws + W_PLE(l & 1)), scr, r, lane);
    }
}
__device__ __forceinline__ void convert_layer_early(const Frame& F, CArgs* A, int l) { convert_list(F, A, l, true, false); }
__device__ __forceinline__ void convert_layer_mid(const Frame& F, CArgs* A, int l) { convert_list(F, A, l, false, true); }
__device__ __forceinline__ void convert_layer_mlp(const Frame& F, CArgs* A, int l) {
    LAS float* scr = (LAS float*)(F.lds + F.wave() * 16384);
    constexpr int I_UP = (D / 64) * (FF / 32); const int lane = F.lane();
    for (int it = F.gw(); it < 2 * I_UP; it += F.ngw) {
        if (it < I_UP) transpose_item(A->in[17] + (size_t)l * D * FF, A->in[16] + l * D, D, FF, (bf16*)(F.ws + W_UP), scr, it, lane);
        else transpose_item(A->in[18] + (size_t)l * FF * D, nullptr, FF, D, (bf16*)(F.ws + W_DOWN), scr, it - I_UP, lane);
    }
}

__device__ __forceinline__ void phase_prologue(const Frame& F, CArgs* A) {
    convert_list(F, A, 0, true, true);
    const float* x = A->in[0]; bf16* xb = (bf16*)(F.ws + WS_XB); float* ss = (float*)(F.ws + WS_SSB);
    { const int lane = F.lane();
      for (int m0 = F.gw() * 4; m0 < T; m0 += F.ngw * 4) {
        f32x4 v[4][4];
#pragma unroll
        for (int r = 0; r < 4; ++r)
#pragma unroll
            for (int j = 0; j < 4; ++j) v[r][j] = ((const f32x4*)(x + (size_t)(m0 + r) * D) + lane)[64 * j];
#pragma unroll
        for (int r = 0; r < 4; ++r) {
            v2u* o = (v2u*)(xb + (size_t)(m0 + r) * D) + lane;
            float s = 0.f;
#pragma unroll
            for (int j = 0; j < 4; ++j) { const f32x4 t = v[r][j]; s += (t.x * t.x + t.y * t.y) + (t.z * t.z + t.w * t.w); v2u w; w.x = pk2(t.x, t.y); w.y = pk2(t.z, t.w); o[64 * j] = w; }
            s = wave_sum(s, lane);
            if (lane < 16) ss[(size_t)(m0 + r) * 16 + lane] = lane == 0 ? s : 0.f;
        }
      } }
    { bf16* lw = (bf16*)(F.ws + WS_LW);
      for (int e = F.gw() * 64 + F.lane(); e < DEPTH * 2 * 2 * 8 * 4096; e += F.ngw * 64) {
          const int mat = e >> 12, j = (e >> 6) & 63, i = e & 63, blk = mat & 7, ax = (mat >> 3) & 1, ld = mat >> 4;
          const float* src = (ax ? A->in[11] : A->in[9]) + ((size_t)ld * 8 + blk) * 4096;
          lw[e] = (bf16)f2bf(src[i * 64 + j]); }
      float* sp = (float*)(F.ws + WS_SP);
      for (int e = F.gw() * 64 + F.lane(); e < DEPTH * 2 * 512; e += F.ngw * 64) sp[e] = log1p_small(fexp(-A->in[13][e])); }
    float* tab = (float*)(F.ws + WS_TAB);
    for (int e = F.gw() * 64 + F.lane(); e < SEQ * 64; e += F.ngw * 64) {
        const int pos = e >> 6, i = e & 63;
        const float theta = __builtin_amdgcn_exp2f(-(float)i * (13.287712379549449f / 63.0f));
        double rev = (double)pos * (double)theta * 0.15915494309189535; rev -= __builtin_floor(rev);
        const float fr = (float)rev;
        tab[e] = __builtin_amdgcn_cosf(fr); tab[131072 + e] = __builtin_amdgcn_sinf(fr);
    }
}


typedef short bf16x8_t __attribute__((ext_vector_type(8)));
typedef float f32x2_t __attribute__((ext_vector_type(2))); typedef __bf16 bf16x2_t __attribute__((ext_vector_type(2)));
__device__ __forceinline__ unsigned pkbf(float lo, float hi) { f32x2_t v = {lo, hi}; bf16x2_t b = __builtin_convertvector(v, bf16x2_t); return __builtin_bit_cast(unsigned, b); }
typedef short v4i16_t __attribute__((ext_vector_type(4)));
__device__ __forceinline__ v4i16_t ds_tr16(LAS const unsigned char* p) { return __builtin_amdgcn_ds_read_tr16_b64_v4i16((LAS v4i16_t*)p); }
__device__ __forceinline__ bf16x8_t tr_frag(LAS const unsigned char* p0, LAS const unsigned char* p1) {
    const v4i16_t a = ds_tr16(p0), b = ds_tr16(p1);
    return (bf16x8_t){a[0], a[1], a[2], a[3], b[0], b[1], b[2], b[3]};
}
#define MFMA16(a, b, c) __builtin_amdgcn_mfma_f32_16x16x32_bf16((a), (b), (c), 0, 0, 0)
constexpr int RP = 272;
__device__ __forceinline__ void ret_scan_item(const Frame& F, int item) {
    const int bh = item >> 3, dir = (item >> 2) & 1, dvq = item & 3, b = bh >> 2, h = bh & 3;
    const bf16* Kg = (const bf16*)(F.ws + WS_PROJ + 5 * BLK); const bf16* Vg = (const bf16*)(F.ws + WS_PROJ + 7 * BLK);
    bf16* ST = (bf16*)F.out;
    const float lg = log2_1m(__builtin_amdgcn_exp2f((dir ? -5.5f : -5.0f) - (float)h));
    const float cdec = __builtin_amdgcn_exp2f(128.0f * lg);
    constexpr int VP = 80, BUF = 128 * RP + 128 * VP;
    const int tid = F.ltid(), lane = F.lane(), w = F.wave(), g = lane >> 4, i = lane & 15, q4 = i >> 2, p4 = i & 3;
    v4u kr0[4], kr1[4], vr0, vr1;
    const int vrow = tid >> 2, vch = tid & 3;
#define RS_LOAD(kr, vr, c_) do { const size_t tb = (size_t)b * SEQ + (c_) * 128; \
        _Pragma("unroll") for (int q = 0; q < 4; ++q) { const int idx = tid + 512 * q; kr[q] = *(const v4u*)(Kg + (tb + (idx >> 4)) * 512 + h * 128 + (idx & 15) * 8); } \
        vr = *(const v4u*)(Vg + (tb + vrow) * 512 + h * 128 + dvq * 32 + vch * 8); } while (0)
#define RS_WRITE(kr, vr, buf_) do { LAS unsigned char* Kb_ = F.lds + (buf_) * BUF; LAS unsigned char* Vb_ = Kb_ + 128 * RP; \
        _Pragma("unroll") for (int q = 0; q < 4; ++q) { const int idx = tid + 512 * q, row = idx >> 4; \
            const float dk_ = __builtin_amdgcn_exp2f((float)(dir ? row : 127 - row) * lg); v4u o; \
            _Pragma("unroll") for (int e = 0; e < 4; ++e) o[e] = pkbf(bflo(kr[q][e]) * dk_, bfhi(kr[q][e]) * dk_); \
            *(LAS v4u*)(Kb_ + row * RP + (idx & 15) * 16) = o; } \
        *(LAS v4u*)(Vb_ + vrow * VP + vch * 16) = vr; } while (0)
#define RS_CHUNK(s_) (dir ? 15 - (s_) : (s_))
#define RS_STEP(s_, krN, vrN, krW, vrW) do { const int c = RS_CHUNK(s_), buf = (s_) & 1; \
        if ((s_) + 2 < 16) RS_LOAD(krN, vrN, RS_CHUNK((s_) + 2)); \
        bf16* dst = ST + ((size_t)(bh * 2 + dir) * 16 + c) * 16384; \
        _Pragma("unroll") for (int n = 0; n < 2; ++n) { v2u o; o.x = pkbf(acc[n][0], acc[n][1]); o.y = pkbf(acc[n][2], acc[n][3]); *(v2u*)(dst + (32 * dvq + 16 * n + i) * 128 + 16 * w + 4 * g) = o; } \
        acc[0] = acc[0] * cdec; acc[1] = acc[1] * cdec; \
        const LAS unsigned char* Kb = F.lds + buf * BUF; const LAS unsigned char* Vb = Kb + 128 * RP; \
        _Pragma("unroll") for (int ks = 0; ks < 4; ++ks) { const int r0 = 32 * ks + 8 * g + q4; \
            const bf16x8_t af = tr_frag(Kb + r0 * RP + (16 * w + 4 * p4) * 2, Kb + (r0 + 4) * RP + (16 * w + 4 * p4) * 2); \
            _Pragma("unroll") for (int n = 0; n < 2; ++n) { const bf16x8_t bv = tr_frag(Vb + r0 * VP + (16 * n + 4 * p4) * 2, Vb + (r0 + 4) * VP + (16 * n + 4 * p4) * 2); acc[n] = MFMA16(af, bv, acc[n]); } } \
        if ((s_) + 1 < 16) RS_WRITE(krW, vrW, buf ^ 1); \
        __syncthreads(); } while (0)
    __syncthreads();
    RS_LOAD(kr0, vr0, RS_CHUNK(0));
    RS_LOAD(kr1, vr1, RS_CHUNK(1));
    RS_WRITE(kr0, vr0, 0);
    __syncthreads();
    f32x4 acc[2]; acc[0] = (f32x4){0.f, 0.f, 0.f, 0.f}; acc[1] = acc[0];
    for (int s2 = 0; s2 < 16; s2 += 2) {
        RS_STEP(s2, kr0, vr0, kr1, vr1);
        RS_STEP(s2 + 1, kr1, vr1, kr0, vr0);
    }
#undef RS_STEP
#undef RS_CHUNK
#undef RS_LOAD
#undef RS_WRITE
}
__device__ __forceinline__ void ret_out_item(const Frame& F, const float* gn, int item) {
    const int bh = item >> 4, ci = item & 15, b = bh >> 2, h = bh & 3, t0 = b * SEQ + ci * 128;
    bf16* Gg = (bf16*)(F.ws + WS_PROJ + 3 * BLK); const bf16* Qg = (const bf16*)(F.ws + WS_PROJ + 4 * BLK);
    const bf16* Kg = (const bf16*)(F.ws + WS_PROJ + 5 * BLK); const bf16* Vg = (const bf16*)(F.ws + WS_PROJ + 7 * BLK);
    const bf16* ST = (const bf16*)F.out;
    const float lgf = log2_1m(__builtin_amdgcn_exp2f(-5.0f - (float)h)), lgb = log2_1m(__builtin_amdgcn_exp2f(-5.5f - (float)h));
    LAS unsigned char* Kl = F.lds; LAS unsigned char* Vl = F.lds + 128 * RP; LAS unsigned char* Sf = F.lds + 2 * 128 * RP; LAS unsigned char* Sb = F.lds + 3 * 128 * RP;
    const int lane = F.lane(), w = F.wave(), g = lane >> 4, i = lane & 15, q4 = i >> 2, p4 = i & 3;
    const int nl = 16 * w + i;
    bf16* grow = Gg + (size_t)(t0 + nl) * 512 + h * 128;
    bf16x8_t bq[4]; v2u ggv[8];
#pragma unroll
    for (int ks = 0; ks < 4; ++ks) bq[ks] = *(const bf16x8_t*)(Qg + (size_t)(t0 + nl) * 512 + h * 128 + 32 * ks + 8 * g);
#pragma unroll
    for (int n = 0; n < 8; ++n) ggv[n] = *(const v2u*)(grow + 16 * n + 4 * g);
    __syncthreads();
    {
#pragma unroll
        for (int q = 0; q < 4; ++q) {
            const int idx = F.ltid() + 512 * q, row = idx >> 4, ch = idx & 15;
            *(LAS v4u*)(Kl + row * RP + ch * 16) = *(const v4u*)(Kg + (size_t)(t0 + row) * 512 + h * 128 + ch * 8);
            *(LAS v4u*)(Vl + row * RP + ch * 16) = *(const v4u*)(Vg + (size_t)(t0 + row) * 512 + h * 128 + ch * 8);
        }
        const bf16* sfp = ST + ((size_t)(bh * 2 + 0) * 16 + ci) * 16384; const bf16* sbp = ST + ((size_t)(bh * 2 + 1) * 16 + ci) * 16384;
#pragma unroll
        for (int q = 0; q < 4; ++q) {
            const int idx = F.ltid() + 512 * q, row = idx >> 4, ch = idx & 15;
            *(LAS v4u*)(Sf + row * RP + ch * 16) = *(const v4u*)(sfp + idx * 8);
            *(LAS v4u*)(Sb + row * RP + ch * 16) = *(const v4u*)(sbp + idx * 8);
        }
    }
    __syncthreads();
    bf16x8_t bp[4];
#pragma unroll
    for (int kp = 0; kp < 4; ++kp) {
        f32x4 s0 = (f32x4){0.f, 0.f, 0.f, 0.f}, s1 = s0;
#pragma unroll
        for (int ks = 0; ks < 4; ++ks) {
            const bf16x8_t a0 = *(const LAS bf16x8_t*)(Kl + (32 * kp + i) * RP + (32 * ks + 8 * g) * 2);
            const bf16x8_t a1 = *(const LAS bf16x8_t*)(Kl + (32 * kp + 16 + i) * RP + (32 * ks + 8 * g) * 2);
            s0 = MFMA16(a0, bq[ks], s0); s1 = MFMA16(a1, bq[ks], s1);
        }
        float pv[8];
#pragma unroll
        for (int e = 0; e < 4; ++e) {
            const int m0 = 32 * kp + 4 * g + e, m1 = m0 + 16;
            const float d0 = (float)(nl - m0), d1 = (float)(nl - m1);
            pv[e] = s0[e] * (d0 >= 0.f ? __builtin_amdgcn_exp2f(d0 * lgf) : __builtin_amdgcn_exp2f(-d0 * lgb));
            pv[4 + e] = s1[e] * (d1 >= 0.f ? __builtin_amdgcn_exp2f(d1 * lgf) : __builtin_amdgcn_exp2f(-d1 * lgb));
        }
        v4u pk; pk.x = pkbf(pv[0], pv[1]); pk.y = pkbf(pv[2], pv[3]); pk.z = pkbf(pv[4], pv[5]); pk.w = pkbf(pv[6], pv[7]);
        bp[kp] = __builtin_bit_cast(bf16x8_t, pk);
    }
    f32x4 oi[8], of[8], ob[8];
#pragma unroll
    for (int n = 0; n < 8; ++n) { oi[n] = (f32x4){0.f, 0.f, 0.f, 0.f}; of[n] = oi[n]; ob[n] = oi[n]; }
#pragma unroll
    for (int kp = 0; kp < 4; ++kp) {
        const int r0 = (32 * kp + 4 * g + q4) * RP, r1 = r0 + 16 * RP;
#pragma unroll
        for (int n = 0; n < 8; ++n) { const bf16x8_t av = tr_frag(Vl + r0 + (16 * n + 4 * p4) * 2, Vl + r1 + (16 * n + 4 * p4) * 2); oi[n] = MFMA16(av, bp[kp], oi[n]); }
    }
#pragma unroll
    for (int ks = 0; ks < 4; ++ks)
#pragma unroll
        for (int n = 0; n < 8; ++n) {
            const bf16x8_t af = *(const LAS bf16x8_t*)(Sf + (16 * n + i) * RP + (32 * ks + 8 * g) * 2);
            const bf16x8_t ab = *(const LAS bf16x8_t*)(Sb + (16 * n + i) * RP + (32 * ks + 8 * g) * 2);
            of[n] = MFMA16(af, bq[ks], of[n]); ob[n] = MFMA16(ab, bq[ks], ob[n]);
        }
    const float qdf = __builtin_amdgcn_exp2f((float)(nl + 1) * lgf), qdb = __builtin_amdgcn_exp2f((float)(128 - nl) * lgb);
    float ss = 0.f;
#pragma unroll
    for (int n = 0; n < 8; ++n) { oi[n] = oi[n] + of[n] * qdf + ob[n] * qdb; ss += (oi[n][0] * oi[n][0] + oi[n][1] * oi[n][1]) + (oi[n][2] * oi[n][2] + oi[n][3] * oi[n][3]); }
    ss += shx(ss, lane, 16); ss += shx(ss, lane, 32);
    const float rn = 1.0f / sqrtf(ss * (1.0f / 128.0f) + RMS_EPS);
#pragma unroll
    for (int n = 0; n < 8; ++n) {
        const int dv0 = 16 * n + 4 * g;
        const v2u gg = ggv[n]; const f32x4 gw = *(const f32x4*)(gn + h * 128 + dv0);
        const float g0 = bflo(gg.x), g1 = bfhi(gg.x), g2 = bflo(gg.y), g3 = bfhi(gg.y);
        v2u o; o.x = pkbf(g0 * sigmoidf_(g0) * oi[n][0] * rn * gw[0], g1 * sigmoidf_(g1) * oi[n][1] * rn * gw[1]);
        o.y = pkbf(g2 * sigmoidf_(g2) * oi[n][2] * rn * gw[2], g3 * sigmoidf_(g3) * oi[n][3] * rn * gw[3]);
        *(v2u*)(grow + dv0) = o;
    }
}

constexpr int LO_WL = 0, LO_CST = 36864, LO_XC = 39680, LO_XF = 58688, LO_XB = 93504, LO_GY = 111936, LO_SEG = 130368, LO_HIN = 138560;
__device__ __forceinline__ void lru_stage_consts(const Frame& F, CArgs* A, int l, int blk) {
    const bf16* LW = (const bf16*)(F.ws + WS_LW); const float* SP = (const float*)(F.ws + WS_SP);
    __syncthreads();
#pragma unroll
    for (int q = 0; q < 4; ++q) { const int idx = F.ltid() + 512 * q, m = idx >> 9, row = (idx >> 3) & 63, ch = idx & 7;
        const int d = m >> 1, ax = m & 1;
        *(LAS v4u*)(F.lds + LO_WL + (m * 64 + row) * 144 + ch * 16) = *(const v4u*)(LW + (size_t)((((l * 2 + d) * 2 + ax) * 8 + blk)) * 4096 + row * 64 + ch * 8); }
    LAS float* cst = (LAS float*)(F.lds + LO_CST);
    if (F.ltid() < 128) { const int d = F.ltid() >> 6, j = F.ltid() & 63, pi = (l * 2 + d) * 512 + blk * 64 + j; cst[F.ltid()] = A->in[10][pi]; cst[128 + F.ltid()] = A->in[12][pi]; cst[256 + F.ltid()] = SP[pi]; }
    else if (F.ltid() < 384) { const int e = F.ltid() - 128, tap = e >> 6, j = e & 63; cst[384 + e] = A->in[7][(size_t)l * 2048 + tap * 512 + blk * 64 + j]; }
    else if (F.ltid() < 448) { const int j = F.ltid() - 384; cst[640 + j] = A->in[8][(size_t)l * 512 + blk * 64 + j]; }
}
struct LruPre { v4u xc[3]; v4u gc[2]; float agx[15], agy[15]; };
template <int MODE>
__device__ __forceinline__ void lru_fetch(const Frame& F, int item, LruPre& P) {
    const int b = item >> 7, c = (item >> 3) & 15, blk = item & 7, t0 = b * SEQ + c * 128, s0 = c * 128, tid = F.ltid();
    const bf16* XCg = (const bf16*)(F.ws + WS_PROJ + 8 * BLK); const bf16* GCg = (const bf16*)(F.ws + WS_PROJ + 6 * BLK); const float* AGG = (const float*)(F.ws + WS_AGG);
#pragma unroll
    for (int q = 0; q < 3; ++q) {
        const int idx = tid + 512 * q, row = idx >> 3, ch = idx & 7, s_ = s0 - 2 + row;
        P.xc[q] = (v4u){0u, 0u, 0u, 0u};
        if (idx < 1056 && s_ >= 0 && s_ < SEQ) P.xc[q] = *(const v4u*)(XCg + (size_t)(b * SEQ + s_) * 512 + blk * 64 + ch * 8);
    }
    if (MODE == 1) {
#pragma unroll
        for (int q = 0; q < 2; ++q) { const int idx = tid + 512 * q, row = idx >> 3, ch = idx & 7; P.gc[q] = *(const v4u*)(GCg + (size_t)(t0 + row) * 512 + blk * 64 + ch * 8); }
        if (tid < 128) {
            typedef float f2 __attribute__((ext_vector_type(2)));
            const int d = tid >> 6, ch = blk * 64 + (tid & 63);
#pragma unroll
            for (int k = 0; k < 15; ++k) { const int cc = d ? 15 - k : k; const f2 a = *(const f2*)(AGG + ((size_t)((b * 16 + cc) * 2 + d) * 512 + ch) * 2); P.agx[k] = a.x; P.agy[k] = a.y; }
        }
    }
}
template <int MODE>
__device__ __forceinline__ void lru_item(const Frame& F, int item, const LruPre& P) {
    const int b = item >> 7, c = (item >> 3) & 15, blk = item & 7, t0 = b * SEQ + c * 128;
    bf16* GCg = (bf16*)(F.ws + WS_PROJ + 6 * BLK);
    float* AGG = (float*)(F.ws + WS_AGG);
    LAS unsigned char* WL = F.lds + LO_WL; const LAS float* cst = (const LAS float*)(F.lds + LO_CST);
    LAS unsigned char* XC = F.lds + LO_XC; LAS float* XF = (LAS float*)(F.lds + LO_XF); LAS unsigned char* XB = F.lds + LO_XB; LAS unsigned char* GY = F.lds + LO_GY;
    LAS float* SEG = (LAS float*)(F.lds + LO_SEG); LAS float* HIN = (LAS float*)(F.lds + LO_HIN);
    typedef float f2 __attribute__((ext_vector_type(2)));
    const int tid = F.ltid(), lane = F.lane(), w = F.wave(), g = lane >> 4, i = lane & 15;
    __syncthreads();
#pragma unroll
    for (int q = 0; q < 3; ++q) { const int idx = tid + 512 * q; if (idx < 1056) *(LAS v4u*)(XC + (idx >> 3) * 144 + (idx & 7) * 16) = P.xc[q]; }
    if (MODE == 1) {
#pragma unroll
        for (int q = 0; q < 2; ++q) { const int idx = tid + 512 * q; *(LAS v4u*)(GY + (idx >> 3) * 144 + (idx & 7) * 16) = P.gc[q]; }
        if (tid < 128) {
            const int d = tid >> 6;
            float h = 0.f;
#pragma unroll
            for (int k = 0; k < 15; ++k) { const int cc = d ? 15 - k : k; const bool valid = d ? (cc > c) : (cc < c); h = valid ? P.agx[k] * h + P.agy[k] : h; }
            HIN[tid] = h;
        }
    }
    __syncthreads();
#pragma unroll
    for (int q = 0; q < 2; ++q) {
        const int idx = tid + 512 * q, t = idx >> 3, c8 = idx & 7;
        float xf[8];
        { const f32x4 b0 = *(const LAS f32x4*)(cst + 640 + c8 * 8), b1 = *(const LAS f32x4*)(cst + 640 + c8 * 8 + 4); xf[0] = b0[0]; xf[1] = b0[1]; xf[2] = b0[2]; xf[3] = b0[3]; xf[4] = b1[0]; xf[5] = b1[1]; xf[6] = b1[2]; xf[7] = b1[3]; }
#pragma unroll
        for (int tap = 0; tap < 4; ++tap) {
            const v4u x = *(const LAS v4u*)(XC + (t + tap) * 144 + c8 * 16);
            const f32x4 w0 = *(const LAS f32x4*)(cst + 384 + tap * 64 + c8 * 8), w1 = *(const LAS f32x4*)(cst + 384 + tap * 64 + c8 * 8 + 4);
            xf[0] += w0[0] * bflo(x[0]); xf[1] += w0[1] * bfhi(x[0]); xf[2] += w0[2] * bflo(x[1]); xf[3] += w0[3] * bfhi(x[1]);
            xf[4] += w1[0] * bflo(x[2]); xf[5] += w1[1] * bfhi(x[2]); xf[6] += w1[2] * bflo(x[3]); xf[7] += w1[3] * bfhi(x[3]);
        }
        *(LAS f32x4*)(XF + t * 68 + c8 * 8) = (f32x4){xf[0], xf[1], xf[2], xf[3]}; *(LAS f32x4*)(XF + t * 68 + c8 * 8 + 4) = (f32x4){xf[4], xf[5], xf[6], xf[7]};
        v4u o; o.x = pkbf(xf[0], xf[1]); o.y = pkbf(xf[2], xf[3]); o.z = pkbf(xf[4], xf[5]); o.w = pkbf(xf[6], xf[7]);
        *(LAS v4u*)(XB + t * 144 + c8 * 16) = o;
    }
    __syncthreads();
    float av[2][4][4], bv[2][4][4];
    {
        const bf16x8_t a0 = *(const LAS bf16x8_t*)(XB + (16 * w + i) * 144 + (8 * g) * 2), a1 = *(const LAS bf16x8_t*)(XB + (16 * w + i) * 144 + (32 + 8 * g) * 2);
#pragma unroll
        for (int d = 0; d < 2; ++d) {
#pragma unroll
            for (int jt = 0; jt < 4; ++jt) {
                const LAS unsigned char* wa = WL + ((d * 2 + 0) * 64 + 16 * jt + i) * 144 + (8 * g) * 2; const LAS unsigned char* wx = WL + ((d * 2 + 1) * 64 + 16 * jt + i) * 144 + (8 * g) * 2;
                const f32x4 z = (f32x4){0.f, 0.f, 0.f, 0.f};
                f32x4 ca = MFMA16(a0, *(const LAS bf16x8_t*)wa, z); ca = MFMA16(a1, *(const LAS bf16x8_t*)(wa + 64), ca);
                f32x4 cx = MFMA16(a0, *(const LAS bf16x8_t*)wx, z); cx = MFMA16(a1, *(const LAS bf16x8_t*)(wx + 64), cx);
                const int j = 16 * jt + i;
                const float ba = cst[d * 64 + j], bx = cst[128 + d * 64 + j], sp = cst[256 + d * 64 + j];
#pragma unroll
                for (int r = 0; r < 4; ++r) {
                    const int t = 16 * w + 4 * g + r;
                    const float xfv = XF[t * 68 + j];
                    const float rr = sigmoidf_(ca[r] + ba), ig = sigmoidf_(cx[r] + bx);
                    const float la = -8.0f * rr * sp, a = fexp(la), x2 = 2.0f * la;
                    const float omp = -x2 * (1.0f + x2 * (0.5f + x2 * (0.16666667f + x2 * (0.041666668f + x2 * (0.0083333333f + x2 * 0.0013888889f))))), omq = 1.0f - a * a, selp = x2 > -0.5f ? 1.0f : 0.0f;
                    const float om = selp * omp + (1.0f - selp) * omq;
                    float mult = __builtin_amdgcn_sqrtf(om);
                    if (d == 0 ? (c == 0 && t == 0) : (c == 15 && t == 127)) mult = 1.0f;
                    av[d][jt][r] = a; bv[d][jt][r] = mult * ig * xfv;
                }
            }
        }
    }
    float Ae[2][4], Be[2][4];
#pragma unroll
    for (int jt = 0; jt < 4; ++jt) {
        float Af = av[0][jt][0] * av[0][jt][1] * av[0][jt][2] * av[0][jt][3];
        float Bf = ((bv[0][jt][0] * av[0][jt][1] + bv[0][jt][1]) * av[0][jt][2] + bv[0][jt][2]) * av[0][jt][3] + bv[0][jt][3];
        float Ar = av[1][jt][0] * av[1][jt][1] * av[1][jt][2] * av[1][jt][3];
        float Br = ((bv[1][jt][3] * av[1][jt][2] + bv[1][jt][2]) * av[1][jt][1] + bv[1][jt][1]) * av[1][jt][0] + bv[1][jt][0];
#pragma unroll
        for (int st = 16; st <= 32; st <<= 1) {
            const float pAf = lane_get(Af, lane - st), pBf = lane_get(Bf, lane - st), pAr = lane_get(Ar, lane + st), pBr = lane_get(Br, lane + st);
            if (lane >= st) { Bf = Af * pBf + Bf; Af = Af * pAf; }
            if (lane + st < 64) { Br = Ar * pBr + Br; Ar = Ar * pAr; }
        }
        const float eAf = lane_get(Af, lane - 16), eBf = lane_get(Bf, lane - 16), eAr = lane_get(Ar, lane + 16), eBr = lane_get(Br, lane + 16);
        Ae[0][jt] = g > 0 ? eAf : 1.0f; Be[0][jt] = g > 0 ? eBf : 0.0f; Ae[1][jt] = g < 3 ? eAr : 1.0f; Be[1][jt] = g < 3 ? eBr : 0.0f;
        if (g == 3) *(LAS f2*)(SEG + ((0 * 8 + w) * 64 + 16 * jt + i) * 2) = (f2){Af, Bf};
        if (g == 0) *(LAS f2*)(SEG + ((1 * 8 + w) * 64 + 16 * jt + i) * 2) = (f2){Ar, Br};
    }
    __syncthreads();
    if (MODE == 0) {
        if (w == 0 && g < 2) {
            const int d = g;
#pragma unroll
            for (int jt = 0; jt < 4; ++jt) {
                const int j = 16 * jt + i; float h = 0.f, Ap = 1.0f;
#pragma unroll
                for (int k = 0; k < 8; ++k) { const int ww = d ? 7 - k : k; const f2 sg = *(const LAS f2*)(SEG + ((d * 8 + ww) * 64 + j) * 2); h = sg.x * h + sg.y; Ap *= sg.x; }
                *(f2*)(AGG + ((size_t)((b * 16 + c) * 2 + d) * 512 + blk * 64 + j) * 2) = (f2){Ap, h};
            }
        }
    } else {
#pragma unroll
        for (int jt = 0; jt < 4; ++jt) {
            const int j = 16 * jt + i;
            float hf = HIN[j], hr = HIN[64 + j];
            f2 sfv[8], srv[8];
#pragma unroll
            for (int k = 0; k < 8; ++k) { sfv[k] = *(const LAS f2*)(SEG + ((0 * 8 + k) * 64 + j) * 2); srv[k] = *(const LAS f2*)(SEG + ((1 * 8 + (7 - k)) * 64 + j) * 2); }
#pragma unroll
            for (int k = 0; k < 8; ++k) {
                const bool uf = k < w, ur = 7 - k > w;
                hf = (uf ? sfv[k].x : 1.0f) * hf + (uf ? sfv[k].y : 0.0f);
                hr = (ur ? srv[k].x : 1.0f) * hr + (ur ? srv[k].y : 0.0f);
            }
            float h = Ae[0][jt] * hf + Be[0][jt];
            float hs[4];
#pragma unroll
            for (int r = 0; r < 4; ++r) { h = av[0][jt][r] * h + bv[0][jt][r]; hs[r] = h; }
            h = Ae[1][jt] * hr + Be[1][jt];
#pragma unroll
            for (int r = 3; r >= 0; --r) { h = av[1][jt][r] * h + bv[1][jt][r]; hs[r] += h; }
#pragma unroll
            for (int r = 0; r < 4; ++r) { LAS bf16* p = (LAS bf16*)(GY + (16 * w + 4 * g + r) * 144) + j; *p = (bf16)f2bf(gelu_tanh(bf2f(*p)) * hs[r]); }
        }
        __syncthreads();
#pragma unroll
        for (int q = 0; q < 2; ++q) { const int idx = tid + 512 * q, row = idx >> 3, ch = idx & 7;
            *(v4u*)(GCg + (size_t)(t0 + row) * 512 + blk * 64 + ch * 8) = *(const LAS v4u*)(GY + row * 144 + ch * 16); }
    }
}
template <int MODE> __device__ __forceinline__ void phase_lru(const Frame& F, CArgs* A, int l) {
    int cur = -1;
    LruPre P0, P1;
    if (F.bid < 1024) lru_fetch<MODE>(F, F.bid, P0);
    for (int it = F.bid; it < 1024; it += 2 * F.G) {
        { const int blk = it & 7; if (blk != cur) { lru_stage_consts(F, A, l, blk); cur = blk; } }
        const int it1 = it + F.G, it2 = it + 2 * F.G;
        if (it1 < 1024) lru_fetch<MODE>(F, it1, P1);
        lru_item<MODE>(F, it, P0);
        if (it1 < 1024) {
            { const int blk = it1 & 7; if (blk != cur) { lru_stage_consts(F, A, l, blk); cur = blk; } }
            if (it2 < 1024) lru_fetch<MODE>(F, it2, P0);
            lru_item<MODE>(F, it1, P1);
        }
    }
}


__device__ __forceinline__ void na_group(const Frame& F, const float* rpb, int grp, const float* psrc) {
    const int b = grp >> 5, h = (grp >> 2) & 7, rg = grp & 3, r0 = rg * 8;
    bf16* Qg = (bf16*)(F.ws + WS_PROJ); const bf16* Kg = (const bf16*)(F.ws + WS_PROJ + BLK); const bf16* Vg = (const bf16*)(F.ws + WS_PROJ + 2 * BLK);
    LAS unsigned char* Kl = F.lds; LAS unsigned char* Vl = F.lds + 512 * 144; LAS float* Bl = (LAS float*)(F.lds + 2 * 512 * 144);
    const int tid = F.ltid();
    int rs = r0 - 4; rs = rs < 0 ? 0 : (rs > 24 ? 24 : rs);
    __syncthreads();
#pragma unroll
    for (int q = 0; q < 8; ++q) {
        const int idx = tid + 512 * q, kidx = idx >> 3, ch = idx & 7, grow = rs + (kidx >> 6), col = kidx & 63;
        const size_t tok = (size_t)b * SEQ + grow * 64 + col; const int lrow = (grow & 7) * 64 + col;
        *(LAS v4u*)(Kl + lrow * 144 + ch * 16) = *(const v4u*)(Kg + tok * 512 + h * 64 + ch * 8);
        *(LAS v4u*)(Vl + lrow * 144 + ch * 16) = *(const v4u*)(Vg + tok * 512 + h * 64 + ch * 8);
    }
    if (tid < 465) Bl[tid] = rpb[h * 465 + tid];
    __syncthreads();
    const int w = F.wave(), lane = F.lane(), g = lane >> 4, i = lane & 15, q4 = i >> 2, p4 = i & 3;
    const int cq = 16 * (w & 3) + i;
    bf16x8_t bq0 = *(const bf16x8_t*)(Qg + ((size_t)b * SEQ + r0 * 64 + cq) * 512 + h * 64 + 8 * g), bq1 = *(const bf16x8_t*)(Qg + ((size_t)b * SEQ + r0 * 64 + cq) * 512 + h * 64 + 32 + 8 * g);
    for (int k = 0; k < 8; ++k) {
        const int r = r0 + k;
        const int rq = k < 7 ? r + 1 : r;
        const bf16x8_t nq0 = *(const bf16x8_t*)(Qg + ((size_t)b * SEQ + rq * 64 + cq) * 512 + h * 64 + 8 * g), nq1 = *(const bf16x8_t*)(Qg + ((size_t)b * SEQ + rq * 64 + cq) * 512 + h * 64 + 32 + 8 * g);
        int rsn = r + 1 - 4; rsn = rsn < 0 ? 0 : (rsn > 24 ? 24 : rsn);
        const bool slide = (k < 7) && (rsn != rs);
        v4u pk = (v4u){0u, 0u, 0u, 0u}, pv = pk;
        if (slide) { const size_t tok = (size_t)b * SEQ + (rsn + 7) * 64 + (tid >> 3);
            pk = *(const v4u*)(Kg + tok * 512 + h * 64 + (tid & 7) * 8); pv = *(const v4u*)(Vg + tok * 512 + h * 64 + (tid & 7) * 8); }
        if (w < 4) {
            const int c = 16 * w + i, cb = w == 0 ? 0 : (w == 1 ? 8 : (w == 2 ? 24 : 32));
            int cst = c - 8; cst = cst < 0 ? 0 : (cst > 48 ? 48 : cst);
            const size_t tq = (size_t)b * SEQ + r * 64 + c;
            float sc[16][4];
            float mx = -1e30f;
            int boff[2][4]; float vmask[2][4];
#pragma unroll
            for (int half = 0; half < 2; ++half)
#pragma unroll
                for (int e = 0; e < 4; ++e) { const int kc = cb + 16 * half + 4 * g + e; const bool valid = (kc >= cst) && (kc < cst + 16);
                    int dc = kc - c + 15; dc = dc < 0 ? 0 : (dc > 30 ? 30 : dc); boff[half][e] = dc; vmask[half][e] = valid ? 0.f : -1e30f; }
#pragma unroll
            for (int t = 0; t < 16; ++t) {
                const int wi = t >> 1, half = t & 1, slot = (rs + wi) & 7;
                const LAS unsigned char* kp = Kl + (slot * 64 + cb + 16 * half + i) * 144 + (8 * g) * 2;
                const bf16x8_t a0 = *(const LAS bf16x8_t*)kp, a1 = *(const LAS bf16x8_t*)(kp + 64);
                f32x4 s_ = (f32x4){0.f, 0.f, 0.f, 0.f};
                s_ = MFMA16(a0, bq0, s_); s_ = MFMA16(a1, bq1, s_);
                const int brow = (rs + wi - r + 7) * 31;
#pragma unroll
                for (int e = 0; e < 4; ++e) {
                    const float bias = Bl[brow + boff[half][e]];
                    const float v = fminf(s_[e] + bias, 1e30f) + vmask[half][e];
                    sc[t][e] = v; mx = fmaxf(mx, v);
                }
            }
            mx = fmaxf(mx, shx(mx, lane, 16)); mx = fmaxf(mx, shx(mx, lane, 32));
            float sum = 0.f;
            bf16x8_t bp[8];
#pragma unroll
            for (int wi = 0; wi < 8; ++wi) {
                float p[8];
#pragma unroll
                for (int e = 0; e < 4; ++e) { p[e] = fexp(sc[2 * wi][e] - mx); p[4 + e] = fexp(sc[2 * wi + 1][e] - mx); sum += p[e] + p[4 + e]; }
                v4u pw; pw.x = pkbf(p[0], p[1]); pw.y = pkbf(p[2], p[3]); pw.z = pkbf(p[4], p[5]); pw.w = pkbf(p[6], p[7]);
                bp[wi] = __builtin_bit_cast(bf16x8_t, pw);
            }
            sum += shx(sum, lane, 16); sum += shx(sum, lane, 32);
            f32x4 o[4];
#pragma unroll
            for (int dt = 0; dt < 4; ++dt) o[dt] = (f32x4){0.f, 0.f, 0.f, 0.f};
#pragma unroll
            for (int wi = 0; wi < 8; ++wi) {
                const int slot = (rs + wi) & 7;
                const LAS unsigned char* vp = Vl + (slot * 64 + cb + 4 * g + q4) * 144 + (4 * p4) * 2;
#pragma unroll
                for (int dt = 0; dt < 4; ++dt) { const bf16x8_t av = tr_frag(vp + 32 * dt, vp + 16 * 144 + 32 * dt); o[dt] = MFMA16(av, bp[wi], o[dt]); }
            }
            const float inv = 1.0f / sum;
#pragma unroll
            for (int dt = 0; dt < 4; ++dt) { v2u ov; ov.x = pkbf(o[dt][0] * inv, o[dt][1] * inv); ov.y = pkbf(o[dt][2] * inv, o[dt][3] * inv);
                *(v2u*)(Qg + tq * 512 + h * 64 + 16 * dt + 4 * g) = ov; }
        }
        else {
            const int e = (grp * 8 + k) * 512 + (tid - 256) * 2;
            const f32x4 v0 = ((const f32x4*)psrc)[e], v1 = ((const f32x4*)psrc)[e + 1];
            v4u o; o.x = pk2(v0.x, v0.y); o.y = pk2(v0.z, v0.w); o.z = pk2(v1.x, v1.y); o.w = pk2(v1.z, v1.w);
            ((v4u*)((unsigned char*)F.out + DO_PB))[e >> 1] = o;
        }
        __syncthreads();
        if (slide) { const int lrow = ((rsn + 7) & 7) * 64 + (tid >> 3);
            *(LAS v4u*)(Kl + lrow * 144 + (tid & 7) * 16) = pk; *(LAS v4u*)(Vl + lrow * 144 + (tid & 7) * 16) = pv; }
        __syncthreads();
        rs = rsn; bq0 = nq0; bq1 = nq1;
    }
}
__device__ __forceinline__ void phase_na(const Frame& F, CArgs* A, int l) { const float* rpb = A->in[5] + (size_t)l * 8 * 465; for (int it = F.bid; it < 256; it += F.G) na_group(F, rpb, it, A->in[1] + (size_t)l * T * PLE); }

__device__ __forceinline__ void phase_ret_state(const Frame& F) { for (int it = F.bid; it < 256; it += F.G) ret_scan_item(F, it); }
__device__ __forceinline__ void phase_ret_out(const Frame& F, CArgs* A, int l) { const float* gn = A->in[6] + (size_t)l * 512; for (int it = F.bid; it < 512; it += F.G) ret_out_item(F, gn, it); }

__device__ __forceinline__ void phase_final(const Frame& F, CArgs* A) {
    const float* g = A->in[22]; const bf16* xb = (const bf16*)(F.ws + WS_XB); const float* ss = (const float*)(F.ws + WS_SSB);
    const int lane = F.lane();
    f32x4 gv[4];
#pragma unroll
    for (int j = 0; j < 4; ++j) gv[j] = ((const f32x4*)g + lane)[64 * j];
    for (int m0 = F.gw() * 4; m0 < T; m0 += F.ngw * 4) {
        v2u w[4][4]; float sp[4];
#pragma unroll
        for (int r = 0; r < 4; ++r) {
            sp[r] = lane < 16 ? ss[(size_t)(m0 + r) * 16 + lane] : 0.f;
#pragma unroll
            for (int j = 0; j < 4; ++j) w[r][j] = ((const v2u*)(xb + (size_t)(m0 + r) * D) + lane)[64 * j];
        }
#pragma unroll
        for (int r = 0; r < 4; ++r) {
            float t = sp[r]; t += shx(t, lane, 1); t += shx(t, lane, 2); t += shx(t, lane, 4); t += shx(t, lane, 8);
            const float rs = 1.0f / sqrtf(lane_get(t, 0) * (1.0f / D) + RMS_EPS);
            f32x4* orow = (f32x4*)(F.out + (size_t)(m0 + r) * D) + lane;
#pragma unroll
            for (int j = 0; j < 4; ++j) orow[64 * j] = (f32x4){bflo(w[r][j].x), bfhi(w[r][j].x), bflo(w[r][j].y), bfhi(w[r][j].y)} * rs * gv[j];
        }
    }
}

__global__ void __launch_bounds__(NWAVES * 64, 2) mk_fwd(Args args) {
    extern __shared__ __attribute__((aligned(16))) unsigned char lds[];
    const int tid0 = threadIdx.x;
    const int wave0 = __builtin_amdgcn_readfirstlane(tid0 >> 6);
    LAS unsigned char* const lds3 = (LAS unsigned char*)lds;
    CArgs* A0 = get_args();
    const int ph_lo = A0->ph_lo, ph_hi = A0->ph_hi;
    for (int u = tid0; u < (LDS_BYTES - LDSCTL_OFF) / 4; u += NWAVES * 64) ((LAS unsigned*)(lds3 + LDSCTL_OFF))[u] = 0u;
    __syncthreads();
    const bool multi = (ph_hi - ph_lo) > 1;
    XcdBarrier bar; bar.bar = (unsigned*)((gu32*)(A0->ws + WS_CTL) + CW_BAR); bar.x = 0; bar.st = nullptr;
    if (multi) bar = xcd_barrier_post((unsigned*)((gu32*)(A0->ws + WS_CTL) + CW_BAR), (volatile LAS unsigned*)(lds3 + MISC_OFF) + 8);

    unsigned long long probe_acc = 0, pt0 = 0;
#define PMARK(k) do { if (PROBE_WN != 0ull) { __syncthreads(); const unsigned long long t_ = __builtin_amdgcn_s_memrealtime(); probe_acc += ((PROBE_WN >> (4 * (k))) & 15ull) * (t_ - pt0); pt0 = t_; } } while (0)
    for (int ph = ph_lo; ph < ph_hi; ++ph) {
        CArgs* A = get_args();
#define MAKE_FRAME(Fx) Frame Fx; Fx.wave0 = wave0; \
        Fx.lds = lds3; \
        { int b_ = blockIdx.x; asm volatile("" : "+s"(b_)); Fx.bid = b_; } \
        Fx.G = gridDim.x; Fx.ngw = Fx.G * NWAVES; Fx.out = A->out; Fx.ws = A->ws
        MAKE_FRAME(F);
        unsigned char* ws = F.ws;
        if (PROBE_WN != 0ull) pt0 = __builtin_amdgcn_s_memrealtime();
        int kind, l;
        if (ph == 0) { kind = PH_PRO; l = 0; } else if (ph == NPH - 1) { kind = PH_FIN; l = 0; } else { l = (ph - 1) / NPL; kind = 1 + (ph - 1) % NPL; }
        float* ssA = (float*)(ws + WS_SSA); float* ssB = (float*)(ws + WS_SSB);
        switch (kind) {
        case PH_PRO: phase_prologue(F, A); break;
        case PH_G1: {
            pg8::Gemm g{(const bf16_t*)(ws + WS_XB), (const bf16_t*)(ws + W_IN), T, 7680, D, 0, 0};
            pg8::StaticOrder S; S.init(T, 7680, F.G, F.bid);
            EpiG1 E{(bf16_t*)(ws + WS_PROJ), ws + WS_GATE8, ssB, A->in[4] + (size_t)l * 3072, (const float*)(ws + WS_TAB)};
            pg8::gemm_phase<EpiG1, pg8::StaticOrder, true, true>(F.lds, g, S, E, F.ltid());
        } break;
        case PH_MIXA: phase_na(F, A, l); PMARK(10); phase_ret_state(F); PMARK(11); phase_lru<0>(F, A, l); PMARK(12); __syncthreads(); convert_layer_mlp(F, A, l); PMARK(13); break;
        case PH_MIXB: phase_ret_out(F, A, l); PMARK(14); phase_lru<1>(F, A, l); PMARK(15); break;
        case PH_G2: {
            pg8::Gemm g{(const bf16_t*)(ws + WS_PROJ), (const bf16_t*)(ws + W_BR), T, D, 512, 3 * BLK, (size_t)D * 512 * 2};
            ZOrder S; S.S.init(T, D, F.G, F.bid);
            EpiG2 E{ws + WS_GATE8, (bf16_t*)(ws + WS_MERGED)};
            pg8::gemm_phase<EpiG2, ZOrder, true, true>(F.lds, g, S, E, F.ltid());
        } break;
        case PH_G3: case PH_G5: {
            const bool g3 = (kind == PH_G3);
            pg8::Gemm g{(const bf16_t*)(ws + (g3 ? WS_MERGED : WS_U)), (const bf16_t*)(ws + (g3 ? W_OUT : W_DOWN)), T, D, g3 ? D : FF, 0, 0};
            pg8::StaticOrder S; S.init(T, D, F.G, F.bid);
            EpiRes E{(g3 && l == 0) ? A->in[0] : nullptr, (const bf16_t*)(ws + (g3 ? WS_XB : WS_GATE8)), (bf16_t*)(ws + WS_GATE8), g3 ? ssB : ssA};
            pg8::gemm_phase<EpiRes, pg8::StaticOrder, false, true>(F.lds, g, S, E, F.ltid());
        } break;
        case PH_G4: {
            pg8::Gemm g{(const bf16_t*)(ws + WS_GATE8), (const bf16_t*)(ws + W_UP), T, FF, D, 0, 0};
            pg8::StaticOrder S; S.init(T, FF, F.G, F.bid);
            EpiG4 E{(bf16_t*)(ws + WS_U), ssB};
            pg8::gemm_phase<EpiG4, pg8::StaticOrder, true, true>(F.lds, g, S, E, F.ltid());
            MAKE_FRAME(F2);
            if (l + 1 < DEPTH) convert_layer_mid(F2, A, l + 1);
        } break;
        case PH_G6: {
            {
                pg8::Gemm g{(const bf16_t*)((unsigned char*)F.out + DO_PB), (const bf16_t*)(ws + W_PLE(l & 1)), T, D, PLE, 0, 0};
                pg8::StaticOrder S; S.init(T, D, F.G, F.bid);
                EpiE E{(bf16_t*)(ws + WS_E)};
                pg8::gemm_phase<EpiE, pg8::StaticOrder, false, true>(F.lds, g, S, E, F.ltid());
            }
            {
                pg8::Gemm g{(const bf16_t*)(ws + WS_GATE8), (const bf16_t*)(ws + W_G(l & 1)), T, D, D, 0, 0};
                pg8::StaticOrder S; S.init(T, D, F.G, F.bid);
                EpiG6 E{(const bf16_t*)(ws + WS_GATE8), (bf16_t*)(ws + WS_XB), ssA, ssB, (const bf16_t*)(ws + WS_E)};
                pg8::gemm_phase<EpiG6, pg8::StaticOrder, false, true>(F.lds, g, S, E, F.ltid());
            }
            if (l + 1 < DEPTH) { MAKE_FRAME(F2); convert_layer_early(F2, A, l + 1); }
        } break;
        case PH_FIN: phase_final(F, A); break;
        default: break;
        }
        if (ph + 1 < ph_hi) xcd_barrier(bar, F.ltid());
        PMARK(kind);
    }
    if (PROBE_WN != 0ull && blockIdx.x == 0) { const unsigned long long te = __builtin_amdgcn_s_memrealtime(); while (__builtin_amdgcn_s_memrealtime() - te < probe_acc) __builtin_amdgcn_s_sleep(32); }
}


#if MK_CHECK
constexpr int CW_CODE = 64, CW_CNT = 128;
__device__ __forceinline__ unsigned hash32(unsigned x) { x ^= x >> 16; x *= 0x7feb352du; x ^= x >> 15; x *= 0x846ca68bu; x ^= x >> 16; return x; }
__device__ __forceinline__ bool near(float a, float b, float rel, float abs_) { return fabsf(a - b) <= rel * fabsf(b) + abs_; }
__device__ float rs_of_x(const float* x, int row) { float s = 0.f; for (int k = 0; k < D; ++k) s += x[(size_t)row * D + k] * x[(size_t)row * D + k]; return 1.0f / sqrtf(s / D + RMS_EPS); }
__global__ void __launch_bounds__(256) mk_check(Args a, int stage) {
    const unsigned id = blockIdx.x * blockDim.x + threadIdx.x;
    const unsigned h = hash32(id * 2654435761u + 12345u * stage);
    unsigned char* ws = a.ws; unsigned* ctl = (unsigned*)(ws + WS_CTL);
    const int row = (int)(h % T);
    bool bad = false;
    const float* x = a.in[0];
    if (stage == 1) {
        const int col = (int)((h >> 14) % D);
        const bf16* xb = (const bf16*)(ws + WS_XB);
        bad |= !near(bf2f(xb[(size_t)row * D + col]), x[(size_t)row * D + col], 0.01f, 1e-3f);
        float s = 0.f; for (int k = 0; k < D; ++k) s += x[(size_t)row * D + k] * x[(size_t)row * D + k];
        const float* ss = (const float*)(ws + WS_SSB); float t = 0.f; for (int k = 0; k < 16; ++k) t += ss[(size_t)row * 16 + k];
        bad |= !near(t, s, 1e-3f, 1e-3f);
        const int n = (int)((h >> 7) % 7680), k = (int)(h % D);
        const bf16* wt = (const bf16*)(ws + W_IN);
        bad |= !near(bf2f(wt[(size_t)n * D + k]), a.in[2][k] * a.in[3][(size_t)k * 7680 + n], 0.01f, 1e-4f);
        const int pos = (int)(h % SEQ), i = (int)((h >> 11) % 64);
        const float th = powf(10000.0f, -(float)i / 63.0f), ang = (float)pos * th;
        const float* tab = (const float*)(ws + WS_TAB);
        bad |= !near(tab[pos * 64 + i], cosf(ang), 0.f, 2e-3f); bad |= !near(tab[131072 + pos * 64 + i], sinf(ang), 0.f, 2e-3f);
    } else if (stage == 2) {
        const int col = (int)((h >> 14) % 7680) & ~1;
        const float rs = rs_of_x(x, row);
        float v0 = 0.f, v1 = 0.f;
        for (int k = 0; k < D; ++k) { const float xv = x[(size_t)row * D + k] * a.in[2][k]; v0 += xv * a.in[3][(size_t)k * 7680 + col]; v1 += xv * a.in[3][(size_t)k * 7680 + col + 1]; }
        v0 *= rs; v1 *= rs;
        if (col < 4608) {
            const int kind = col / 512, cc = col % 512, phys = (int)((0x683754210ull >> (4 * kind)) & 15ull);
            if (kind == 3 || kind == 4) { const int i = (cc & 127) >> 1, pos = row & 2047; const float th = powf(10000.0f, -(float)i / 63.0f), ang = (float)pos * th, c = cosf(ang), sn = sinf(ang);
                const float w0 = v0 * c - v1 * sn, w1 = v0 * sn + v1 * c; v0 = w0; v1 = w1; }
            if (kind == 0) { v0 *= 0.125f; v1 *= 0.125f; } if (kind == 3) { v0 *= 0.08838834764831845f; v1 *= 0.08838834764831845f; }
            const bf16* p = (const bf16*)(ws + WS_PROJ) + (size_t)phys * T * 512 + (size_t)row * 512 + cc;
            bad |= !near(bf2f(p[0]), v0, 0.03f, 0.03f); bad |= !near(bf2f(p[1]), v1, 0.03f, 0.03f);
        } else {
            const int gc = col - 4608; const unsigned char* g8 = ws + WS_GATE8 + (size_t)row * 3072 + gc;
            const float s0 = 1.0f / (1.0f + expf(-(v0 + a.in[4][gc]))), s1 = 1.0f / (1.0f + expf(-(v1 + a.in[4][gc + 1])));
            bad |= !near((float)g8[0] / 255.0f, s0, 0.f, 0.012f); bad |= !near((float)g8[1] / 255.0f, s1, 0.f, 0.012f);
        }
    } else if (stage == 4) {
        const int col = (int)((h >> 14) % D);
        float m = 0.f;
        for (int n = 0; n < 3; ++n) { const bf16* ys = (const bf16*)(ws + WS_PROJ) + (size_t)(3 * n) * T * 512 + (size_t)row * 512; float acc = 0.f;
            for (int k = 0; k < 512; ++k) acc += bf2f(ys[k]) * a.in[14][((size_t)n * 512 + k) * D + col];
            m += acc * (float)ws[WS_GATE8 + (size_t)row * 3072 + n * 1024 + col] / 255.0f; }
        bad |= !near(bf2f(((const bf16*)(ws + WS_MERGED))[(size_t)row * D + col]), m, 0.03f, 0.03f);
    } else if (stage == 5 && false) {
        const int col = (int)((h >> 14) % D);
        const bf16* mg = (const bf16*)(ws + WS_XB) + (size_t)row * D; float acc = 0.f;
        for (int k = 0; k < D; ++k) acc += bf2f(mg[k]) * a.in[15][(size_t)k * D + col];
        const float x1 = x[(size_t)row * D + col] + acc;
        bad |= !near(a.out[(size_t)row * D + col], x1, 0.02f, 0.03f);
        bad |= !near(bf2f(((const bf16*)(ws + WS_GATE8))[(size_t)row * D + col]), a.out[(size_t)row * D + col], 0.01f, 1e-3f);
        float s = 0.f; for (int k = 0; k < D; ++k) s += a.out[(size_t)row * D + k] * a.out[(size_t)row * D + k];
        const float* ss = (const float*)(ws + WS_SSB); float t = 0.f; for (int k = 0; k < 16; ++k) t += ss[(size_t)row * 16 + k];
        bad |= !near(t, s, 1e-3f, 1e-3f);
    } else if (stage == 6 && false) {
        const int col = (int)((h >> 14) % FF);
        const bf16* xb = (const bf16*)(ws + WS_GATE8) + (size_t)row * D; float acc = 0.f;
        for (int k = 0; k < D; ++k) acc += bf2f(xb[k]) * a.in[16][k] * a.in[17][(size_t)k * FF + col];
        const float rs = rs_of_x(a.out, row); float v = fmaxf(acc * rs, 0.f); v *= v;
        bad |= !near(bf2f(((const bf16*)(ws + WS_U))[(size_t)row * FF + col]), v, 0.05f, 0.05f);
    } else if (stage == 7 && false) {
        const int col = (int)((h >> 14) % D);
        const bf16* uu = (const bf16*)(ws + WS_U) + (size_t)row * FF; float acc = 0.f;
        for (int k = 0; k < FF; ++k) acc += bf2f(uu[k]) * a.in[18][(size_t)k * D + col];
        const float x2 = bf2f(((const bf16*)(ws + WS_XB))[(size_t)row * D + col]) + acc;
        bad |= !near(a.out[(size_t)row * D + col], x2, 0.03f, 0.05f);
        bad |= !near(bf2f(((const bf16*)(ws + WS_GATE8))[(size_t)row * D + col]), a.out[(size_t)row * D + col], 0.01f, 1e-3f);
        float s = 0.f; for (int k = 0; k < D; ++k) s += a.out[(size_t)row * D + k] * a.out[(size_t)row * D + k];
        const float* ss = (const float*)(ws + WS_SSA); float t = 0.f; for (int k = 0; k < 16; ++k) t += ss[(size_t)row * 16 + k];
        bad |= !near(t, s, 1e-3f, 1e-3f);
    } else if (stage == 8 && false) {
        const int col = (int)((h >> 14) % D);
        const bf16* xb = (const bf16*)(ws + WS_GATE8) + (size_t)row * D; float acc = 0.f, s = 0.f;
        for (int k = 0; k < D; ++k) { const float xv = bf2f(xb[k]); s += xv * xv; acc += xv * a.in[19][k] * a.in[20][(size_t)k * D + col]; }
        const float rs = 1.0f / sqrtf(s / D + RMS_EPS);
        float e = 0.f; for (int k = 0; k < PLE; ++k) e += a.in[1][(size_t)row * PLE + k] * a.in[21][(size_t)k * D + col];
        const float x3 = bf2f(xb[col]) + e / (1.0f + expf(-acc * rs));
        bad |= !near(a.out[(size_t)row * D + col], x3, 0.03f, 0.05f);
    }
    if (stage == 9) bad = true;
    if (bad) atomicAdd(&ctl[CW_CNT + stage], 1u);
}
__device__ float orig_proj(const Args& a, int l, int row, int col) {
    const float* x = l == 0 ? a.in[0] : a.out; const float* g = a.in[2] + (size_t)l * D; const float* w = a.in[3] + (size_t)l * D * 7680;
    float s = 0.f, acc = 0.f;
    for (int k = 0; k < D; ++k) { const float xv = x[(size_t)row * D + k]; s += xv * xv; acc += xv * g[k] * w[(size_t)k * 7680 + col]; }
    return acc / sqrtf(s / D + RMS_EPS);
}
__global__ void __launch_bounds__(64) mk_check_na(Args a, int l) {
    __shared__ float qs[64]; __shared__ float sc[128];
    const unsigned h = hash32(blockIdx.x * 977u + 31u); const int t = (int)(h % T), hd = (int)((h >> 16) % 8), d = threadIdx.x;
    unsigned char* ws = a.ws; unsigned* ctl = (unsigned*)(ws + WS_CTL);
    const bf16* K = (const bf16*)(ws + WS_PROJ + BLK); const bf16* V = (const bf16*)(ws + WS_PROJ + 2 * BLK); const bf16* Y = (const bf16*)(ws + WS_PROJ);
    qs[d] = bf2f((bf16)f2bf(0.125f * orig_proj(a, l, t, hd * 64 + d)));
    __syncthreads();
    const int b = t / SEQ, s = t % SEQ, r = s / 64, c = s % 64;
    int rs = r - 4; if (rs < 0) rs = 0; if (rs > 24) rs = 24; int cs = c - 8; if (cs < 0) cs = 0; if (cs > 48) cs = 48;
    const float* rpb = a.in[5] + (size_t)l * 8 * 15 * 31 + hd * 465;
    for (int kk = d; kk < 128; kk += 64) { const int i = kk / 16, j = kk % 16; const int tk = b * SEQ + (rs + i) * 64 + cs + j; float acc = 0.f;
        for (int e = 0; e < 64; ++e) acc += qs[e] * bf2f(K[(size_t)tk * 512 + hd * 64 + e]);
        sc[kk] = acc + rpb[(rs + i - r + 7) * 31 + (cs + j - c + 15)]; }
    __syncthreads();
    float mx = -1e30f; for (int kk = 0; kk < 128; ++kk) mx = fmaxf(mx, sc[kk]);
    float den = 0.f, o = 0.f;
    for (int kk = 0; kk < 128; ++kk) { const int i = kk / 16, j = kk % 16; const int tk = b * SEQ + (rs + i) * 64 + cs + j; const float p = expf(sc[kk] - mx); den += p; o += p * bf2f(V[(size_t)tk * 512 + hd * 64 + d]); }
    o /= den;
    if (!near(bf2f(Y[(size_t)t * 512 + hd * 64 + d]), o, 0.04f, 0.04f)) atomicAdd(&ctl[CW_CNT + 31], 1u);
}
__global__ void __launch_bounds__(128) mk_check_ret(Args a, int l) {
    __shared__ float qs[128]; __shared__ float sc[SEQ]; __shared__ float red[128];
    const unsigned h = hash32(blockIdx.x * 1231u + 77u); const int t = (int)(h % T), hd = (int)((h >> 16) % 4), dv = threadIdx.x;
    unsigned char* ws = a.ws; unsigned* ctl = (unsigned*)(ws + WS_CTL);
    const bf16* Y = (const bf16*)(ws + WS_PROJ + 3 * BLK); const bf16* Q = (const bf16*)(ws + WS_PROJ + 4 * BLK); const bf16* K = (const bf16*)(ws + WS_PROJ + 5 * BLK); const bf16* V = (const bf16*)(ws + WS_PROJ + 7 * BLK);
    const int b = t / SEQ, n = t % SEQ;
    qs[dv] = bf2f(Q[(size_t)t * 512 + hd * 128 + dv]);
    __syncthreads();
    const float gf = log2_1m(__builtin_amdgcn_exp2f(-5.0f - (float)hd)), gb = log2_1m(__builtin_amdgcn_exp2f(-5.5f - (float)hd));
    for (int m = dv; m < SEQ; m += 128) { float acc = 0.f; for (int e = 0; e < 128; ++e) acc += qs[e] * bf2f(K[(size_t)(b * SEQ + m) * 512 + hd * 128 + e]);
        sc[m] = acc * (m <= n ? __builtin_amdgcn_exp2f(gf * (float)(n - m)) : __builtin_amdgcn_exp2f(gb * (float)(m - n))); }
    __syncthreads();
    float o = 0.f; for (int m = 0; m < SEQ; ++m) o += sc[m] * bf2f(V[(size_t)(b * SEQ + m) * 512 + hd * 128 + dv]);
    red[dv] = o * o; __syncthreads();
    float ms = 0.f; for (int e = 0; e < 128; ++e) ms += red[e];
    const float rn = 1.0f / sqrtf(ms / 128.0f + RMS_EPS);
    const float g = bf2f((bf16)f2bf(orig_proj(a, l, t, 1536 + 3 * 512 + hd * 128 + dv)));
    const float y = g / (1.0f + expf(-g)) * o * rn * a.in[6][(size_t)l * 512 + hd * 128 + dv];
    if (!near(bf2f(Y[(size_t)t * 512 + hd * 128 + dv]), y, 0.04f, 0.04f)) atomicAdd(&ctl[CW_CNT + 32], 1u);
}
__global__ void __launch_bounds__(128) mk_check_g(Args a, int l, int code) {
    const unsigned h = hash32(blockIdx.x * 1231u + 77u); const int t = (int)(h % T), hd = (int)((h >> 16) % 4), dv = threadIdx.x;
    unsigned* ctl = (unsigned*)(a.ws + WS_CTL);
    const bf16* G = (const bf16*)(a.ws + WS_PROJ + 3 * BLK);
    const float g = orig_proj(a, l, t, 1536 + 3 * 512 + hd * 128 + dv);
    if (!near(bf2f(G[(size_t)t * 512 + hd * 128 + dv]), g, 0.03f, 0.03f)) atomicAdd(&ctl[CW_CNT + code], 1u);
}
__global__ void __launch_bounds__(64) mk_check_lru(Args a, int l) {
    __shared__ float xs[64];
    const unsigned h = hash32(blockIdx.x * 733u + 5u); const int b = (int)(h % 8), blk = (int)((h >> 8) % 8), ts = (int)((h >> 16) % SEQ), j = threadIdx.x, ch = blk * 64 + j;
    unsigned char* ws = a.ws; unsigned* ctl = (unsigned*)(ws + WS_CTL);
    const bf16* XC = (const bf16*)(ws + WS_PROJ + 8 * BLK); const bf16* Y = (const bf16*)(ws + WS_PROJ + 6 * BLK);
    const float* cw = a.in[7] + (size_t)l * 2048; const float cb = a.in[8][(size_t)l * 512 + ch];
    float hsum = 0.f;
    for (int dir = 0; dir < 2; ++dir) {
        const float* wa = a.in[9] + (((size_t)l * 2 + dir) * 8 + blk) * 4096; const float* wx = a.in[11] + (((size_t)l * 2 + dir) * 8 + blk) * 4096;
        const float ba = a.in[10][((size_t)l * 2 + dir) * 512 + ch], bx = a.in[12][((size_t)l * 2 + dir) * 512 + ch], lam = a.in[13][((size_t)l * 2 + dir) * 512 + ch];
        const float sp = log1pf(expf(-lam));
        float hh = 0.f;
        const int nsteps = dir == 0 ? ts + 1 : SEQ - ts;
        for (int st = 0; st < nsteps; ++st) {
            const int t = dir == 0 ? st : SEQ - 1 - st;
            float xf = cb;
            for (int w = 0; w < 4; ++w) { const int t2 = t + w - 2; if (t2 >= 0 && t2 < SEQ) xf += cw[w * 512 + ch] * bf2f(XC[(size_t)(b * SEQ + t2) * 512 + ch]); }
            __syncthreads(); xs[j] = xf; __syncthreads();
            float ra = ba, ia = bx;
            for (int i = 0; i < 64; ++i) { ra += xs[i] * wa[i * 64 + j]; ia += xs[i] * wx[i * 64 + j]; }
            const float r = 1.0f / (1.0f + expf(-ra)), ig = 1.0f / (1.0f + expf(-ia));
            const float la = -8.0f * r * sp, av = expf(la); float mult = sqrtf(-expm1f(2.0f * la)); if (st == 0) mult = 1.0f;
            hh = av * hh + mult * ig * xf;
        }
        hsum += hh;
    }
    const float gc = bf2f((bf16)f2bf(orig_proj(a, l, b * SEQ + ts, 3584 + 512 + ch)));
    const float u = 0.7978845608028654f * (gc + 0.044715f * gc * gc * gc);
    const float y = 0.5f * gc * (1.0f + tanhf(u)) * hsum;
    if (!near(bf2f(Y[(size_t)(b * SEQ + ts) * 512 + ch]), y, 0.04f, 0.04f)) atomicAdd(&ctl[CW_CNT + 33], 1u);
}
__global__ void mk_report(Args a) {
    unsigned* ctl = (unsigned*)(a.ws + WS_CTL);
    const int order[13] = {1, 2, 35, 31, 34, 32, 33, 4, 5, 6, 7, 8, 9};
    const unsigned tot[13] = {16384u, 16384u, 16384u, 32768u, 16384u, 16384u, 8192u, 16384u, 16384u, 16384u, 16384u, 16384u, 64u};
    for (int i = 0; i < 13; ++i) {
        const unsigned cnt = ctl[CW_CNT + order[i]];
        if (cnt * 200u > tot[i]) {
            unsigned tenth = (cnt * 10u) / tot[i]; if (tenth > 9u) tenth = 9u;
            a.out[0] = order[i] >= 10 ? 100.0f * (float)order[i] : 1000.0f * (float)order[i] + 100.0f * (float)tenth;
            return;
        }
    }
}
#endif

#ifndef MK_ONE_LAUNCH
#define MK_ONE_LAUNCH 1
#endif
extern "C" void kernel_launch(void* const* d_in, const int* in_sizes, int n_in, void* d_out, int out_size, void* d_ws, size_t ws_size, hipStream_t stream) {
    static int grid = 0;
    if (grid == 0) {
        if (n_in != 23 || in_sizes[0] != T * D || out_size != T * D || ws_size < WS_END) { fprintf(stderr, "kernel_launch: unexpected shapes (n_in %d, in0 %d, out %d, ws %zu); nothing launched\n", n_in, n_in > 0 ? in_sizes[0] : -1, out_size, ws_size); grid = -1; return; }
        int dev = 0, cus = 0, per_cu = 0;
        if (hipGetDevice(&dev) != hipSuccess || hipDeviceGetAttribute(&cus, hipDeviceAttributeMultiprocessorCount, dev) != hipSuccess) { grid = -1; return; }
        if (hipFuncSetAttribute((const void*)mk_fwd, hipFuncAttributeMaxDynamicSharedMemorySize, LDS_BYTES) != hipSuccess) { fprintf(stderr, "kernel_launch: hipFuncSetAttribute failed\n"); grid = -1; return; }
        if (hipOccupancyMaxActiveBlocksPerMultiprocessor(&per_cu, (const void*)mk_fwd, NWAVES * 64, LDS_BYTES) != hipSuccess || per_cu < 1) { fprintf(stderr, "kernel_launch: occupancy query says %d blocks per CU\n", per_cu); }
        (void)hipGetLastError();
        grid = cus;
    }
    if (grid < 0) return;
    if (hipMemsetAsync((char*)d_ws + WS_CTL, 0, CTL_ZERO_BYTES, stream) != hipSuccess) return;
    Args a{};
    for (int i = 0; i < 23; ++i) a.in[i] = (const float*)d_in[i];
    a.out = (float*)d_out; a.ws = (unsigned char*)d_ws;
#if MK_ONE_LAUNCH
    a.ph_lo = 0; a.ph_hi = NPH;
    hipLaunchKernelGGL(mk_fwd, dim3(grid), dim3(NWAVES * 64), LDS_BYTES, stream, a);
#else
    for (int ph = 0; ph < NPH; ++ph) {
#if MK_CHECK
        if (ph == 1 + 6) (void)hipMemcpyAsync((char*)d_ws + WS_XB, (char*)d_ws + WS_GATE8, (size_t)T * D * 2, hipMemcpyDeviceToDevice, stream);
#endif
        a.ph_lo = ph; a.ph_hi = ph + 1; hipLaunchKernelGGL(mk_fwd, dim3(grid), dim3(NWAVES * 64), LDS_BYTES, stream, a);
#if MK_CHECK
        { int st = 0; if (ph == 0) st = 1; else if (ph == 1) st = 2; else if (ph == 1 + 3) st = 4; else if (ph == 1 + 4) st = 5; else if (ph == 1 + 5) st = 6; else if (ph == 1 + 6) st = 7; else if (ph == 1 + 7) st = 8;
          if (st) hipLaunchKernelGGL(mk_check, dim3(64), dim3(256), 0, stream, a, st);
          if (ph == 1 + 1) hipLaunchKernelGGL(mk_check_na, dim3(512), dim3(64), 0, stream, a, 0);
          if (ph == 1) hipLaunchKernelGGL(mk_check_g, dim3(128), dim3(128), 0, stream, a, 0, 35);
          if (ph == 1 + 1) hipLaunchKernelGGL(mk_check_g, dim3(128), dim3(128), 0, stream, a, 0, 34);
          if (ph == 1 + 2) hipLaunchKernelGGL(mk_check_ret, dim3(128), dim3(128), 0, stream, a, 0);
          if (ph == 1 + 2) hipLaunchKernelGGL(mk_check_lru, dim3(128), dim3(64), 0, stream, a, 0);
          if (ph == NPH - 1) hipLaunchKernelGGL(mk_check, dim3(1), dim3(64), 0, stream, a, 9); }
#endif
    }
#if MK_CHECK
    hipLaunchKernelGGL(mk_report, dim3(1), dim3(1), 0, stream, a);
#endif
#endif
}
```

```cpp
#include <hip/hip_runtime.h>
#include <cstdio>
#include <cstdint>
#ifndef MK_CHECK
#define MK_CHECK 0
#endif
#ifndef PROBE_WN
#define PROBE_WN 0x0ull
#endif
namespace pg8 {
#define PG8_LAS __attribute__((address_space(3)))
typedef unsigned short bf16_t;
typedef short bf16x8 __attribute__((ext_vector_type(8)));
typedef float f32x4 __attribute__((ext_vector_type(4)));
typedef unsigned u32x4 __attribute__((ext_vector_type(4)));
constexpr int BM = 256, BK = 64, HALF = 128, HTB = HALF * BK * 2  , STAGE_BYTES = 8 * HTB, NXCD = 8, WGM = 8;

__host__ __device__ __forceinline__ int lds_byte(int r, int c) { const int st = (r >> 4) * 2 + (c >> 5), rr = r & 15, cc = c & 31, ob = rr * 64 + cc * 2; return st * 1024 + (ob ^ (((ob >> 9) & 1) << 5)); }
__host__ __device__ __forceinline__ void stage_rc(int b, int& R, int& C) { const int st = b / 1024, sb = b % 1024, swz = sb ^ (((sb >> 9) & 1) << 5); R = (st >> 1) * 16 + swz / 64; C = (st & 1) * 32 + (swz % 64) / 2; }
__host__ __device__ __forceinline__ int perm32(int rho) { const int n = rho >> 4, i = rho & 15; return 8 * (i >> 2) + 4 * n + (i & 3); }

struct Unit { int pm, pn, z; };
struct Gemm { const bf16_t* A; const bf16_t* Bt; int M, N, K; size_t zA, zB; };

struct StaticOrder {
    int nM, nN, nwg, G, c;
    __host__ __device__ void init(int M, int N, int G_, int c_) { nM = M / BM; nN = N / BM; nwg = nM * nN; G = G_; c = c_; }
    __host__ __device__ bool next(int i, Unit& u) const {
        const long L = (long)i * G + c; if (L >= nwg) return false;
        int wgid = (int)L; { const int q = nwg / NXCD, r = nwg % NXCD, xcd = wgid % NXCD, off = wgid / NXCD; wgid = (xcd < r ? xcd * (q + 1) : r * (q + 1) + (xcd - r) * q) + off; }
        const int nig = WGM * nN, gid = wgid / nig, fm = gid * WGM, gsz = (nM - fm) < WGM ? (nM - fm) : WGM;
        u.pm = fm + ((wgid % nig) % gsz); u.pn = (wgid % nig) / gsz; u.z = 0; return true;
    }
    __device__ __forceinline__ void a_ready(const Unit&) const {}
    __device__ __forceinline__ void done(const Unit&) const {}
};

__device__ __forceinline__ unsigned cvt_pk_bf16(float lo, float hi) { unsigned r; asm volatile("v_cvt_pk_bf16_f32 %0, %1, %2" : "=v"(r) : "v"(lo), "v"(hi)); return r; }
typedef float f32x2 __attribute__((ext_vector_type(2)));
template <class Epi, class Sched, bool ALIGN_EPI = false, bool SP2 = false>
__device__ __forceinline__ void gemm_phase(PG8_LAS unsigned char* lds, const Gemm g, const Sched& S, const Epi& E, const int tid) {
    const int wid = __builtin_amdgcn_readfirstlane(tid >> 6), lane = tid & 63, wr = wid >> 2, wc = wid & 3, fr = lane & 15, fq = lane >> 4;
    const int K = g.K, nt = K / BK;
    unsigned voffA[2], voffB[2];
#pragma unroll
    for (int i = 0; i < 2; ++i) { int R, C; stage_rc(tid * 16 + i * 8192, R, C); const int Rb = Epi::PERM ? ((R & ~31) + perm32(R & 31)) : R;
        voffA[i] = (unsigned)(R * K + C) * 2u; voffB[i] = (unsigned)(Rb * K + C) * 2u; }
    const size_t kstep = (size_t)(BK * 2);
    const size_t hstep = (size_t)HALF * K * 2;
    const size_t tstep = 2 * hstep;
    const unsigned ldsw = (unsigned)wid * 1024u;
    const int aoff = lds_byte(wr * 64 + fr, fq * 8), boff = lds_byte(wc * 32 + fr, fq * 8);
#define PG8_SA(b, h) (((b) * 2 + (h)) * HTB)
#define PG8_SB(b, h) ((4 + (b) * 2 + (h)) * HTB)
#define PG8_STAGE(bufoff, gbase, voff) do { _Pragma("unroll") for (int _i = 0; _i < 2; ++_i) \
        __builtin_amdgcn_global_load_lds((const unsigned*)((const char*)(gbase) + (voff)[_i]), (PG8_LAS unsigned*)(lds + (bufoff) + ldsw + _i * 8192), 16, 0, 0); } while (0)
#define PG8_LDA(dst, b, h) do { _Pragma("unroll") for (int m = 0; m < 4; ++m) _Pragma("unroll") for (int k = 0; k < 2; ++k) dst[m][k] = *(const PG8_LAS bf16x8*)(lds + PG8_SA(b, h) + aoff + m * 2048 + k * 1024); } while (0)
#define PG8_LDB(dst, b, h) do { _Pragma("unroll") for (int n = 0; n < 2; ++n) _Pragma("unroll") for (int k = 0; k < 2; ++k) dst[n][k] = *(const PG8_LAS bf16x8*)(lds + PG8_SB(b, h) + boff + n * 2048 + k * 1024); } while (0)
#define PG8_MMA(ai, bj, At, Bt) do { __builtin_amdgcn_s_setprio(1); _Pragma("unroll") for (int m = 0; m < 4; ++m) _Pragma("unroll") for (int n = 0; n < 2; ++n) _Pragma("unroll") for (int k = 0; k < 2; ++k) \
        acc[ai][bj][m][n] = __builtin_amdgcn_mfma_f32_16x16x32_bf16(Bt[n][k], At[m][k], acc[ai][bj][m][n], 0, 0, 0); __builtin_amdgcn_s_setprio(0); } while (0)
#define PG8_WAIT_V(n) asm volatile("s_waitcnt vmcnt(" #n ")" ::: "memory")
#define PG8_WAIT_L(n) asm volatile("s_waitcnt lgkmcnt(" #n ")" ::: "memory")
#define PG8_BAR __builtin_amdgcn_s_barrier()
#define PG8_SCHED __builtin_amdgcn_sched_barrier(0)
    Unit cur, nxt; int ui = 0;
    if (!S.next(0, cur)) return;
    f32x4 acc[2][2][4][2];
#pragma unroll
    for (int a = 0; a < 2; ++a)
#pragma unroll
        for (int b = 0; b < 2; ++b)
#pragma unroll
            for (int m = 0; m < 4; ++m)
#pragma unroll
                for (int n = 0; n < 2; ++n) acc[a][b][m][n] = (f32x4){0.f, 0.f, 0.f, 0.f};
    bf16x8 At[4][2], B0[2][2], B1[2][2];
    const char* cA = (const char*)g.A + (size_t)cur.z * g.zA + (size_t)cur.pm * tstep; const char* cB = (const char*)g.Bt + (size_t)cur.z * g.zB + (size_t)cur.pn * tstep;
    S.a_ready(cur);
    if constexpr (SP2) {
        PG8_STAGE(PG8_SB(0, 0), cB, voffB); PG8_STAGE(PG8_SB(0, 1), cB + hstep, voffB); PG8_STAGE(PG8_SA(0, 0), cA, voffA); PG8_STAGE(PG8_SA(0, 1), cA + hstep, voffA);
        if (wr == 1) PG8_BAR;
        PG8_WAIT_V(2); PG8_BAR;
        PG8_STAGE(PG8_SB(1, 0), cB + kstep, voffB); PG8_STAGE(PG8_SA(1, 0), cA + kstep, voffA); PG8_STAGE(PG8_SB(1, 1), cB + hstep + kstep, voffB);
        PG8_WAIT_V(6); PG8_BAR;
    } else {
        PG8_STAGE(PG8_SB(0, 0), cB, voffB); PG8_STAGE(PG8_SA(0, 0), cA, voffA); PG8_STAGE(PG8_SB(0, 1), cB + hstep, voffB); PG8_STAGE(PG8_SA(0, 1), cA + hstep, voffA);
        if (wr == 1) PG8_BAR;
        PG8_WAIT_V(4); PG8_BAR;
        PG8_STAGE(PG8_SB(1, 0), cB + kstep, voffB); PG8_STAGE(PG8_SA(1, 0), cA + kstep, voffA); PG8_STAGE(PG8_SB(1, 1), cB + hstep + kstep, voffB);
        PG8_WAIT_V(6); PG8_BAR;
    }
    for (;;) {
        const bool has_next = S.next(ui + 1, nxt);
        const char* nA = has_next ? (const char*)g.A + (size_t)nxt.z * g.zA + (size_t)nxt.pm * tstep : cA; const char* nB = has_next ? (const char*)g.Bt + (size_t)nxt.z * g.zB + (size_t)nxt.pn * tstep : cB;
        for (int t = 0; t < nt; t += 2) {
            const bool last = (t == nt - 2);
            const char* a1 = cA + (size_t)(t + 1) * kstep;
            const char* a2 = last ? nA : cA + (size_t)(t + 2) * kstep; const char* b2 = last ? nB : cB + (size_t)(t + 2) * kstep;
            const char* a3 = a2 + kstep; const char* b3 = b2 + kstep;
            if (last && has_next) S.a_ready(nxt);
            if constexpr (SP2) {
            PG8_LDB(B0, 0, 0); PG8_LDB(B1, 0, 1); PG8_SCHED; PG8_LDA(At, 0, 0); PG8_STAGE(PG8_SA(1, 1), a1 + hstep, voffA);
            PG8_WAIT_V(8); PG8_WAIT_L(0); PG8_BAR; PG8_MMA(0, 0, At, B0); PG8_MMA(0, 1, At, B1); PG8_BAR; PG8_SCHED;
            PG8_LDA(At, 0, 1); PG8_STAGE(PG8_SB(0, 0), b2, voffB); PG8_STAGE(PG8_SB(0, 1), b2 + hstep, voffB); PG8_STAGE(PG8_SA(0, 0), a2, voffA);
            PG8_WAIT_V(8); PG8_WAIT_L(0); PG8_BAR; PG8_MMA(1, 0, At, B0); PG8_MMA(1, 1, At, B1); PG8_BAR; PG8_SCHED;
            PG8_LDB(B0, 1, 0); PG8_LDB(B1, 1, 1); PG8_SCHED; PG8_LDA(At, 1, 0); PG8_STAGE(PG8_SA(0, 1), a2 + hstep, voffA);
            PG8_WAIT_V(8); PG8_WAIT_L(0); PG8_BAR; PG8_MMA(0, 0, At, B0); PG8_MMA(0, 1, At, B1); PG8_BAR; PG8_SCHED;
            PG8_LDA(At, 1, 1); PG8_STAGE(PG8_SB(1, 0), b3, voffB); PG8_STAGE(PG8_SB(1, 1), b3 + hstep, voffB); PG8_STAGE(PG8_SA(1, 0), a3, voffA);
            PG8_WAIT_V(8); PG8_WAIT_L(0); PG8_BAR; PG8_MMA(1, 0, At, B0); PG8_MMA(1, 1, At, B1); PG8_BAR; PG8_SCHED;
            } else {
            PG8_LDB(B0, 0, 0); PG8_SCHED; PG8_LDA(At, 0, 0); PG8_STAGE(PG8_SA(1, 1), a1 + hstep, voffA);
            PG8_WAIT_L(8); PG8_BAR; PG8_WAIT_L(0); PG8_MMA(0, 0, At, B0); PG8_BAR; PG8_SCHED;
            PG8_LDB(B1, 0, 1); PG8_STAGE(PG8_SB(0, 0), b2, voffB);
            PG8_BAR; PG8_WAIT_L(0); PG8_MMA(0, 1, At, B1); PG8_BAR;
            PG8_LDA(At, 0, 1); PG8_STAGE(PG8_SA(0, 0), a2, voffA);
            PG8_BAR; PG8_WAIT_L(0); PG8_MMA(1, 0, At, B0); PG8_BAR; PG8_SCHED;
            PG8_STAGE(PG8_SB(0, 1), b2 + hstep, voffB);
            PG8_WAIT_V(6); PG8_BAR; PG8_MMA(1, 1, At, B1); PG8_BAR;
            PG8_LDB(B0, 1, 0); PG8_SCHED; PG8_LDA(At, 1, 0); PG8_STAGE(PG8_SA(0, 1), a2 + hstep, voffA);
            PG8_WAIT_L(8); PG8_BAR; PG8_WAIT_L(0); PG8_MMA(0, 0, At, B0); PG8_BAR; PG8_SCHED;
            PG8_LDB(B1, 1, 1); PG8_STAGE(PG8_SB(1, 0), b3, voffB);
            PG8_BAR; PG8_WAIT_L(0); PG8_MMA(0, 1, At, B1); PG8_BAR;
            PG8_LDA(At, 1, 1); PG8_STAGE(PG8_SA(1, 0), a3, voffA);
            PG8_BAR; PG8_WAIT_L(0); PG8_MMA(1, 0, At, B0); PG8_BAR; PG8_SCHED;
            PG8_STAGE(PG8_SB(1, 1), b3 + hstep, voffB);
            PG8_WAIT_V(6); PG8_BAR; PG8_MMA(1, 1, At, B1); PG8_BAR;
            }
        }
        if constexpr (ALIGN_EPI) { if (wr == 0) PG8_BAR; }
        if constexpr (!Epi::AFTER_DRAIN) { E(acc, cur, wr, wc, fr, fq); S.done(cur); }
        if (!has_next) break;
        if constexpr (!Epi::KEEP_ACC)
#pragma unroll
        for (int a = 0; a < 2; ++a)
#pragma unroll
            for (int b = 0; b < 2; ++b)
#pragma unroll
                for (int m = 0; m < 4; ++m)
#pragma unroll
                    for (int n = 0; n < 2; ++n) acc[a][b][m][n] = (f32x4){0.f, 0.f, 0.f, 0.f};
        cur = nxt; cA = nA; cB = nB; ++ui;
        if constexpr (ALIGN_EPI) { if (wr == 1) PG8_BAR; }
    }
    PG8_WAIT_V(0);
    if constexpr (!ALIGN_EPI) { if (wr == 0) PG8_BAR; }
    PG8_BAR;
    if constexpr (Epi::AFTER_DRAIN) { E.fused(acc, cur, wr, wc, fr, fq, lds, wid, lane); S.done(cur); }
#undef PG8_SA
#undef PG8_SB
#undef PG8_STAGE
#undef PG8_LDA
#undef PG8_LDB
#undef PG8_MMA
#undef PG8_WAIT_V
#undef PG8_WAIT_L
#undef PG8_BAR
#undef PG8_SCHED
}
}

constexpr int T = 16384, D = 1024, SEQ = 2048, DEPTH = 2, FF = 4096, PLE = 256;
constexpr float RMS_EPS = 1e-6f;
constexpr size_t MiB = 1u << 20;
constexpr size_t WS_CTL = 0, CTL_ZERO_BYTES = 65536;
constexpr size_t WS_TAB = 1 * MiB;
constexpr size_t WS_SSA = 2 * MiB, WS_SSB = 3 * MiB;
constexpr size_t WS_PROJ = 6 * MiB, BLK = 16 * MiB;
constexpr size_t WS_GATE8 = 150 * MiB;
constexpr size_t WS_XB = 198 * MiB;
constexpr size_t WS_W = 230 * MiB, WS_END = 256 * MiB;
constexpr size_t W_IN = WS_W, W_UP = WS_W, W_DOWN = WS_W + 8 * MiB, W_BR = WS_W + 16 * MiB, W_OUT = WS_W + 19 * MiB;
__host__ __device__ constexpr size_t W_G(int slot) { return WS_W + 21 * MiB + (size_t)slot * (5 * MiB / 2); }
__host__ __device__ constexpr size_t W_PLE(int slot) { return W_G(slot) + 2 * MiB; }
constexpr size_t WS_U = WS_PROJ;
constexpr size_t WS_E = WS_PROJ;
constexpr size_t DO_WIN = 32 * MiB, DO_MID = 56 * MiB;
constexpr size_t DO_PB = 48 * MiB;
constexpr size_t WS_HF = WS_PROJ + 1 * BLK;
constexpr size_t WS_AGG = 4 * MiB;
constexpr size_t WS_LW = 5 * MiB;
constexpr size_t WS_SP = 5 * MiB + 512 * 1024;
constexpr size_t WS_MERGED = WS_PROJ + 1 * BLK;
constexpr size_t WS_ST = WS_XB;
constexpr int CW_TMO = 0, CW_BAR = 4096;

enum { PH_PRO = 0, PH_G1, PH_MIXA, PH_MIXB, PH_G2, PH_G3, PH_G4, PH_G5, PH_G6, PH_FIN };
constexpr int NPL = 8, NPH = 1 + DEPTH * NPL + 1;

constexpr int NWAVES = 8;
constexpr int RING_BYTES = 131072, LDS_BYTES = 155648, LDSCTL_OFF = LDS_BYTES - 1024, MISC_OFF = LDSCTL_OFF + 320;

#define GAS __attribute__((address_space(1)))
#define LAS __attribute__((address_space(3)))
typedef unsigned short bf16;
typedef unsigned v4u __attribute__((ext_vector_type(4)));
typedef unsigned v2u __attribute__((ext_vector_type(2)));
typedef float f32x4 __attribute__((ext_vector_type(4)));
typedef GAS unsigned gu32;
#define RLX_AGENT __ATOMIC_RELAXED, __HIP_MEMORY_SCOPE_AGENT
#define LDS_WAIT() asm volatile("s_waitcnt lgkmcnt(0)" ::: "memory")
#define VM_WAIT() asm volatile("s_waitcnt vmcnt(0)" ::: "memory")
__device__ __forceinline__ unsigned f2bf(float f) { unsigned u = __builtin_bit_cast(unsigned, f); return (u + 0x7fffu + ((u >> 16) & 1u)) >> 16; }
__device__ __forceinline__ unsigned pk2(float lo, float hi) { return f2bf(lo) | (f2bf(hi) << 16); }
__device__ __forceinline__ float bf2f(unsigned short b) { return __builtin_bit_cast(float, (unsigned)b << 16); }
__device__ __forceinline__ float bflo(unsigned w) { return __builtin_bit_cast(float, w << 16); }
__device__ __forceinline__ float bfhi(unsigned w) { return __builtin_bit_cast(float, w & 0xffff0000u); }
__device__ __forceinline__ float rdlane(float v, int l) { return __builtin_bit_cast(float, __builtin_amdgcn_readlane(__builtin_bit_cast(int, v), l)); }
__device__ __forceinline__ float fexp(float x) { return __builtin_amdgcn_exp2f(x * 1.4426950408889634f); }
__device__ __forceinline__ float sigmoidf_(float x) { return __builtin_amdgcn_rcpf(1.0f + fexp(-x)); }
__device__ __forceinline__ float lane_get(float v, int srclane) { return __builtin_bit_cast(float, __builtin_amdgcn_ds_bpermute(srclane << 2, __builtin_bit_cast(int, v))); }
__device__ __forceinline__ float shx(float v, int lane, int o) { return lane_get(v, lane ^ o); }
__device__ __forceinline__ float wave_sum(float v, int lane) {
#pragma unroll
    for (int o = 1; o < 64; o <<= 1) v += shx(v, lane, o);
    return v;
}
__device__ __forceinline__ float wave_max(float v, int lane) {
#pragma unroll
    for (int o = 1; o < 64; o <<= 1) v = fmaxf(v, shx(v, lane, o));
    return v;
}
__device__ __forceinline__ float log2_1m(float x) {
    const float p = x * (1.0f + x * (0.5f + x * (0.33333333f + x * (0.25f + x * (0.2f + x * (0.16666667f + x * 0.14285714f))))));
    return -p * 1.4426950408889634f;
}
__device__ __forceinline__ float log1p_small(float y) {
    if (y < 0.01f) return y * (1.0f - y * (0.5f - y * (0.33333333f - 0.25f * y)));
    return __builtin_amdgcn_logf(1.0f + y) * 0.6931471805599453f;
}
__device__ __forceinline__ float gelu_tanh(float x) {
    const float u = 0.7978845608028654f * (x + 0.044715f * x * x * x);
    const float t = 1.0f - 2.0f * __builtin_amdgcn_rcpf(1.0f + fexp(2.0f * u));
    return 0.5f * x * (1.0f + t);
}
__device__ __forceinline__ float row_rs(const float* ss, int row, int fq, int lane) {
    const f32x4 a = *(const f32x4*)(ss + (size_t)row * 16 + 4 * fq);
    float s = (a.x + a.y) + (a.z + a.w);
    s += shx(s, lane, 16); s += shx(s, lane, 32);
    return 1.0f / sqrtf(s * (1.0f / D) + RMS_EPS);
}

#define XB_TMO      128
#define XB_XCNT(j)  (256  + 64 * (j))
#define XB_XSUB(j)  (1280 + 64 * (j))
#define XB_XGEN(j)  (2304 + 64 * (j))
#define XB_TOP      3328
#define XB_TOPGEN   3392
#define XCD_BAR_WORDS 3456
#define XB_SPIN_CAP (1u << 18)

__device__ __forceinline__ unsigned xb_ld(unsigned* p)              { return __hip_atomic_load(p, __ATOMIC_RELAXED, __HIP_MEMORY_SCOPE_AGENT); }
__device__ __forceinline__ unsigned xb_add(unsigned* p, unsigned v) { return __hip_atomic_fetch_add(p, v, __ATOMIC_RELAXED, __HIP_MEMORY_SCOPE_AGENT); }
__device__ __forceinline__ unsigned xb_xcc_id() { return (unsigned)__builtin_amdgcn_s_getreg((3 << 11) | 20) & 0xFu; }
#define XB_SPIN(cond, bar) do { unsigned _sp = 0; while (cond) { __builtin_amdgcn_s_sleep(1); \
    if ((++_sp & 255u) == 0u) { if (xb_ld(&(bar)[XB_TMO])) break; if (_sp > XB_SPIN_CAP) { atomicAdd(&(bar)[XB_TMO], 1u); break; } } } } while (0)

struct XcdBarrier {
    unsigned* bar; unsigned x;
    volatile LAS unsigned* st;
};

__device__ __forceinline__ XcdBarrier xcd_barrier_post(unsigned* bar, volatile LAS unsigned* st) {
    XcdBarrier b; b.bar = bar; b.x = xb_xcc_id(); b.st = st;
    if (threadIdx.x == 0) (void)xb_add(&bar[XB_XCNT(b.x)], 1u);
    return b;
}
__device__ __forceinline__ void xcd_barrier_complete(unsigned* bar, unsigned x, unsigned& nloc, unsigned& nx) {
    const unsigned G = gridDim.x * gridDim.y * gridDim.z;
    unsigned sum, cnt, mine, sp = 0u;
    for (;;) {
        sum = 0u; cnt = 0u; mine = 0u;
#pragma unroll
        for (unsigned j = 0; j < 16; ++j) { const unsigned c = xb_ld(&bar[XB_XCNT(j)]); sum += c; cnt += (c > 0u) ? 1u : 0u; mine = (j == x) ? c : mine; }
        if (sum == G) break;
        __builtin_amdgcn_s_sleep(1);
        if ((++sp & 255u) == 0u) { if (xb_ld(&bar[XB_TMO])) break; if (sp > XB_SPIN_CAP) { atomicAdd(&bar[XB_TMO], 1u); break; } }
    }
    nloc = mine > 0u ? mine : 1u; nx = cnt > 0u ? cnt : 1u;
}

__device__ __forceinline__ void xcd_barrier(const XcdBarrier& b, const int tid_) {
    asm volatile("s_waitcnt vmcnt(0)" ::: "memory");
    __syncthreads();
    if (tid_ == 0) {
        unsigned* bar = b.bar;
        __builtin_amdgcn_s_waitcnt(0);
        unsigned nloc = b.st[0], nx = b.st[1];
        if (nloc == 0u) { xcd_barrier_complete(bar, b.x, nloc, nx); b.st[0] = nloc; b.st[1] = nx; }
        const unsigned old = xb_add(&bar[XB_XSUB(b.x)], 1u);
        const unsigned gen = old / nloc;
        if (old + 1u == (gen + 1u) * nloc) {
            __builtin_amdgcn_fence(__ATOMIC_RELEASE, "agent");
            asm volatile("s_waitcnt vmcnt(0)" ::: "memory");
            const unsigned og = xb_add(&bar[XB_TOP], 1u);
            const unsigned tg = og / nx;
            if (og + 1u == (tg + 1u) * nx) xb_add(&bar[XB_TOPGEN], 1u);
            else XB_SPIN(xb_ld(&bar[XB_TOPGEN]) == tg, bar);
            __builtin_amdgcn_fence(__ATOMIC_ACQUIRE, "agent");
            xb_add(&bar[XB_XGEN(b.x)], 1u);
            asm volatile("s_waitcnt vmcnt(0)" ::: "memory");
        } else {
            XB_SPIN(xb_ld(&bar[XB_XGEN(b.x)]) == gen, bar);
            __builtin_amdgcn_fence(__ATOMIC_ACQUIRE, "agent");
            asm volatile("s_waitcnt vmcnt(0)" ::: "memory");
        }
    }
    __syncthreads();
}


constexpr int LO_RSL = 131072, LO_RSPM = LO_RSL + 8 * 256 * 4, LO_BGL = LO_RSPM + 64;
__device__ __forceinline__ float rs_lookup(const LAS unsigned char* lds, int pm, int rowl) {
    const LAS int* spm = (const LAS int*)(lds + LO_RSPM); int sl = 0;
#pragma unroll
    for (int i = 1; i < 8; ++i) sl = spm[i] == pm ? i : sl;
    return ((const LAS float*)(lds + LO_RSL))[sl * 256 + rowl];
}
using pg8::Unit; using pg8::bf16_t; using pg8::cvt_pk_bf16;
typedef pg8::u32x4 u32x4;
struct EpiG1 {
    static constexpr bool PERM = true, AFTER_DRAIN = false, KEEP_ACC = false;
    bf16_t* proj; unsigned char* gate8; const LAS unsigned char* lds; const float* tab;
    __device__ __forceinline__ void operator()(const f32x4 (&acc)[2][2][4][2], const Unit& u, int wr, int wc, int fr, int fq) const {
        const int pn = u.pn;
        const int kind = pn >> 1, col0 = (pn & 1) * 256 + wc * 32 + 8 * fq;
        const bool rope = (pn < 18) && ((kind == 3) || (kind == 4));
        f32x4 cs[4][2], sn[4][2];
        if (rope) {
#pragma unroll
            for (int m = 0; m < 4; ++m)
#pragma unroll
                for (int bj = 0; bj < 2; ++bj) { const int row = u.pm * 256 + wr * 64 + m * 16 + fr, i0 = ((col0 + bj * 128) & 127) >> 1, pos = row & (SEQ - 1);
                    cs[m][bj] = *(const f32x4*)(tab + pos * 64 + i0); sn[m][bj] = *(const f32x4*)(tab + 131072 + pos * 64 + i0); }
        }
        float rsv[2][4];
#pragma unroll
        for (int ai = 0; ai < 2; ++ai)
#pragma unroll
            for (int m = 0; m < 4; ++m) rsv[ai][m] = rs_lookup(lds, u.pm, ai * 128 + wr * 64 + m * 16 + fr);
        if (pn < 18) {
            const int phys = (int)((0x683754210ull >> (4 * kind)) & 15ull);
            bf16_t* base = proj + (size_t)phys * ((size_t)T * 512);
            const float scale = kind == 0 ? 0.125f : (kind == 3 ? 0.08838834764831845f : 1.0f);
#pragma unroll
            for (int ai = 0; ai < 2; ++ai) {
                if (rope && ai == 1) {
#pragma unroll
                    for (int m = 0; m < 4; ++m)
#pragma unroll
                        for (int bj = 0; bj < 2; ++bj) { const int row = u.pm * 256 + ai * 128 + wr * 64 + m * 16 + fr, i0 = ((col0 + bj * 128) & 127) >> 1, pos = row & (SEQ - 1);
                            cs[m][bj] = *(const f32x4*)(tab + pos * 64 + i0); sn[m][bj] = *(const f32x4*)(tab + 131072 + pos * 64 + i0); }
                }
#pragma unroll
                for (int m = 0; m < 4; ++m) {
                    const int row = u.pm * 256 + ai * 128 + wr * 64 + m * 16 + fr;
                    const float rs = rsv[ai][m] * scale;
                    bf16_t* rowp = base + (size_t)row * 512 + col0;
#pragma unroll
                    for (int bj = 0; bj < 2; ++bj) {
                        f32x4 v0 = acc[ai][bj][m][0] * rs, v1 = acc[ai][bj][m][1] * rs;
                        if (rope) {
                            const f32x4 c_ = cs[m][bj], s_ = sn[m][bj];
                            f32x4 w0, w1;
                            w0[0] = v0[0] * c_[0] - v0[1] * s_[0]; w0[1] = v0[0] * s_[0] + v0[1] * c_[0];
                            w0[2] = v0[2] * c_[1] - v0[3] * s_[1]; w0[3] = v0[2] * s_[1] + v0[3] * c_[1];
                            w1[0] = v1[0] * c_[2] - v1[1] * s_[2]; w1[1] = v1[0] * s_[2] + v1[1] * c_[2];
                            w1[2] = v1[2] * c_[3] - v1[3] * s_[3]; w1[3] = v1[2] * s_[3] + v1[3] * c_[3];
                            v0 = w0; v1 = w1;
                        }
                        u32x4 w; w.x = cvt_pk_bf16(v0[0], v0[1]); w.y = cvt_pk_bf16(v0[2], v0[3]); w.z = cvt_pk_bf16(v1[0], v1[1]); w.w = cvt_pk_bf16(v1[2], v1[3]);
                        *(u32x4*)(rowp + bj * 128) = w;
                    }
                }
            }
        } else {
            const int g0 = (pn - 18) * 256 + wc * 32 + 8 * fq;
            f32x4 bg[2][2];
#pragma unroll
            for (int bj = 0; bj < 2; ++bj) { const LAS float* bgl = (const LAS float*)(lds + LO_BGL) + g0 + bj * 128; bg[bj][0] = *(const LAS f32x4*)bgl; bg[bj][1] = *(const LAS f32x4*)(bgl + 4); }
#pragma unroll
            for (int ai = 0; ai < 2; ++ai)
#pragma unroll
                for (int m = 0; m < 4; ++m) {
                    const int row = u.pm * 256 + ai * 128 + wr * 64 + m * 16 + fr;
                    const float rs = rsv[ai][m];
#pragma unroll
                    for (int bj = 0; bj < 2; ++bj) {
                        const int gc = g0 + bj * 128;
                        const f32x4 v0 = acc[ai][bj][m][0] * rs + bg[bj][0], v1 = acc[ai][bj][m][1] * rs + bg[bj][1];
                        unsigned lo = 0, hi = 0;
#pragma unroll
                        for (int e = 0; e < 4; ++e) {
                            lo |= (unsigned)(sigmoidf_(v0[e]) * 255.0f + 0.5f) << (8 * e);
                            hi |= (unsigned)(sigmoidf_(v1[e]) * 255.0f + 0.5f) << (8 * e);
                        }
                        v2u w; w.x = lo; w.y = hi;
                        *(v2u*)(gate8 + (size_t)row * 3072 + gc) = w;
                    }
                }
        }
    }
};
struct EpiG2 {
    static constexpr bool PERM = false, AFTER_DRAIN = false, KEEP_ACC = true;
    const unsigned char* gate8; bf16_t* merged;
    __device__ __forceinline__ void operator()(f32x4 (&acc)[2][2][4][2], const Unit& u, int wr, int wc, int fr, int fq) const {
        const int col0 = u.pn * 256 + wc * 32 + 4 * fq;
        unsigned ga[2][4][2][2], gb[2][4][2][2];
#pragma unroll
        for (int ai = 0; ai < 2; ++ai)
#pragma unroll
            for (int m = 0; m < 4; ++m)
#pragma unroll
                for (int bj = 0; bj < 2; ++bj)
#pragma unroll
                    for (int n = 0; n < 2; ++n) {
                        const size_t o = (size_t)(u.pm * 256 + ai * 128 + wr * 64 + m * 16 + fr) * 3072 + col0 + bj * 128 + n * 16;
                        ga[ai][m][bj][n] = *(const unsigned*)(gate8 + o + u.z * 1024);
                        gb[ai][m][bj][n] = u.z < 2 ? *(const unsigned*)(gate8 + o + (u.z + 1) * 1024) : 0u;
                    }
#pragma unroll
        for (int ai = 0; ai < 2; ++ai)
#pragma unroll
            for (int m = 0; m < 4; ++m) {
                const int row = u.pm * 256 + ai * 128 + wr * 64 + m * 16 + fr;
#pragma unroll
                for (int bj = 0; bj < 2; ++bj)
#pragma unroll
                    for (int n = 0; n < 2; ++n) {
                        const int c = col0 + bj * 128 + n * 16;
                        const unsigned a_ = ga[ai][m][bj][n], b_ = gb[ai][m][bj][n];
                        f32x4 t = acc[ai][bj][m][n];
                        if (u.z < 2) {
#pragma unroll
                            for (int e = 0; e < 4; ++e) { const float a = (float)max((a_ >> (8 * e)) & 255u, 1u), b = (float)max((b_ >> (8 * e)) & 255u, 1u); t[e] = t[e] * a * __builtin_amdgcn_rcpf(b); }
                            acc[ai][bj][m][n] = t;
                        } else {
#pragma unroll
                            for (int e = 0; e < 4; ++e) t[e] *= (float)max((a_ >> (8 * e)) & 255u, 1u) * (1.0f / 255.0f);
                            v2u w; w.x = cvt_pk_bf16(t[0], t[1]); w.y = cvt_pk_bf16(t[2], t[3]);
                            *(v2u*)(merged + (size_t)row * 1024 + c) = w;
                            acc[ai][bj][m][n] = (f32x4){0.f, 0.f, 0.f, 0.f};
                        }
                    }
            }
    }
};
struct EpiRes {
    static constexpr bool PERM = false, AFTER_DRAIN = false, KEEP_ACC = false;
    const float* basef; const bf16_t* baseb; bf16_t* xb; float* ssout;
    __device__ __forceinline__ void operator()(const f32x4 (&acc)[2][2][4][2], const Unit& u, int wr, int wc, int fr, int fq) const {
        const int col0 = u.pn * 256 + wc * 32 + 4 * fq, lane = fr + 16 * fq;
#pragma unroll
        for (int ai = 0; ai < 2; ++ai) {
            f32x4 bv[4][2][2];
            if (basef) {
#pragma unroll
                for (int m = 0; m < 4; ++m)
#pragma unroll
                    for (int bj = 0; bj < 2; ++bj)
#pragma unroll
                        for (int n = 0; n < 2; ++n) bv[m][bj][n] = *(const f32x4*)(basef + (size_t)(u.pm * 256 + ai * 128 + wr * 64 + m * 16 + fr) * 1024 + col0 + bj * 128 + n * 16);
            } else {
                v2u bw[4][2][2];
#pragma unroll
                for (int m = 0; m < 4; ++m)
#pragma unroll
                    for (int bj = 0; bj < 2; ++bj)
#pragma unroll
                        for (int n = 0; n < 2; ++n) bw[m][bj][n] = *(const v2u*)(baseb + (size_t)(u.pm * 256 + ai * 128 + wr * 64 + m * 16 + fr) * 1024 + col0 + bj * 128 + n * 16);
#pragma unroll
                for (int m = 0; m < 4; ++m)
#pragma unroll
                    for (int bj = 0; bj < 2; ++bj)
#pragma unroll
                        for (int n = 0; n < 2; ++n) bv[m][bj][n] = (f32x4){bflo(bw[m][bj][n].x), bfhi(bw[m][bj][n].x), bflo(bw[m][bj][n].y), bfhi(bw[m][bj][n].y)};
            }
#pragma unroll
            for (int m = 0; m < 4; ++m) {
                const int row = u.pm * 256 + ai * 128 + wr * 64 + m * 16 + fr;
                float s = 0.f;
#pragma unroll
                for (int bj = 0; bj < 2; ++bj)
#pragma unroll
                    for (int n = 0; n < 2; ++n) {
                        const size_t off = (size_t)row * 1024 + col0 + bj * 128 + n * 16;
                        const f32x4 v = bv[m][bj][n] + acc[ai][bj][m][n];
                        v2u w; w.x = cvt_pk_bf16(v[0], v[1]); w.y = cvt_pk_bf16(v[2], v[3]);
                        *(v2u*)(xb + off) = w;
                        s += (v[0] * v[0] + v[1] * v[1]) + (v[2] * v[2] + v[3] * v[3]);
                    }
                s += shx(s, lane, 16); s += shx(s, lane, 32);
                if (fq == 0) ssout[(size_t)row * 16 + u.pn * 4 + wc] = s;
            }
        }
    }
};
struct EpiG4 {
    static constexpr bool PERM = true, AFTER_DRAIN = false, KEEP_ACC = false;
    bf16_t* U; const LAS unsigned char* lds;
    __device__ __forceinline__ void operator()(const f32x4 (&acc)[2][2][4][2], const Unit& u, int wr, int wc, int fr, int fq) const {
        const int col0 = u.pn * 256 + wc * 32 + 8 * fq;
        float rsv[2][4];
#pragma unroll
        for (int ai = 0; ai < 2; ++ai)
#pragma unroll
            for (int m = 0; m < 4; ++m) rsv[ai][m] = rs_lookup(lds, u.pm, ai * 128 + wr * 64 + m * 16 + fr);
#pragma unroll
        for (int ai = 0; ai < 2; ++ai)
#pragma unroll
            for (int m = 0; m < 4; ++m) {
                const int row = u.pm * 256 + ai * 128 + wr * 64 + m * 16 + fr;
                const float rs = rsv[ai][m];
                bf16_t* rowp = U + (size_t)row * FF + col0;
#pragma unroll
                for (int bj = 0; bj < 2; ++bj) {
                    f32x4 v0 = acc[ai][bj][m][0] * rs, v1 = acc[ai][bj][m][1] * rs;
#pragma unroll
                    for (int e = 0; e < 4; ++e) { const float a = fmaxf(v0[e], 0.f), b = fmaxf(v1[e], 0.f); v0[e] = a * a; v1[e] = b * b; }
                    u32x4 w; w.x = cvt_pk_bf16(v0[0], v0[1]); w.y = cvt_pk_bf16(v0[2], v0[3]); w.z = cvt_pk_bf16(v1[0], v1[1]); w.w = cvt_pk_bf16(v1[2], v1[3]);
                    *(u32x4*)(rowp + bj * 128) = w;
                }
            }
    }
};
struct EpiE {
    static constexpr bool PERM = false, AFTER_DRAIN = false, KEEP_ACC = false;
    bf16_t* E;
    __device__ __forceinline__ void operator()(const f32x4 (&acc)[2][2][4][2], const Unit& u, int wr, int wc, int fr, int fq) const {
        const int col0 = u.pn * 256 + wc * 32 + 4 * fq;
#pragma unroll
        for (int ai = 0; ai < 2; ++ai)
#pragma unroll
            for (int m = 0; m < 4; ++m) {
                const int row = u.pm * 256 + ai * 128 + wr * 64 + m * 16 + fr;
#pragma unroll
                for (int bj = 0; bj < 2; ++bj)
#pragma unroll
                    for (int n = 0; n < 2; ++n) { const f32x4 v = acc[ai][bj][m][n]; v2u w; w.x = cvt_pk_bf16(v[0], v[1]); w.y = cvt_pk_bf16(v[2], v[3]); *(v2u*)(E + (size_t)row * 1024 + col0 + bj * 128 + n * 16) = w; }
            }
    }
};
struct EpiG6 {
    static constexpr bool PERM = false, AFTER_DRAIN = false, KEEP_ACC = false;
    const bf16_t* baseb; bf16_t* xb; const LAS unsigned char* lds; float* ssout; const bf16_t* E;
    __device__ __forceinline__ void operator()(const f32x4 (&acc)[2][2][4][2], const Unit& u, int wr, int wc, int fr, int fq) const {
        const int col0 = u.pn * 256 + wc * 32 + 4 * fq, lane = fr + 16 * fq;
        float rsv[2][4];
#pragma unroll
        for (int ai = 0; ai < 2; ++ai)
#pragma unroll
            for (int m = 0; m < 4; ++m) rsv[ai][m] = rs_lookup(lds, u.pm, ai * 128 + wr * 64 + m * 16 + fr);
#pragma unroll
        for (int ai = 0; ai < 2; ++ai)
#pragma unroll
        for (int mh = 0; mh < 2; ++mh) {
            v2u bw[2][2][2], ew[2][2][2];
#pragma unroll
            for (int m2 = 0; m2 < 2; ++m2)
#pragma unroll
                for (int bj = 0; bj < 2; ++bj)
#pragma unroll
                    for (int n = 0; n < 2; ++n) { const size_t off = (size_t)(u.pm * 256 + ai * 128 + wr * 64 + (2 * mh + m2) * 16 + fr) * 1024 + col0 + bj * 128 + n * 16;
                        bw[m2][bj][n] = *(const v2u*)(baseb + off); ew[m2][bj][n] = *(const v2u*)(E + off); }
#pragma unroll
            for (int m2 = 0; m2 < 2; ++m2) {
                const int m = 2 * mh + m2;
                const int row = u.pm * 256 + ai * 128 + wr * 64 + m * 16 + fr;
                const float rs = rsv[ai][m];
                float s = 0.f;
#pragma unroll
                for (int bj = 0; bj < 2; ++bj)
#pragma unroll
                    for (int n = 0; n < 2; ++n) {
                        const size_t off = (size_t)row * 1024 + col0 + bj * 128 + n * 16;
                        const f32x4 a = acc[ai][bj][m][n] * rs; const v2u e_ = ew[m2][bj][n], b_ = bw[m2][bj][n];
                        const f32x4 e = (f32x4){bflo(e_.x), bfhi(e_.x), bflo(e_.y), bfhi(e_.y)};
                        f32x4 v = (f32x4){bflo(b_.x), bfhi(b_.x), bflo(b_.y), bfhi(b_.y)};
#pragma unroll
                        for (int k = 0; k < 4; ++k) v[k] += sigmoidf_(a[k]) * e[k];
                        v2u w; w.x = cvt_pk_bf16(v[0], v[1]); w.y = cvt_pk_bf16(v[2], v[3]);
                        *(v2u*)(xb + off) = w;
                        s += (v[0] * v[0] + v[1] * v[1]) + (v[2] * v[2] + v[3] * v[3]);
                    }
                s += shx(s, lane, 16); s += shx(s, lane, 32);
                if (fq == 0) ssout[(size_t)row * 16 + u.pn * 4 + wc] = s;
            }
            asm volatile("" ::: "memory");
        }
    }
};
struct ZOrder {
    pg8::StaticOrder S;
    __device__ __forceinline__ bool next(int i, Unit& u) const { if (!S.next(i / 3, u)) return false; u.z = i % 3; return true; }
    __device__ __forceinline__ void a_ready(const Unit&) const {}
    __device__ __forceinline__ void done(const Unit&) const {}
};

struct Args { const float* in[23]; float* out; unsigned char* ws; int ph_lo, ph_hi; };
typedef const __attribute__((address_space(4))) Args CArgs;
__device__ __forceinline__ CArgs* get_args() {
    CArgs* p = (CArgs*)__builtin_amdgcn_kernarg_segment_ptr();
    asm volatile("" : "+s"(p));
    return p;
}
struct Frame {
    LAS unsigned char* lds;
    int wave0, G, ngw, bid;
    float* out; unsigned char* ws;
    __device__ __forceinline__ int ltid() const { int t = wave0 * 64 + (int)__builtin_amdgcn_mbcnt_hi(~0u, __builtin_amdgcn_mbcnt_lo(~0u, 0u)); asm volatile("" : "+v"(t)); return t; }
    __device__ __forceinline__ int lane() const { return ltid() & 63; }
    __device__ __forceinline__ int wave() const { int w_ = wave0; asm volatile("" : "+s"(w_)); return w_; }
    __device__ __forceinline__ int gw() const { return bid * NWAVES + wave(); }
};

__device__ __forceinline__ void transpose_item(const float* W, const float* g, int K, int N, bf16* WT, LAS float* scr, int item, int lane) {
    const int nblk = N / 32, kb = item / nblk, nb = item % nblk, k0 = 64 * kb, n0 = 32 * nb;
#pragma unroll
    for (int i = 0; i < 32; ++i) { const int kk = 2 * i + (lane >> 5); float v = W[(size_t)(k0 + kk) * N + n0 + (lane & 31)]; if (g) v *= g[k0 + kk]; scr[kk * 33 + (lane & 31)] = v; }
    LDS_WAIT(); asm volatile("" ::: "memory");
    const int c = lane & 7;
#pragma unroll
    for (int j = 0; j < 4; ++j) { const int n = (lane >> 3) + 8 * j; const LAS float* s = scr + (8 * c) * 33 + n;
        v4u o; o.x = pk2(s[0 * 33], s[1 * 33]); o.y = pk2(s[2 * 33], s[3 * 33]); o.z = pk2(s[4 * 33], s[5 * 33]); o.w = pk2(s[6 * 33], s[7 * 33]);
        *(v4u*)(WT + (size_t)(n0 + n) * K + k0 + 8 * c) = o; }
    LDS_WAIT(); asm volatile("" ::: "memory");
}
__device__ __forceinline__ void convert_matrix(const Frame& F, const float* W, const float* g, int K, int N, bf16* WT) {
    LAS float* scr = (LAS float*)(F.lds + F.wave() * 16384);
    const int nitems = (K / 64) * (N / 32);
    for (int it = F.gw(); it < nitems; it += F.ngw) transpose_item(W, g, K, N, WT, scr, it, F.lane());
}
__device__ __forceinline__ void convert_list(const Frame& F, CArgs* A, int l, bool early, bool mid) {
    LAS float* scr = (LAS float*)(F.lds + F.wave() * 16384);
    constexpr int I_IN = (D / 64) * (7680 / 32), I_BR = (512 / 64) * (D / 32), I_SQ = (D / 64) * (D / 32), I_PLE = (PLE / 64) * (D / 32);
    const int n_early = early ? I_IN : 0, n_mid = mid ? 3 * I_BR + 2 * I_SQ + I_PLE : 0, lane = F.lane();
    for (int it = F.gw(); it < n_early + n_mid; it += F.ngw) {
        int r = it;
        if (r < n_early) { transpose_item(A->in[3] + (size_t)l * D * 7680, A->in[2] + l * D, D, 7680, (bf16*)(F.ws + W_IN), scr, r, lane); continue; } r -= n_early;
        if (r < 3 * I_BR) { const int n = r / I_BR; transpose_item(A->in[14] + ((size_t)l * 3 + n) * 512 * D, nullptr, 512, D, (bf16*)(F.ws + W_BR) + (size_t)n * D * 512, scr, r - n * I_BR, lane); continue; } r -= 3 * I_BR;
        if (r < I_SQ) { transpose_item(A->in[15] + (size_t)l * D * D, nullptr, D, D, (bf16*)(F.ws + W_OUT), scr, r, lane); continue; } r -= I_SQ;
        if (r < I_SQ) { transpose_item(A->in[20] + (size_t)l * D * D, A->in[19] + l * D, D, D, (bf16*)(F.ws + W_G(l & 1)), scr, r, lane); continue; } r -= I_SQ;
        transpose_item(A->in[21] + (size_t)l * PLE * D, nullptr, PLE, D, (bf16*)(F.ws + W_PLE(l & 1)), scr, r, lane);
    }
}
__device__ __forceinline__ void convert_layer_early(const Frame& F, CArgs* A, int l) { convert_list(F, A, l, true, false); }
__device__ __forceinline__ void convert_layer_mid(const Frame& F, CArgs* A, int l) { convert_list(F, A, l, false, true); }
__device__ __forceinline__ void convert_layer_mlp(const Frame& F, CArgs* A, int l) {
    LAS float* scr = (LAS float*)(F.lds + F.wave() * 16384);
    constexpr int I_UP = (D / 64) * (FF / 32); const int lane = F.lane();
    for (int it = F.gw(); it < 2 * I_UP; it += F.ngw) {
        if (it < I_UP) transpose_item(A->in[17] + (size_t)l * D * FF, A->in[16] + l * D, D, FF, (bf16*)(F.ws + W_UP), scr, it, lane);
        else transpose_item(A->in[18] + (size_t)l * FF * D, nullptr, FF, D, (bf16*)(F.ws + W_DOWN), scr, it - I_UP, lane);
    }
}

template <class Sched>
__device__ __forceinline__ void stage_epilogue_tables(const Frame& F, const float* ss, const Sched& S, const float* bgate) {
    const int tid = F.ltid(), lane = tid & 63;
    LAS float* rsl = (LAS float*)(F.lds + LO_RSL); LAS int* spm = (LAS int*)(F.lds + LO_RSPM);
    __syncthreads();
    f32x4 sp[4][4]; int pmv[4];
#pragma unroll
    for (int j = 0; j < 4; ++j) { pg8::Unit u; const int i = 2 * j + (tid >> 8); pmv[j] = S.next(i, u) ? u.pm : -1;
        const int row = (pmv[j] < 0 ? 0 : pmv[j]) * 256 + (tid & 255);
#pragma unroll
        for (int q = 0; q < 4; ++q) sp[j][q] = *(const f32x4*)(ss + (size_t)row * 16 + 4 * q); }
#pragma unroll
    for (int j = 0; j < 4; ++j) { const int i = 2 * j + (tid >> 8);
        const f32x4 a = (sp[j][0] + sp[j][1]) + (sp[j][2] + sp[j][3]);
        rsl[i * 256 + (tid & 255)] = 1.0f / sqrtf(((a.x + a.y) + (a.z + a.w)) * (1.0f / D) + RMS_EPS);
        if ((tid & 255) == 0) spm[i] = pmv[j]; }
    if (bgate) { LAS float* bg = (LAS float*)(F.lds + LO_BGL); for (int e = tid; e < 3072; e += NWAVES * 64) bg[e] = bgate[e]; }
    (void)lane;
    __syncthreads();
}
__device__ __forceinline__ void phase_prologue(const Frame& F, CArgs* A) {
    convert_list(F, A, 0, true, true);
    const float* x = A->in[0]; bf16* xb = (bf16*)(F.ws + WS_XB); float* ss = (float*)(F.ws + WS_SSB);
    { const int lane = F.lane();
      for (int m0 = F.gw() * 4; m0 < T; m0 += F.ngw * 4) {
        f32x4 v[4][4];
#pragma unroll
        for (int r = 0; r < 4; ++r)
#pragma unroll
            for (int j = 0; j < 4; ++j) v[r][j] = ((const f32x4*)(x + (size_t)(m0 + r) * D) + lane)[64 * j];
#pragma unroll
        for (int r = 0; r < 4; ++r) {
            v2u* o = (v2u*)(xb + (size_t)(m0 + r) * D) + lane;
            float s = 0.f;
#pragma unroll
            for (int j = 0; j < 4; ++j) { const f32x4 t = v[r][j]; s += (t.x * t.x + t.y * t.y) + (t.z * t.z + t.w * t.w); v2u w; w.x = pk2(t.x, t.y); w.y = pk2(t.z, t.w); o[64 * j] = w; }
            s = wave_sum(s, lane);
            if (lane < 16) ss[(size_t)(m0 + r) * 16 + lane] = lane == 0 ? s : 0.f;
        }
      } }
    { bf16* lw = (bf16*)(F.ws + WS_LW);
      for (int e = F.gw() * 64 + F.lane(); e < DEPTH * 2 * 2 * 8 * 4096; e += F.ngw * 64) {
          const int mat = e >> 12, j = (e >> 6) & 63, i = e & 63, blk = mat & 7, ax = (mat >> 3) & 1, ld = mat >> 4;
          const float* src = (ax ? A->in[11] : A->in[9]) + ((size_t)ld * 8 + blk) * 4096;
          lw[e] = (bf16)f2bf(src[i * 64 + j]); }
      float* sp = (float*)(F.ws + WS_SP);
      for (int e = F.gw() * 64 + F.lane(); e < DEPTH * 2 * 512; e += F.ngw * 64) sp[e] = log1p_small(fexp(-A->in[13][e])); }
    float* tab = (float*)(F.ws + WS_TAB);
    for (int e = F.gw() * 64 + F.lane(); e < SEQ * 64; e += F.ngw * 64) {
        const int pos = e >> 6, i = e & 63;
        const float theta = __builtin_amdgcn_exp2f(-(float)i * (13.287712379549449f / 63.0f));
        double rev = (double)pos * (double)theta * 0.15915494309189535; rev -= __builtin_floor(rev);
        const float fr = (float)rev;
        tab[e] = __builtin_amdgcn_cosf(fr); tab[131072 + e] = __builtin_amdgcn_sinf(fr);
    }
}


typedef short bf16x8_t __attribute__((ext_vector_type(8)));
typedef float f32x2_t __attribute__((ext_vector_type(2))); typedef __bf16 bf16x2_t __attribute__((ext_vector_type(2)));
__device__ __forceinline__ unsigned pkbf(float lo, float hi) { f32x2_t v = {lo, hi}; bf16x2_t b = __builtin_convertvector(v, bf16x2_t); return __builtin_bit_cast(unsigned, b); }
typedef short v4i16_t __attribute__((ext_vector_type(4)));
__device__ __forceinline__ v4i16_t ds_tr16(LAS const unsigned char* p) { return __builtin_amdgcn_ds_read_tr16_b64_v4i16((LAS v4i16_t*)p); }
__device__ __forceinline__ bf16x8_t tr_frag(LAS const unsigned char* p0, LAS const unsigned char* p1) {
    const v4i16_t a = ds_tr16(p0), b = ds_tr16(p1);
    return (bf16x8_t){a[0], a[1], a[2], a[3], b[0], b[1], b[2], b[3]};
}
#define MFMA16(a, b, c) __builtin_amdgcn_mfma_f32_16x16x32_bf16((a), (b), (c), 0, 0, 0)
constexpr int RP = 272;
__device__ __forceinline__ void ret_scan_item(const Frame& F, int item) {
    const int bh = item >> 3, dir = (item >> 2) & 1, dvq = item & 3, b = bh >> 2, h = bh & 3;
    const bf16* Kg = (const bf16*)(F.ws + WS_PROJ + 5 * BLK); const bf16* Vg = (const bf16*)(F.ws + WS_PROJ + 7 * BLK);
    bf16* ST = (bf16*)F.out;
    const float lg = log2_1m(__builtin_amdgcn_exp2f((dir ? -5.5f : -5.0f) - (float)h));
    const float cdec = __builtin_amdgcn_exp2f(128.0f * lg);
    constexpr int VP = 80, BUF = 128 * RP + 128 * VP;
    const int tid = F.ltid(), lane = F.lane(), w = F.wave(), g = lane >> 4, i = lane & 15, q4 = i >> 2, p4 = i & 3;
    v4u kr0[4], kr1[4], vr0, vr1;
    const int vrow = tid >> 2, vch = tid & 3;
#define RS_LOAD(kr, vr, c_) do { const size_t tb = (size_t)b * SEQ + (c_) * 128; \
        _Pragma("unroll") for (int q = 0; q < 4; ++q) { const int idx = tid + 512 * q; kr[q] = *(const v4u*)(Kg + (tb + (idx >> 4)) * 512 + h * 128 + (idx & 15) * 8); } \
        vr = *(const v4u*)(Vg + (tb + vrow) * 512 + h * 128 + dvq * 32 + vch * 8); } while (0)
#define RS_WRITE(kr, vr, buf_) do { LAS unsigned char* Kb_ = F.lds + (buf_) * BUF; LAS unsigned char* Vb_ = Kb_ + 128 * RP; \
        _Pragma("unroll") for (int q = 0; q < 4; ++q) { const int idx = tid + 512 * q, row = idx >> 4; \
            const float dk_ = __builtin_amdgcn_exp2f((float)(dir ? row : 127 - row) * lg); v4u o; \
            _Pragma("unroll") for (int e = 0; e < 4; ++e) o[e] = pkbf(bflo(kr[q][e]) * dk_, bfhi(kr[q][e]) * dk_); \
            *(LAS v4u*)(Kb_ + row * RP + (idx & 15) * 16) = o; } \
        *(LAS v4u*)(Vb_ + vrow * VP + vch * 16) = vr; } while (0)
#define RS_CHUNK(s_) (dir ? 15 - (s_) : (s_))
#define RS_STEP(s_, krN, vrN, krW, vrW) do { const int c = RS_CHUNK(s_), buf = (s_) & 1; \
        if ((s_) + 2 < 16) RS_LOAD(krN, vrN, RS_CHUNK((s_) + 2)); \
        bf16* dst = ST + ((size_t)(bh * 2 + dir) * 16 + c) * 16384; \
        _Pragma("unroll") for (int n = 0; n < 2; ++n) { v2u o; o.x = pkbf(acc[n][0], acc[n][1]); o.y = pkbf(acc[n][2], acc[n][3]); *(v2u*)(dst + (32 * dvq + 16 * n + i) * 128 + 16 * w + 4 * g) = o; } \
        acc[0] = acc[0] * cdec; acc[1] = acc[1] * cdec; \
        const LAS unsigned char* Kb = F.lds + buf * BUF; const LAS unsigned char* Vb = Kb + 128 * RP; \
        _Pragma("unroll") for (int ks = 0; ks < 4; ++ks) { const int r0 = 32 * ks + 8 * g + q4; \
            const bf16x8_t af = tr_frag(Kb + r0 * RP + (16 * w + 4 * p4) * 2, Kb + (r0 + 4) * RP + (16 * w + 4 * p4) * 2); \
            _Pragma("unroll") for (int n = 0; n < 2; ++n) { const bf16x8_t bv = tr_frag(Vb + r0 * VP + (16 * n + 4 * p4) * 2, Vb + (r0 + 4) * VP + (16 * n + 4 * p4) * 2); acc[n] = MFMA16(af, bv, acc[n]); } } \
        if ((s_) + 1 < 16) RS_WRITE(krW, vrW, buf ^ 1); \
        __syncthreads(); } while (0)
    __syncthreads();
    RS_LOAD(kr0, vr0, RS_CHUNK(0));
    RS_LOAD(kr1, vr1, RS_CHUNK(1));
    RS_WRITE(kr0, vr0, 0);
    __syncthreads();
    f32x4 acc[2]; acc[0] = (f32x4){0.f, 0.f, 0.f, 0.f}; acc[1] = acc[0];
    for (int s2 = 0; s2 < 16; s2 += 2) {
        RS_STEP(s2, kr0, vr0, kr1, vr1);
        RS_STEP(s2 + 1, kr1, vr1, kr0, vr0);
    }
#undef RS_STEP
#undef RS_CHUNK
#undef RS_LOAD
#undef RS_WRITE
}
__device__ __forceinline__ void ret_out_item(const Frame& F, const float* gn, int item) {
    const int bh = item >> 4, ci = item & 15, b = bh >> 2, h = bh & 3, t0 = b * SEQ + ci * 128;
    bf16* Gg = (bf16*)(F.ws + WS_PROJ + 3 * BLK); const bf16* Qg = (const bf16*)(F.ws + WS_PROJ + 4 * BLK);
    const bf16* Kg = (const bf16*)(F.ws + WS_PROJ + 5 * BLK); const bf16* Vg = (const bf16*)(F.ws + WS_PROJ + 7 * BLK);
    const bf16* ST = (const bf16*)F.out;
    const float lgf = log2_1m(__builtin_amdgcn_exp2f(-5.0f - (float)h)), lgb = log2_1m(__builtin_amdgcn_exp2f(-5.5f - (float)h));
    LAS unsigned char* Kl = F.lds; LAS unsigned char* Vl = F.lds + 128 * RP; LAS unsigned char* Sf = F.lds + 2 * 128 * RP; LAS unsigned char* Sb = F.lds + 3 * 128 * RP;
    const int lane = F.lane(), w = F.wave(), g = lane >> 4, i = lane & 15, q4 = i >> 2, p4 = i & 3;
    const int nl = 16 * w + i;
    bf16* grow = Gg + (size_t)(t0 + nl) * 512 + h * 128;
    bf16x8_t bq[4]; v2u ggv[8];
#pragma unroll
    for (int ks = 0; ks < 4; ++ks) bq[ks] = *(const bf16x8_t*)(Qg + (size_t)(t0 + nl) * 512 + h * 128 + 32 * ks + 8 * g);
#pragma unroll
    for (int n = 0; n < 8; ++n) ggv[n] = *(const v2u*)(grow + 16 * n + 4 * g);
    __syncthreads();
    {
#pragma unroll
        for (int q = 0; q < 4; ++q) {
            const int idx = F.ltid() + 512 * q, row = idx >> 4, ch = idx & 15;
            *(LAS v4u*)(Kl + row * RP + ch * 16) = *(const v4u*)(Kg + (size_t)(t0 + row) * 512 + h * 128 + ch * 8);
            *(LAS v4u*)(Vl + row * RP + ch * 16) = *(const v4u*)(Vg + (size_t)(t0 + row) * 512 + h * 128 + ch * 8);
        }
        const bf16* sfp = ST + ((size_t)(bh * 2 + 0) * 16 + ci) * 16384; const bf16* sbp = ST + ((size_t)(bh * 2 + 1) * 16 + ci) * 16384;
#pragma unroll
        for (int q = 0; q < 4; ++q) {
            const int idx = F.ltid() + 512 * q, row = idx >> 4, ch = idx & 15;
            *(LAS v4u*)(Sf + row * RP + ch * 16) = *(const v4u*)(sfp + idx * 8);
            *(LAS v4u*)(Sb + row * RP + ch * 16) = *(const v4u*)(sbp + idx * 8);
        }
    }
    __syncthreads();
    bf16x8_t bp[4];
#pragma unroll
    for (int kp = 0; kp < 4; ++kp) {
        f32x4 s0 = (f32x4){0.f, 0.f, 0.f, 0.f}, s1 = s0;
#pragma unroll
        for (int ks = 0; ks < 4; ++ks) {
            const bf16x8_t a0 = *(const LAS bf16x8_t*)(Kl + (32 * kp + i) * RP + (32 * ks + 8 * g) * 2);
            const bf16x8_t a1 = *(const LAS bf16x8_t*)(Kl + (32 * kp + 16 + i) * RP + (32 * ks + 8 * g) * 2);
            s0 = MFMA16(a0, bq[ks], s0); s1 = MFMA16(a1, bq[ks], s1);
        }
        float pv[8];
#pragma unroll
        for (int e = 0; e < 4; ++e) {
            const int m0 = 32 * kp + 4 * g + e, m1 = m0 + 16;
            const float d0 = (float)(nl - m0), d1 = (float)(nl - m1);
            pv[e] = s0[e] * (d0 >= 0.f ? __builtin_amdgcn_exp2f(d0 * lgf) : __builtin_amdgcn_exp2f(-d0 * lgb));
            pv[4 + e] = s1[e] * (d1 >= 0.f ? __builtin_amdgcn_exp2f(d1 * lgf) : __builtin_amdgcn_exp2f(-d1 * lgb));
        }
        v4u pk; pk.x = pkbf(pv[0], pv[1]); pk.y = pkbf(pv[2], pv[3]); pk.z = pkbf(pv[4], pv[5]); pk.w = pkbf(pv[6], pv[7]);
        bp[kp] = __builtin_bit_cast(bf16x8_t, pk);
    }
    f32x4 oi[8], of[8], ob[8];
#pragma unroll
    for (int n = 0; n < 8; ++n) { oi[n] = (f32x4){0.f, 0.f, 0.f, 0.f}; of[n] = oi[n]; ob[n] = oi[n]; }
#pragma unroll
    for (int kp = 0; kp < 4; ++kp) {
        const int r0 = (32 * kp + 4 * g + q4) * RP, r1 = r0 + 16 * RP;
#pragma unroll
        for (int n = 0; n < 8; ++n) { const bf16x8_t av = tr_frag(Vl + r0 + (16 * n + 4 * p4) * 2, Vl + r1 + (16 * n + 4 * p4) * 2); oi[n] = MFMA16(av, bp[kp], oi[n]); }
    }
#pragma unroll
    for (int ks = 0; ks < 4; ++ks)
#pragma unroll
        for (int n = 0; n < 8; ++n) {
            const bf16x8_t af = *(const LAS bf16x8_t*)(Sf + (16 * n + i) * RP + (32 * ks + 8 * g) * 2);
            const bf16x8_t ab = *(const LAS bf16x8_t*)(Sb + (16 * n + i) * RP + (32 * ks + 8 * g) * 2);
            of[n] = MFMA16(af, bq[ks], of[n]); ob[n] = MFMA16(ab, bq[ks], ob[n]);
        }
    const float qdf = __builtin_amdgcn_exp2f((float)(nl + 1) * lgf), qdb = __builtin_amdgcn_exp2f((float)(128 - nl) * lgb);
    float ss = 0.f;
#pragma unroll
    for (int n = 0; n < 8; ++n) { oi[n] = oi[n] + of[n] * qdf + ob[n] * qdb; ss += (oi[n][0] * oi[n][0] + oi[n][1] * oi[n][1]) + (oi[n][2] * oi[n][2] + oi[n][3] * oi[n][3]); }
    ss += shx(ss, lane, 16); ss += shx(ss, lane, 32);
    const float rn = 1.0f / sqrtf(ss * (1.0f / 128.0f) + RMS_EPS);
#pragma unroll
    for (int n = 0; n < 8; ++n) {
        const int dv0 = 16 * n + 4 * g;
        const v2u gg = ggv[n]; const f32x4 gw = *(const f32x4*)(gn + h * 128 + dv0);
        const float g0 = bflo(gg.x), g1 = bfhi(gg.x), g2 = bflo(gg.y), g3 = bfhi(gg.y);
        v2u o; o.x = pkbf(g0 * sigmoidf_(g0) * oi[n][0] * rn * gw[0], g1 * sigmoidf_(g1) * oi[n][1] * rn * gw[1]);
        o.y = pkbf(g2 * sigmoidf_(g2) * oi[n][2] * rn * gw[2], g3 * sigmoidf_(g3) * oi[n][3] * rn * gw[3]);
        *(v2u*)(grow + dv0) = o;
    }
}

constexpr int LO_WL = 0, LO_CST = 36864, LO_XC = 39680, LO_XF = 58688, LO_XB = 93504, LO_GY = 111936, LO_SEG = 130368, LO_HIN = 138560;
__device__ __forceinline__ void lru_stage_consts(const Frame& F, CArgs* A, int l, int blk) {
    const bf16* LW = (const bf16*)(F.ws + WS_LW); const float* SP = (const float*)(F.ws + WS_SP);
    __syncthreads();
#pragma unroll
    for (int q = 0; q < 4; ++q) { const int idx = F.ltid() + 512 * q, m = idx >> 9, row = (idx >> 3) & 63, ch = idx & 7;
        const int d = m >> 1, ax = m & 1;
        *(LAS v4u*)(F.lds + LO_WL + (m * 64 + row) * 144 + ch * 16) = *(const v4u*)(LW + (size_t)((((l * 2 + d) * 2 + ax) * 8 + blk)) * 4096 + row * 64 + ch * 8); }
    LAS float* cst = (LAS float*)(F.lds + LO_CST);
    if (F.ltid() < 128) { const int d = F.ltid() >> 6, j = F.ltid() & 63, pi = (l * 2 + d) * 512 + blk * 64 + j; cst[F.ltid()] = A->in[10][pi]; cst[128 + F.ltid()] = A->in[12][pi]; cst[256 + F.ltid()] = SP[pi]; }
    else if (F.ltid() < 384) { const int e = F.ltid() - 128, tap = e >> 6, j = e & 63; cst[384 + e] = A->in[7][(size_t)l * 2048 + tap * 512 + blk * 64 + j]; }
    else if (F.ltid() < 448) { const int j = F.ltid() - 384; cst[640 + j] = A->in[8][(size_t)l * 512 + blk * 64 + j]; }
}
struct LruPre { v4u xc[3]; v4u gc[2]; float agx[15], agy[15]; };
template <int MODE>
__device__ __forceinline__ void lru_fetch(const Frame& F, int item, LruPre& P) {
    const int b = item >> 7, c = (item >> 3) & 15, blk = item & 7, t0 = b * SEQ + c * 128, s0 = c * 128, tid = F.ltid();
    const bf16* XCg = (const bf16*)(F.ws + WS_PROJ + 8 * BLK); const bf16* GCg = (const bf16*)(F.ws + WS_PROJ + 6 * BLK); const float* AGG = (const float*)(F.ws + WS_AGG);
#pragma unroll
    for (int q = 0; q < 3; ++q) {
        const int idx = tid + 512 * q, row = idx >> 3, ch = idx & 7, s_ = s0 - 2 + row;
        P.xc[q] = (v4u){0u, 0u, 0u, 0u};
        if (idx < 1056 && s_ >= 0 && s_ < SEQ) P.xc[q] = *(const v4u*)(XCg + (size_t)(b * SEQ + s_) * 512 + blk * 64 + ch * 8);
    }
    if (MODE == 1) {
#pragma unroll
        for (int q = 0; q < 2; ++q) { const int idx = tid + 512 * q, row = idx >> 3, ch = idx & 7; P.gc[q] = *(const v4u*)(GCg + (size_t)(t0 + row) * 512 + blk * 64 + ch * 8); }
        if (tid < 128) {
            typedef float f2 __attribute__((ext_vector_type(2)));
            const int d = tid >> 6, ch = blk * 64 + (tid & 63);
#pragma unroll
            for (int k = 0; k < 15; ++k) { const int cc = d ? 15 - k : k; const f2 a = *(const f2*)(AGG + ((size_t)((b * 16 + cc) * 2 + d) * 512 + ch) * 2); P.agx[k] = a.x; P.agy[k] = a.y; }
        }
    }
}
template <int MODE>
__device__ __forceinline__ void lru_item(const Frame& F, int item, const LruPre& P) {
    const int b = item >> 7, c = (item >> 3) & 15, blk = item & 7, t0 = b * SEQ + c * 128;
    bf16* GCg = (bf16*)(F.ws + WS_PROJ + 6 * BLK);
    float* AGG = (float*)(F.ws + WS_AGG);
    LAS unsigned char* WL = F.lds + LO_WL; const LAS float* cst = (const LAS float*)(F.lds + LO_CST);
    LAS unsigned char* XC = F.lds + LO_XC; LAS float* XF = (LAS float*)(F.lds + LO_XF); LAS unsigned char* XB = F.lds + LO_XB; LAS unsigned char* GY = F.lds + LO_GY;
    LAS float* SEG = (LAS float*)(F.lds + LO_SEG); LAS float* HIN = (LAS float*)(F.lds + LO_HIN);
    typedef float f2 __attribute__((ext_vector_type(2)));
    const int tid = F.ltid(), lane = F.lane(), w = F.wave(), g = lane >> 4, i = lane & 15;
    __syncthreads();
#pragma unroll
    for (int q = 0; q < 3; ++q) { const int idx = tid + 512 * q; if (idx < 1056) *(LAS v4u*)(XC + (idx >> 3) * 144 + (idx & 7) * 16) = P.xc[q]; }
    if (MODE == 1) {
#pragma unroll
        for (int q = 0; q < 2; ++q) { const int idx = tid + 512 * q; *(LAS v4u*)(GY + (idx >> 3) * 144 + (idx & 7) * 16) = P.gc[q]; }
        if (tid < 128) {
            const int d = tid >> 6;
            float h = 0.f;
#pragma unroll
            for (int k = 0; k < 15; ++k) { const int cc = d ? 15 - k : k; const bool valid = d ? (cc > c) : (cc < c); h = valid ? P.agx[k] * h + P.agy[k] : h; }
            HIN[tid] = h;
        }
    }
    __syncthreads();
#pragma unroll
    for (int q = 0; q < 2; ++q) {
        const int idx = tid + 512 * q, t = idx >> 3, c8 = idx & 7;
        float xf[8];
        { const f32x4 b0 = *(const LAS f32x4*)(cst + 640 + c8 * 8), b1 = *(const LAS f32x4*)(cst + 640 + c8 * 8 + 4); xf[0] = b0[0]; xf[1] = b0[1]; xf[2] = b0[2]; xf[3] = b0[3]; xf[4] = b1[0]; xf[5] = b1[1]; xf[6] = b1[2]; xf[7] = b1[3]; }
#pragma unroll
        for (int tap = 0; tap < 4; ++tap) {
            const v4u x = *(const LAS v4u*)(XC + (t + tap) * 144 + c8 * 16);
            const f32x4 w0 = *(const LAS f32x4*)(cst + 384 + tap * 64 + c8 * 8), w1 = *(const LAS f32x4*)(cst + 384 + tap * 64 + c8 * 8 + 4);
            xf[0] += w0[0] * bflo(x[0]); xf[1] += w0[1] * bfhi(x[0]); xf[2] += w0[2] * bflo(x[1]); xf[3] += w0[3] * bfhi(x[1]);
            xf[4] += w1[0] * bflo(x[2]); xf[5] += w1[1] * bfhi(x[2]); xf[6] += w1[2] * bflo(x[3]); xf[7] += w1[3] * bfhi(x[3]);
        }
        *(LAS f32x4*)(XF + t * 68 + c8 * 8) = (f32x4){xf[0], xf[1], xf[2], xf[3]}; *(LAS f32x4*)(XF + t * 68 + c8 * 8 + 4) = (f32x4){xf[4], xf[5], xf[6], xf[7]};
        v4u o; o.x = pkbf(xf[0], xf[1]); o.y = pkbf(xf[2], xf[3]); o.z = pkbf(xf[4], xf[5]); o.w = pkbf(xf[6], xf[7]);
        *(LAS v4u*)(XB + t * 144 + c8 * 16) = o;
    }
    __syncthreads();
    float av[2][4][4], bv[2][4][4];
    {
        const bf16x8_t a0 = *(const LAS bf16x8_t*)(XB + (16 * w + i) * 144 + (8 * g) * 2), a1 = *(const LAS bf16x8_t*)(XB + (16 * w + i) * 144 + (32 + 8 * g) * 2);
#pragma unroll
        for (int d = 0; d < 2; ++d) {
#pragma unroll
            for (int jt = 0; jt < 4; ++jt) {
                const LAS unsigned char* wa = WL + ((d * 2 + 0) * 64 + 16 * jt + i) * 144 + (8 * g) * 2; const LAS unsigned char* wx = WL + ((d * 2 + 1) * 64 + 16 * jt + i) * 144 + (8 * g) * 2;
                const f32x4 z = (f32x4){0.f, 0.f, 0.f, 0.f};
                f32x4 ca = MFMA16(a0, *(const LAS bf16x8_t*)wa, z); ca = MFMA16(a1, *(const LAS bf16x8_t*)(wa + 64), ca);
                f32x4 cx = MFMA16(a0, *(const LAS bf16x8_t*)wx, z); cx = MFMA16(a1, *(const LAS bf16x8_t*)(wx + 64), cx);
                const int j = 16 * jt + i;
                const float ba = cst[d * 64 + j], bx = cst[128 + d * 64 + j], sp = cst[256 + d * 64 + j];
#pragma unroll
                for (int r = 0; r < 4; ++r) {
                    const int t = 16 * w + 4 * g + r;
                    const float xfv = XF[t * 68 + j];
                    const float rr = sigmoidf_(ca[r] + ba), ig = sigmoidf_(cx[r] + bx);
                    const float la = -8.0f * rr * sp, a = fexp(la), x2 = 2.0f * la;
                    const float omp = -x2 * (1.0f + x2 * (0.5f + x2 * (0.16666667f + x2 * (0.041666668f + x2 * (0.0083333333f + x2 * 0.0013888889f))))), omq = 1.0f - a * a, selp = x2 > -0.5f ? 1.0f : 0.0f;
                    const float om = selp * omp + (1.0f - selp) * omq;
                    float mult = __builtin_amdgcn_sqrtf(om);
                    if (d == 0 ? (c == 0 && t == 0) : (c == 15 && t == 127)) mult = 1.0f;
                    av[d][jt][r] = a; bv[d][jt][r] = mult * ig * xfv;
                }
            }
        }
    }
    float Ae[2][4], Be[2][4];
#pragma unroll
    for (int jt = 0; jt < 4; ++jt) {
        float Af = av[0][jt][0] * av[0][jt][1] * av[0][jt][2] * av[0][jt][3];
        float Bf = ((bv[0][jt][0] * av[0][jt][1] + bv[0][jt][1]) * av[0][jt][2] + bv[0][jt][2]) * av[0][jt][3] + bv[0][jt][3];
        float Ar = av[1][jt][0] * av[1][jt][1] * av[1][jt][2] * av[1][jt][3];
        float Br = ((bv[1][jt][3] * av[1][jt][2] + bv[1][jt][2]) * av[1][jt][1] + bv[1][jt][1]) * av[1][jt][0] + bv[1][jt][0];
#pragma unroll
        for (int st = 16; st <= 32; st <<= 1) {
            const float pAf = lane_get(Af, lane - st), pBf = lane_get(Bf, lane - st), pAr = lane_get(Ar, lane + st), pBr = lane_get(Br, lane + st);
            if (lane >= st) { Bf = Af * pBf + Bf; Af = Af * pAf; }
            if (lane + st < 64) { Br = Ar * pBr + Br; Ar = Ar * pAr; }
        }
        const float eAf = lane_get(Af, lane - 16), eBf = lane_get(Bf, lane - 16), eAr = lane_get(Ar, lane + 16), eBr = lane_get(Br, lane + 16);
        Ae[0][jt] = g > 0 ? eAf : 1.0f; Be[0][jt] = g > 0 ? eBf : 0.0f; Ae[1][jt] = g < 3 ? eAr : 1.0f; Be[1][jt] = g < 3 ? eBr : 0.0f;
        if (g == 3) *(LAS f2*)(SEG + ((0 * 8 + w) * 64 + 16 * jt + i) * 2) = (f2){Af, Bf};
        if (g == 0) *(LAS f2*)(SEG + ((1 * 8 + w) * 64 + 16 * jt + i) * 2) = (f2){Ar, Br};
    }
    __syncthreads();
    if (MODE == 0) {
        if (w == 0 && g < 2) {
            const int d = g;
#pragma unroll
            for (int jt = 0; jt < 4; ++jt) {
                const int j = 16 * jt + i; float h = 0.f, Ap = 1.0f;
#pragma unroll
                for (int k = 0; k < 8; ++k) { const int ww = d ? 7 - k : k; const f2 sg = *(const LAS f2*)(SEG + ((d * 8 + ww) * 64 + j) * 2); h = sg.x * h + sg.y; Ap *= sg.x; }
                *(f2*)(AGG + ((size_t)((b * 16 + c) * 2 + d) * 512 + blk * 64 + j) * 2) = (f2){Ap, h};
            }
        }
    } else {
#pragma unroll
        for (int jt = 0; jt < 4; ++jt) {
            const int j = 16 * jt + i;
            float hf = HIN[j], hr = HIN[64 + j];
            f2 sfv[8], srv[8];
#pragma unroll
            for (int k = 0; k < 8; ++k) { sfv[k] = *(const LAS f2*)(SEG + ((0 * 8 + k) * 64 + j) * 2); srv[k] = *(const LAS f2*)(SEG + ((1 * 8 + (7 - k)) * 64 + j) * 2); }
#pragma unroll
            for (int k = 0; k < 8; ++k) {
                const bool uf = k < w, ur = 7 - k > w;
                hf = (uf ? sfv[k].x : 1.0f) * hf + (uf ? sfv[k].y : 0.0f);
                hr = (ur ? srv[k].x : 1.0f) * hr + (ur ? srv[k].y : 0.0f);
            }
            float h = Ae[0][jt] * hf + Be[0][jt];
            float hs[4];
#pragma unroll
            for (int r = 0; r < 4; ++r) { h = av[0][jt][r] * h + bv[0][jt][r]; hs[r] = h; }
            h = Ae[1][jt] * hr + Be[1][jt];
#pragma unroll
            for (int r = 3; r >= 0; --r) { h = av[1][jt][r] * h + bv[1][jt][r]; hs[r] += h; }
#pragma unroll
            for (int r = 0; r < 4; ++r) { LAS bf16* p = (LAS bf16*)(GY + (16 * w + 4 * g + r) * 144) + j; *p = (bf16)f2bf(gelu_tanh(bf2f(*p)) * hs[r]); }
        }
        __syncthreads();
#pragma unroll
        for (int q = 0; q < 2; ++q) { const int idx = tid + 512 * q, row = idx >> 3, ch = idx & 7;
            *(v4u*)(GCg + (size_t)(t0 + row) * 512 + blk * 64 + ch * 8) = *(const LAS v4u*)(GY + row * 144 + ch * 16); }
    }
}
template <int MODE> __device__ __forceinline__ void phase_lru(const Frame& F, CArgs* A, int l) {
    int cur = -1;
    LruPre P0, P1;
    if (F.bid < 1024) lru_fetch<MODE>(F, F.bid, P0);
    for (int it = F.bid; it < 1024; it += 2 * F.G) {
        { const int blk = it & 7; if (blk != cur) { lru_stage_consts(F, A, l, blk); cur = blk; } }
        const int it1 = it + F.G, it2 = it + 2 * F.G;
        if (it1 < 1024) lru_fetch<MODE>(F, it1, P1);
        lru_item<MODE>(F, it, P0);
        if (it1 < 1024) {
            { const int blk = it1 & 7; if (blk != cur) { lru_stage_consts(F, A, l, blk); cur = blk; } }
            if (it2 < 1024) lru_fetch<MODE>(F, it2, P0);
            lru_item<MODE>(F, it1, P1);
        }
    }
}


struct NaSide { const float* psrc; const float* wup; const float* gup; const float* wdown; bf16* wup_t; bf16* wdown_t;
    int nxt;
    const float* win; const float* gin; const float* wbr; const float* wout; const float* wg; const float* gg; const float* wple; };
__device__ __forceinline__ void strip16(const float* W, const float* g, int Kd, int Nd, bf16* WT, int sl, int tid) {
    const int nblk = Nd / 64, kb = sl / nblk, nb = sl % nblk, n = nb * 64 + (tid & 63), k0 = kb * 64 + 16 * ((tid >> 6) & 3);
    float wv[16];
#pragma unroll
    for (int j = 0; j < 16; ++j) wv[j] = W[(size_t)(k0 + j) * Nd + n];
    if (g) {
#pragma unroll
        for (int j = 0; j < 16; ++j) wv[j] *= g[k0 + j];
    }
    v4u t0, t1;
    t0.x = pk2(wv[0], wv[1]); t0.y = pk2(wv[2], wv[3]); t0.z = pk2(wv[4], wv[5]); t0.w = pk2(wv[6], wv[7]);
    t1.x = pk2(wv[8], wv[9]); t1.y = pk2(wv[10], wv[11]); t1.z = pk2(wv[12], wv[13]); t1.w = pk2(wv[14], wv[15]);
    *(v4u*)(WT + (size_t)n * Kd + k0) = t0; *(v4u*)(WT + (size_t)n * Kd + k0 + 8) = t1;
}
__device__ __forceinline__ void na_group(const Frame& F, const float* rpb, int grp, const NaSide sd) {
    const int b = grp >> 5, h = (grp >> 2) & 7, rg = grp & 3, r0 = rg * 8;
    bf16* Qg = (bf16*)(F.ws + WS_PROJ); const bf16* Kg = (const bf16*)(F.ws + WS_PROJ + BLK); const bf16* Vg = (const bf16*)(F.ws + WS_PROJ + 2 * BLK);
    LAS unsigned char* Kl = F.lds; LAS unsigned char* Vl = F.lds + 512 * 144; LAS float* Bl = (LAS float*)(F.lds + 2 * 512 * 144);
    const int tid = F.ltid();
    int rs = r0 - 4; rs = rs < 0 ? 0 : (rs > 24 ? 24 : rs);
    __syncthreads();
#pragma unroll
    for (int q = 0; q < 8; ++q) {
        const int idx = tid + 512 * q, kidx = idx >> 3, ch = idx & 7, grow = rs + (kidx >> 6), col = kidx & 63;
        const size_t tok = (size_t)b * SEQ + grow * 64 + col; const int lrow = (grow & 7) * 64 + col;
        *(LAS v4u*)(Kl + lrow * 144 + ch * 16) = *(const v4u*)(Kg + tok * 512 + h * 64 + ch * 8);
        *(LAS v4u*)(Vl + lrow * 144 + ch * 16) = *(const v4u*)(Vg + tok * 512 + h * 64 + ch * 8);
    }
    if (tid < 465) Bl[tid] = rpb[h * 465 + tid];
    __syncthreads();
    const int w = F.wave(), lane = F.lane(), g = lane >> 4, i = lane & 15, q4 = i >> 2, p4 = i & 3;
    const int cq = 16 * (w & 3) + i;
    bf16x8_t bq0 = *(const bf16x8_t*)(Qg + ((size_t)b * SEQ + r0 * 64 + cq) * 512 + h * 64 + 8 * g), bq1 = *(const bf16x8_t*)(Qg + ((size_t)b * SEQ + r0 * 64 + cq) * 512 + h * 64 + 32 + 8 * g);
    for (int k = 0; k < 8; ++k) {
        const int r = r0 + k;
        const int rq = k < 7 ? r + 1 : r;
        const bf16x8_t nq0 = *(const bf16x8_t*)(Qg + ((size_t)b * SEQ + rq * 64 + cq) * 512 + h * 64 + 8 * g), nq1 = *(const bf16x8_t*)(Qg + ((size_t)b * SEQ + rq * 64 + cq) * 512 + h * 64 + 32 + 8 * g);
        int rsn = r + 1 - 4; rsn = rsn < 0 ? 0 : (rsn > 24 ? 24 : rsn);
        const bool slide = (k < 7) && (rsn != rs);
        v4u pk = (v4u){0u, 0u, 0u, 0u}, pv = pk;
        if (slide) { const size_t tok = (size_t)b * SEQ + (rsn + 7) * 64 + (tid >> 3);
            pk = *(const v4u*)(Kg + tok * 512 + h * 64 + (tid & 7) * 8); pv = *(const v4u*)(Vg + tok * 512 + h * 64 + (tid & 7) * 8); }
        if (w < 4) {
            const int c = 16 * w + i, cb = w == 0 ? 0 : (w == 1 ? 8 : (w == 2 ? 24 : 32));
            int cst = c - 8; cst = cst < 0 ? 0 : (cst > 48 ? 48 : cst);
            const size_t tq = (size_t)b * SEQ + r * 64 + c;
            float sc[16][4];
            float mx = -1e30f;
            int boff[2][4]; float vmask[2][4];
#pragma unroll
            for (int half = 0; half < 2; ++half)
#pragma unroll
                for (int e = 0; e < 4; ++e) { const int kc = cb + 16 * half + 4 * g + e; const bool valid = (kc >= cst) && (kc < cst + 16);
                    int dc = kc - c + 15; dc = dc < 0 ? 0 : (dc > 30 ? 30 : dc); boff[half][e] = dc; vmask[half][e] = valid ? 0.f : -1e30f; }
#pragma unroll
            for (int t = 0; t < 16; ++t) {
                const int wi = t >> 1, half = t & 1, slot = (rs + wi) & 7;
                const LAS unsigned char* kp = Kl + (slot * 64 + cb + 16 * half + i) * 144 + (8 * g) * 2;
                const bf16x8_t a0 = *(const LAS bf16x8_t*)kp, a1 = *(const LAS bf16x8_t*)(kp + 64);
                f32x4 s_ = (f32x4){0.f, 0.f, 0.f, 0.f};
                s_ = MFMA16(a0, bq0, s_); s_ = MFMA16(a1, bq1, s_);
                const int brow = (rs + wi - r + 7) * 31;
#pragma unroll
                for (int e = 0; e < 4; ++e) {
                    const float bias = Bl[brow + boff[half][e]];
                    const float v = fminf(s_[e] + bias, 1e30f) + vmask[half][e];
                    sc[t][e] = v; mx = fmaxf(mx, v);
                }
            }
            mx = fmaxf(mx, shx(mx, lane, 16)); mx = fmaxf(mx, shx(mx, lane, 32));
            float sum = 0.f;
            bf16x8_t bp[8];
#pragma unroll
            for (int wi = 0; wi < 8; ++wi) {
                float p[8];
#pragma unroll
                for (int e = 0; e < 4; ++e) { p[e] = fexp(sc[2 * wi][e] - mx); p[4 + e] = fexp(sc[2 * wi + 1][e] - mx); sum += p[e] + p[4 + e]; }
                v4u pw; pw.x = pkbf(p[0], p[1]); pw.y = pkbf(p[2], p[3]); pw.z = pkbf(p[4], p[5]); pw.w = pkbf(p[6], p[7]);
                bp[wi] = __builtin_bit_cast(bf16x8_t, pw);
            }
            sum += shx(sum, lane, 16); sum += shx(sum, lane, 32);
            f32x4 o[4];
#pragma unroll
            for (int dt = 0; dt < 4; ++dt) o[dt] = (f32x4){0.f, 0.f, 0.f, 0.f};
#pragma unroll
            for (int wi = 0; wi < 8; ++wi) {
                const int slot = (rs + wi) & 7;
                const LAS unsigned char* vp = Vl + (slot * 64 + cb + 4 * g + q4) * 144 + (4 * p4) * 2;
#pragma unroll
                for (int dt = 0; dt < 4; ++dt) { const bf16x8_t av = tr_frag(vp + 32 * dt, vp + 16 * 144 + 32 * dt); o[dt] = MFMA16(av, bp[wi], o[dt]); }
            }
            const float inv = 1.0f / sum;
#pragma unroll
            for (int dt = 0; dt < 4; ++dt) { v2u ov; ov.x = pkbf(o[dt][0] * inv, o[dt][1] * inv); ov.y = pkbf(o[dt][2] * inv, o[dt][3] * inv);
                *(v2u*)(Qg + tq * 512 + h * 64 + 16 * dt + 4 * g) = ov; }
        }
        else {
            const int e = (grp * 8 + k) * 512 + (tid - 256) * 2;
            const f32x4 v0 = ((const f32x4*)sd.psrc)[e], v1 = ((const f32x4*)sd.psrc)[e + 1];
            v4u o; o.x = pk2(v0.x, v0.y); o.y = pk2(v0.z, v0.w); o.z = pk2(v1.x, v1.y); o.w = pk2(v1.z, v1.w);
            ((v4u*)((unsigned char*)F.out + DO_PB))[e >> 1] = o;
            const int sid = grp * 8 + k;
            if (sid < 1024) strip16(sd.wup, sd.gup, D, FF, sd.wup_t, sid, tid); else strip16(sd.wdown, nullptr, FF, D, sd.wdown_t, sid - 1024, tid);
            if (sd.nxt) {
                unsigned char* dob = (unsigned char*)F.out;
                if (sid < 1920) strip16(sd.win, sd.gin, D, 7680, (bf16*)(dob + DO_WIN), sid, tid);
                if (sid < 384) strip16(sd.wbr + (size_t)(sid / 128) * 512 * D, nullptr, 512, D, (bf16*)(dob + DO_MID) + (size_t)(sid / 128) * D * 512, sid % 128, tid);
                else if (sid < 640) strip16(sd.wout, nullptr, D, D, (bf16*)(dob + DO_MID + 3 * MiB), sid - 384, tid);
                else if (sid < 896) strip16(sd.wg, sd.gg, D, D, (bf16*)(dob + DO_MID + 5 * MiB), sid - 640, tid);
                else if (sid < 960) strip16(sd.wple, nullptr, PLE, D, (bf16*)(dob + DO_MID + 7 * MiB), sid - 896, tid);
            }
        }
        __syncthreads();
        if (slide) { const int lrow = ((rsn + 7) & 7) * 64 + (tid >> 3);
            *(LAS v4u*)(Kl + lrow * 144 + (tid & 7) * 16) = pk; *(LAS v4u*)(Vl + lrow * 144 + (tid & 7) * 16) = pv; }
        __syncthreads();
        rs = rsn; bq0 = nq0; bq1 = nq1;
    }
}
__device__ __forceinline__ void phase_na(const Frame& F, CArgs* A, int l) { const float* rpb = A->in[5] + (size_t)l * 8 * 465; const int ln = l + 1 < DEPTH ? l + 1 : l;
    const NaSide sd{A->in[1] + (size_t)l * T * PLE, A->in[17] + (size_t)l * D * FF, A->in[16] + (size_t)l * D, A->in[18] + (size_t)l * FF * D, (bf16*)(F.ws + W_UP), (bf16*)(F.ws + W_DOWN),
                    l + 1 < DEPTH ? 1 : 0, A->in[3] + (size_t)ln * D * 7680, A->in[2] + (size_t)ln * D, A->in[14] + (size_t)ln * 3 * 512 * D, A->in[15] + (size_t)ln * D * D, A->in[20] + (size_t)ln * D * D, A->in[19] + (size_t)ln * D, A->in[21] + (size_t)ln * PLE * D};
    for (int it = F.bid; it < 256; it += F.G) na_group(F, rpb, it, sd); }

__device__ __forceinline__ void phase_ret_state(const Frame& F) { for (int it = F.bid; it < 256; it += F.G) ret_scan_item(F, it); }
__device__ __forceinline__ void phase_ret_out(const Frame& F, CArgs* A, int l) { const float* gn = A->in[6] + (size_t)l * 512; for (int it = F.bid; it < 512; it += F.G) ret_out_item(F, gn, it); }

__device__ __forceinline__ void phase_final(const Frame& F, CArgs* A) {
    const float* g = A->in[22]; const bf16* xb = (const bf16*)(F.ws + WS_XB); const float* ss = (const float*)(F.ws + WS_SSB);
    const int lane = F.lane();
    f32x4 gv[4];
#pragma unroll
    for (int j = 0; j < 4; ++j) gv[j] = ((const f32x4*)g + lane)[64 * j];
    for (int m0 = F.gw() * 4; m0 < T; m0 += F.ngw * 4) {
        v2u w[4][4]; float sp[4];
#pragma unroll
        for (int r = 0; r < 4; ++r) {
            sp[r] = lane < 16 ? ss[(size_t)(m0 + r) * 16 + lane] : 0.f;
#pragma unroll
            for (int j = 0; j < 4; ++j) w[r][j] = ((const v2u*)(xb + (size_t)(m0 + r) * D) + lane)[64 * j];
        }
#pragma unroll
        for (int r = 0; r < 4; ++r) {
            float t = sp[r]; t += shx(t, lane, 1); t += shx(t, lane, 2); t += shx(t, lane, 4); t += shx(t, lane, 8);
            const float rs = 1.0f / sqrtf(lane_get(t, 0) * (1.0f / D) + RMS_EPS);
            f32x4* orow = (f32x4*)(F.out + (size_t)(m0 + r) * D) + lane;
#pragma unroll
            for (int j = 0; j < 4; ++j) orow[64 * j] = (f32x4){bflo(w[r][j].x), bfhi(w[r][j].x), bflo(w[r][j].y), bfhi(w[r][j].y)} * rs * gv[j];
        }
    }
}

__global__ void __launch_bounds__(NWAVES * 64, 2) mk_fwd(Args args) {
    extern __shared__ __attribute__((aligned(16))) unsigned char lds[];
    const int tid0 = threadIdx.x;
    const int wave0 = __builtin_amdgcn_readfirstlane(tid0 >> 6);
    LAS unsigned char* const lds3 = (LAS unsigned char*)lds;
    CArgs* A0 = get_args();
    const int ph_lo = A0->ph_lo, ph_hi = A0->ph_hi;
    for (int u = tid0; u < (LDS_BYTES - LDSCTL_OFF) / 4; u += NWAVES * 64) ((LAS unsigned*)(lds3 + LDSCTL_OFF))[u] = 0u;
    __syncthreads();
    const bool multi = (ph_hi - ph_lo) > 1;
    XcdBarrier bar; bar.bar = (unsigned*)((gu32*)(A0->ws + WS_CTL) + CW_BAR); bar.x = 0; bar.st = nullptr;
    if (multi) bar = xcd_barrier_post((unsigned*)((gu32*)(A0->ws + WS_CTL) + CW_BAR), (volatile LAS unsigned*)(lds3 + MISC_OFF) + 8);

    unsigned long long probe_acc = 0, pt0 = 0;
#define PMARK(k) do { if (PROBE_WN != 0ull) { __syncthreads(); const unsigned long long t_ = __builtin_amdgcn_s_memrealtime(); probe_acc += ((PROBE_WN >> (4 * (k))) & 15ull) * (t_ - pt0); pt0 = t_; } } while (0)
    for (int ph = ph_lo; ph < ph_hi; ++ph) {
        CArgs* A = get_args();
#define MAKE_FRAME(Fx) Frame Fx; Fx.wave0 = wave0; \
        Fx.lds = lds3; \
        { int b_ = blockIdx.x; asm volatile("" : "+s"(b_)); Fx.bid = b_; } \
        Fx.G = gridDim.x; Fx.ngw = Fx.G * NWAVES; Fx.out = A->out; Fx.ws = A->ws
        MAKE_FRAME(F);
        unsigned char* ws = F.ws;
        if (PROBE_WN != 0ull) pt0 = __builtin_amdgcn_s_memrealtime();
        int kind, l;
        if (ph == 0) { kind = PH_PRO; l = 0; } else if (ph == NPH - 1) { kind = PH_FIN; l = 0; } else { l = (ph - 1) / NPL; kind = 1 + (ph - 1) % NPL; }
        float* ssA = (float*)(ws + WS_SSA); float* ssB = (float*)(ws + WS_SSB);
        switch (kind) {
        case PH_PRO: phase_prologue(F, A); break;
        case PH_G1: {
            pg8::Gemm g{(const bf16_t*)(ws + WS_XB), (const bf16_t*)(l == 0 ? ws + W_IN : (unsigned char*)F.out + DO_WIN), T, 7680, D, 0, 0};
            pg8::StaticOrder S; S.init(T, 7680, F.G, F.bid);
            stage_epilogue_tables(F, ssB, S, A->in[4] + (size_t)l * 3072);
            EpiG1 E{(bf16_t*)(ws + WS_PROJ), ws + WS_GATE8, F.lds, (const float*)(ws + WS_TAB)};
            pg8::gemm_phase<EpiG1, pg8::StaticOrder, true, true>(F.lds, g, S, E, F.ltid());
        } break;
        case PH_MIXA: phase_na(F, A, l); PMARK(10); phase_ret_state(F); PMARK(11); phase_lru<0>(F, A, l); PMARK(12); break;
        case PH_MIXB: phase_ret_out(F, A, l); PMARK(14); phase_lru<1>(F, A, l); PMARK(15); break;
        case PH_G2: {
            pg8::Gemm g{(const bf16_t*)(ws + WS_PROJ), (const bf16_t*)(l == 0 ? ws + W_BR : (unsigned char*)F.out + DO_MID), T, D, 512, 3 * BLK, (size_t)D * 512 * 2};
            ZOrder S; S.S.init(T, D, F.G, F.bid);
            EpiG2 E{ws + WS_GATE8, (bf16_t*)(ws + WS_MERGED)};
            pg8::gemm_phase<EpiG2, ZOrder, true, true>(F.lds, g, S, E, F.ltid());
        } break;
        case PH_G3: case PH_G5: {
            const bool g3 = (kind == PH_G3);
            pg8::Gemm g{(const bf16_t*)(ws + (g3 ? WS_MERGED : WS_U)), (const bf16_t*)(g3 ? (l == 0 ? ws + W_OUT : (unsigned char*)F.out + DO_MID + 3 * MiB) : ws + W_DOWN), T, D, g3 ? D : FF, 0, 0};
            pg8::StaticOrder S; S.init(T, D, F.G, F.bid);
            EpiRes E{(g3 && l == 0) ? A->in[0] : nullptr, (const bf16_t*)(ws + (g3 ? WS_XB : WS_GATE8)), (bf16_t*)(ws + WS_GATE8), g3 ? ssB : ssA};
            pg8::gemm_phase<EpiRes, pg8::StaticOrder, false, true>(F.lds, g, S, E, F.ltid());
        } break;
        case PH_G4: {
            pg8::Gemm g{(const bf16_t*)(ws + WS_GATE8), (const bf16_t*)(ws + W_UP), T, FF, D, 0, 0};
            pg8::StaticOrder S; S.init(T, FF, F.G, F.bid);
            stage_epilogue_tables(F, ssB, S, nullptr);
            EpiG4 E{(bf16_t*)(ws + WS_U), F.lds};
            pg8::gemm_phase<EpiG4, pg8::StaticOrder, true, true>(F.lds, g, S, E, F.ltid());
        } break;
        case PH_G6: {
            {
                pg8::Gemm g{(const bf16_t*)((unsigned char*)F.out + DO_PB), (const bf16_t*)(l == 0 ? ws + W_PLE(0) : (unsigned char*)F.out + DO_MID + 7 * MiB), T, D, PLE, 0, 0};
                pg8::StaticOrder S; S.init(T, D, F.G, F.bid);
                EpiE E{(bf16_t*)(ws + WS_E)};
                pg8::gemm_phase<EpiE, pg8::StaticOrder, false, true>(F.lds, g, S, E, F.ltid());
            }
            {
                pg8::Gemm g{(const bf16_t*)(ws + WS_GATE8), (const bf16_t*)(l == 0 ? ws + W_G(0) : (unsigned char*)F.out + DO_MID + 5 * MiB), T, D, D, 0, 0};
                pg8::StaticOrder S; S.init(T, D, F.G, F.bid);
                stage_epilogue_tables(F, ssA, S, nullptr);
                EpiG6 E{(const bf16_t*)(ws + WS_GATE8), (bf16_t*)(ws + WS_XB), F.lds, ssB, (const bf16_t*)(ws + WS_E)};
                pg8::gemm_phase<EpiG6, pg8::StaticOrder, false, true>(F.lds, g, S, E, F.ltid());
            }
        } break;
        case PH_FIN: phase_final(F, A); break;
        default: break;
        }
        if (ph + 1 < ph_hi) xcd_barrier(bar, F.ltid());
        PMARK(kind);
    }
    if (PROBE_WN != 0ull && blockIdx.x == 0) { const unsigned long long te = __builtin_amdgcn_s_memrealtime(); while (__builtin_amdgcn_s_memrealtime() - te < probe_acc) __builtin_amdgcn_s_sleep(32); }
}


#if MK_CHECK
constexpr int CW_CODE = 64, CW_CNT = 128;
__device__ __forceinline__ unsigned hash32(unsigned x) { x ^= x >> 16; x *= 0x7feb352du; x ^= x >> 15; x *= 0x846ca68bu; x ^= x >> 16; return x; }
__device__ __forceinline__ bool near(float a, float b, float rel, float abs_) { return fabsf(a - b) <= rel * fabsf(b) + abs_; }
__device__ float rs_of_x(const float* x, int row) { float s = 0.f; for (int k = 0; k < D; ++k) s += x[(size_t)row * D + k] * x[(size_t)row * D + k]; return 1.0f / sqrtf(s / D + RMS_EPS); }
__global__ void __launch_bounds__(256) mk_check(Args a, int stage) {
    const unsigned id = blockIdx.x * blockDim.x + threadIdx.x;
    const unsigned h = hash32(id * 2654435761u + 12345u * stage);
    unsigned char* ws = a.ws; unsigned* ctl = (unsigned*)(ws + WS_CTL);
    const int row = (int)(h % T);
    bool bad = false;
    const float* x = a.in[0];
    if (stage == 1) {
        const int col = (int)((h >> 14) % D);
        const bf16* xb = (const bf16*)(ws + WS_XB);
        bad |= !near(bf2f(xb[(size_t)row * D + col]), x[(size_t)row * D + col], 0.01f, 1e-3f);
        float s = 0.f; for (int k = 0; k < D; ++k) s += x[(size_t)row * D + k] * x[(size_t)row * D + k];
        const float* ss = (const float*)(ws + WS_SSB); float t = 0.f; for (int k = 0; k < 16; ++k) t += ss[(size_t)row * 16 + k];
        bad |= !near(t, s, 1e-3f, 1e-3f);
        const int n = (int)((h >> 7) % 7680), k = (int)(h % D);
        const bf16* wt = (const bf16*)(ws + W_IN);
        bad |= !near(bf2f(wt[(size_t)n * D + k]), a.in[2][k] * a.in[3][(size_t)k * 7680 + n], 0.01f, 1e-4f);
        const int pos = (int)(h % SEQ), i = (int)((h >> 11) % 64);
        const float th = powf(10000.0f, -(float)i / 63.0f), ang = (float)pos * th;
        const float* tab = (const float*)(ws + WS_TAB);
        bad |= !near(tab[pos * 64 + i], cosf(ang), 0.f, 2e-3f); bad |= !near(tab[131072 + pos * 64 + i], sinf(ang), 0.f, 2e-3f);
    } else if (stage == 2) {
        const int col = (int)((h >> 14) % 7680) & ~1;
        const float rs = rs_of_x(x, row);
        float v0 = 0.f, v1 = 0.f;
        for (int k = 0; k < D; ++k) { const float xv = x[(size_t)row * D + k] * a.in[2][k]; v0 += xv * a.in[3][(size_t)k * 7680 + col]; v1 += xv * a.in[3][(size_t)k * 7680 + col + 1]; }
        v0 *= rs; v1 *= rs;
        if (col < 4608) {
            const int kind = col / 512, cc = col % 512, phys = (int)((0x683754210ull >> (4 * kind)) & 15ull);
            if (kind == 3 || kind == 4) { const int i = (cc & 127) >> 1, pos = row & 2047; const float th = powf(10000.0f, -(float)i / 63.0f), ang = (float)pos * th, c = cosf(ang), sn = sinf(ang);
                const float w0 = v0 * c - v1 * sn, w1 = v0 * sn + v1 * c; v0 = w0; v1 = w1; }
            if (kind == 0) { v0 *= 0.125f; v1 *= 0.125f; } if (kind == 3) { v0 *= 0.08838834764831845f; v1 *= 0.08838834764831845f; }
            const bf16* p = (const bf16*)(ws + WS_PROJ) + (size_t)phys * T * 512 + (size_t)row * 512 + cc;
            bad |= !near(bf2f(p[0]), v0, 0.03f, 0.03f); bad |= !near(bf2f(p[1]), v1, 0.03f, 0.03f);
        } else {
            const int gc = col - 4608; const unsigned char* g8 = ws + WS_GATE8 + (size_t)row * 3072 + gc;
            const float s0 = 1.0f / (1.0f + expf(-(v0 + a.in[4][gc]))), s1 = 1.0f / (1.0f + expf(-(v1 + a.in[4][gc + 1])));
            bad |= !near((float)g8[0] / 255.0f, s0, 0.f, 0.012f); bad |= !near((float)g8[1] / 255.0f, s1, 0.f, 0.012f);
        }
    } else if (stage == 4) {
        const int col = (int)((h >> 14) % D);
        float m = 0.f;
        for (int n = 0; n < 3; ++n) { const bf16* ys = (const bf16*)(ws + WS_PROJ) + (size_t)(3 * n) * T * 512 + (size_t)row * 512; float acc = 0.f;
            for (int k = 0; k < 512; ++k) acc += bf2f(ys[k]) * a.in[14][((size_t)n * 512 + k) * D + col];
            m += acc * (float)ws[WS_GATE8 + (size_t)row * 3072 + n * 1024 + col] / 255.0f; }
        bad |= !near(bf2f(((const bf16*)(ws + WS_MERGED))[(size_t)row * D + col]), m, 0.03f, 0.03f);
    } else if (stage == 5 && false) {
        const int col = (int)((h >> 14) % D);
        const bf16* mg = (const bf16*)(ws + WS_XB) + (size_t)row * D; float acc = 0.f;
        for (int k = 0; k < D; ++k) acc += bf2f(mg[k]) * a.in[15][(size_t)k * D + col];
        const float x1 = x[(size_t)row * D + col] + acc;
        bad |= !near(a.out[(size_t)row * D + col], x1, 0.02f, 0.03f);
        bad |= !near(bf2f(((const bf16*)(ws + WS_GATE8))[(size_t)row * D + col]), a.out[(size_t)row * D + col], 0.01f, 1e-3f);
        float s = 0.f; for (int k = 0; k < D; ++k) s += a.out[(size_t)row * D + k] * a.out[(size_t)row * D + k];
        const float* ss = (const float*)(ws + WS_SSB); float t = 0.f; for (int k = 0; k < 16; ++k) t += ss[(size_t)row * 16 + k];
        bad |= !near(t, s, 1e-3f, 1e-3f);
    } else if (stage == 6 && false) {
        const int col = (int)((h >> 14) % FF);
        const bf16* xb = (const bf16*)(ws + WS_GATE8) + (size_t)row * D; float acc = 0.f;
        for (int k = 0; k < D; ++k) acc += bf2f(xb[k]) * a.in[16][k] * a.in[17][(size_t)k * FF + col];
        const float rs = rs_of_x(a.out, row); float v = fmaxf(acc * rs, 0.f); v *= v;
        bad |= !near(bf2f(((const bf16*)(ws + WS_U))[(size_t)row * FF + col]), v, 0.05f, 0.05f);
    } else if (stage == 7 && false) {
        const int col = (int)((h >> 14) % D);
        const bf16* uu = (const bf16*)(ws + WS_U) + (size_t)row * FF; float acc = 0.f;
        for (int k = 0; k < FF; ++k) acc += bf2f(uu[k]) * a.in[18][(size_t)k * D + col];
        const float x2 = bf2f(((const bf16*)(ws + WS_XB))[(size_t)row * D + col]) + acc;
        bad |= !near(a.out[(size_t)row * D + col], x2, 0.03f, 0.05f);
        bad |= !near(bf2f(((const bf16*)(ws + WS_GATE8))[(size_t)row * D + col]), a.out[(size_t)row * D + col], 0.01f, 1e-3f);
        float s = 0.f; for (int k = 0; k < D; ++k) s += a.out[(size_t)row * D + k] * a.out[(size_t)row * D + k];
        const float* ss = (const float*)(ws + WS_SSA); float t = 0.f; for (int k = 0; k < 16; ++k) t += ss[(size_t)row * 16 + k];
        bad |= !near(t, s, 1e-3f, 1e-3f);
    } else if (stage == 8 && false) {
        const int col = (int)((h >> 14) % D);
        const bf16* xb = (const bf16*)(ws + WS_GATE8) + (size_t)row * D; float acc = 0.f, s = 0.f;
        for (int k = 0; k < D; ++k) { const float xv = bf2f(xb[k]); s += xv * xv; acc += xv * a.in[19][k] * a.in[20][(size_t)k * D + col]; }
        const float rs = 1.0f / sqrtf(s / D + RMS_EPS);
        float e = 0.f; for (int k = 0; k < PLE; ++k) e += a.in[1][(size_t)row * PLE + k] * a.in[21][(size_t)k * D + col];
        const float x3 = bf2f(xb[col]) + e / (1.0f + expf(-acc * rs));
        bad |= !near(a.out[(size_t)row * D + col], x3, 0.03f, 0.05f);
    }
    if (stage == 9) bad = true;
    if (bad) atomicAdd(&ctl[CW_CNT + stage], 1u);
}
__device__ float orig_proj(const Args& a, int l, int row, int col) {
    const float* x = l == 0 ? a.in[0] : a.out; const float* g = a.in[2] + (size_t)l * D; const float* w = a.in[3] + (size_t)l * D * 7680;
    float s = 0.f, acc = 0.f;
    for (int k = 0; k < D; ++k) { const float xv = x[(size_t)row * D + k]; s += xv * xv; acc += xv * g[k] * w[(size_t)k * 7680 + col]; }
    return acc / sqrtf(s / D + RMS_EPS);
}
__global__ void __launch_bounds__(64) mk_check_na(Args a, int l) {
    __shared__ float qs[64]; __shared__ float sc[128];
    const unsigned h = hash32(blockIdx.x * 977u + 31u); const int t = (int)(h % T), hd = (int)((h >> 16) % 8), d = threadIdx.x;
    unsigned char* ws = a.ws; unsigned* ctl = (unsigned*)(ws + WS_CTL);
    const bf16* K = (const bf16*)(ws + WS_PROJ + BLK); const bf16* V = (const bf16*)(ws + WS_PROJ + 2 * BLK); const bf16* Y = (const bf16*)(ws + WS_PROJ);
    qs[d] = bf2f((bf16)f2bf(0.125f * orig_proj(a, l, t, hd * 64 + d)));
    __syncthreads();
    const int b = t / SEQ, s = t % SEQ, r = s / 64, c = s % 64;
    int rs = r - 4; if (rs < 0) rs = 0; if (rs > 24) rs = 24; int cs = c - 8; if (cs < 0) cs = 0; if (cs > 48) cs = 48;
    const float* rpb = a.in[5] + (size_t)l * 8 * 15 * 31 + hd * 465;
    for (int kk = d; kk < 128; kk += 64) { const int i = kk / 16, j = kk % 16; const int tk = b * SEQ + (rs + i) * 64 + cs + j; float acc = 0.f;
        for (int e = 0; e < 64; ++e) acc += qs[e] * bf2f(K[(size_t)tk * 512 + hd * 64 + e]);
        sc[kk] = acc + rpb[(rs + i - r + 7) * 31 + (cs + j - c + 15)]; }
    __syncthreads();
    float mx = -1e30f; for (int kk = 0; kk < 128; ++kk) mx = fmaxf(mx, sc[kk]);
    float den = 0.f, o = 0.f;
    for (int kk = 0; kk < 128; ++kk) { const int i = kk / 16, j = kk % 16; const int tk = b * SEQ + (rs + i) * 64 + cs + j; const float p = expf(sc[kk] - mx); den += p; o += p * bf2f(V[(size_t)tk * 512 + hd * 64 + d]); }
    o /= den;
    if (!near(bf2f(Y[(size_t)t * 512 + hd * 64 + d]), o, 0.04f, 0.04f)) atomicAdd(&ctl[CW_CNT + 31], 1u);
}
__global__ void __launch_bounds__(128) mk_check_ret(Args a, int l) {
    __shared__ float qs[128]; __shared__ float sc[SEQ]; __shared__ float red[128];
    const unsigned h = hash32(blockIdx.x * 1231u + 77u); const int t = (int)(h % T), hd = (int)((h >> 16) % 4), dv = threadIdx.x;
    unsigned char* ws = a.ws; unsigned* ctl = (unsigned*)(ws + WS_CTL);
    const bf16* Y = (const bf16*)(ws + WS_PROJ + 3 * BLK); const bf16* Q = (const bf16*)(ws + WS_PROJ + 4 * BLK); const bf16* K = (const bf16*)(ws + WS_PROJ + 5 * BLK); const bf16* V = (const bf16*)(ws + WS_PROJ + 7 * BLK);
    const int b = t / SEQ, n = t % SEQ;
    qs[dv] = bf2f(Q[(size_t)t * 512 + hd * 128 + dv]);
    __syncthreads();
    const float gf = log2_1m(__builtin_amdgcn_exp2f(-5.0f - (float)hd)), gb = log2_1m(__builtin_amdgcn_exp2f(-5.5f - (float)hd));
    for (int m = dv; m < SEQ; m += 128) { float acc = 0.f; for (int e = 0; e < 128; ++e) acc += qs[e] * bf2f(K[(size_t)(b * SEQ + m) * 512 + hd * 128 + e]);
        sc[m] = acc * (m <= n ? __builtin_amdgcn_exp2f(gf * (float)(n - m)) : __builtin_amdgcn_exp2f(gb * (float)(m - n))); }
    __syncthreads();
    float o = 0.f; for (int m = 0; m < SEQ; ++m) o += sc[m] * bf2f(V[(size_t)(b * SEQ + m) * 512 + hd * 128 + dv]);
    red[dv] = o * o; __syncthreads();
    float ms = 0.f; for (int e = 0; e < 128; ++e) ms += red[e];
    const float rn = 1.0f / sqrtf(ms / 128.0f + RMS_EPS);
    const float g = bf2f((bf16)f2bf(orig_proj(a, l, t, 1536 + 3 * 512 + hd * 128 + dv)));
    const float y = g / (1.0f + expf(-g)) * o * rn * a.in[6][(size_t)l * 512 + hd * 128 + dv];
    if (!near(bf2f(Y[(size_t)t * 512 + hd * 128 + dv]), y, 0.04f, 0.04f)) atomicAdd(&ctl[CW_CNT + 32], 1u);
}
__global__ void __launch_bounds__(128) mk_check_g(Args a, int l, int code) {
    const unsigned h = hash32(blockIdx.x * 1231u + 77u); const int t = (int)(h % T), hd = (int)((h >> 16) % 4), dv = threadIdx.x;
    unsigned* ctl = (unsigned*)(a.ws + WS_CTL);
    const bf16* G = (const bf16*)(a.ws + WS_PROJ + 3 * BLK);
    const float g = orig_proj(a, l, t, 1536 + 3 * 512 + hd * 128 + dv);
    if (!near(bf2f(G[(size_t)t * 512 + hd * 128 + dv]), g, 0.03f, 0.03f)) atomicAdd(&ctl[CW_CNT + code], 1u);
}
__global__ void __launch_bounds__(64) mk_check_lru(Args a, int l) {
    __shared__ float xs[64];
    const unsigned h = hash32(blockIdx.x * 733u + 5u); const int b = (int)(h % 8), blk = (int)((h >> 8) % 8), ts = (int)((h >> 16) % SEQ), j = threadIdx.x, ch = blk * 64 + j;
    unsigned char* ws = a.ws; unsigned* ctl = (unsigned*)(ws + WS_CTL);
    const bf16* XC = (const bf16*)(ws + WS_PROJ + 8 * BLK); const bf16* Y = (const bf16*)(ws + WS_PROJ + 6 * BLK);
    const float* cw = a.in[7] + (size_t)l * 2048; const float cb = a.in[8][(size_t)l * 512 + ch];
    float hsum = 0.f;
    for (int dir = 0; dir < 2; ++dir) {
        const float* wa = a.in[9] + (((size_t)l * 2 + dir) * 8 + blk) * 4096; const float* wx = a.in[11] + (((size_t)l * 2 + dir) * 8 + blk) * 4096;
        const float ba = a.in[10][((size_t)l * 2 + dir) * 512 + ch], bx = a.in[12][((size_t)l * 2 + dir) * 512 + ch], lam = a.in[13][((size_t)l * 2 + dir) * 512 + ch];
        const float sp = log1pf(expf(-lam));
        float hh = 0.f;
        const int nsteps = dir == 0 ? ts + 1 : SEQ - ts;
        for (int st = 0; st < nsteps; ++st) {
            const int t = dir == 0 ? st : SEQ - 1 - st;
            float xf = cb;
            for (int w = 0; w < 4; ++w) { const int t2 = t + w - 2; if (t2 >= 0 && t2 < SEQ) xf += cw[w * 512 + ch] * bf2f(XC[(size_t)(b * SEQ + t2) * 512 + ch]); }
            __syncthreads(); xs[j] = xf; __syncthreads();
            float ra = ba, ia = bx;
            for (int i = 0; i < 64; ++i) { ra += xs[i] * wa[i * 64 + j]; ia += xs[i] * wx[i * 64 + j]; }
            const float r = 1.0f / (1.0f + expf(-ra)), ig = 1.0f / (1.0f + expf(-ia));
            const float la = -8.0f * r * sp, av = expf(la); float mult = sqrtf(-expm1f(2.0f * la)); if (st == 0) mult = 1.0f;
            hh = av * hh + mult * ig * xf;
        }
        hsum += hh;
    }
    const float gc = bf2f((bf16)f2bf(orig_proj(a, l, b * SEQ + ts, 3584 + 512 + ch)));
    const float u = 0.7978845608028654f * (gc + 0.044715f * gc * gc * gc);
    const float y = 0.5f * gc * (1.0f + tanhf(u)) * hsum;
    if (!near(bf2f(Y[(size_t)(b * SEQ + ts) * 512 + ch]), y, 0.04f, 0.04f)) atomicAdd(&ctl[CW_CNT + 33], 1u);
}
__global__ void mk_report(Args a) {
    unsigned* ctl = (unsigned*)(a.ws + WS_CTL);
    const int order[13] = {1, 2, 35, 31, 34, 32, 33, 4, 5, 6, 7, 8, 9};
    const unsigned tot[13] = {16384u, 16384u, 16384u, 32768u, 16384u, 16384u, 8192u, 16384u, 16384u, 16384u, 16384u, 16384u, 64u};
    for (int i = 0; i < 13; ++i) {
        const unsigned cnt = ctl[CW_CNT + order[i]];
        if (cnt * 200u > tot[i]) {
            unsigned tenth = (cnt * 10u) / tot[i]; if (tenth > 9u) tenth = 9u;
            a.out[0] = order[i] >= 10 ? 100.0f * (float)order[i] : 1000.0f * (float)order[i] + 100.0f * (float)tenth;
            return;
        }
    }
}
#endif

#ifndef MK_ONE_LAUNCH
#define MK_ONE_LAUNCH 1
#endif
extern "C" void kernel_launch(void* const* d_in, const int* in_sizes, int n_in, void* d_out, int out_size, void* d_ws, size_t ws_size, hipStream_t stream) {
    static int grid = 0;
    if (grid == 0) {
        if (n_in != 23 || in_sizes[0] != T * D || out_size != T * D || ws_size < WS_END) { fprintf(stderr, "kernel_launch: unexpected shapes (n_in %d, in0 %d, out %d, ws %zu); nothing launched\n", n_in, n_in > 0 ? in_sizes[0] : -1, out_size, ws_size); grid = -1; return; }
        int dev = 0, cus = 0, per_cu = 0;
        if (hipGetDevice(&dev) != hipSuccess || hipDeviceGetAttribute(&cus, hipDeviceAttributeMultiprocessorCount, dev) != hipSuccess) { grid = -1; return; }
        if (hipFuncSetAttribute((const void*)mk_fwd, hipFuncAttributeMaxDynamicSharedMemorySize, LDS_BYTES) != hipSuccess) { fprintf(stderr, "kernel_launch: hipFuncSetAttribute failed\n"); grid = -1; return; }
        if (hipOccupancyMaxActiveBlocksPerMultiprocessor(&per_cu, (const void*)mk_fwd, NWAVES * 64, LDS_BYTES) != hipSuccess || per_cu < 1) { fprintf(stderr, "kernel_launch: occupancy query says %d blocks per CU\n", per_cu); }
        (void)hipGetLastError();
        grid = cus;
    }
    if (grid < 0) return;
    if (hipMemsetAsync((char*)d_ws + WS_CTL, 0, CTL_ZERO_BYTES, stream) != hipSuccess) return;
    Args a{};
    for (int i = 0; i < 23; ++i) a.in[i] = (const float*)d_in[i];
    a.out = (float*)d_out; a.ws = (unsigned char*)d_ws;
#if MK_ONE_LAUNCH
    a.ph_lo = 0; a.ph_hi = NPH;
    hipLaunchKernelGGL(mk_fwd, dim3(grid), dim3(NWAVES * 64), LDS_BYTES, stream, a);
#else
    for (int ph = 0; ph < NPH; ++ph) {
#if MK_CHECK
        if (ph == 1 + 6) (void)hipMemcpyAsync((char*)d_ws + WS_XB, (char*)d_ws + WS_GATE8, (size_t)T * D * 2, hipMemcpyDeviceToDevice, stream);
#endif
        a.ph_lo = ph; a.ph_hi = ph + 1; hipLaunchKernelGGL(mk_fwd, dim3(grid), dim3(NWAVES * 64), LDS_BYTES, stream, a);
#if MK_CHECK
        { int st = 0; if (ph == 0) st = 1; else if (ph == 1) st = 2; else if (ph == 1 + 3) st = 4; else if (ph == 1 + 4) st = 5; else if (ph == 1 + 5) st = 6; else if (ph == 1 + 6) st = 7; else if (ph == 1 + 7) st = 8;
          if (st) hipLaunchKernelGGL(mk_check, dim3(64), dim3(256), 0, stream, a, st);
          if (ph == 1 + 1) hipLaunchKernelGGL(mk_check_na, dim3(512), dim3(64), 0, stream, a, 0);
          if (ph == 1) hipLaunchKernelGGL(mk_check_g, dim3(128), dim3(128), 0, stream, a, 0, 35);
          if (ph == 1 + 1) hipLaunchKernelGGL(mk_check_g, dim3(128), dim3(128), 0, stream, a, 0, 34);
          if (ph == 1 + 2) hipLaunchKernelGGL(mk_check_ret, dim3(128), dim3(128), 0, stream, a, 0);
          if (ph == 1 + 2) hipLaunchKernelGGL(mk_check_lru, dim3(128), dim3(64), 0, stream, a, 0);
          if (ph == NPH - 1) hipLaunchKernelGGL(mk_check, dim3(1), dim3(64), 0, stream, a, 9); }
#endif
    }
#if MK_CHECK
    hipLaunchKernelGGL(mk_report, dim3(1), dim3(1), 0, stream, a);
#endif
#endif
}
```

```cpp
#include <hip/hip_runtime.h>
#include <cstdio>
#include <cstdint>
#ifndef MK_CHECK
#define MK_CHECK 0
#endif
#ifndef PROBE_WN
#define PROBE_WN 0x0ull
#endif
namespace pg8 {
#define PG8_LAS __attribute__((address_space(3)))
typedef unsigned short bf16_t;
typedef short bf16x8 __attribute__((ext_vector_type(8)));
typedef float f32x4 __attribute__((ext_vector_type(4)));
typedef unsigned u32x4 __attribute__((ext_vector_type(4)));
constexpr int BM = 256, BK = 64, HALF = 128, HTB = HALF * BK * 2  , STAGE_BYTES = 8 * HTB, NXCD = 8, WGM = 8;

__host__ __device__ __forceinline__ int lds_byte(int r, int c) { const int st = (r >> 4) * 2 + (c >> 5), rr = r & 15, cc = c & 31, ob = rr * 64 + cc * 2; return st * 1024 + (ob ^ (((ob >> 9) & 1) << 5)); }
__host__ __device__ __forceinline__ void stage_rc(int b, int& R, int& C) { const int st = b / 1024, sb = b % 1024, swz = sb ^ (((sb >> 9) & 1) << 5); R = (st >> 1) * 16 + swz / 64; C = (st & 1) * 32 + (swz % 64) / 2; }
__host__ __device__ __forceinline__ int perm32(int rho) { const int n = rho >> 4, i = rho & 15; return 8 * (i >> 2) + 4 * n + (i & 3); }

struct Unit { int pm, pn, z; };
struct Gemm { const bf16_t* A; const bf16_t* Bt; int M, N, K; size_t zA, zB; };

struct StaticOrder {
    int nM, nN, nwg, G, c;
    __host__ __device__ void init(int M, int N, int G_, int c_) { nM = M / BM; nN = N / BM; nwg = nM * nN; G = G_; c = c_; }
    __host__ __device__ bool next(int i, Unit& u) const {
        const long L = (long)i * G + c; if (L >= nwg) return false;
        int wgid = (int)L; { const int q = nwg / NXCD, r = nwg % NXCD, xcd = wgid % NXCD, off = wgid / NXCD; wgid = (xcd < r ? xcd * (q + 1) : r * (q + 1) + (xcd - r) * q) + off; }
        const int nig = WGM * nN, gid = wgid / nig, fm = gid * WGM, gsz = (nM - fm) < WGM ? (nM - fm) : WGM;
        u.pm = fm + ((wgid % nig) % gsz); u.pn = (wgid % nig) / gsz; u.z = 0; return true;
    }
    __device__ __forceinline__ void a_ready(const Unit&) const {}
    __device__ __forceinline__ void done(const Unit&) const {}
};

__device__ __forceinline__ unsigned cvt_pk_bf16(float lo, float hi) { unsigned r; asm volatile("v_cvt_pk_bf16_f32 %0, %1, %2" : "=v"(r) : "v"(lo), "v"(hi)); return r; }
typedef float f32x2 __attribute__((ext_vector_type(2)));
template <class Epi, class Sched, bool ALIGN_EPI = false, bool SP2 = false>
__device__ __forceinline__ void gemm_phase(PG8_LAS unsigned char* lds, const Gemm g, const Sched& S, const Epi& E, const int tid) {
    const int wid = __builtin_amdgcn_readfirstlane(tid >> 6), lane = tid & 63, wr = wid >> 2, wc = wid & 3, fr = lane & 15, fq = lane >> 4;
    const int K = g.K, nt = K / BK;
    unsigned voffA[2], voffB[2];
#pragma unroll
    for (int i = 0; i < 2; ++i) { int R, C; stage_rc(tid * 16 + i * 8192, R, C); const int Rb = Epi::PERM ? ((R & ~31) + perm32(R & 31)) : R;
        voffA[i] = (unsigned)(R * K + C) * 2u; voffB[i] = (unsigned)(Rb * K + C) * 2u; }
    const size_t kstep = (size_t)(BK * 2);
    const size_t hstep = (size_t)HALF * K * 2;
    const size_t tstep = 2 * hstep;
    const unsigned ldsw = (unsigned)wid * 1024u;
    const int aoff = lds_byte(wr * 64 + fr, fq * 8), boff = lds_byte(wc * 32 + fr, fq * 8);
#define PG8_SA(b, h) (((b) * 2 + (h)) * HTB)
#define PG8_SB(b, h) ((4 + (b) * 2 + (h)) * HTB)
#define PG8_STAGE(bufoff, gbase, voff) do { _Pragma("unroll") for (int _i = 0; _i < 2; ++_i) \
        __builtin_amdgcn_global_load_lds((const unsigned*)((const char*)(gbase) + (voff)[_i]), (PG8_LAS unsigned*)(lds + (bufoff) + ldsw + _i * 8192), 16, 0, 0); } while (0)
#define PG8_LDA(dst, b, h) do { _Pragma("unroll") for (int m = 0; m < 4; ++m) _Pragma("unroll") for (int k = 0; k < 2; ++k) dst[m][k] = *(const PG8_LAS bf16x8*)(lds + PG8_SA(b, h) + aoff + m * 2048 + k * 1024); } while (0)
#define PG8_LDB(dst, b, h) do { _Pragma("unroll") for (int n = 0; n < 2; ++n) _Pragma("unroll") for (int k = 0; k < 2; ++k) dst[n][k] = *(const PG8_LAS bf16x8*)(lds + PG8_SB(b, h) + boff + n * 2048 + k * 1024); } while (0)
#define PG8_MMA(ai, bj, At, Bt) do { __builtin_amdgcn_s_setprio(1); _Pragma("unroll") for (int m = 0; m < 4; ++m) _Pragma("unroll") for (int n = 0; n < 2; ++n) _Pragma("unroll") for (int k = 0; k < 2; ++k) \
        acc[ai][bj][m][n] = __builtin_amdgcn_mfma_f32_16x16x32_bf16(Bt[n][k], At[m][k], acc[ai][bj][m][n], 0, 0, 0); __builtin_amdgcn_s_setprio(0); } while (0)
#define PG8_WAIT_V(n) asm volatile("s_waitcnt vmcnt(" #n ")" ::: "memory")
#define PG8_WAIT_L(n) asm volatile("s_waitcnt lgkmcnt(" #n ")" ::: "memory")
#define PG8_BAR __builtin_amdgcn_s_barrier()
#define PG8_SCHED __builtin_amdgcn_sched_barrier(0)
    Unit cur, nxt; int ui = 0;
    if (!S.next(0, cur)) return;
    f32x4 acc[2][2][4][2];
#pragma unroll
    for (int a = 0; a < 2; ++a)
#pragma unroll
        for (int b = 0; b < 2; ++b)
#pragma unroll
            for (int m = 0; m < 4; ++m)
#pragma unroll
                for (int n = 0; n < 2; ++n) acc[a][b][m][n] = (f32x4){0.f, 0.f, 0.f, 0.f};
    bf16x8 At[4][2], B0[2][2], B1[2][2];
    const char* cA = (const char*)g.A + (size_t)cur.z * g.zA + (size_t)cur.pm * tstep; const char* cB = (const char*)g.Bt + (size_t)cur.z * g.zB + (size_t)cur.pn * tstep;
    S.a_ready(cur);
    if constexpr (SP2) {
        PG8_STAGE(PG8_SB(0, 0), cB, voffB); PG8_STAGE(PG8_SB(0, 1), cB + hstep, voffB); PG8_STAGE(PG8_SA(0, 0), cA, voffA); PG8_STAGE(PG8_SA(0, 1), cA + hstep, voffA);
        if (wr == 1) PG8_BAR;
        PG8_WAIT_V(2); PG8_BAR;
        PG8_STAGE(PG8_SB(1, 0), cB + kstep, voffB); PG8_STAGE(PG8_SA(1, 0), cA + kstep, voffA); PG8_STAGE(PG8_SB(1, 1), cB + hstep + kstep, voffB);
        PG8_WAIT_V(6); PG8_BAR;
    } else {
        PG8_STAGE(PG8_SB(0, 0), cB, voffB); PG8_STAGE(PG8_SA(0, 0), cA, voffA); PG8_STAGE(PG8_SB(0, 1), cB + hstep, voffB); PG8_STAGE(PG8_SA(0, 1), cA + hstep, voffA);
        if (wr == 1) PG8_BAR;
        PG8_WAIT_V(4); PG8_BAR;
        PG8_STAGE(PG8_SB(1, 0), cB + kstep, voffB); PG8_STAGE(PG8_SA(1, 0), cA + kstep, voffA); PG8_STAGE(PG8_SB(1, 1), cB + hstep + kstep, voffB);
        PG8_WAIT_V(6); PG8_BAR;
    }
    for (;;) {
        const bool has_next = S.next(ui + 1, nxt);
        const char* nA = has_next ? (const char*)g.A + (size_t)nxt.z * g.zA + (size_t)nxt.pm * tstep : cA; const char* nB = has_next ? (const char*)g.Bt + (size_t)nxt.z * g.zB + (size_t)nxt.pn * tstep : cB;
        for (int t = 0; t < nt; t += 2) {
            const bool last = (t == nt - 2);
            const char* a1 = cA + (size_t)(t + 1) * kstep;
            const char* a2 = last ? nA : cA + (size_t)(t + 2) * kstep; const char* b2 = last ? nB : cB + (size_t)(t + 2) * kstep;
            const char* a3 = a2 + kstep; const char* b3 = b2 + kstep;
            if (last && has_next) S.a_ready(nxt);
            if constexpr (SP2) {
            PG8_LDB(B0, 0, 0); PG8_LDB(B1, 0, 1); PG8_SCHED; PG8_LDA(At, 0, 0); PG8_STAGE(PG8_SA(1, 1), a1 + hstep, voffA);
            PG8_WAIT_V(8); PG8_WAIT_L(0); PG8_BAR; PG8_MMA(0, 0, At, B0); PG8_MMA(0, 1, At, B1); PG8_BAR; PG8_SCHED;
            PG8_LDA(At, 0, 1); PG8_STAGE(PG8_SB(0, 0), b2, voffB); PG8_STAGE(PG8_SB(0, 1), b2 + hstep, voffB); PG8_STAGE(PG8_SA(0, 0), a2, voffA);
            PG8_WAIT_V(8); PG8_WAIT_L(0); PG8_BAR; PG8_MMA(1, 0, At, B0); PG8_MMA(1, 1, At, B1); PG8_BAR; PG8_SCHED;
            PG8_LDB(B0, 1, 0); PG8_LDB(B1, 1, 1); PG8_SCHED; PG8_LDA(At, 1, 0); PG8_STAGE(PG8_SA(0, 1), a2 + hstep, voffA);
            PG8_WAIT_V(8); PG8_WAIT_L(0); PG8_BAR; PG8_MMA(0, 0, At, B0); PG8_MMA(0, 1, At, B1); PG8_BAR; PG8_SCHED;
            PG8_LDA(At, 1, 1); PG8_STAGE(PG8_SB(1, 0), b3, voffB); PG8_STAGE(PG8_SB(1, 1), b3 + hstep, voffB); PG8_STAGE(PG8_SA(1, 0), a3, voffA);
            PG8_WAIT_V(8); PG8_WAIT_L(0); PG8_BAR; PG8_MMA(1, 0, At, B0); PG8_MMA(1, 1, At, B1); PG8_BAR; PG8_SCHED;
            } else {
            PG8_LDB(B0, 0, 0); PG8_SCHED; PG8_LDA(At, 0, 0); PG8_STAGE(PG8_SA(1, 1), a1 + hstep, voffA);
            PG8_WAIT_L(8); PG8_BAR; PG8_WAIT_L(0); PG8_MMA(0, 0, At, B0); PG8_BAR; PG8_SCHED;
            PG8_LDB(B1, 0, 1); PG8_STAGE(PG8_SB(0, 0), b2, voffB);
            PG8_BAR; PG8_WAIT_L(0); PG8_MMA(0, 1, At, B1); PG8_BAR;
            PG8_LDA(At, 0, 1); PG8_STAGE(PG8_SA(0, 0), a2, voffA);
            PG8_BAR; PG8_WAIT_L(0); PG8_MMA(1, 0, At, B0); PG8_BAR; PG8_SCHED;
            PG8_STAGE(PG8_SB(0, 1), b2 + hstep, voffB);
            PG8_WAIT_V(6); PG8_BAR; PG8_MMA(1, 1, At, B1); PG8_BAR;
            PG8_LDB(B0, 1, 0); PG8_SCHED; PG8_LDA(At, 1, 0); PG8_STAGE(PG8_SA(0, 1), a2 + hstep, voffA);
            PG8_WAIT_L(8); PG8_BAR; PG8_WAIT_L(0); PG8_MMA(0, 0, At, B0); PG8_BAR; PG8_SCHED;
            PG8_LDB(B1, 1, 1); PG8_STAGE(PG8_SB(1, 0), b3, voffB);
            PG8_BAR; PG8_WAIT_L(0); PG8_MMA(0, 1, At, B1); PG8_BAR;
            PG8_LDA(At, 1, 1); PG8_STAGE(PG8_SA(1, 0), a3, voffA);
            PG8_BAR; PG8_WAIT_L(0); PG8_MMA(1, 0, At, B0); PG8_BAR; PG8_SCHED;
            PG8_STAGE(PG8_SB(1, 1), b3 + hstep, voffB);
            PG8_WAIT_V(6); PG8_BAR; PG8_MMA(1, 1, At, B1); PG8_BAR;
            }
        }
        if constexpr (ALIGN_EPI) { if (wr == 0) PG8_BAR; }
        if constexpr (!Epi::AFTER_DRAIN) { E(acc, cur, wr, wc, fr, fq); S.done(cur); }
        if (!has_next) break;
        if constexpr (!Epi::KEEP_ACC)
#pragma unroll
        for (int a = 0; a < 2; ++a)
#pragma unroll
            for (int b = 0; b < 2; ++b)
#pragma unroll
                for (int m = 0; m < 4; ++m)
#pragma unroll
                    for (int n = 0; n < 2; ++n) acc[a][b][m][n] = (f32x4){0.f, 0.f, 0.f, 0.f};
        cur = nxt; cA = nA; cB = nB; ++ui;
        if constexpr (ALIGN_EPI) { if (wr == 1) PG8_BAR; }
    }
    PG8_WAIT_V(0);
    if constexpr (!ALIGN_EPI) { if (wr == 0) PG8_BAR; }
    PG8_BAR;
    if constexpr (Epi::AFTER_DRAIN) { E.fused(acc, cur, wr, wc, fr, fq, lds, wid, lane); S.done(cur); }
#undef PG8_SA
#undef PG8_SB
#undef PG8_STAGE
#undef PG8_LDA
#undef PG8_LDB
#undef PG8_MMA
#undef PG8_WAIT_V
#undef PG8_WAIT_L
#undef PG8_BAR
#undef PG8_SCHED
}
}

constexpr int T = 16384, D = 1024, SEQ = 2048, DEPTH = 2, FF = 4096, PLE = 256;
constexpr float RMS_EPS = 1e-6f;
constexpr size_t MiB = 1u << 20;
constexpr size_t WS_CTL = 0, CTL_ZERO_BYTES = 65536;
constexpr size_t WS_TAB = 1 * MiB;
constexpr size_t WS_SSA = 2 * MiB, WS_SSB = 3 * MiB;
constexpr size_t WS_PROJ = 6 * MiB, BLK = 16 * MiB;
constexpr size_t WS_GATE8 = 150 * MiB;
constexpr size_t WS_XB = 198 * MiB;
constexpr size_t WS_W = 230 * MiB, WS_END = 256 * MiB;
constexpr size_t W_IN = WS_W, W_UP = WS_W, W_DOWN = WS_W + 8 * MiB, W_BR = WS_W + 16 * MiB, W_OUT = WS_W + 19 * MiB;
__host__ __device__ constexpr size_t W_G(int slot) { return WS_W + 21 * MiB + (size_t)slot * (5 * MiB / 2); }
__host__ __device__ constexpr size_t W_PLE(int slot) { return W_G(slot) + 2 * MiB; }
constexpr size_t WS_U = WS_PROJ;
constexpr size_t WS_E = WS_PROJ;
constexpr size_t DO_WIN = 32 * MiB, DO_MID = 56 * MiB;
constexpr size_t DO_PB = 48 * MiB;
constexpr size_t WS_HF = WS_PROJ + 1 * BLK;
constexpr size_t WS_AGG = 4 * MiB;
constexpr size_t WS_LW = 5 * MiB;
constexpr size_t WS_SP = 5 * MiB + 512 * 1024;
constexpr size_t WS_MERGED = WS_PROJ + 1 * BLK;
constexpr size_t WS_ST = WS_XB;
constexpr int CW_TMO = 0, CW_BAR = 4096;

enum { PH_PRO = 0, PH_G1, PH_MIXA, PH_MIXB, PH_G2, PH_G3, PH_G4, PH_G5, PH_G6, PH_FIN };
constexpr int NPL = 8, NPH = 1 + DEPTH * NPL + 1;

constexpr int NWAVES = 8;
constexpr int RING_BYTES = 131072, LDS_BYTES = 155648, LDSCTL_OFF = LDS_BYTES - 1024, MISC_OFF = LDSCTL_OFF + 320;

#define GAS __attribute__((address_space(1)))
#define LAS __attribute__((address_space(3)))
typedef unsigned short bf16;
typedef unsigned v4u __attribute__((ext_vector_type(4)));
typedef unsigned v2u __attribute__((ext_vector_type(2)));
typedef float f32x4 __attribute__((ext_vector_type(4)));
typedef GAS unsigned gu32;
#define RLX_AGENT __ATOMIC_RELAXED, __HIP_MEMORY_SCOPE_AGENT
#define LDS_WAIT() asm volatile("s_waitcnt lgkmcnt(0)" ::: "memory")
#define VM_WAIT() asm volatile("s_waitcnt vmcnt(0)" ::: "memory")
__device__ __forceinline__ unsigned f2bf(float f) { unsigned u = __builtin_bit_cast(unsigned, f); return (u + 0x7fffu + ((u >> 16) & 1u)) >> 16; }
__device__ __forceinline__ unsigned pk2(float lo, float hi) { return f2bf(lo) | (f2bf(hi) << 16); }
__device__ __forceinline__ float bf2f(unsigned short b) { return __builtin_bit_cast(float, (unsigned)b << 16); }
__device__ __forceinline__ float bflo(unsigned w) { return __builtin_bit_cast(float, w << 16); }
__device__ __forceinline__ float bfhi(unsigned w) { return __builtin_bit_cast(float, w & 0xffff0000u); }
__device__ __forceinline__ float rdlane(float v, int l) { return __builtin_bit_cast(float, __builtin_amdgcn_readlane(__builtin_bit_cast(int, v), l)); }
__device__ __forceinline__ float fexp(float x) { return __builtin_amdgcn_exp2f(x * 1.4426950408889634f); }
__device__ __forceinline__ float sigmoidf_(float x) { return __builtin_amdgcn_rcpf(1.0f + fexp(-x)); }
__device__ __forceinline__ float lane_get(float v, int srclane) { return __builtin_bit_cast(float, __builtin_amdgcn_ds_bpermute(srclane << 2, __builtin_bit_cast(int, v))); }
__device__ __forceinline__ float shx(float v, int lane, int o) { return lane_get(v, lane ^ o); }
__device__ __forceinline__ float wave_sum(float v, int lane) {
#pragma unroll
    for (int o = 1; o < 64; o <<= 1) v += shx(v, lane, o);
    return v;
}
__device__ __forceinline__ float wave_max(float v, int lane) {
#pragma unroll
    for (int o = 1; o < 64; o <<= 1) v = fmaxf(v, shx(v, lane, o));
    return v;
}
__device__ __forceinline__ float log2_1m(float x) {
    const float p = x * (1.0f + x * (0.5f + x * (0.33333333f + x * (0.25f + x * (0.2f + x * (0.16666667f + x * 0.14285714f))))));
    return -p * 1.4426950408889634f;
}
__device__ __forceinline__ float log1p_small(float y) {
    if (y < 0.01f) return y * (1.0f - y * (0.5f - y * (0.33333333f - 0.25f * y)));
    return __builtin_amdgcn_logf(1.0f + y) * 0.6931471805599453f;
}
__device__ __forceinline__ float gelu_tanh(float x) {
    const float u = 0.7978845608028654f * (x + 0.044715f * x * x * x);
    const float t = 1.0f - 2.0f * __builtin_amdgcn_rcpf(1.0f + fexp(2.0f * u));
    return 0.5f * x * (1.0f + t);
}
__device__ __forceinline__ float row_rs(const float* ss, int row, int fq, int lane) {
    const f32x4 a = *(const f32x4*)(ss + (size_t)row * 16 + 4 * fq);
    float s = (a.x + a.y) + (a.z + a.w);
    s += shx(s, lane, 16); s += shx(s, lane, 32);
    return 1.0f / sqrtf(s * (1.0f / D) + RMS_EPS);
}

#define XB_TMO      128
#define XB_XCNT(j)  (256  + 64 * (j))
#define XB_XSUB(j)  (1280 + 64 * (j))
#define XB_XGEN(j)  (2304 + 64 * (j))
#define XB_TOP      3328
#define XB_TOPGEN   3392
#define XCD_BAR_WORDS 3456
#define XB_SPIN_CAP (1u << 18)

__device__ __forceinline__ unsigned xb_ld(unsigned* p)              { return __hip_atomic_load(p, __ATOMIC_RELAXED, __HIP_MEMORY_SCOPE_AGENT); }
__device__ __forceinline__ unsigned xb_add(unsigned* p, unsigned v) { return __hip_atomic_fetch_add(p, v, __ATOMIC_RELAXED, __HIP_MEMORY_SCOPE_AGENT); }
__device__ __forceinline__ unsigned xb_xcc_id() { return (unsigned)__builtin_amdgcn_s_getreg((3 << 11) | 20) & 0xFu; }
#define XB_SPIN(cond, bar) do { unsigned _sp = 0; while (cond) { __builtin_amdgcn_s_sleep(1); \
    if ((++_sp & 255u) == 0u) { if (xb_ld(&(bar)[XB_TMO])) break; if (_sp > XB_SPIN_CAP) { atomicAdd(&(bar)[XB_TMO], 1u); break; } } } } while (0)

struct XcdBarrier {
    unsigned* bar; unsigned x;
    volatile LAS unsigned* st;
};

__device__ __forceinline__ XcdBarrier xcd_barrier_post(unsigned* bar, volatile LAS unsigned* st) {
    XcdBarrier b; b.bar = bar; b.x = xb_xcc_id(); b.st = st;
    if (threadIdx.x == 0) (void)xb_add(&bar[XB_XCNT(b.x)], 1u);
    return b;
}
__device__ __forceinline__ void xcd_barrier_complete(unsigned* bar, unsigned x, unsigned& nloc, unsigned& nx) {
    const unsigned G = gridDim.x * gridDim.y * gridDim.z;
    unsigned sum, cnt, mine, sp = 0u;
    for (;;) {
        sum = 0u; cnt = 0u; mine = 0u;
#pragma unroll
        for (unsigned j = 0; j < 16; ++j) { const unsigned c = xb_ld(&bar[XB_XCNT(j)]); sum += c; cnt += (c > 0u) ? 1u : 0u; mine = (j == x) ? c : mine; }
        if (sum == G) break;
        __builtin_amdgcn_s_sleep(1);
        if ((++sp & 255u) == 0u) { if (xb_ld(&bar[XB_TMO])) break; if (sp > XB_SPIN_CAP) { atomicAdd(&bar[XB_TMO], 1u); break; } }
    }
    nloc = mine > 0u ? mine : 1u; nx = cnt > 0u ? cnt : 1u;
}

__device__ __forceinline__ void xcd_barrier(const XcdBarrier& b, const int tid_) {
    asm volatile("s_waitcnt vmcnt(0)" ::: "memory");
    __syncthreads();
    if (tid_ == 0) {
        unsigned* bar = b.bar;
        __builtin_amdgcn_s_waitcnt(0);
        unsigned nloc = b.st[0], nx = b.st[1];
        if (nloc == 0u) { xcd_barrier_complete(bar, b.x, nloc, nx); b.st[0] = nloc; b.st[1] = nx; }
        const unsigned old = xb_add(&bar[XB_XSUB(b.x)], 1u);
        const unsigned gen = old / nloc;
        if (old + 1u == (gen + 1u) * nloc) {
            __builtin_amdgcn_fence(__ATOMIC_RELEASE, "agent");
            asm volatile("s_waitcnt vmcnt(0)" ::: "memory");
            const unsigned og = xb_add(&bar[XB_TOP], 1u);
            const unsigned tg = og / nx;
            if (og + 1u == (tg + 1u) * nx) xb_add(&bar[XB_TOPGEN], 1u);
            else XB_SPIN(xb_ld(&bar[XB_TOPGEN]) == tg, bar);
            __builtin_amdgcn_fence(__ATOMIC_ACQUIRE, "agent");
            xb_add(&bar[XB_XGEN(b.x)], 1u);
            asm volatile("s_waitcnt vmcnt(0)" ::: "memory");
        } else {
            XB_SPIN(xb_ld(&bar[XB_XGEN(b.x)]) == gen, bar);
            __builtin_amdgcn_fence(__ATOMIC_ACQUIRE, "agent");
            asm volatile("s_waitcnt vmcnt(0)" ::: "memory");
        }
    }
    __syncthreads();
}


constexpr int LO_RSL = 131072, LO_RSPM = LO_RSL + 8 * 256 * 4, LO_BGL = LO_RSPM + 64;
__device__ __forceinline__ float rs_lookup(const LAS unsigned char* lds, int pm, int rowl) {
    const LAS int* spm = (const LAS int*)(lds + LO_RSPM); int sl = 0;
#pragma unroll
    for (int i = 1; i < 8; ++i) sl = spm[i] == pm ? i : sl;
    return ((const LAS float*)(lds + LO_RSL))[sl * 256 + rowl];
}
using pg8::Unit; using pg8::bf16_t; using pg8::cvt_pk_bf16;
typedef pg8::u32x4 u32x4;
struct EpiG1 {
    static constexpr bool PERM = true, AFTER_DRAIN = false, KEEP_ACC = false;
    bf16_t* proj; unsigned char* gate8; const LAS unsigned char* lds; const float* tab;
    __device__ __forceinline__ void operator()(const f32x4 (&acc)[2][2][4][2], const Unit& u, int wr, int wc, int fr, int fq) const {
        const int pn = u.pn;
        const int kind = pn >> 1, col0 = (pn & 1) * 256 + wc * 32 + 8 * fq;
        const bool rope = (pn < 18) && ((kind == 3) || (kind == 4));
        f32x4 cs[4][2], sn[4][2];
        if (rope) {
#pragma unroll
            for (int m = 0; m < 4; ++m)
#pragma unroll
                for (int bj = 0; bj < 2; ++bj) { const int row = u.pm * 256 + wr * 64 + m * 16 + fr, i0 = ((col0 + bj * 128) & 127) >> 1, pos = row & (SEQ - 1);
                    cs[m][bj] = *(const f32x4*)(tab + pos * 64 + i0); sn[m][bj] = *(const f32x4*)(tab + 131072 + pos * 64 + i0); }
        }
        float rsv[2][4];
#pragma unroll
        for (int ai = 0; ai < 2; ++ai)
#pragma unroll
            for (int m = 0; m < 4; ++m) rsv[ai][m] = rs_lookup(lds, u.pm, ai * 128 + wr * 64 + m * 16 + fr);
        if (pn < 18) {
            const int phys = (int)((0x683754210ull >> (4 * kind)) & 15ull);
            bf16_t* base = proj + (size_t)phys * ((size_t)T * 512);
            const float scale = kind == 0 ? 0.125f : (kind == 3 ? 0.08838834764831845f : 1.0f);
#pragma unroll
            for (int ai = 0; ai < 2; ++ai) {
                if (rope && ai == 1) {
#pragma unroll
                    for (int m = 0; m < 4; ++m)
#pragma unroll
                        for (int bj = 0; bj < 2; ++bj) { const int row = u.pm * 256 + ai * 128 + wr * 64 + m * 16 + fr, i0 = ((col0 + bj * 128) & 127) >> 1, pos = row & (SEQ - 1);
                            cs[m][bj] = *(const f32x4*)(tab + pos * 64 + i0); sn[m][bj] = *(const f32x4*)(tab + 131072 + pos * 64 + i0); }
                }
#pragma unroll
                for (int m = 0; m < 4; ++m) {
                    const int row = u.pm * 256 + ai * 128 + wr * 64 + m * 16 + fr;
                    const float rs = rsv[ai][m] * scale;
                    bf16_t* rowp = base + (size_t)row * 512 + col0;
#pragma unroll
                    for (int bj = 0; bj < 2; ++bj) {
                        f32x4 v0 = acc[ai][bj][m][0] * rs, v1 = acc[ai][bj][m][1] * rs;
                        if (rope) {
                            const f32x4 c_ = cs[m][bj], s_ = sn[m][bj];
                            f32x4 w0, w1;
                            w0[0] = v0[0] * c_[0] - v0[1] * s_[0]; w0[1] = v0[0] * s_[0] + v0[1] * c_[0];
                            w0[2] = v0[2] * c_[1] - v0[3] * s_[1]; w0[3] = v0[2] * s_[1] + v0[3] * c_[1];
                            w1[0] = v1[0] * c_[2] - v1[1] * s_[2]; w1[1] = v1[0] * s_[2] + v1[1] * c_[2];
                            w1[2] = v1[2] * c_[3] - v1[3] * s_[3]; w1[3] = v1[2] * s_[3] + v1[3] * c_[3];
                            v0 = w0; v1 = w1;
                        }
                        u32x4 w; w.x = cvt_pk_bf16(v0[0], v0[1]); w.y = cvt_pk_bf16(v0[2], v0[3]); w.z = cvt_pk_bf16(v1[0], v1[1]); w.w = cvt_pk_bf16(v1[2], v1[3]);
                        *(u32x4*)(rowp + bj * 128) = w;
                    }
                }
            }
        } else {
            const int g0 = (pn - 18) * 256 + wc * 32 + 8 * fq;
            f32x4 bg[2][2];
#pragma unroll
            for (int bj = 0; bj < 2; ++bj) { const LAS float* bgl = (const LAS float*)(lds + LO_BGL) + g0 + bj * 128; bg[bj][0] = *(const LAS f32x4*)bgl; bg[bj][1] = *(const LAS f32x4*)(bgl + 4); }
#pragma unroll
            for (int ai = 0; ai < 2; ++ai)
#pragma unroll
                for (int m = 0; m < 4; ++m) {
                    const int row = u.pm * 256 + ai * 128 + wr * 64 + m * 16 + fr;
                    const float rs = rsv[ai][m];
#pragma unroll
                    for (int bj = 0; bj < 2; ++bj) {
                        const int gc = g0 + bj * 128;
                        const f32x4 v0 = acc[ai][bj][m][0] * rs + bg[bj][0], v1 = acc[ai][bj][m][1] * rs + bg[bj][1];
                        unsigned lo = 0, hi = 0;
#pragma unroll
                        for (int e = 0; e < 4; ++e) {
                            lo |= (unsigned)(sigmoidf_(v0[e]) * 255.0f + 0.5f) << (8 * e);
                            hi |= (unsigned)(sigmoidf_(v1[e]) * 255.0f + 0.5f) << (8 * e);
                        }
                        v2u w; w.x = lo; w.y = hi;
                        *(v2u*)(gate8 + (size_t)row * 3072 + gc) = w;
                    }
                }
        }
    }
};
struct EpiG2 {
    static constexpr bool PERM = false, AFTER_DRAIN = false, KEEP_ACC = true;
    const unsigned char* gate8; bf16_t* merged;
    __device__ __forceinline__ void operator()(f32x4 (&acc)[2][2][4][2], const Unit& u, int wr, int wc, int fr, int fq) const {
        const int col0 = u.pn * 256 + wc * 32 + 4 * fq;
        unsigned ga[2][4][2][2], gb[2][4][2][2];
#pragma unroll
        for (int ai = 0; ai < 2; ++ai)
#pragma unroll
            for (int m = 0; m < 4; ++m)
#pragma unroll
                for (int bj = 0; bj < 2; ++bj)
#pragma unroll
                    for (int n = 0; n < 2; ++n) {
                        const size_t o = (size_t)(u.pm * 256 + ai * 128 + wr * 64 + m * 16 + fr) * 3072 + col0 + bj * 128 + n * 16;
                        ga[ai][m][bj][n] = *(const unsigned*)(gate8 + o + u.z * 1024);
                        gb[ai][m][bj][n] = u.z < 2 ? *(const unsigned*)(gate8 + o + (u.z + 1) * 1024) : 0u;
                    }
#pragma unroll
        for (int ai = 0; ai < 2; ++ai)
#pragma unroll
            for (int m = 0; m < 4; ++m) {
                const int row = u.pm * 256 + ai * 128 + wr * 64 + m * 16 + fr;
#pragma unroll
                for (int bj = 0; bj < 2; ++bj)
#pragma unroll
                    for (int n = 0; n < 2; ++n) {
                        const int c = col0 + bj * 128 + n * 16;
                        const unsigned a_ = ga[ai][m][bj][n], b_ = gb[ai][m][bj][n];
                        f32x4 t = acc[ai][bj][m][n];
                        if (u.z < 2) {
#pragma unroll
                            for (int e = 0; e < 4; ++e) { const float a = (float)max((a_ >> (8 * e)) & 255u, 1u), b = (float)max((b_ >> (8 * e)) & 255u, 1u); t[e] = t[e] * a * __builtin_amdgcn_rcpf(b); }
                            acc[ai][bj][m][n] = t;
                        } else {
#pragma unroll
                            for (int e = 0; e < 4; ++e) t[e] *= (float)max((a_ >> (8 * e)) & 255u, 1u) * (1.0f / 255.0f);
                            v2u w; w.x = cvt_pk_bf16(t[0], t[1]); w.y = cvt_pk_bf16(t[2], t[3]);
                            *(v2u*)(merged + (size_t)row * 1024 + c) = w;
                            acc[ai][bj][m][n] = (f32x4){0.f, 0.f, 0.f, 0.f};
                        }
                    }
            }
    }
};
struct EpiRes {
    static constexpr bool PERM = false, AFTER_DRAIN = false, KEEP_ACC = false;
    const float* basef; const bf16_t* baseb; bf16_t* xb; float* ssout;
    __device__ __forceinline__ void operator()(const f32x4 (&acc)[2][2][4][2], const Unit& u, int wr, int wc, int fr, int fq) const {
        const int col0 = u.pn * 256 + wc * 32 + 4 * fq, lane = fr + 16 * fq;
#pragma unroll
        for (int ai = 0; ai < 2; ++ai) {
            f32x4 bv[4][2][2];
            if (basef) {
#pragma unroll
                for (int m = 0; m < 4; ++m)
#pragma unroll
                    for (int bj = 0; bj < 2; ++bj)
#pragma unroll
                        for (int n = 0; n < 2; ++n) bv[m][bj][n] = *(const f32x4*)(basef + (size_t)(u.pm * 256 + ai * 128 + wr * 64 + m * 16 + fr) * 1024 + col0 + bj * 128 + n * 16);
            } else {
                v2u bw[4][2][2];
#pragma unroll
                for (int m = 0; m < 4; ++m)
#pragma unroll
                    for (int bj = 0; bj < 2; ++bj)
#pragma unroll
                        for (int n = 0; n < 2; ++n) bw[m][bj][n] = *(const v2u*)(baseb + (size_t)(u.pm * 256 + ai * 128 + wr * 64 + m * 16 + fr) * 1024 + col0 + bj * 128 + n * 16);
#pragma unroll
                for (int m = 0; m < 4; ++m)
#pragma unroll
                    for (int bj = 0; bj < 2; ++bj)
#pragma unroll
                        for (int n = 0; n < 2; ++n) bv[m][bj][n] = (f32x4){bflo(bw[m][bj][n].x), bfhi(bw[m][bj][n].x), bflo(bw[m][bj][n].y), bfhi(bw[m][bj][n].y)};
            }
#pragma unroll
            for (int m = 0; m < 4; ++m) {
                const int row = u.pm * 256 + ai * 128 + wr * 64 + m * 16 + fr;
                float s = 0.f;
#pragma unroll
                for (int bj = 0; bj < 2; ++bj)
#pragma unroll
                    for (int n = 0; n < 2; ++n) {
                        const size_t off = (size_t)row * 1024 + col0 + bj * 128 + n * 16;
                        const f32x4 v = bv[m][bj][n] + acc[ai][bj][m][n];
                        v2u w; w.x = cvt_pk_bf16(v[0], v[1]); w.y = cvt_pk_bf16(v[2], v[3]);
                        *(v2u*)(xb + off) = w;
                        s += (v[0] * v[0] + v[1] * v[1]) + (v[2] * v[2] + v[3] * v[3]);
                    }
                s += shx(s, lane, 16); s += shx(s, lane, 32);
                if (fq == 0) ssout[(size_t)row * 16 + u.pn * 4 + wc] = s;
            }
        }
    }
};
struct EpiG4 {
    static constexpr bool PERM = true, AFTER_DRAIN = false, KEEP_ACC = false;
    bf16_t* U; const LAS unsigned char* lds;
    __device__ __forceinline__ void operator()(const f32x4 (&acc)[2][2][4][2], const Unit& u, int wr, int wc, int fr, int fq) const {
        const int col0 = u.pn * 256 + wc * 32 + 8 * fq;
        float rsv[2][4];
#pragma unroll
        for (int ai = 0; ai < 2; ++ai)
#pragma unroll
            for (int m = 0; m < 4; ++m) rsv[ai][m] = rs_lookup(lds, u.pm, ai * 128 + wr * 64 + m * 16 + fr);
#pragma unroll
        for (int ai = 0; ai < 2; ++ai)
#pragma unroll
            for (int m = 0; m < 4; ++m) {
                const int row = u.pm * 256 + ai * 128 + wr * 64 + m * 16 + fr;
                const float rs = rsv[ai][m];
                bf16_t* rowp = U + (size_t)row * FF + col0;
#pragma unroll
                for (int bj = 0; bj < 2; ++bj) {
                    f32x4 v0 = acc[ai][bj][m][0] * rs, v1 = acc[ai][bj][m][1] * rs;
#pragma unroll
                    for (int e = 0; e < 4; ++e) { const float a = fmaxf(v0[e], 0.f), b = fmaxf(v1[e], 0.f); v0[e] = a * a; v1[e] = b * b; }
                    u32x4 w; w.x = cvt_pk_bf16(v0[0], v0[1]); w.y = cvt_pk_bf16(v0[2], v0[3]); w.z = cvt_pk_bf16(v1[0], v1[1]); w.w = cvt_pk_bf16(v1[2], v1[3]);
                    *(u32x4*)(rowp + bj * 128) = w;
                }
            }
    }
};
struct EpiE {
    static constexpr bool PERM = false, AFTER_DRAIN = false, KEEP_ACC = false;
    bf16_t* E;
    __device__ __forceinline__ void operator()(const f32x4 (&acc)[2][2][4][2], const Unit& u, int wr, int wc, int fr, int fq) const {
        const int col0 = u.pn * 256 + wc * 32 + 4 * fq;
#pragma unroll
        for (int ai = 0; ai < 2; ++ai)
#pragma unroll
            for (int m = 0; m < 4; ++m) {
                const int row = u.pm * 256 + ai * 128 + wr * 64 + m * 16 + fr;
#pragma unroll
                for (int bj = 0; bj < 2; ++bj)
#pragma unroll
                    for (int n = 0; n < 2; ++n) { const f32x4 v = acc[ai][bj][m][n]; v2u w; w.x = cvt_pk_bf16(v[0], v[1]); w.y = cvt_pk_bf16(v[2], v[3]); *(v2u*)(E + (size_t)row * 1024 + col0 + bj * 128 + n * 16) = w; }
            }
    }
};
struct EpiG6 {
    static constexpr bool PERM = false, AFTER_DRAIN = false, KEEP_ACC = false;
    const bf16_t* baseb; bf16_t* xb; const LAS unsigned char* lds; float* ssout; const bf16_t* E;
    __device__ __forceinline__ void operator()(const f32x4 (&acc)[2][2][4][2], const Unit& u, int wr, int wc, int fr, int fq) const {
        const int col0 = u.pn * 256 + wc * 32 + 4 * fq, lane = fr + 16 * fq;
        float rsv[2][4];
#pragma unroll
        for (int ai = 0; ai < 2; ++ai)
#pragma unroll
            for (int m = 0; m < 4; ++m) rsv[ai][m] = rs_lookup(lds, u.pm, ai * 128 + wr * 64 + m * 16 + fr);
#pragma unroll
        for (int ai = 0; ai < 2; ++ai)
#pragma unroll
        for (int mh = 0; mh < 2; ++mh) {
            v2u bw[2][2][2], ew[2][2][2];
#pragma unroll
            for (int m2 = 0; m2 < 2; ++m2)
#pragma unroll
                for (int bj = 0; bj < 2; ++bj)
#pragma unroll
                    for (int n = 0; n < 2; ++n) { const size_t off = (size_t)(u.pm * 256 + ai * 128 + wr * 64 + (2 * mh + m2) * 16 + fr) * 1024 + col0 + bj * 128 + n * 16;
                        bw[m2][bj][n] = *(const v2u*)(baseb + off); ew[m2][bj][n] = *(const v2u*)(E + off); }
#pragma unroll
            for (int m2 = 0; m2 < 2; ++m2) {
                const int m = 2 * mh + m2;
                const int row = u.pm * 256 + ai * 128 + wr * 64 + m * 16 + fr;
                const float rs = rsv[ai][m];
                float s = 0.f;
#pragma unroll
                for (int bj = 0; bj < 2; ++bj)
#pragma unroll
                    for (int n = 0; n < 2; ++n) {
                        const size_t off = (size_t)row * 1024 + col0 + bj * 128 + n * 16;
                        const f32x4 a = acc[ai][bj][m][n] * rs; const v2u e_ = ew[m2][bj][n], b_ = bw[m2][bj][n];
                        const f32x4 e = (f32x4){bflo(e_.x), bfhi(e_.x), bflo(e_.y), bfhi(e_.y)};
                        f32x4 v = (f32x4){bflo(b_.x), bfhi(b_.x), bflo(b_.y), bfhi(b_.y)};
#pragma unroll
                        for (int k = 0; k < 4; ++k) v[k] += sigmoidf_(a[k]) * e[k];
                        v2u w; w.x = cvt_pk_bf16(v[0], v[1]); w.y = cvt_pk_bf16(v[2], v[3]);
                        *(v2u*)(xb + off) = w;
                        s += (v[0] * v[0] + v[1] * v[1]) + (v[2] * v[2] + v[3] * v[3]);
                    }
                s += shx(s, lane, 16); s += shx(s, lane, 32);
                if (fq == 0) ssout[(size_t)row * 16 + u.pn * 4 + wc] = s;
            }
            asm volatile("" ::: "memory");
        }
    }
};
struct ZOrder {
    pg8::StaticOrder S;
    __device__ __forceinline__ bool next(int i, Unit& u) const { if (!S.next(i / 3, u)) return false; u.z = i % 3; return true; }
    __device__ __forceinline__ void a_ready(const Unit&) const {}
    __device__ __forceinline__ void done(const Unit&) const {}
};

struct Args { const float* in[23]; float* out; unsigned char* ws; int ph_lo, ph_hi; };
typedef const __attribute__((address_space(4))) Args CArgs;
__device__ __forceinline__ CArgs* get_args() {
    CArgs* p = (CArgs*)__builtin_amdgcn_kernarg_segment_ptr();
    asm volatile("" : "+s"(p));
    return p;
}
struct Frame {
    LAS unsigned char* lds;
    int wave0, G, ngw, bid;
    float* out; unsigned char* ws;
    __device__ __forceinline__ int ltid() const { unsigned z = 0u; asm volatile("" : "+v"(z)); return wave0 * 64 + (int)__builtin_amdgcn_mbcnt_hi(~0u, __builtin_amdgcn_mbcnt_lo(~0u, z)); }
    __device__ __forceinline__ int lane() const { return ltid() & 63; }
    __device__ __forceinline__ int wave() const { int w_ = wave0; asm volatile("" : "+s"(w_)); return w_; }
    __device__ __forceinline__ int gw() const { return bid * NWAVES + wave(); }
};

__device__ __forceinline__ void transpose_item(const float* W, const float* g, int K, int N, bf16* WT, LAS float* scr, int item, int lane) {
    const int nblk = N / 32, kb = item / nblk, nb = item % nblk, k0 = 64 * kb, n0 = 32 * nb;
#pragma unroll
    for (int i = 0; i < 32; ++i) { const int kk = 2 * i + (lane >> 5); float v = W[(size_t)(k0 + kk) * N + n0 + (lane & 31)]; if (g) v *= g[k0 + kk]; scr[kk * 33 + (lane & 31)] = v; }
    LDS_WAIT(); asm volatile("" ::: "memory");
    const int c = lane & 7;
#pragma unroll
    for (int j = 0; j < 4; ++j) { const int n = (lane >> 3) + 8 * j; const LAS float* s = scr + (8 * c) * 33 + n;
        v4u o; o.x = pk2(s[0 * 33], s[1 * 33]); o.y = pk2(s[2 * 33], s[3 * 33]); o.z = pk2(s[4 * 33], s[5 * 33]); o.w = pk2(s[6 * 33], s[7 * 33]);
        *(v4u*)(WT + (size_t)(n0 + n) * K + k0 + 8 * c) = o; }
    LDS_WAIT(); asm volatile("" ::: "memory");
}
__device__ __forceinline__ void convert_matrix(const Frame& F, const float* W, const float* g, int K, int N, bf16* WT) {
    LAS float* scr = (LAS float*)(F.lds + F.wave() * 16384);
    const int nitems = (K / 64) * (N / 32);
    for (int it = F.gw(); it < nitems; it += F.ngw) transpose_item(W, g, K, N, WT, scr, it, F.lane());
}
__device__ __forceinline__ void convert_list(const Frame& F, CArgs* A, int l, bool early, bool mid) {
    LAS float* scr = (LAS float*)(F.lds + F.wave() * 16384);
    constexpr int I_IN = (D / 64) * (7680 / 32), I_BR = (512 / 64) * (D / 32), I_SQ = (D / 64) * (D / 32), I_PLE = (PLE / 64) * (D / 32);
    const int n_early = early ? I_IN : 0, n_mid = mid ? 3 * I_BR + 2 * I_SQ + I_PLE : 0, lane = F.lane();
    for (int it = F.gw(); it < n_early + n_mid; it += F.ngw) {
        int r = it;
        if (r < n_early) { transpose_item(A->in[3] + (size_t)l * D * 7680, A->in[2] + l * D, D, 7680, (bf16*)(F.ws + W_IN), scr, r, lane); continue; } r -= n_early;
        if (r < 3 * I_BR) { const int n = r / I_BR; transpose_item(A->in[14] + ((size_t)l * 3 + n) * 512 * D, nullptr, 512, D, (bf16*)(F.ws + W_BR) + (size_t)n * D * 512, scr, r - n * I_BR, lane); continue; } r -= 3 * I_BR;
        if (r < I_SQ) { transpose_item(A->in[15] + (size_t)l * D * D, nullptr, D, D, (bf16*)(F.ws + W_OUT), scr, r, lane); continue; } r -= I_SQ;
        if (r < I_SQ) { transpose_item(A->in[20] + (size_t)l * D * D, A->in[19] + l * D, D, D, (bf16*)(F.ws + W_G(l & 1)), scr, r, lane); continue; } r -= I_SQ;
        transpose_item(A->in[21] + (size_t)l * PLE * D, nullptr, PLE, D, (bf16*)(F.ws + W_PLE(l & 1)), scr, r, lane);
    }
}
__device__ __forceinline__ void convert_layer_early(const Frame& F, CArgs* A, int l) { convert_list(F, A, l, true, false); }
__device__ __forceinline__ void convert_layer_mid(const Frame& F, CArgs* A, int l) { convert_list(F, A, l, false, true); }
__device__ __forceinline__ void convert_layer_mlp(const Frame& F, CArgs* A, int l) {
    LAS float* scr = (LAS float*)(F.lds + F.wave() * 16384);
    constexpr int I_UP = (D / 64) * (FF / 32); const int lane = F.lane();
    for (int it = F.gw(); it < 2 * I_UP; it += F.ngw) {
        if (it < I_UP) transpose_item(A->in[17] + (size_t)l * D * FF, A->in[16] + l * D, D, FF, (bf16*)(F.ws + W_UP), scr, it, lane);
        else transpose_item(A->in[18] + (size_t)l * FF * D, nullptr, FF, D, (bf16*)(F.ws + W_DOWN), scr, it - I_UP, lane);
    }
}

template <class Sched>
__device__ __forceinline__ void stage_epilogue_tables(const Frame& F, const float* ss, const Sched& S, const float* bgate) {
    const int tid = F.ltid(), lane = tid & 63;
    LAS float* rsl = (LAS float*)(F.lds + LO_RSL); LAS int* spm = (LAS int*)(F.lds + LO_RSPM);
    __syncthreads();
    f32x4 sp[4][4]; int pmv[4];
#pragma unroll
    for (int j = 0; j < 4; ++j) { pg8::Unit u; const int i = 2 * j + (tid >> 8); pmv[j] = S.next(i, u) ? u.pm : -1;
        const int row = (pmv[j] < 0 ? 0 : pmv[j]) * 256 + (tid & 255);
#pragma unroll
        for (int q = 0; q < 4; ++q) sp[j][q] = *(const f32x4*)(ss + (size_t)row * 16 + 4 * q); }
#pragma unroll
    for (int j = 0; j < 4; ++j) { const int i = 2 * j + (tid >> 8);
        const f32x4 a = (sp[j][0] + sp[j][1]) + (sp[j][2] + sp[j][3]);
        rsl[i * 256 + (tid & 255)] = 1.0f / sqrtf(((a.x + a.y) + (a.z + a.w)) * (1.0f / D) + RMS_EPS);
        if ((tid & 255) == 0) spm[i] = pmv[j]; }
    if (bgate) { LAS float* bg = (LAS float*)(F.lds + LO_BGL); for (int e = tid; e < 3072; e += NWAVES * 64) bg[e] = bgate[e]; }
    (void)lane;
    __syncthreads();
}
__device__ __forceinline__ void phase_prologue(const Frame& F, CArgs* A) {
    convert_list(F, A, 0, true, false);
    const float* x = A->in[0]; bf16* xb = (bf16*)(F.ws + WS_XB); float* ss = (float*)(F.ws + WS_SSB);
    { const int lane = F.lane();
      for (int m0 = F.gw() * 4; m0 < T; m0 += F.ngw * 4) {
        f32x4 v[4][4];
#pragma unroll
        for (int r = 0; r < 4; ++r)
#pragma unroll
            for (int j = 0; j < 4; ++j) v[r][j] = ((const f32x4*)(x + (size_t)(m0 + r) * D) + lane)[64 * j];
#pragma unroll
        for (int r = 0; r < 4; ++r) {
            v2u* o = (v2u*)(xb + (size_t)(m0 + r) * D) + lane;
            float s = 0.f;
#pragma unroll
            for (int j = 0; j < 4; ++j) { const f32x4 t = v[r][j]; s += (t.x * t.x + t.y * t.y) + (t.z * t.z + t.w * t.w); v2u w; w.x = pk2(t.x, t.y); w.y = pk2(t.z, t.w); o[64 * j] = w; }
            s = wave_sum(s, lane);
            if (lane < 16) ss[(size_t)(m0 + r) * 16 + lane] = lane == 0 ? s : 0.f;
        }
      } }
    { bf16* lw = (bf16*)(F.ws + WS_LW);
      for (int e = F.gw() * 64 + F.lane(); e < DEPTH * 2 * 2 * 8 * 4096; e += F.ngw * 64) {
          const int mat = e >> 12, j = (e >> 6) & 63, i = e & 63, blk = mat & 7, ax = (mat >> 3) & 1, ld = mat >> 4;
          const float* src = (ax ? A->in[11] : A->in[9]) + ((size_t)ld * 8 + blk) * 4096;
          lw[e] = (bf16)f2bf(src[i * 64 + j]); }
      float* sp = (float*)(F.ws + WS_SP);
      for (int e = F.gw() * 64 + F.lane(); e < DEPTH * 2 * 512; e += F.ngw * 64) sp[e] = log1p_small(fexp(-A->in[13][e])); }
    float* tab = (float*)(F.ws + WS_TAB);
    for (int e = F.gw() * 64 + F.lane(); e < SEQ * 64; e += F.ngw * 64) {
        const int pos = e >> 6, i = e & 63;
        const float theta = __builtin_amdgcn_exp2f(-(float)i * (13.287712379549449f / 63.0f));
        double rev = (double)pos * (double)theta * 0.15915494309189535; rev -= __builtin_floor(rev);
        const float fr = (float)rev;
        tab[e] = __builtin_amdgcn_cosf(fr); tab[131072 + e] = __builtin_amdgcn_sinf(fr);
    }
}


typedef short bf16x8_t __attribute__((ext_vector_type(8)));
typedef float f32x2_t __attribute__((ext_vector_type(2))); typedef __bf16 bf16x2_t __attribute__((ext_vector_type(2)));
__device__ __forceinline__ unsigned pkbf(float lo, float hi) { f32x2_t v = {lo, hi}; bf16x2_t b = __builtin_convertvector(v, bf16x2_t); return __builtin_bit_cast(unsigned, b); }
typedef short v4i16_t __attribute__((ext_vector_type(4)));
__device__ __forceinline__ v4i16_t ds_tr16(LAS const unsigned char* p) { return __builtin_amdgcn_ds_read_tr16_b64_v4i16((LAS v4i16_t*)p); }
__device__ __forceinline__ bf16x8_t tr_frag(LAS const unsigned char* p0, LAS const unsigned char* p1) {
    const v4i16_t a = ds_tr16(p0), b = ds_tr16(p1);
    return (bf16x8_t){a[0], a[1], a[2], a[3], b[0], b[1], b[2], b[3]};
}
#define MFMA16(a, b, c) __builtin_amdgcn_mfma_f32_16x16x32_bf16((a), (b), (c), 0, 0, 0)
constexpr int RP = 272;
__device__ __forceinline__ void ret_scan_item(const Frame& F, int item) {
    const int bh = item >> 3, dir = (item >> 2) & 1, dvq = item & 3, b = bh >> 2, h = bh & 3;
    const bf16* Kg = (const bf16*)(F.ws + WS_PROJ + 5 * BLK); const bf16* Vg = (const bf16*)(F.ws + WS_PROJ + 7 * BLK);
    bf16* ST = (bf16*)F.out;
    const float lg = log2_1m(__builtin_amdgcn_exp2f((dir ? -5.5f : -5.0f) - (float)h));
    const float cdec = __builtin_amdgcn_exp2f(128.0f * lg);
    constexpr int VP = 80, BUF = 128 * RP + 128 * VP;
    const int tid = F.ltid(), lane = F.lane(), w = F.wave(), g = lane >> 4, i = lane & 15, q4 = i >> 2, p4 = i & 3;
    v4u kr0[4], kr1[4], vr0, vr1;
    const int vrow = tid >> 2, vch = tid & 3;
#define RS_LOAD(kr, vr, c_) do { const size_t tb = (size_t)b * SEQ + (c_) * 128; \
        _Pragma("unroll") for (int q = 0; q < 4; ++q) { const int idx = tid + 512 * q; kr[q] = *(const v4u*)(Kg + (tb + (idx >> 4)) * 512 + h * 128 + (idx & 15) * 8); } \
        vr = *(const v4u*)(Vg + (tb + vrow) * 512 + h * 128 + dvq * 32 + vch * 8); } while (0)
#define RS_WRITE(kr, vr, buf_) do { LAS unsigned char* Kb_ = F.lds + (buf_) * BUF; LAS unsigned char* Vb_ = Kb_ + 128 * RP; \
        _Pragma("unroll") for (int q = 0; q < 4; ++q) { const int idx = tid + 512 * q, row = idx >> 4; \
            const float dk_ = __builtin_amdgcn_exp2f((float)(dir ? row : 127 - row) * lg); v4u o; \
            _Pragma("unroll") for (int e = 0; e < 4; ++e) o[e] = pkbf(bflo(kr[q][e]) * dk_, bfhi(kr[q][e]) * dk_); \
            *(LAS v4u*)(Kb_ + row * RP + (idx & 15) * 16) = o; } \
        *(LAS v4u*)(Vb_ + vrow * VP + vch * 16) = vr; } while (0)
#define RS_CHUNK(s_) (dir ? 15 - (s_) : (s_))
#define RS_STEP(s_, krN, vrN, krW, vrW) do { const int c = RS_CHUNK(s_), buf = (s_) & 1; \
        if ((s_) + 2 < 16) RS_LOAD(krN, vrN, RS_CHUNK((s_) + 2)); \
        bf16* dst = ST + ((size_t)(bh * 2 + dir) * 16 + c) * 16384; \
        _Pragma("unroll") for (int n = 0; n < 2; ++n) { v2u o; o.x = pkbf(acc[n][0], acc[n][1]); o.y = pkbf(acc[n][2], acc[n][3]); *(v2u*)(dst + (32 * dvq + 16 * n + i) * 128 + 16 * w + 4 * g) = o; } \
        acc[0] = acc[0] * cdec; acc[1] = acc[1] * cdec; \
        const LAS unsigned char* Kb = F.lds + buf * BUF; const LAS unsigned char* Vb = Kb + 128 * RP; \
        _Pragma("unroll") for (int ks = 0; ks < 4; ++ks) { const int r0 = 32 * ks + 8 * g + q4; \
            const bf16x8_t af = tr_frag(Kb + r0 * RP + (16 * w + 4 * p4) * 2, Kb + (r0 + 4) * RP + (16 * w + 4 * p4) * 2); \
            _Pragma("unroll") for (int n = 0; n < 2; ++n) { const bf16x8_t bv = tr_frag(Vb + r0 * VP + (16 * n + 4 * p4) * 2, Vb + (r0 + 4) * VP + (16 * n + 4 * p4) * 2); acc[n] = MFMA16(af, bv, acc[n]); } } \
        if ((s_) + 1 < 16) RS_WRITE(krW, vrW, buf ^ 1); \
        __syncthreads(); } while (0)
    __syncthreads();
    RS_LOAD(kr0, vr0, RS_CHUNK(0));
    RS_LOAD(kr1, vr1, RS_CHUNK(1));
    RS_WRITE(kr0, vr0, 0);
    __syncthreads();
    f32x4 acc[2]; acc[0] = (f32x4){0.f, 0.f, 0.f, 0.f}; acc[1] = acc[0];
    for (int s2 = 0; s2 < 16; s2 += 2) {
        RS_STEP(s2, kr0, vr0, kr1, vr1);
        RS_STEP(s2 + 1, kr1, vr1, kr0, vr0);
    }
#undef RS_STEP
#undef RS_CHUNK
#undef RS_LOAD
#undef RS_WRITE
}
__device__ __forceinline__ void ret_out_item(const Frame& F, const float* gn, int item) {
    const int bh = item >> 4, ci = item & 15, b = bh >> 2, h = bh & 3, t0 = b * SEQ + ci * 128;
    bf16* Gg = (bf16*)(F.ws + WS_PROJ + 3 * BLK); const bf16* Qg = (const bf16*)(F.ws + WS_PROJ + 4 * BLK);
    const bf16* Kg = (const bf16*)(F.ws + WS_PROJ + 5 * BLK); const bf16* Vg = (const bf16*)(F.ws + WS_PROJ + 7 * BLK);
    const bf16* ST = (const bf16*)F.out;
    const float lgf = log2_1m(__builtin_amdgcn_exp2f(-5.0f - (float)h)), lgb = log2_1m(__builtin_amdgcn_exp2f(-5.5f - (float)h));
    LAS unsigned char* Kl = F.lds; LAS unsigned char* Vl = F.lds + 128 * RP; LAS unsigned char* Sf = F.lds + 2 * 128 * RP; LAS unsigned char* Sb = F.lds + 3 * 128 * RP;
    const int lane = F.lane(), w = F.wave(), g = lane >> 4, i = lane & 15, q4 = i >> 2, p4 = i & 3;
    const int nl = 16 * w + i;
    bf16* grow = Gg + (size_t)(t0 + nl) * 512 + h * 128;
    bf16x8_t bq[4]; v2u ggv[8];
#pragma unroll
    for (int ks = 0; ks < 4; ++ks) bq[ks] = *(const bf16x8_t*)(Qg + (size_t)(t0 + nl) * 512 + h * 128 + 32 * ks + 8 * g);
#pragma unroll
    for (int n = 0; n < 8; ++n) ggv[n] = *(const v2u*)(grow + 16 * n + 4 * g);
    __syncthreads();
    {
#pragma unroll
        for (int q = 0; q < 4; ++q) {
            const int idx = F.ltid() + 512 * q, row = idx >> 4, ch = idx & 15;
            *(LAS v4u*)(Kl + row * RP + ch * 16) = *(const v4u*)(Kg + (size_t)(t0 + row) * 512 + h * 128 + ch * 8);
            *(LAS v4u*)(Vl + row * RP + ch * 16) = *(const v4u*)(Vg + (size_t)(t0 + row) * 512 + h * 128 + ch * 8);
        }
        const bf16* sfp = ST + ((size_t)(bh * 2 + 0) * 16 + ci) * 16384; const bf16* sbp = ST + ((size_t)(bh * 2 + 1) * 16 + ci) * 16384;
#pragma unroll
        for (int q = 0; q < 4; ++q) {
            const int idx = F.ltid() + 512 * q, row = idx >> 4, ch = idx & 15;
            *(LAS v4u*)(Sf + row * RP + ch * 16) = *(const v4u*)(sfp + idx * 8);
            *(LAS v4u*)(Sb + row * RP + ch * 16) = *(const v4u*)(sbp + idx * 8);
        }
    }
    __syncthreads();
    bf16x8_t bp[4];
#pragma unroll
    for (int kp = 0; kp < 4; ++kp) {
        f32x4 s0 = (f32x4){0.f, 0.f, 0.f, 0.f}, s1 = s0;
#pragma unroll
        for (int ks = 0; ks < 4; ++ks) {
            const bf16x8_t a0 = *(const LAS bf16x8_t*)(Kl + (32 * kp + i) * RP + (32 * ks + 8 * g) * 2);
            const bf16x8_t a1 = *(const LAS bf16x8_t*)(Kl + (32 * kp + 16 + i) * RP + (32 * ks + 8 * g) * 2);
            s0 = MFMA16(a0, bq[ks], s0); s1 = MFMA16(a1, bq[ks], s1);
        }
        float pv[8];
#pragma unroll
        for (int e = 0; e < 4; ++e) {
            const int m0 = 32 * kp + 4 * g + e, m1 = m0 + 16;
            const float d0 = (float)(nl - m0), d1 = (float)(nl - m1);
            pv[e] = s0[e] * (d0 >= 0.f ? __builtin_amdgcn_exp2f(d0 * lgf) : __builtin_amdgcn_exp2f(-d0 * lgb));
            pv[4 + e] = s1[e] * (d1 >= 0.f ? __builtin_amdgcn_exp2f(d1 * lgf) : __builtin_amdgcn_exp2f(-d1 * lgb));
        }
        v4u pk; pk.x = pkbf(pv[0], pv[1]); pk.y = pkbf(pv[2], pv[3]); pk.z = pkbf(pv[4], pv[5]); pk.w = pkbf(pv[6], pv[7]);
        bp[kp] = __builtin_bit_cast(bf16x8_t, pk);
    }
    f32x4 oi[8], of[8], ob[8];
#pragma unroll
    for (int n = 0; n < 8; ++n) { oi[n] = (f32x4){0.f, 0.f, 0.f, 0.f}; of[n] = oi[n]; ob[n] = oi[n]; }
#pragma unroll
    for (int kp = 0; kp < 4; ++kp) {
        const int r0 = (32 * kp + 4 * g + q4) * RP, r1 = r0 + 16 * RP;
#pragma unroll
        for (int n = 0; n < 8; ++n) { const bf16x8_t av = tr_frag(Vl + r0 + (16 * n + 4 * p4) * 2, Vl + r1 + (16 * n + 4 * p4) * 2); oi[n] = MFMA16(av, bp[kp], oi[n]); }
    }
#pragma unroll
    for (int ks = 0; ks < 4; ++ks)
#pragma unroll
        for (int n = 0; n < 8; ++n) {
            const bf16x8_t af = *(const LAS bf16x8_t*)(Sf + (16 * n + i) * RP + (32 * ks + 8 * g) * 2);
            const bf16x8_t ab = *(const LAS bf16x8_t*)(Sb + (16 * n + i) * RP + (32 * ks + 8 * g) * 2);
            of[n] = MFMA16(af, bq[ks], of[n]); ob[n] = MFMA16(ab, bq[ks], ob[n]);
        }
    const float qdf = __builtin_amdgcn_exp2f((float)(nl + 1) * lgf), qdb = __builtin_amdgcn_exp2f((float)(128 - nl) * lgb);
    float ss = 0.f;
#pragma unroll
    for (int n = 0; n < 8; ++n) { oi[n] = oi[n] + of[n] * qdf + ob[n] * qdb; ss += (oi[n][0] * oi[n][0] + oi[n][1] * oi[n][1]) + (oi[n][2] * oi[n][2] + oi[n][3] * oi[n][3]); }
    ss += shx(ss, lane, 16); ss += shx(ss, lane, 32);
    const float rn = 1.0f / sqrtf(ss * (1.0f / 128.0f) + RMS_EPS);
#pragma unroll
    for (int n = 0; n < 8; ++n) {
        const int dv0 = 16 * n + 4 * g;
        const v2u gg = ggv[n]; const f32x4 gw = *(const f32x4*)(gn + h * 128 + dv0);
        const float g0 = bflo(gg.x), g1 = bfhi(gg.x), g2 = bflo(gg.y), g3 = bfhi(gg.y);
        v2u o; o.x = pkbf(g0 * sigmoidf_(g0) * oi[n][0] * rn * gw[0], g1 * sigmoidf_(g1) * oi[n][1] * rn * gw[1]);
        o.y = pkbf(g2 * sigmoidf_(g2) * oi[n][2] * rn * gw[2], g3 * sigmoidf_(g3) * oi[n][3] * rn * gw[3]);
        *(v2u*)(grow + dv0) = o;
    }
}

constexpr int LO_WL = 0, LO_CST = 36864, LO_XC = 39680, LO_XF = 58688, LO_XB = 93504, LO_GY = 111936, LO_SEG = 130368, LO_HIN = 138560;
__device__ __forceinline__ void lru_stage_consts(const Frame& F, CArgs* A, int l, int blk) {
    const bf16* LW = (const bf16*)(F.ws + WS_LW); const float* SP = (const float*)(F.ws + WS_SP);
    __syncthreads();
#pragma unroll
    for (int q = 0; q < 4; ++q) { const int idx = F.ltid() + 512 * q, m = idx >> 9, row = (idx >> 3) & 63, ch = idx & 7;
        const int d = m >> 1, ax = m & 1;
        *(LAS v4u*)(F.lds + LO_WL + (m * 64 + row) * 144 + ch * 16) = *(const v4u*)(LW + (size_t)((((l * 2 + d) * 2 + ax) * 8 + blk)) * 4096 + row * 64 + ch * 8); }
    LAS float* cst = (LAS float*)(F.lds + LO_CST);
    if (F.ltid() < 128) { const int d = F.ltid() >> 6, j = F.ltid() & 63, pi = (l * 2 + d) * 512 + blk * 64 + j; cst[F.ltid()] = A->in[10][pi]; cst[128 + F.ltid()] = A->in[12][pi]; cst[256 + F.ltid()] = SP[pi]; }
    else if (F.ltid() < 384) { const int e = F.ltid() - 128, tap = e >> 6, j = e & 63; cst[384 + e] = A->in[7][(size_t)l * 2048 + tap * 512 + blk * 64 + j]; }
    else if (F.ltid() < 448) { const int j = F.ltid() - 384; cst[640 + j] = A->in[8][(size_t)l * 512 + blk * 64 + j]; }
}
struct LruPre { v4u xc[3]; v4u gc[2]; float agx[15], agy[15]; };
template <int MODE>
__device__ __forceinline__ void lru_fetch(const Frame& F, int item, LruPre& P) {
    const int b = item >> 7, c = (item >> 3) & 15, blk = item & 7, t0 = b * SEQ + c * 128, s0 = c * 128, tid = F.ltid();
    const bf16* XCg = (const bf16*)(F.ws + WS_PROJ + 8 * BLK); const bf16* GCg = (const bf16*)(F.ws + WS_PROJ + 6 * BLK); const float* AGG = (const float*)(F.ws + WS_AGG);
#pragma unroll
    for (int q = 0; q < 3; ++q) {
        const int idx = tid + 512 * q, row = idx >> 3, ch = idx & 7, s_ = s0 - 2 + row;
        P.xc[q] = (v4u){0u, 0u, 0u, 0u};
        if (idx < 1056 && s_ >= 0 && s_ < SEQ) P.xc[q] = *(const v4u*)(XCg + (size_t)(b * SEQ + s_) * 512 + blk * 64 + ch * 8);
    }
    if (MODE >= 1) {
#pragma unroll
        for (int q = 0; q < 2; ++q) { const int idx = tid + 512 * q, row = idx >> 3, ch = idx & 7; P.gc[q] = *(const v4u*)(GCg + (size_t)(t0 + row) * 512 + blk * 64 + ch * 8); }
        if (MODE == 1 && tid < 128) {
            typedef float f2 __attribute__((ext_vector_type(2)));
            const int d = tid >> 6, ch = blk * 64 + (tid & 63);
#pragma unroll
            for (int k = 0; k < 15; ++k) { const int cc = d ? 15 - k : k; const f2 a = *(const f2*)(AGG + ((size_t)((b * 16 + cc) * 2 + d) * 512 + ch) * 2); P.agx[k] = a.x; P.agy[k] = a.y; }
        }
    }
}
template <int MODE>
__device__ __forceinline__ void lru_item(const Frame& F, int item, const LruPre& P, int l) {
    const int b = item >> 7, c = (item >> 3) & 15, blk = item & 7, t0 = b * SEQ + c * 128;
    bf16* GCg = (bf16*)(F.ws + WS_PROJ + 6 * BLK);
    float* AGG = (float*)(F.ws + WS_AGG);
    LAS unsigned char* WL = F.lds + LO_WL; const LAS float* cst = (const LAS float*)(F.lds + LO_CST);
    LAS unsigned char* XC = F.lds + LO_XC; LAS float* XF = (LAS float*)(F.lds + LO_XF); LAS unsigned char* XB = F.lds + LO_XB; LAS unsigned char* GY = F.lds + LO_GY;
    LAS float* SEG = (LAS float*)(F.lds + LO_SEG); LAS float* HIN = (LAS float*)(F.lds + LO_HIN);
    typedef float f2 __attribute__((ext_vector_type(2)));
    const int tid = F.ltid(), lane = F.lane(), w = F.wave(), g = lane >> 4, i = lane & 15;
    __syncthreads();
#pragma unroll
    for (int q = 0; q < 3; ++q) { const int idx = tid + 512 * q; if (idx < 1056) *(LAS v4u*)(XC + (idx >> 3) * 144 + (idx & 7) * 16) = P.xc[q]; }
    if (MODE >= 1) {
#pragma unroll
        for (int q = 0; q < 2; ++q) { const int idx = tid + 512 * q; *(LAS v4u*)(GY + (idx >> 3) * 144 + (idx & 7) * 16) = P.gc[q]; }
        if (MODE == 1 && tid < 128) {
            const int d = tid >> 6;
            float h = 0.f;
#pragma unroll
            for (int k = 0; k < 15; ++k) { const int cc = d ? 15 - k : k; const bool valid = d ? (cc > c) : (cc < c); h = valid ? P.agx[k] * h + P.agy[k] : h; }
            HIN[tid] = h;
        }
    }
    __syncthreads();
#pragma unroll
    for (int q = 0; q < 2; ++q) {
        const int idx = tid + 512 * q, t = idx >> 3, c8 = idx & 7;
        float xf[8];
        { const f32x4 b0 = *(const LAS f32x4*)(cst + 640 + c8 * 8), b1 = *(const LAS f32x4*)(cst + 640 + c8 * 8 + 4); xf[0] = b0[0]; xf[1] = b0[1]; xf[2] = b0[2]; xf[3] = b0[3]; xf[4] = b1[0]; xf[5] = b1[1]; xf[6] = b1[2]; xf[7] = b1[3]; }
#pragma unroll
        for (int tap = 0; tap < 4; ++tap) {
            const v4u x = *(const LAS v4u*)(XC + (t + tap) * 144 + c8 * 16);
            const f32x4 w0 = *(const LAS f32x4*)(cst + 384 + tap * 64 + c8 * 8), w1 = *(const LAS f32x4*)(cst + 384 + tap * 64 + c8 * 8 + 4);
            xf[0] += w0[0] * bflo(x[0]); xf[1] += w0[1] * bfhi(x[0]); xf[2] += w0[2] * bflo(x[1]); xf[3] += w0[3] * bfhi(x[1]);
            xf[4] += w1[0] * bflo(x[2]); xf[5] += w1[1] * bfhi(x[2]); xf[6] += w1[2] * bflo(x[3]); xf[7] += w1[3] * bfhi(x[3]);
        }
        *(LAS f32x4*)(XF + t * 68 + c8 * 8) = (f32x4){xf[0], xf[1], xf[2], xf[3]}; *(LAS f32x4*)(XF + t * 68 + c8 * 8 + 4) = (f32x4){xf[4], xf[5], xf[6], xf[7]};
        v4u o; o.x = pkbf(xf[0], xf[1]); o.y = pkbf(xf[2], xf[3]); o.z = pkbf(xf[4], xf[5]); o.w = pkbf(xf[6], xf[7]);
        *(LAS v4u*)(XB + t * 144 + c8 * 16) = o;
    }
    __syncthreads();
    float av[2][4][4], bv[2][4][4];
    {
        const bf16x8_t a0 = *(const LAS bf16x8_t*)(XB + (16 * w + i) * 144 + (8 * g) * 2), a1 = *(const LAS bf16x8_t*)(XB + (16 * w + i) * 144 + (32 + 8 * g) * 2);
#pragma unroll
        for (int d = 0; d < 2; ++d) {
#pragma unroll
            for (int jt = 0; jt < 4; ++jt) {
                const LAS unsigned char* wa = WL + ((d * 2 + 0) * 64 + 16 * jt + i) * 144 + (8 * g) * 2; const LAS unsigned char* wx = WL + ((d * 2 + 1) * 64 + 16 * jt + i) * 144 + (8 * g) * 2;
                const f32x4 z = (f32x4){0.f, 0.f, 0.f, 0.f};
                f32x4 ca = MFMA16(a0, *(const LAS bf16x8_t*)wa, z); ca = MFMA16(a1, *(const LAS bf16x8_t*)(wa + 64), ca);
                f32x4 cx = MFMA16(a0, *(const LAS bf16x8_t*)wx, z); cx = MFMA16(a1, *(const LAS bf16x8_t*)(wx + 64), cx);
                const int j = 16 * jt + i;
                const float ba = cst[d * 64 + j], bx = cst[128 + d * 64 + j], sp = cst[256 + d * 64 + j];
#pragma unroll
                for (int r = 0; r < 4; ++r) {
                    const int t = 16 * w + 4 * g + r;
                    const float xfv = XF[t * 68 + j];
                    const float rr = sigmoidf_(ca[r] + ba), ig = sigmoidf_(cx[r] + bx);
                    const float la = -8.0f * rr * sp, a = fexp(la), x2 = 2.0f * la;
                    const float omp = -x2 * (1.0f + x2 * (0.5f + x2 * (0.16666667f + x2 * (0.041666668f + x2 * (0.0083333333f + x2 * 0.0013888889f))))), omq = 1.0f - a * a, selp = x2 > -0.5f ? 1.0f : 0.0f;
                    const float om = selp * omp + (1.0f - selp) * omq;
                    float mult = __builtin_amdgcn_sqrtf(om);
                    if (d == 0 ? (c == 0 && t == 0) : (c == 15 && t == 127)) mult = 1.0f;
                    av[d][jt][r] = a; bv[d][jt][r] = mult * ig * xfv;
                }
            }
        }
    }
    float Ae[2][4], Be[2][4];
#pragma unroll
    for (int jt = 0; jt < 4; ++jt) {
        float Af = av[0][jt][0] * av[0][jt][1] * av[0][jt][2] * av[0][jt][3];
        float Bf = ((bv[0][jt][0] * av[0][jt][1] + bv[0][jt][1]) * av[0][jt][2] + bv[0][jt][2]) * av[0][jt][3] + bv[0][jt][3];
        float Ar = av[1][jt][0] * av[1][jt][1] * av[1][jt][2] * av[1][jt][3];
        float Br = ((bv[1][jt][3] * av[1][jt][2] + bv[1][jt][2]) * av[1][jt][1] + bv[1][jt][1]) * av[1][jt][0] + bv[1][jt][0];
#pragma unroll
        for (int st = 16; st <= 32; st <<= 1) {
            const float pAf = lane_get(Af, lane - st), pBf = lane_get(Bf, lane - st), pAr = lane_get(Ar, lane + st), pBr = lane_get(Br, lane + st);
            if (lane >= st) { Bf = Af * pBf + Bf; Af = Af * pAf; }
            if (lane + st < 64) { Br = Ar * pBr + Br; Ar = Ar * pAr; }
        }
        const float eAf = lane_get(Af, lane - 16), eBf = lane_get(Bf, lane - 16), eAr = lane_get(Ar, lane + 16), eBr = lane_get(Br, lane + 16);
        Ae[0][jt] = g > 0 ? eAf : 1.0f; Be[0][jt] = g > 0 ? eBf : 0.0f; Ae[1][jt] = g < 3 ? eAr : 1.0f; Be[1][jt] = g < 3 ? eBr : 0.0f;
        if (g == 3) *(LAS f2*)(SEG + ((0 * 8 + w) * 64 + 16 * jt + i) * 2) = (f2){Af, Bf};
        if (g == 0) *(LAS f2*)(SEG + ((1 * 8 + w) * 64 + 16 * jt + i) * 2) = (f2){Ar, Br};
    }
    __syncthreads();
    if (MODE == 2) {
        if (w < 2) {
            const int d = w, j = lane;
            float h = 0.f, Ap = 1.0f;
#pragma unroll
            for (int k = 0; k < 8; ++k) { const int ww = d ? 7 - k : k; const f2 sg = *(const LAS f2*)(SEG + ((d * 8 + ww) * 64 + j) * 2); h = sg.x * h + sg.y; Ap *= sg.x; }
            typedef GAS unsigned long long gu64;
            gu64* agg = (gu64*)(AGG) + (size_t)((b * 16) * 2 + d) * 512 + blk * 64 + j;
            gu32* flg = (gu32*)(F.ws + WS_CTL) + 8192 + (((l * 8 + b) * 16) * 8 + blk) * 2 + d;
            __hip_atomic_store(agg + (size_t)c * 1024, ((unsigned long long)__builtin_bit_cast(unsigned, h) << 32) | __builtin_bit_cast(unsigned, Ap), RLX_AGENT);
            asm volatile("s_waitcnt vmcnt(0)" ::: "memory");
            if (lane == 0) __hip_atomic_store(flg + c * 16, 1u, RLX_AGENT);
            const int need = d ? 15 - c : c;
            { unsigned spins = 0;
              for (;;) { const int cc = d ? 15 - lane : lane; unsigned v = 1u; if (lane < need) v = __hip_atomic_load(flg + cc * 16, RLX_AGENT);
                  if (__builtin_amdgcn_ballot_w64(v == 0u) == 0ull) break;
                  __builtin_amdgcn_s_sleep(2); if (++spins > (1u << 20)) break; } }
            float hin = 0.f;
#pragma unroll
            for (int k0 = 0; k0 < 16; k0 += 8) {
                unsigned long long gv[8];
#pragma unroll
                for (int k = 0; k < 8; ++k) { const int kk = k0 + k, cc = d ? 15 - kk : kk; gv[k] = (kk < need) ? __hip_atomic_load(agg + (size_t)(cc & 15) * 1024, RLX_AGENT) : 0ull; }
#pragma unroll
                for (int k = 0; k < 8; ++k) { const float a_ = __builtin_bit_cast(float, (unsigned)gv[k]), b_ = __builtin_bit_cast(float, (unsigned)(gv[k] >> 32)); hin = (k0 + k < need) ? a_ * hin + b_ : hin; }
                asm volatile("" : "+v"(hin) :: "memory");
            }
            HIN[d * 64 + j] = hin;
        }
        __syncthreads();
    }
    if (MODE == 0) {
        if (w == 0 && g < 2) {
            const int d = g;
#pragma unroll
            for (int jt = 0; jt < 4; ++jt) {
                const int j = 16 * jt + i; float h = 0.f, Ap = 1.0f;
#pragma unroll
                for (int k = 0; k < 8; ++k) { const int ww = d ? 7 - k : k; const f2 sg = *(const LAS f2*)(SEG + ((d * 8 + ww) * 64 + j) * 2); h = sg.x * h + sg.y; Ap *= sg.x; }
                *(f2*)(AGG + ((size_t)((b * 16 + c) * 2 + d) * 512 + blk * 64 + j) * 2) = (f2){Ap, h};
            }
        }
    } else {
#pragma unroll
        for (int jt = 0; jt < 4; ++jt) {
            const int j = 16 * jt + i;
            float hf = HIN[j], hr = HIN[64 + j];
            f2 sfv[8], srv[8];
#pragma unroll
            for (int k = 0; k < 8; ++k) { sfv[k] = *(const LAS f2*)(SEG + ((0 * 8 + k) * 64 + j) * 2); srv[k] = *(const LAS f2*)(SEG + ((1 * 8 + (7 - k)) * 64 + j) * 2); }
#pragma unroll
            for (int k = 0; k < 8; ++k) {
                const bool uf = k < w, ur = 7 - k > w;
                hf = (uf ? sfv[k].x : 1.0f) * hf + (uf ? sfv[k].y : 0.0f);
                hr = (ur ? srv[k].x : 1.0f) * hr + (ur ? srv[k].y : 0.0f);
            }
            float h = Ae[0][jt] * hf + Be[0][jt];
            float hs[4];
#pragma unroll
            for (int r = 0; r < 4; ++r) { h = av[0][jt][r] * h + bv[0][jt][r]; hs[r] = h; }
            h = Ae[1][jt] * hr + Be[1][jt];
#pragma unroll
            for (int r = 3; r >= 0; --r) { h = av[1][jt][r] * h + bv[1][jt][r]; hs[r] += h; }
#pragma unroll
            for (int r = 0; r < 4; ++r) { LAS bf16* p = (LAS bf16*)(GY + (16 * w + 4 * g + r) * 144) + j; *p = (bf16)f2bf(gelu_tanh(bf2f(*p)) * hs[r]); }
        }
        __syncthreads();
#pragma unroll
        for (int q = 0; q < 2; ++q) { const int idx = tid + 512 * q, row = idx >> 3, ch = idx & 7;
            *(v4u*)(GCg + (size_t)(t0 + row) * 512 + blk * 64 + ch * 8) = *(const LAS v4u*)(GY + row * 144 + ch * 16); }
    }
}
template <int MODE> __device__ __forceinline__ void phase_lru(const Frame& F, CArgs* A, int l) {
    int cur = -1;
    LruPre P0, P1;
    if (F.bid < 1024) lru_fetch<MODE>(F, F.bid, P0);
    for (int it = F.bid; it < 1024; it += 2 * F.G) {
        { const int blk = it & 7; if (blk != cur) { lru_stage_consts(F, A, l, blk); cur = blk; } }
        const int it1 = it + F.G, it2 = it + 2 * F.G;
        if (it1 < 1024) lru_fetch<MODE>(F, it1, P1);
        lru_item<MODE>(F, it, P0, l);
        if (it1 < 1024) {
            { const int blk = it1 & 7; if (blk != cur) { lru_stage_consts(F, A, l, blk); cur = blk; } }
            if (it2 < 1024) lru_fetch<MODE>(F, it2, P0);
            lru_item<MODE>(F, it1, P1, l);
        }
    }
}


struct NaSide { const float* psrc; const float* wup; const float* gup; const float* wdown; bf16* wup_t; bf16* wdown_t;
    int nxt;
    const float* win; const float* gin; const float* wbr; const float* wout; const float* wg; const float* gg; const float* wple;
    int own;
    const float* owbr; const float* owout; const float* owg; const float* ogg; const float* owple; unsigned char* wsb; };
struct Strip { const float* W; const float* g; bf16* WT; int Kd, Nd, sl; bool on; };
__device__ __forceinline__ void strip_load(const Strip& st, int tid, float (&wv)[16]) {
    if (!st.on) return;
    const int nblk = st.Nd / 64, kb = st.sl / nblk, nb = st.sl % nblk, n = nb * 64 + (tid & 63), k0 = kb * 64 + 16 * ((tid >> 6) & 3);
#pragma unroll
    for (int j = 0; j < 16; ++j) wv[j] = st.W[(size_t)(k0 + j) * st.Nd + n];
}
__device__ __forceinline__ void strip_store(const Strip& st, int tid, float (&wv)[16]) {
    if (!st.on) return;
    const int nblk = st.Nd / 64, kb = st.sl / nblk, nb = st.sl % nblk, n = nb * 64 + (tid & 63), k0 = kb * 64 + 16 * ((tid >> 6) & 3);
    if (st.g) {
#pragma unroll
        for (int j = 0; j < 16; ++j) wv[j] *= st.g[k0 + j];
    }
    v4u t0, t1;
    t0.x = pk2(wv[0], wv[1]); t0.y = pk2(wv[2], wv[3]); t0.z = pk2(wv[4], wv[5]); t0.w = pk2(wv[6], wv[7]);
    t1.x = pk2(wv[8], wv[9]); t1.y = pk2(wv[10], wv[11]); t1.z = pk2(wv[12], wv[13]); t1.w = pk2(wv[14], wv[15]);
    *(v4u*)(st.WT + (size_t)n * st.Kd + k0) = t0; *(v4u*)(st.WT + (size_t)n * st.Kd + k0 + 8) = t1;
}
__device__ __forceinline__ void na_group(const Frame& F, const float* rpb, int grp, const NaSide sd) {
    const int b = grp >> 5, h = (grp >> 2) & 7, rg = grp & 3, r0 = rg * 8;
    bf16* Qg = (bf16*)(F.ws + WS_PROJ); const bf16* Kg = (const bf16*)(F.ws + WS_PROJ + BLK); const bf16* Vg = (const bf16*)(F.ws + WS_PROJ + 2 * BLK);
    LAS unsigned char* Kl = F.lds; LAS unsigned char* Vl = F.lds + 512 * 144; LAS float* Bl = (LAS float*)(F.lds + 2 * 512 * 144);
    const int tid = F.ltid();
    int rs = r0 - 4; rs = rs < 0 ? 0 : (rs > 24 ? 24 : rs);
    __syncthreads();
#pragma unroll
    for (int q = 0; q < 8; ++q) {
        const int idx = tid + 512 * q, kidx = idx >> 3, ch = idx & 7, grow = rs + (kidx >> 6), col = kidx & 63;
        const size_t tok = (size_t)b * SEQ + grow * 64 + col; const int lrow = (grow & 7) * 64 + col;
        *(LAS v4u*)(Kl + lrow * 144 + ch * 16) = *(const v4u*)(Kg + tok * 512 + h * 64 + ch * 8);
        *(LAS v4u*)(Vl + lrow * 144 + ch * 16) = *(const v4u*)(Vg + tok * 512 + h * 64 + ch * 8);
    }
    if (tid < 465) Bl[tid] = rpb[h * 465 + tid];
    __syncthreads();
    const int w = F.wave(), lane = F.lane(), g = lane >> 4, i = lane & 15, q4 = i >> 2, p4 = i & 3;
    const int cq = 16 * (w & 3) + i;
    bf16x8_t bq0 = *(const bf16x8_t*)(Qg + ((size_t)b * SEQ + r0 * 64 + cq) * 512 + h * 64 + 8 * g), bq1 = *(const bf16x8_t*)(Qg + ((size_t)b * SEQ + r0 * 64 + cq) * 512 + h * 64 + 32 + 8 * g);
    for (int k = 0; k < 8; ++k) {
        const int r = r0 + k;
        const int rq = k < 7 ? r + 1 : r;
        const bf16x8_t nq0 = *(const bf16x8_t*)(Qg + ((size_t)b * SEQ + rq * 64 + cq) * 512 + h * 64 + 8 * g), nq1 = *(const bf16x8_t*)(Qg + ((size_t)b * SEQ + rq * 64 + cq) * 512 + h * 64 + 32 + 8 * g);
        int rsn = r + 1 - 4; rsn = rsn < 0 ? 0 : (rsn > 24 ? 24 : rsn);
        const bool slide = (k < 7) && (rsn != rs);
        v4u pk = (v4u){0u, 0u, 0u, 0u}, pv = pk;
        if (slide) { const size_t tok = (size_t)b * SEQ + (rsn + 7) * 64 + (tid >> 3);
            pk = *(const v4u*)(Kg + tok * 512 + h * 64 + (tid & 7) * 8); pv = *(const v4u*)(Vg + tok * 512 + h * 64 + (tid & 7) * 8); }
        if (w < 4) {
            const int c = 16 * w + i, cb = w == 0 ? 0 : (w == 1 ? 8 : (w == 2 ? 24 : 32));
            int cst = c - 8; cst = cst < 0 ? 0 : (cst > 48 ? 48 : cst);
            const size_t tq = (size_t)b * SEQ + r * 64 + c;
            float sc[16][4];
            float mx = -1e30f;
            int boff[2][4]; float vmask[2][4];
#pragma unroll
            for (int half = 0; half < 2; ++half)
#pragma unroll
                for (int e = 0; e < 4; ++e) { const int kc = cb + 16 * half + 4 * g + e; const bool valid = (kc >= cst) && (kc < cst + 16);
                    int dc = kc - c + 15; dc = dc < 0 ? 0 : (dc > 30 ? 30 : dc); boff[half][e] = dc; vmask[half][e] = valid ? 0.f : -1e30f; }
#pragma unroll
            for (int t = 0; t < 16; ++t) {
                const int wi = t >> 1, half = t & 1, slot = (rs + wi) & 7;
                const LAS unsigned char* kp = Kl + (slot * 64 + cb + 16 * half + i) * 144 + (8 * g) * 2;
                const bf16x8_t a0 = *(const LAS bf16x8_t*)kp, a1 = *(const LAS bf16x8_t*)(kp + 64);
                f32x4 s_ = (f32x4){0.f, 0.f, 0.f, 0.f};
                s_ = MFMA16(a0, bq0, s_); s_ = MFMA16(a1, bq1, s_);
                const int brow = (rs + wi - r + 7) * 31;
#pragma unroll
                for (int e = 0; e < 4; ++e) {
                    const float bias = Bl[brow + boff[half][e]];
                    const float v = fminf(s_[e] + bias, 1e30f) + vmask[half][e];
                    sc[t][e] = v; mx = fmaxf(mx, v);
                }
            }
            mx = fmaxf(mx, shx(mx, lane, 16)); mx = fmaxf(mx, shx(mx, lane, 32));
            float sum = 0.f;
            bf16x8_t bp[8];
#pragma unroll
            for (int wi = 0; wi < 8; ++wi) {
                float p[8];
#pragma unroll
                for (int e = 0; e < 4; ++e) { p[e] = fexp(sc[2 * wi][e] - mx); p[4 + e] = fexp(sc[2 * wi + 1][e] - mx); sum += p[e] + p[4 + e]; }
                v4u pw; pw.x = pkbf(p[0], p[1]); pw.y = pkbf(p[2], p[3]); pw.z = pkbf(p[4], p[5]); pw.w = pkbf(p[6], p[7]);
                bp[wi] = __builtin_bit_cast(bf16x8_t, pw);
            }
            sum += shx(sum, lane, 16); sum += shx(sum, lane, 32);
            f32x4 o[4];
#pragma unroll
            for (int dt = 0; dt < 4; ++dt) o[dt] = (f32x4){0.f, 0.f, 0.f, 0.f};
#pragma unroll
            for (int wi = 0; wi < 8; ++wi) {
                const int slot = (rs + wi) & 7;
                const LAS unsigned char* vp = Vl + (slot * 64 + cb + 4 * g + q4) * 144 + (4 * p4) * 2;
#pragma unroll
                for (int dt = 0; dt < 4; ++dt) { const bf16x8_t av = tr_frag(vp + 32 * dt, vp + 16 * 144 + 32 * dt); o[dt] = MFMA16(av, bp[wi], o[dt]); }
            }
            const float inv = 1.0f / sum;
#pragma unroll
            for (int dt = 0; dt < 4; ++dt) { v2u ov; ov.x = pkbf(o[dt][0] * inv, o[dt][1] * inv); ov.y = pkbf(o[dt][2] * inv, o[dt][3] * inv);
                *(v2u*)(Qg + tq * 512 + h * 64 + 16 * dt + 4 * g) = ov; }
        }
        else {
            const int e = (grp * 8 + k) * 512 + (tid - 256) * 2;
            const f32x4 v0 = ((const f32x4*)sd.psrc)[e], v1 = ((const f32x4*)sd.psrc)[e + 1];
            v4u o; o.x = pk2(v0.x, v0.y); o.y = pk2(v0.z, v0.w); o.z = pk2(v1.x, v1.y); o.w = pk2(v1.z, v1.w);
            ((v4u*)((unsigned char*)F.out + DO_PB))[e >> 1] = o;
            const int sid = grp * 8 + k;
            unsigned char* dob = (unsigned char*)F.out;
            Strip s0, s1, s2;
            if (sid < 1024) s0 = Strip{sd.wup, sd.gup, sd.wup_t, D, FF, sid, true}; else s0 = Strip{sd.wdown, nullptr, sd.wdown_t, FF, D, sid - 1024, true};
            s1 = Strip{sd.win, sd.gin, (bf16*)(dob + DO_WIN), D, 7680, sid, sd.nxt != 0 && sid < 1920};
            if (sid < 384) s2 = Strip{sd.wbr + (size_t)(sid / 128) * 512 * D, nullptr, (bf16*)(dob + DO_MID) + (size_t)(sid / 128) * D * 512, 512, D, sid % 128, sd.nxt != 0};
            else if (sid < 640) s2 = Strip{sd.wout, nullptr, (bf16*)(dob + DO_MID + 3 * MiB), D, D, sid - 384, sd.nxt != 0};
            else if (sid < 896) s2 = Strip{sd.wg, sd.gg, (bf16*)(dob + DO_MID + 5 * MiB), D, D, sid - 640, sd.nxt != 0};
            else s2 = Strip{sd.wple, nullptr, (bf16*)(dob + DO_MID + 7 * MiB), PLE, D, sid - 896, sd.nxt != 0 && sid < 960};
            Strip s3;
            if (sid < 384) s3 = Strip{sd.owbr + (size_t)(sid / 128) * 512 * D, nullptr, (bf16*)(sd.wsb + W_BR) + (size_t)(sid / 128) * D * 512, 512, D, sid % 128, sd.own != 0};
            else if (sid < 640) s3 = Strip{sd.owout, nullptr, (bf16*)(sd.wsb + W_OUT), D, D, sid - 384, sd.own != 0};
            else if (sid < 896) s3 = Strip{sd.owg, sd.ogg, (bf16*)(sd.wsb + W_G(0)), D, D, sid - 640, sd.own != 0};
            else s3 = Strip{sd.owple, nullptr, (bf16*)(sd.wsb + W_PLE(0)), PLE, D, sid - 896, sd.own != 0 && sid < 960};
            float w0[16], w1[16], w2[16], w3[16];
            strip_load(s0, tid, w0); strip_load(s1, tid, w1); strip_load(s2, tid, w2); strip_load(s3, tid, w3);
            strip_store(s0, tid, w0); strip_store(s1, tid, w1); strip_store(s2, tid, w2); strip_store(s3, tid, w3);
        }
        __syncthreads();
        if (slide) { const int lrow = ((rsn + 7) & 7) * 64 + (tid >> 3);
            *(LAS v4u*)(Kl + lrow * 144 + (tid & 7) * 16) = pk; *(LAS v4u*)(Vl + lrow * 144 + (tid & 7) * 16) = pv; }
        __syncthreads();
        rs = rsn; bq0 = nq0; bq1 = nq1;
    }
}
__device__ __forceinline__ void phase_na(const Frame& F, CArgs* A, int l) { const float* rpb = A->in[5] + (size_t)l * 8 * 465; const int ln = l + 1 < DEPTH ? l + 1 : l;
    const NaSide sd{A->in[1] + (size_t)l * T * PLE, A->in[17] + (size_t)l * D * FF, A->in[16] + (size_t)l * D, A->in[18] + (size_t)l * FF * D, (bf16*)(F.ws + W_UP), (bf16*)(F.ws + W_DOWN),
                    l + 1 < DEPTH ? 1 : 0, A->in[3] + (size_t)ln * D * 7680, A->in[2] + (size_t)ln * D, A->in[14] + (size_t)ln * 3 * 512 * D, A->in[15] + (size_t)ln * D * D, A->in[20] + (size_t)ln * D * D, A->in[19] + (size_t)ln * D, A->in[21] + (size_t)ln * PLE * D,
                    l == 0 ? 1 : 0, A->in[14], A->in[15], A->in[20], A->in[19], A->in[21], F.ws};
    for (int it = F.bid; it < 256; it += F.G) na_group(F, rpb, it, sd); }

__device__ __forceinline__ void phase_ret_state(const Frame& F) { for (int it = F.bid; it < 256; it += F.G) ret_scan_item(F, it); }
__device__ __forceinline__ void phase_ret_out(const Frame& F, CArgs* A, int l) { const float* gn = A->in[6] + (size_t)l * 512; for (int it = F.bid; it < 512; it += F.G) ret_out_item(F, gn, it); }

__device__ __forceinline__ void phase_final(const Frame& F, CArgs* A) {
    const float* g = A->in[22]; const bf16* xb = (const bf16*)(F.ws + WS_XB); const float* ss = (const float*)(F.ws + WS_SSB);
    const int lane = F.lane();
    f32x4 gv[4];
#pragma unroll
    for (int j = 0; j < 4; ++j) gv[j] = ((const f32x4*)g + lane)[64 * j];
    for (int m0 = F.gw() * 4; m0 < T; m0 += F.ngw * 4) {
        v2u w[4][4]; float sp[4];
#pragma unroll
        for (int r = 0; r < 4; ++r) {
            sp[r] = lane < 16 ? ss[(size_t)(m0 + r) * 16 + lane] : 0.f;
#pragma unroll
            for (int j = 0; j < 4; ++j) w[r][j] = ((const v2u*)(xb + (size_t)(m0 + r) * D) + lane)[64 * j];
        }
#pragma unroll
        for (int r = 0; r < 4; ++r) {
            float t = sp[r]; t += shx(t, lane, 1); t += shx(t, lane, 2); t += shx(t, lane, 4); t += shx(t, lane, 8);
            const float rs = 1.0f / sqrtf(lane_get(t, 0) * (1.0f / D) + RMS_EPS);
            f32x4* orow = (f32x4*)(F.out + (size_t)(m0 + r) * D) + lane;
#pragma unroll
            for (int j = 0; j < 4; ++j) orow[64 * j] = (f32x4){bflo(w[r][j].x), bfhi(w[r][j].x), bflo(w[r][j].y), bfhi(w[r][j].y)} * rs * gv[j];
        }
    }
}

__global__ void __launch_bounds__(NWAVES * 64, 2) mk_fwd(Args args) {
    extern __shared__ __attribute__((aligned(16))) unsigned char lds[];
    const int tid0 = threadIdx.x;
    const int wave0 = __builtin_amdgcn_readfirstlane(tid0 >> 6);
    LAS unsigned char* const lds3 = (LAS unsigned char*)lds;
    CArgs* A0 = get_args();
    const int ph_lo = A0->ph_lo, ph_hi = A0->ph_hi;
    for (int u = tid0; u < (LDS_BYTES - LDSCTL_OFF) / 4; u += NWAVES * 64) ((LAS unsigned*)(lds3 + LDSCTL_OFF))[u] = 0u;
    __syncthreads();
    const bool multi = (ph_hi - ph_lo) > 1;
    XcdBarrier bar; bar.bar = (unsigned*)((gu32*)(A0->ws + WS_CTL) + CW_BAR); bar.x = 0; bar.st = nullptr;
    if (multi) bar = xcd_barrier_post((unsigned*)((gu32*)(A0->ws + WS_CTL) + CW_BAR), (volatile LAS unsigned*)(lds3 + MISC_OFF) + 8);

    unsigned long long probe_acc = 0, pt0 = 0;
#define PMARK(k) do { if (PROBE_WN != 0ull) { __syncthreads(); const unsigned long long t_ = __builtin_amdgcn_s_memrealtime(); probe_acc += ((PROBE_WN >> (4 * (k))) & 15ull) * (t_ - pt0); pt0 = t_; } } while (0)
    for (int ph = ph_lo; ph < ph_hi; ++ph) {
        CArgs* A = get_args();
#define MAKE_FRAME(Fx) Frame Fx; Fx.wave0 = wave0; \
        Fx.lds = lds3; \
        { int b_ = blockIdx.x; asm volatile("" : "+s"(b_)); Fx.bid = b_; } \
        Fx.G = gridDim.x; Fx.ngw = Fx.G * NWAVES; Fx.out = A->out; Fx.ws = A->ws
        MAKE_FRAME(F);
        unsigned char* ws = F.ws;
        if (PROBE_WN != 0ull) pt0 = __builtin_amdgcn_s_memrealtime();
        int kind, l;
        if (ph == 0) { kind = PH_PRO; l = 0; } else if (ph == NPH - 1) { kind = PH_FIN; l = 0; } else { l = (ph - 1) / NPL; kind = 1 + (ph - 1) % NPL; }
        float* ssA = (float*)(ws + WS_SSA); float* ssB = (float*)(ws + WS_SSB);
        switch (kind) {
        case PH_PRO: phase_prologue(F, A); break;
        case PH_G1: {
            pg8::Gemm g{(const bf16_t*)(ws + WS_XB), (const bf16_t*)(l == 0 ? ws + W_IN : (unsigned char*)F.out + DO_WIN), T, 7680, D, 0, 0};
            pg8::StaticOrder S; S.init(T, 7680, F.G, F.bid);
            stage_epilogue_tables(F, ssB, S, A->in[4] + (size_t)l * 3072);
            EpiG1 E{(bf16_t*)(ws + WS_PROJ), ws + WS_GATE8, F.lds, (const float*)(ws + WS_TAB)};
            pg8::gemm_phase<EpiG1, pg8::StaticOrder, true, true>(F.lds, g, S, E, F.ltid());
        } break;
        case PH_MIXA: phase_na(F, A, l); PMARK(10); phase_ret_state(F); PMARK(11); PMARK(12); break;
        case PH_MIXB: phase_ret_out(F, A, l); PMARK(14); phase_lru<2>(F, A, l); PMARK(15); break;
        case PH_G2: {
            pg8::Gemm g{(const bf16_t*)(ws + WS_PROJ), (const bf16_t*)(l == 0 ? ws + W_BR : (unsigned char*)F.out + DO_MID), T, D, 512, 3 * BLK, (size_t)D * 512 * 2};
            ZOrder S; S.S.init(T, D, F.G, F.bid);
            EpiG2 E{ws + WS_GATE8, (bf16_t*)(ws + WS_MERGED)};
            pg8::gemm_phase<EpiG2, ZOrder, true, true>(F.lds, g, S, E, F.ltid());
        } break;
        case PH_G3: case PH_G5: {
            const bool g3 = (kind == PH_G3);
            pg8::Gemm g{(const bf16_t*)(ws + (g3 ? WS_MERGED : WS_U)), (const bf16_t*)(g3 ? (l == 0 ? ws + W_OUT : (unsigned char*)F.out + DO_MID + 3 * MiB) : ws + W_DOWN), T, D, g3 ? D : FF, 0, 0};
            pg8::StaticOrder S; S.init(T, D, F.G, F.bid);
            EpiRes E{(g3 && l == 0) ? A->in[0] : nullptr, (const bf16_t*)(ws + (g3 ? WS_XB : WS_GATE8)), (bf16_t*)(ws + WS_GATE8), g3 ? ssB : ssA};
            pg8::gemm_phase<EpiRes, pg8::StaticOrder, false, true>(F.lds, g, S, E, F.ltid());
        } break;
        case PH_G4: {
            pg8::Gemm g{(const bf16_t*)(ws + WS_GATE8), (const bf16_t*)(ws + W_UP), T, FF, D, 0, 0};
            pg8::StaticOrder S; S.init(T, FF, F.G, F.bid);
            stage_epilogue_tables(F, ssB, S, nullptr);
            EpiG4 E{(bf16_t*)(ws + WS_U), F.lds};
            pg8::gemm_phase<EpiG4, pg8::StaticOrder, true, true>(F.lds, g, S, E, F.ltid());
        } break;
        case PH_G6: {
            {
                pg8::Gemm g{(const bf16_t*)((unsigned char*)F.out + DO_PB), (const bf16_t*)(l == 0 ? ws + W_PLE(0) : (unsigned char*)F.out + DO_MID + 7 * MiB), T, D, PLE, 0, 0};
                pg8::StaticOrder S; S.init(T, D, F.G, F.bid);
                EpiE E{(bf16_t*)(ws + WS_E)};
                pg8::gemm_phase<EpiE, pg8::StaticOrder, false, true>(F.lds, g, S, E, F.ltid());
            }
            {
                pg8::Gemm g{(const bf16_t*)(ws + WS_GATE8), (const bf16_t*)(l == 0 ? ws + W_G(0) : (unsigned char*)F.out + DO_MID + 5 * MiB), T, D, D, 0, 0};
                pg8::StaticOrder S; S.init(T, D, F.G, F.bid);
                stage_epilogue_tables(F, ssA, S, nullptr);
                EpiG6 E{(const bf16_t*)(ws + WS_GATE8), (bf16_t*)(ws + WS_XB), F.lds, ssB, (const bf16_t*)(ws + WS_E)};
                pg8::gemm_phase<EpiG6, pg8::StaticOrder, false, true>(F.lds, g, S, E, F.ltid());
            }
        } break;
        case PH_FIN: phase_final(F, A); break;
        default: break;
        }
        if (ph + 1 < ph_hi) xcd_barrier(bar, F.ltid());
        PMARK(kind);
    }
    if (PROBE_WN != 0ull && blockIdx.x == 0) { const unsigned long long te = __builtin_amdgcn_s_memrealtime(); while (__builtin_amdgcn_s_memrealtime() - te < probe_acc) __builtin_amdgcn_s_sleep(32); }
}


#if MK_CHECK
constexpr int CW_CODE = 64, CW_CNT = 128;
__device__ __forceinline__ unsigned hash32(unsigned x) { x ^= x >> 16; x *= 0x7feb352du; x ^= x >> 15; x *= 0x846ca68bu; x ^= x >> 16; return x; }
__device__ __forceinline__ bool near(float a, float b, float rel, float abs_) { return fabsf(a - b) <= rel * fabsf(b) + abs_; }
__device__ float rs_of_x(const float* x, int row) { float s = 0.f; for (int k = 0; k < D; ++k) s += x[(size_t)row * D + k] * x[(size_t)row * D + k]; return 1.0f / sqrtf(s / D + RMS_EPS); }
__global__ void __launch_bounds__(256) mk_check(Args a, int stage) {
    const unsigned id = blockIdx.x * blockDim.x + threadIdx.x;
    const unsigned h = hash32(id * 2654435761u + 12345u * stage);
    unsigned char* ws = a.ws; unsigned* ctl = (unsigned*)(ws + WS_CTL);
    const int row = (int)(h % T);
    bool bad = false;
    const float* x = a.in[0];
    if (stage == 1) {
        const int col = (int)((h >> 14) % D);
        const bf16* xb = (const bf16*)(ws + WS_XB);
        bad |= !near(bf2f(xb[(size_t)row * D + col]), x[(size_t)row * D + col], 0.01f, 1e-3f);
        float s = 0.f; for (int k = 0; k < D; ++k) s += x[(size_t)row * D + k] * x[(size_t)row * D + k];
        const float* ss = (const float*)(ws + WS_SSB); float t = 0.f; for (int k = 0; k < 16; ++k) t += ss[(size_t)row * 16 + k];
        bad |= !near(t, s, 1e-3f, 1e-3f);
        const int n = (int)((h >> 7) % 7680), k = (int)(h % D);
        const bf16* wt = (const bf16*)(ws + W_IN);
        bad |= !near(bf2f(wt[(size_t)n * D + k]), a.in[2][k] * a.in[3][(size_t)k * 7680 + n], 0.01f, 1e-4f);
        const int pos = (int)(h % SEQ), i = (int)((h >> 11) % 64);
        const float th = powf(10000.0f, -(float)i / 63.0f), ang = (float)pos * th;
        const float* tab = (const float*)(ws + WS_TAB);
        bad |= !near(tab[pos * 64 + i], cosf(ang), 0.f, 2e-3f); bad |= !near(tab[131072 + pos * 64 + i], sinf(ang), 0.f, 2e-3f);
    } else if (stage == 2) {
        const int col = (int)((h >> 14) % 7680) & ~1;
        const float rs = rs_of_x(x, row);
        float v0 = 0.f, v1 = 0.f;
        for (int k = 0; k < D; ++k) { const float xv = x[(size_t)row * D + k] * a.in[2][k]; v0 += xv * a.in[3][(size_t)k * 7680 + col]; v1 += xv * a.in[3][(size_t)k * 7680 + col + 1]; }
        v0 *= rs; v1 *= rs;
        if (col < 4608) {
            const int kind = col / 512, cc = col % 512, phys = (int)((0x683754210ull >> (4 * kind)) & 15ull);
            if (kind == 3 || kind == 4) { const int i = (cc & 127) >> 1, pos = row & 2047; const float th = powf(10000.0f, -(float)i / 63.0f), ang = (float)pos * th, c = cosf(ang), sn = sinf(ang);
                const float w0 = v0 * c - v1 * sn, w1 = v0 * sn + v1 * c; v0 = w0; v1 = w1; }
            if (kind == 0) { v0 *= 0.125f; v1 *= 0.125f; } if (kind == 3) { v0 *= 0.08838834764831845f; v1 *= 0.08838834764831845f; }
            const bf16* p = (const bf16*)(ws + WS_PROJ) + (size_t)phys * T * 512 + (size_t)row * 512 + cc;
            bad |= !near(bf2f(p[0]), v0, 0.03f, 0.03f); bad |= !near(bf2f(p[1]), v1, 0.03f, 0.03f);
        } else {
            const int gc = col - 4608; const unsigned char* g8 = ws + WS_GATE8 + (size_t)row * 3072 + gc;
            const float s0 = 1.0f / (1.0f + expf(-(v0 + a.in[4][gc]))), s1 = 1.0f / (1.0f + expf(-(v1 + a.in[4][gc + 1])));
            bad |= !near((float)g8[0] / 255.0f, s0, 0.f, 0.012f); bad |= !near((float)g8[1] / 255.0f, s1, 0.f, 0.012f);
        }
    } else if (stage == 4) {
        const int col = (int)((h >> 14) % D);
        float m = 0.f;
        for (int n = 0; n < 3; ++n) { const bf16* ys = (const bf16*)(ws + WS_PROJ) + (size_t)(3 * n) * T * 512 + (size_t)row * 512; float acc = 0.f;
            for (int k = 0; k < 512; ++k) acc += bf2f(ys[k]) * a.in[14][((size_t)n * 512 + k) * D + col];
            m += acc * (float)ws[WS_GATE8 + (size_t)row * 3072 + n * 1024 + col] / 255.0f; }
        bad |= !near(bf2f(((const bf16*)(ws + WS_MERGED))[(size_t)row * D + col]), m, 0.03f, 0.03f);
    } else if (stage == 5 && false) {
        const int col = (int)((h >> 14) % D);
        const bf16* mg = (const bf16*)(ws + WS_XB) + (size_t)row * D; float acc = 0.f;
        for (int k = 0; k < D; ++k) acc += bf2f(mg[k]) * a.in[15][(size_t)k * D + col];
        const float x1 = x[(size_t)row * D + col] + acc;
        bad |= !near(a.out[(size_t)row * D + col], x1, 0.02f, 0.03f);
        bad |= !near(bf2f(((const bf16*)(ws + WS_GATE8))[(size_t)row * D + col]), a.out[(size_t)row * D + col], 0.01f, 1e-3f);
        float s = 0.f; for (int k = 0; k < D; ++k) s += a.out[(size_t)row * D + k] * a.out[(size_t)row * D + k];
        const float* ss = (const float*)(ws + WS_SSB); float t = 0.f; for (int k = 0; k < 16; ++k) t += ss[(size_t)row * 16 + k];
        bad |= !near(t, s, 1e-3f, 1e-3f);
    } else if (stage == 6 && false) {
        const int col = (int)((h >> 14) % FF);
        const bf16* xb = (const bf16*)(ws + WS_GATE8) + (size_t)row * D; float acc = 0.f;
        for (int k = 0; k < D; ++k) acc += bf2f(xb[k]) * a.in[16][k] * a.in[17][(size_t)k * FF + col];
        const float rs = rs_of_x(a.out, row); float v = fmaxf(acc * rs, 0.f); v *= v;
        bad |= !near(bf2f(((const bf16*)(ws + WS_U))[(size_t)row * FF + col]), v, 0.05f, 0.05f);
    } else if (stage == 7 && false) {
        const int col = (int)((h >> 14) % D);
        const bf16* uu = (const bf16*)(ws + WS_U) + (size_t)row * FF; float acc = 0.f;
        for (int k = 0; k < FF; ++k) acc += bf2f(uu[k]) * a.in[18][(size_t)k * D + col];
        const float x2 = bf2f(((const bf16*)(ws + WS_XB))[(size_t)row * D + col]) + acc;
        bad |= !near(a.out[(size_t)row * D + col], x2, 0.03f, 0.05f);
        bad |= !near(bf2f(((const bf16*)(ws + WS_GATE8))[(size_t)row * D + col]), a.out[(size_t)row * D + col], 0.01f, 1e-3f);
        float s = 0.f; for (int k = 0; k < D; ++k) s += a.out[(size_t)row * D + k] * a.out[(size_t)row * D + k];
        const float* ss = (const float*)(ws + WS_SSA); float t = 0.f; for (int k = 0; k < 16; ++k) t += ss[(size_t)row * 16 + k];
        bad |= !near(t, s, 1e-3f, 1e-3f);
    } else if (stage == 8 && false) {
        const int col = (int)((h >> 14) % D);
        const bf16* xb = (const bf16*)(ws + WS_GATE8) + (size_t)row * D; float acc = 0.f, s = 0.f;
        for (int k = 0; k < D; ++k) { const float xv = bf2f(xb[k]); s += xv * xv; acc += xv * a.in[19][k] * a.in[20][(size_t)k * D + col]; }
        const float rs = 1.0f / sqrtf(s / D + RMS_EPS);
        float e = 0.f; for (int k = 0; k < PLE; ++k) e += a.in[1][(size_t)row * PLE + k] * a.in[21][(size_t)k * D + col];
        const float x3 = bf2f(xb[col]) + e / (1.0f + expf(-acc * rs));
        bad |= !near(a.out[(size_t)row * D + col], x3, 0.03f, 0.05f);
    }
    if (stage == 9) bad = true;
    if (bad) atomicAdd(&ctl[CW_CNT + stage], 1u);
}
__device__ float orig_proj(const Args& a, int l, int row, int col) {
    const float* x = l == 0 ? a.in[0] : a.out; const float* g = a.in[2] + (size_t)l * D; const float* w = a.in[3] + (size_t)l * D * 7680;
    float s = 0.f, acc = 0.f;
    for (int k = 0; k < D; ++k) { const float xv = x[(size_t)row * D + k]; s += xv * xv; acc += xv * g[k] * w[(size_t)k * 7680 + col]; }
    return acc / sqrtf(s / D + RMS_EPS);
}
__global__ void __launch_bounds__(64) mk_check_na(Args a, int l) {
    __shared__ float qs[64]; __shared__ float sc[128];
    const unsigned h = hash32(blockIdx.x * 977u + 31u); const int t = (int)(h % T), hd = (int)((h >> 16) % 8), d = threadIdx.x;
    unsigned char* ws = a.ws; unsigned* ctl = (unsigned*)(ws + WS_CTL);
    const bf16* K = (const bf16*)(ws + WS_PROJ + BLK); const bf16* V = (const bf16*)(ws + WS_PROJ + 2 * BLK); const bf16* Y = (const bf16*)(ws + WS_PROJ);
    qs[d] = bf2f((bf16)f2bf(0.125f * orig_proj(a, l, t, hd * 64 + d)));
    __syncthreads();
    const int b = t / SEQ, s = t % SEQ, r = s / 64, c = s % 64;
    int rs = r - 4; if (rs < 0) rs = 0; if (rs > 24) rs = 24; int cs = c - 8; if (cs < 0) cs = 0; if (cs > 48) cs = 48;
    const float* rpb = a.in[5] + (size_t)l * 8 * 15 * 31 + hd * 465;
    for (int kk = d; kk < 128; kk += 64) { const int i = kk / 16, j = kk % 16; const int tk = b * SEQ + (rs + i) * 64 + cs + j; float acc = 0.f;
        for (int e = 0; e < 64; ++e) acc += qs[e] * bf2f(K[(size_t)tk * 512 + hd * 64 + e]);
        sc[kk] = acc + rpb[(rs + i - r + 7) * 31 + (cs + j - c + 15)]; }
    __syncthreads();
    float mx = -1e30f; for (int kk = 0; kk < 128; ++kk) mx = fmaxf(mx, sc[kk]);
    float den = 0.f, o = 0.f;
    for (int kk = 0; kk < 128; ++kk) { const int i = kk / 16, j = kk % 16; const int tk = b * SEQ + (rs + i) * 64 + cs + j; const float p = expf(sc[kk] - mx); den += p; o += p * bf2f(V[(size_t)tk * 512 + hd * 64 + d]); }
    o /= den;
    if (!near(bf2f(Y[(size_t)t * 512 + hd * 64 + d]), o, 0.04f, 0.04f)) atomicAdd(&ctl[CW_CNT + 31], 1u);
}
__global__ void __launch_bounds__(128) mk_check_ret(Args a, int l) {
    __shared__ float qs[128]; __shared__ float sc[SEQ]; __shared__ float red[128];
    const unsigned h = hash32(blockIdx.x * 1231u + 77u); const int t = (int)(h % T), hd = (int)((h >> 16) % 4), dv = threadIdx.x;
    unsigned char* ws = a.ws; unsigned* ctl = (unsigned*)(ws + WS_CTL);
    const bf16* Y = (const bf16*)(ws + WS_PROJ + 3 * BLK); const bf16* Q = (const bf16*)(ws + WS_PROJ + 4 * BLK); const bf16* K = (const bf16*)(ws + WS_PROJ + 5 * BLK); const bf16* V = (const bf16*)(ws + WS_PROJ + 7 * BLK);
    const int b = t / SEQ, n = t % SEQ;
    qs[dv] = bf2f(Q[(size_t)t * 512 + hd * 128 + dv]);
    __syncthreads();
    const float gf = log2_1m(__builtin_amdgcn_exp2f(-5.0f - (float)hd)), gb = log2_1m(__builtin_amdgcn_exp2f(-5.5f - (float)hd));
    for (int m = dv; m < SEQ; m += 128) { float acc = 0.f; for (int e = 0; e < 128; ++e) acc += qs[e] * bf2f(K[(size_t)(b * SEQ + m) * 512 + hd * 128 + e]);
        sc[m] = acc * (m <= n ? __builtin_amdgcn_exp2f(gf * (float)(n - m)) : __builtin_amdgcn_exp2f(gb * (float)(m - n))); }
    __syncthreads();
    float o = 0.f; for (int m = 0; m < SEQ; ++m) o += sc[m] * bf2f(V[(size_t)(b * SEQ + m) * 512 + hd * 128 + dv]);
    red[dv] = o * o; __syncthreads();
    float ms = 0.f; for (int e = 0; e < 128; ++e) ms += red[e];
    const float rn = 1.0f / sqrtf(ms / 128.0f + RMS_EPS);
    const float g = bf2f((bf16)f2bf(orig_proj(a, l, t, 1536 + 3 * 512 + hd * 128 + dv)));
    const float y = g / (1.0f + expf(-g)) * o * rn * a.in[6][(size_t)l * 512 + hd * 128 + dv];
    if (!near(bf2f(Y[(size_t)t * 512 + hd * 128 + dv]), y, 0.04f, 0.04f)) atomicAdd(&ctl[CW_CNT + 32], 1u);
}
__global__ void __launch_bounds__(128) mk_check_g(Args a, int l, int code) {
    const unsigned h = hash32(blockIdx.x * 1231u + 77u); const int t = (int)(h % T), hd = (int)((h >> 16) % 4), dv = threadIdx.x;
    unsigned* ctl = (unsigned*)(a.ws + WS_CTL);
    const bf16* G = (const bf16*)(a.ws + WS_PROJ + 3 * BLK);
    const float g = orig_proj(a, l, t, 1536 + 3 * 512 + hd * 128 + dv);
    if (!near(bf2f(G[(size_t)t * 512 + hd * 128 + dv]), g, 0.03f, 0.03f)) atomicAdd(&ctl[CW_CNT + code], 1u);
}
__global__ void __launch_bounds__(64) mk_check_lru(Args a, int l) {
    __shared__ float xs[64];
    const unsigned h = hash32(blockIdx.x * 733u + 5u); const int b = (int)(h % 8), blk = (int)((h >> 8) % 8), ts = (int)((h >> 16) % SEQ), j = threadIdx.x, ch = blk * 64 + j;
    unsigned char* ws = a.ws; unsigned* ctl = (unsigned*)(ws + WS_CTL);
    const bf16* XC = (const bf16*)(ws + WS_PROJ + 8 * BLK); const bf16* Y = (const bf16*)(ws + WS_PROJ + 6 * BLK);
    const float* cw = a.in[7] + (size_t)l * 2048; const float cb = a.in[8][(size_t)l * 512 + ch];
    float hsum = 0.f;
    for (int dir = 0; dir < 2; ++dir) {
        const float* wa = a.in[9] + (((size_t)l * 2 + dir) * 8 + blk) * 4096; const float* wx = a.in[11] + (((size_t)l * 2 + dir) * 8 + blk) * 4096;
        const float ba = a.in[10][((size_t)l * 2 + dir) * 512 + ch], bx = a.in[12][((size_t)l * 2 + dir) * 512 + ch], lam = a.in[13][((size_t)l * 2 + dir) * 512 + ch];
        const float sp = log1pf(expf(-lam));
        float hh = 0.f;
        const int nsteps = dir == 0 ? ts + 1 : SEQ - ts;
        for (int st = 0; st < nsteps; ++st) {
            const int t = dir == 0 ? st : SEQ - 1 - st;
            float xf = cb;
            for (int w = 0; w < 4; ++w) { const int t2 = t + w - 2; if (t2 >= 0 && t2 < SEQ) xf += cw[w * 512 + ch] * bf2f(XC[(size_t)(b * SEQ + t2) * 512 + ch]); }
            __syncthreads(); xs[j] = xf; __syncthreads();
            float ra = ba, ia = bx;
            for (int i = 0; i < 64; ++i) { ra += xs[i] * wa[i * 64 + j]; ia += xs[i] * wx[i * 64 + j]; }
            const float r = 1.0f / (1.0f + expf(-ra)), ig = 1.0f / (1.0f + expf(-ia));
            const float la = -8.0f * r * sp, av = expf(la); float mult = sqrtf(-expm1f(2.0f * la)); if (st == 0) mult = 1.0f;
            hh = av * hh + mult * ig * xf;
        }
        hsum += hh;
    }
    const float gc = bf2f((bf16)f2bf(orig_proj(a, l, b * SEQ + ts, 3584 + 512 + ch)));
    const float u = 0.7978845608028654f * (gc + 0.044715f * gc * gc * gc);
    const float y = 0.5f * gc * (1.0f + tanhf(u)) * hsum;
    if (!near(bf2f(Y[(size_t)(b * SEQ + ts) * 512 + ch]), y, 0.04f, 0.04f)) atomicAdd(&ctl[CW_CNT + 33], 1u);
}
__global__ void mk_report(Args a) {
    unsigned* ctl = (unsigned*)(a.ws + WS_CTL);
    const int order[13] = {1, 2, 35, 31, 34, 32, 33, 4, 5, 6, 7, 8, 9};
    const unsigned tot[13] = {16384u, 16384u, 16384u, 32768u, 16384u, 16384u, 8192u, 16384u, 16384u, 16384u, 16384u, 16384u, 64u};
    for (int i = 0; i < 13; ++i) {
        const unsigned cnt = ctl[CW_CNT + order[i]];
        if (cnt * 200u > tot[i]) {
            unsigned tenth = (cnt * 10u) / tot[i]; if (tenth > 9u) tenth = 9u;
            a.out[0] = order[i] >= 10 ? 100.0f * (float)order[i] : 1000.0f * (float)order[i] + 100.0f * (float)tenth;
            return;
        }
    }
}
#endif

#ifndef MK_ONE_LAUNCH
#define MK_ONE_LAUNCH 1
#endif
extern "C" void kernel_launch(void* const* d_in, const int* in_sizes, int n_in, void* d_out, int out_size, void* d_ws, size_t ws_size, hipStream_t stream) {
    static int grid = 0;
    if (grid == 0) {
        if (n_in != 23 || in_sizes[0] != T * D || out_size != T * D || ws_size < WS_END) { fprintf(stderr, "kernel_launch: unexpected shapes (n_in %d, in0 %d, out %d, ws %zu); nothing launched\n", n_in, n_in > 0 ? in_sizes[0] : -1, out_size, ws_size); grid = -1; return; }
        int dev = 0, cus = 0, per_cu = 0;
        if (hipGetDevice(&dev) != hipSuccess || hipDeviceGetAttribute(&cus, hipDeviceAttributeMultiprocessorCount, dev) != hipSuccess) { grid = -1; return; }
        if (hipFuncSetAttribute((const void*)mk_fwd, hipFuncAttributeMaxDynamicSharedMemorySize, LDS_BYTES) != hipSuccess) { fprintf(stderr, "kernel_launch: hipFuncSetAttribute failed\n"); grid = -1; return; }
        if (hipOccupancyMaxActiveBlocksPerMultiprocessor(&per_cu, (const void*)mk_fwd, NWAVES * 64, LDS_BYTES) != hipSuccess || per_cu < 1) { fprintf(stderr, "kernel_launch: occupancy query says %d blocks per CU\n", per_cu); }
        (void)hipGetLastError();
        grid = cus;
    }
    if (grid < 0) return;
    if (hipMemsetAsync((char*)d_ws + WS_CTL, 0, CTL_ZERO_BYTES, stream) != hipSuccess) return;
    Args a{};
    for (int i = 0; i < 23; ++i) a.in[i] = (const float*)d_in[i];
    a.out = (float*)d_out; a.ws = (unsigned char*)d_ws;
#if MK_ONE_LAUNCH
    a.ph_lo = 0; a.ph_hi = NPH;
    hipLaunchKernelGGL(mk_fwd, dim3(grid), dim3(NWAVES * 64), LDS_BYTES, stream, a);
#else
    for (int ph = 0; ph < NPH; ++ph) {
#if MK_CHECK
        if (ph == 1 + 6) (void)hipMemcpyAsync((char*)d_ws + WS_XB, (char*)d_ws + WS_GATE8, (size_t)T * D * 2, hipMemcpyDeviceToDevice, stream);
#endif
        a.ph_lo = ph; a.ph_hi = ph + 1; hipLaunchKernelGGL(mk_fwd, dim3(grid), dim3(NWAVES * 64), LDS_BYTES, stream, a);
#if MK_CHECK
        { int st = 0; if (ph == 0) st = 1; else if (ph == 1) st = 2; else if (ph == 1 + 3) st = 4; else if (ph == 1 + 4) st = 5; else if (ph == 1 + 5) st = 6; else if (ph == 1 + 6) st = 7; else if (ph == 1 + 7) st = 8;
          if (st) hipLaunchKernelGGL(mk_check, dim3(64), dim3(256), 0, stream, a, st);
          if (ph == 1 + 1) hipLaunchKernelGGL(mk_check_na, dim3(512), dim3(64), 0, stream, a, 0);
          if (ph == 1) hipLaunchKernelGGL(mk_check_g, dim3(128), dim3(128), 0, stream, a, 0, 35);
          if (ph == 1 + 1) hipLaunchKernelGGL(mk_check_g, dim3(128), dim3(128), 0, stream, a, 0, 34);
          if (ph == 1 + 2) hipLaunchKernelGGL(mk_check_ret, dim3(128), dim3(128), 0, stream, a, 0);
          if (ph == 1 + 2) hipLaunchKernelGGL(mk_check_lru, dim3(128), dim3(64), 0, stream, a, 0);
          if (ph == NPH - 1) hipLaunchKernelGGL(mk_check, dim3(1), dim3(64), 0, stream, a, 9); }
#endif
    }
#if MK_CHECK
    hipLaunchKernelGGL(mk_report, dim3(1), dim3(1), 0, stream, a);
#endif
#endif
}
```

```cpp
#include <hip/hip_runtime.h>
#include <cstdio>
#include <cstdint>
#ifndef MK_CHECK
#define MK_CHECK 0
#endif
#ifndef PROBE_WN
#define PROBE_WN 0x0ull
#endif
namespace pg8 {
#define PG8_LAS __attribute__((address_space(3)))
typedef unsigned short bf16_t;
typedef short bf16x8 __attribute__((ext_vector_type(8)));
typedef float f32x4 __attribute__((ext_vector_type(4)));
typedef unsigned u32x4 __attribute__((ext_vector_type(4)));
constexpr int BM = 256, BK = 64, HALF = 128, HTB = HALF * BK * 2  , STAGE_BYTES = 8 * HTB, NXCD = 8, WGM = 8;

__host__ __device__ __forceinline__ int lds_byte(int r, int c) { const int st = (r >> 4) * 2 + (c >> 5), rr = r & 15, cc = c & 31, ob = rr * 64 + cc * 2; return st * 1024 + (ob ^ (((ob >> 9) & 1) << 5)); }
__host__ __device__ __forceinline__ void stage_rc(int b, int& R, int& C) { const int st = b / 1024, sb = b % 1024, swz = sb ^ (((sb >> 9) & 1) << 5); R = (st >> 1) * 16 + swz / 64; C = (st & 1) * 32 + (swz % 64) / 2; }
__host__ __device__ __forceinline__ int perm32(int rho) { const int n = rho >> 4, i = rho & 15; return 8 * (i >> 2) + 4 * n + (i & 3); }

struct Unit { int pm, pn, z; };
struct Gemm { const bf16_t* A; const bf16_t* Bt; int M, N, K; size_t zA, zB; };

struct StaticOrder {
    int nM, nN, nwg, G, c;
    __host__ __device__ void init(int M, int N, int G_, int c_) { nM = M / BM; nN = N / BM; nwg = nM * nN; G = G_; c = c_; }
    __host__ __device__ bool next(int i, Unit& u) const {
        const long L = (long)i * G + c; if (L >= nwg) return false;
        int wgid = (int)L; { const int q = nwg / NXCD, r = nwg % NXCD, xcd = wgid % NXCD, off = wgid / NXCD; wgid = (xcd < r ? xcd * (q + 1) : r * (q + 1) + (xcd - r) * q) + off; }
        const int nig = WGM * nN, gid = wgid / nig, fm = gid * WGM, gsz = (nM - fm) < WGM ? (nM - fm) : WGM;
        u.pm = fm + ((wgid % nig) % gsz); u.pn = (wgid % nig) / gsz; u.z = 0; return true;
    }
    __device__ __forceinline__ void a_ready(const Unit&) const {}
    __device__ __forceinline__ void done(const Unit&) const {}
};

__device__ __forceinline__ unsigned cvt_pk_bf16(float lo, float hi) { unsigned r; asm volatile("v_cvt_pk_bf16_f32 %0, %1, %2" : "=v"(r) : "v"(lo), "v"(hi)); return r; }
typedef float f32x2 __attribute__((ext_vector_type(2)));
template <class Epi, class Sched, bool ALIGN_EPI = false, bool SP2 = false>
__device__ __forceinline__ void gemm_phase(PG8_LAS unsigned char* lds, const Gemm g, const Sched& S, const Epi& E, const int tid) {
    const int wid = __builtin_amdgcn_readfirstlane(tid >> 6), lane = tid & 63, wr = wid >> 2, wc = wid & 3, fr = lane & 15, fq = lane >> 4;
    const int K = g.K, nt = K / BK;
    unsigned voffA[2], voffB[2];
#pragma unroll
    for (int i = 0; i < 2; ++i) { int R, C; stage_rc(tid * 16 + i * 8192, R, C); const int Rb = Epi::PERM ? ((R & ~31) + perm32(R & 31)) : R;
        voffA[i] = (unsigned)(R * K + C) * 2u; voffB[i] = (unsigned)(Rb * K + C) * 2u; }
    const size_t kstep = (size_t)(BK * 2);
    const size_t hstep = (size_t)HALF * K * 2;
    const size_t tstep = 2 * hstep;
    const unsigned ldsw = (unsigned)wid * 1024u;
    const int aoff = lds_byte(wr * 64 + fr, fq * 8), boff = lds_byte(wc * 32 + fr, fq * 8);
#define PG8_SA(b, h) (((b) * 2 + (h)) * HTB)
#define PG8_SB(b, h) ((4 + (b) * 2 + (h)) * HTB)
#define PG8_STAGE(bufoff, gbase, voff) do { _Pragma("unroll") for (int _i = 0; _i < 2; ++_i) \
        __builtin_amdgcn_global_load_lds((const unsigned*)((const char*)(gbase) + (voff)[_i]), (PG8_LAS unsigned*)(lds + (bufoff) + ldsw + _i * 8192), 16, 0, 0); } while (0)
#define PG8_LDA(dst, b, h) do { _Pragma("unroll") for (int m = 0; m < 4; ++m) _Pragma("unroll") for (int k = 0; k < 2; ++k) dst[m][k] = *(const PG8_LAS bf16x8*)(lds + PG8_SA(b, h) + aoff + m * 2048 + k * 1024); } while (0)
#define PG8_LDB(dst, b, h) do { _Pragma("unroll") for (int n = 0; n < 2; ++n) _Pragma("unroll") for (int k = 0; k < 2; ++k) dst[n][k] = *(const PG8_LAS bf16x8*)(lds + PG8_SB(b, h) + boff + n * 2048 + k * 1024); } while (0)
#define PG8_MMA(ai, bj, At, Bt) do { __builtin_amdgcn_s_setprio(1); _Pragma("unroll") for (int m = 0; m < 4; ++m) _Pragma("unroll") for (int n = 0; n < 2; ++n) _Pragma("unroll") for (int k = 0; k < 2; ++k) \
        acc[ai][bj][m][n] = __builtin_amdgcn_mfma_f32_16x16x32_bf16(Bt[n][k], At[m][k], acc[ai][bj][m][n], 0, 0, 0); __builtin_amdgcn_s_setprio(0); } while (0)
#define PG8_WAIT_V(n) asm volatile("s_waitcnt vmcnt(" #n ")" ::: "memory")
#define PG8_WAIT_L(n) asm volatile("s_waitcnt lgkmcnt(" #n ")" ::: "memory")
#define PG8_BAR __builtin_amdgcn_s_barrier()
#define PG8_SCHED __builtin_amdgcn_sched_barrier(0)
    Unit cur, nxt; int ui = 0;
    if (!S.next(0, cur)) return;
    f32x4 acc[2][2][4][2];
#pragma unroll
    for (int a = 0; a < 2; ++a)
#pragma unroll
        for (int b = 0; b < 2; ++b)
#pragma unroll
            for (int m = 0; m < 4; ++m)
#pragma unroll
                for (int n = 0; n < 2; ++n) acc[a][b][m][n] = (f32x4){0.f, 0.f, 0.f, 0.f};
    bf16x8 At[4][2], B0[2][2], B1[2][2];
    const char* cA = (const char*)g.A + (size_t)cur.z * g.zA + (size_t)cur.pm * tstep; const char* cB = (const char*)g.Bt + (size_t)cur.z * g.zB + (size_t)cur.pn * tstep;
    S.a_ready(cur);
    if constexpr (SP2) {
        PG8_STAGE(PG8_SB(0, 0), cB, voffB); PG8_STAGE(PG8_SB(0, 1), cB + hstep, voffB); PG8_STAGE(PG8_SA(0, 0), cA, voffA); PG8_STAGE(PG8_SA(0, 1), cA + hstep, voffA);
        if (wr == 1) PG8_BAR;
        PG8_WAIT_V(2); PG8_BAR;
        PG8_STAGE(PG8_SB(1, 0), cB + kstep, voffB); PG8_STAGE(PG8_SA(1, 0), cA + kstep, voffA); PG8_STAGE(PG8_SB(1, 1), cB + hstep + kstep, voffB);
        PG8_WAIT_V(6); PG8_BAR;
    } else {
        PG8_STAGE(PG8_SB(0, 0), cB, voffB); PG8_STAGE(PG8_SA(0, 0), cA, voffA); PG8_STAGE(PG8_SB(0, 1), cB + hstep, voffB); PG8_STAGE(PG8_SA(0, 1), cA + hstep, voffA);
        if (wr == 1) PG8_BAR;
        PG8_WAIT_V(4); PG8_BAR;
        PG8_STAGE(PG8_SB(1, 0), cB + kstep, voffB); PG8_STAGE(PG8_SA(1, 0), cA + kstep, voffA); PG8_STAGE(PG8_SB(1, 1), cB + hstep + kstep, voffB);
        PG8_WAIT_V(6); PG8_BAR;
    }
    for (;;) {
        const bool has_next = S.next(ui + 1, nxt);
        const char* nA = has_next ? (const char*)g.A + (size_t)nxt.z * g.zA + (size_t)nxt.pm * tstep : cA; const char* nB = has_next ? (const char*)g.Bt + (size_t)nxt.z * g.zB + (size_t)nxt.pn * tstep : cB;
        for (int t = 0; t < nt; t += 2) {
            const bool last = (t == nt - 2);
            const char* a1 = cA + (size_t)(t + 1) * kstep;
            const char* a2 = last ? nA : cA + (size_t)(t + 2) * kstep; const char* b2 = last ? nB : cB + (size_t)(t + 2) * kstep;
            const char* a3 = a2 + kstep; const char* b3 = b2 + kstep;
            if (last && has_next) S.a_ready(nxt);
            if constexpr (SP2) {
            PG8_LDB(B0, 0, 0); PG8_LDB(B1, 0, 1); PG8_SCHED; PG8_LDA(At, 0, 0); PG8_STAGE(PG8_SA(1, 1), a1 + hstep, voffA);
            PG8_WAIT_V(8); PG8_WAIT_L(0); PG8_BAR; PG8_MMA(0, 0, At, B0); PG8_MMA(0, 1, At, B1); PG8_BAR; PG8_SCHED;
            PG8_LDA(At, 0, 1); PG8_STAGE(PG8_SB(0, 0), b2, voffB); PG8_STAGE(PG8_SB(0, 1), b2 + hstep, voffB); PG8_STAGE(PG8_SA(0, 0), a2, voffA);
            PG8_WAIT_V(8); PG8_WAIT_L(0); PG8_BAR; PG8_MMA(1, 0, At, B0); PG8_MMA(1, 1, At, B1); PG8_BAR; PG8_SCHED;
            PG8_LDB(B0, 1, 0); PG8_LDB(B1, 1, 1); PG8_SCHED; PG8_LDA(At, 1, 0); PG8_STAGE(PG8_SA(0, 1), a2 + hstep, voffA);
            PG8_WAIT_V(8); PG8_WAIT_L(0); PG8_BAR; PG8_MMA(0, 0, At, B0); PG8_MMA(0, 1, At, B1); PG8_BAR; PG8_SCHED;
            PG8_LDA(At, 1, 1); PG8_STAGE(PG8_SB(1, 0), b3, voffB); PG8_STAGE(PG8_SB(1, 1), b3 + hstep, voffB); PG8_STAGE(PG8_SA(1, 0), a3, voffA);
            PG8_WAIT_V(8); PG8_WAIT_L(0); PG8_BAR; PG8_MMA(1, 0, At, B0); PG8_MMA(1, 1, At, B1); PG8_BAR; PG8_SCHED;
            } else {
            PG8_LDB(B0, 0, 0); PG8_SCHED; PG8_LDA(At, 0, 0); PG8_STAGE(PG8_SA(1, 1), a1 + hstep, voffA);
            PG8_WAIT_L(8); PG8_BAR; PG8_WAIT_L(0); PG8_MMA(0, 0, At, B0); PG8_BAR; PG8_SCHED;
            PG8_LDB(B1, 0, 1); PG8_STAGE(PG8_SB(0, 0), b2, voffB);
            PG8_BAR; PG8_WAIT_L(0); PG8_MMA(0, 1, At, B1); PG8_BAR;
            PG8_LDA(At, 0, 1); PG8_STAGE(PG8_SA(0, 0), a2, voffA);
            PG8_BAR; PG8_WAIT_L(0); PG8_MMA(1, 0, At, B0); PG8_BAR; PG8_SCHED;
            PG8_STAGE(PG8_SB(0, 1), b2 + hstep, voffB);
            PG8_WAIT_V(6); PG8_BAR; PG8_MMA(1, 1, At, B1); PG8_BAR;
            PG8_LDB(B0, 1, 0); PG8_SCHED; PG8_LDA(At, 1, 0); PG8_STAGE(PG8_SA(0, 1), a2 + hstep, voffA);
            PG8_WAIT_L(8); PG8_BAR; PG8_WAIT_L(0); PG8_MMA(0, 0, At, B0); PG8_BAR; PG8_SCHED;
            PG8_LDB(B1, 1, 1); PG8_STAGE(PG8_SB(1, 0), b3, voffB);
            PG8_BAR; PG8_WAIT_L(0); PG8_MMA(0, 1, At, B1); PG8_BAR;
            PG8_LDA(At, 1, 1); PG8_STAGE(PG8_SA(1, 0), a3, voffA);
            PG8_BAR; PG8_WAIT_L(0); PG8_MMA(1, 0, At, B0); PG8_BAR; PG8_SCHED;
            PG8_STAGE(PG8_SB(1, 1), b3 + hstep, voffB);
            PG8_WAIT_V(6); PG8_BAR; PG8_MMA(1, 1, At, B1); PG8_BAR;
            }
        }
        if constexpr (ALIGN_EPI) { if (wr == 0) PG8_BAR; }
        if constexpr (!Epi::AFTER_DRAIN) { E(acc, cur, wr, wc, fr, fq); S.done(cur); }
        if (!has_next) break;
        if constexpr (!Epi::KEEP_ACC)
#pragma unroll
        for (int a = 0; a < 2; ++a)
#pragma unroll
            for (int b = 0; b < 2; ++b)
#pragma unroll
                for (int m = 0; m < 4; ++m)
#pragma unroll
                    for (int n = 0; n < 2; ++n) acc[a][b][m][n] = (f32x4){0.f, 0.f, 0.f, 0.f};
        cur = nxt; cA = nA; cB = nB; ++ui;
        if constexpr (ALIGN_EPI) { if (wr == 1) PG8_BAR; }
    }
    PG8_WAIT_V(0);
    if constexpr (!ALIGN_EPI) { if (wr == 0) PG8_BAR; }
    PG8_BAR;
    if constexpr (Epi::AFTER_DRAIN) { E.fused(acc, cur, wr, wc, fr, fq, lds, wid, lane); S.done(cur); }
#undef PG8_SA
#undef PG8_SB
#undef PG8_STAGE
#undef PG8_LDA
#undef PG8_LDB
#undef PG8_MMA
#undef PG8_WAIT_V
#undef PG8_WAIT_L
#undef PG8_BAR
#undef PG8_SCHED
}
}

constexpr int T = 16384, D = 1024, SEQ = 2048, DEPTH = 2, FF = 4096, PLE = 256;
constexpr float RMS_EPS = 1e-6f;
constexpr size_t MiB = 1u << 20;
constexpr size_t WS_CTL = 0, CTL_ZERO_BYTES = 65536;
constexpr size_t WS_TAB = 1 * MiB;
constexpr size_t WS_SSA = 2 * MiB, WS_SSB = 3 * MiB;
constexpr size_t WS_PROJ = 6 * MiB, BLK = 16 * MiB;
constexpr size_t WS_GATE8 = 150 * MiB;
constexpr size_t WS_XB = 198 * MiB;
constexpr size_t WS_W = 230 * MiB, WS_END = 256 * MiB;
constexpr size_t W_IN = WS_W, W_UP = WS_W, W_DOWN = WS_W + 8 * MiB, W_BR = WS_W + 16 * MiB, W_OUT = WS_W + 19 * MiB;
__host__ __device__ constexpr size_t W_G(int slot) { return WS_W + 21 * MiB + (size_t)slot * (5 * MiB / 2); }
__host__ __device__ constexpr size_t W_PLE(int slot) { return W_G(slot) + 2 * MiB; }
constexpr size_t WS_U = WS_PROJ;
constexpr size_t WS_E = WS_PROJ;
constexpr size_t DO_WIN = 32 * MiB, DO_MID = 56 * MiB;
constexpr size_t DO_PB = 48 * MiB;
constexpr size_t WS_HF = WS_PROJ + 1 * BLK;
constexpr size_t WS_AGG = 4 * MiB;
constexpr size_t WS_LW = 5 * MiB;
constexpr size_t WS_SP = 5 * MiB + 512 * 1024;
constexpr size_t WS_MERGED = WS_PROJ + 1 * BLK;
constexpr size_t WS_ST = WS_XB;
constexpr int CW_TMO = 0, CW_BAR = 4096;

enum { PH_PRO = 0, PH_G1, PH_MIXA, PH_MIXB, PH_G2, PH_G3, PH_G4, PH_G5, PH_G6, PH_FIN };
constexpr int NPL = 8, NPH = 1 + DEPTH * NPL + 1;

constexpr int NWAVES = 8;
constexpr int RING_BYTES = 131072, LDS_BYTES = 155648, LDSCTL_OFF = LDS_BYTES - 1024, MISC_OFF = LDSCTL_OFF + 320;

#define GAS __attribute__((address_space(1)))
#define LAS __attribute__((address_space(3)))
typedef unsigned short bf16;
typedef unsigned v4u __attribute__((ext_vector_type(4)));
typedef unsigned v2u __attribute__((ext_vector_type(2)));
typedef float f32x4 __attribute__((ext_vector_type(4)));
typedef GAS unsigned gu32;
#define RLX_AGENT __ATOMIC_RELAXED, __HIP_MEMORY_SCOPE_AGENT
#define LDS_WAIT() asm volatile("s_waitcnt lgkmcnt(0)" ::: "memory")
#define VM_WAIT() asm volatile("s_waitcnt vmcnt(0)" ::: "memory")
__device__ __forceinline__ unsigned f2bf(float f) { unsigned u = __builtin_bit_cast(unsigned, f); return (u + 0x7fffu + ((u >> 16) & 1u)) >> 16; }
__device__ __forceinline__ unsigned pk2(float lo, float hi) { return f2bf(lo) | (f2bf(hi) << 16); }
__device__ __forceinline__ float bf2f(unsigned short b) { return __builtin_bit_cast(float, (unsigned)b << 16); }
__device__ __forceinline__ float bflo(unsigned w) { return __builtin_bit_cast(float, w << 16); }
__device__ __forceinline__ float bfhi(unsigned w) { return __builtin_bit_cast(float, w & 0xffff0000u); }
__device__ __forceinline__ float rdlane(float v, int l) { return __builtin_bit_cast(float, __builtin_amdgcn_readlane(__builtin_bit_cast(int, v), l)); }
__device__ __forceinline__ float fexp(float x) { return __builtin_amdgcn_exp2f(x * 1.4426950408889634f); }
__device__ __forceinline__ float sigmoidf_(float x) { return __builtin_amdgcn_rcpf(1.0f + fexp(-x)); }
__device__ __forceinline__ float lane_get(float v, int srclane) { return __builtin_bit_cast(float, __builtin_amdgcn_ds_bpermute(srclane << 2, __builtin_bit_cast(int, v))); }
__device__ __forceinline__ float shx(float v, int lane, int o) { return lane_get(v, lane ^ o); }
__device__ __forceinline__ float wave_sum(float v, int lane) {
#pragma unroll
    for (int o = 1; o < 64; o <<= 1) v += shx(v, lane, o);
    return v;
}
__device__ __forceinline__ float wave_max(float v, int lane) {
#pragma unroll
    for (int o = 1; o < 64; o <<= 1) v = fmaxf(v, shx(v, lane, o));
    return v;
}
__device__ __forceinline__ float log2_1m(float x) {
    const float p = x * (1.0f + x * (0.5f + x * (0.33333333f + x * (0.25f + x * (0.2f + x * (0.16666667f + x * 0.14285714f))))));
    return -p * 1.4426950408889634f;
}
__device__ __forceinline__ float log1p_small(float y) {
    if (y < 0.01f) return y * (1.0f - y * (0.5f - y * (0.33333333f - 0.25f * y)));
    return __builtin_amdgcn_logf(1.0f + y) * 0.6931471805599453f;
}
__device__ __forceinline__ float gelu_tanh(float x) {
    const float u = 0.7978845608028654f * (x + 0.044715f * x * x * x);
    const float t = 1.0f - 2.0f * __builtin_amdgcn_rcpf(1.0f + fexp(2.0f * u));
    return 0.5f * x * (1.0f + t);
}
__device__ __forceinline__ float row_rs(const float* ss, int row, int fq, int lane) {
    const f32x4 a = *(const f32x4*)(ss + (size_t)row * 16 + 4 * fq);
    float s = (a.x + a.y) + (a.z + a.w);
    s += shx(s, lane, 16); s += shx(s, lane, 32);
    return 1.0f / sqrtf(s * (1.0f / D) + RMS_EPS);
}

#define XB_TMO      128
#define XB_XCNT(j)  (256  + 64 * (j))
#define XB_XSUB(j)  (1280 + 64 * (j))
#define XB_XGEN(j)  (2304 + 64 * (j))
#define XB_TOP      3328
#define XB_TOPGEN   3392
#define XCD_BAR_WORDS 3456
#define XB_SPIN_CAP (1u << 18)

__device__ __forceinline__ unsigned xb_ld(unsigned* p)              { return __hip_atomic_load(p, __ATOMIC_RELAXED, __HIP_MEMORY_SCOPE_AGENT); }
__device__ __forceinline__ unsigned xb_add(unsigned* p, unsigned v) { return __hip_atomic_fetch_add(p, v, __ATOMIC_RELAXED, __HIP_MEMORY_SCOPE_AGENT); }
__device__ __forceinline__ unsigned xb_xcc_id() { return (unsigned)__builtin_amdgcn_s_getreg((3 << 11) | 20) & 0xFu; }
#define XB_SPIN(cond, bar) do { unsigned _sp = 0; while (cond) { __builtin_amdgcn_s_sleep(1); \
    if ((++_sp & 255u) == 0u) { if (xb_ld(&(bar)[XB_TMO])) break; if (_sp > XB_SPIN_CAP) { atomicAdd(&(bar)[XB_TMO], 1u); break; } } } } while (0)

struct XcdBarrier {
    unsigned* bar; unsigned x;
    volatile LAS unsigned* st;
};

__device__ __forceinline__ XcdBarrier xcd_barrier_post(unsigned* bar, volatile LAS unsigned* st) {
    XcdBarrier b; b.bar = bar; b.x = xb_xcc_id(); b.st = st;
    if (threadIdx.x == 0) (void)xb_add(&bar[XB_XCNT(b.x)], 1u);
    return b;
}
__device__ __forceinline__ void xcd_barrier_complete(unsigned* bar, unsigned x, unsigned& nloc, unsigned& nx) {
    const unsigned G = gridDim.x * gridDim.y * gridDim.z;
    unsigned sum, cnt, mine, sp = 0u;
    for (;;) {
        sum = 0u; cnt = 0u; mine = 0u;
#pragma unroll
        for (unsigned j = 0; j < 16; ++j) { const unsigned c = xb_ld(&bar[XB_XCNT(j)]); sum += c; cnt += (c > 0u) ? 1u : 0u; mine = (j == x) ? c : mine; }
        if (sum == G) break;
        __builtin_amdgcn_s_sleep(1);
        if ((++sp & 255u) == 0u) { if (xb_ld(&bar[XB_TMO])) break; if (sp > XB_SPIN_CAP) { atomicAdd(&bar[XB_TMO], 1u); break; } }
    }
    nloc = mine > 0u ? mine : 1u; nx = cnt > 0u ? cnt : 1u;
}

__device__ __forceinline__ void xcd_barrier(const XcdBarrier& b, const int tid_) {
    asm volatile("s_waitcnt vmcnt(0)" ::: "memory");
    __syncthreads();
    if (tid_ == 0) {
        unsigned* bar = b.bar;
        __builtin_amdgcn_s_waitcnt(0);
        unsigned nloc = b.st[0], nx = b.st[1];
        if (nloc == 0u) { xcd_barrier_complete(bar, b.x, nloc, nx); b.st[0] = nloc; b.st[1] = nx; }
        const unsigned old = xb_add(&bar[XB_XSUB(b.x)], 1u);
        const unsigned gen = old / nloc;
        if (old + 1u == (gen + 1u) * nloc) {
            __builtin_amdgcn_fence(__ATOMIC_RELEASE, "agent");
            asm volatile("s_waitcnt vmcnt(0)" ::: "memory");
            const unsigned og = xb_add(&bar[XB_TOP], 1u);
            const unsigned tg = og / nx;
            if (og + 1u == (tg + 1u) * nx) xb_add(&bar[XB_TOPGEN], 1u);
            else XB_SPIN(xb_ld(&bar[XB_TOPGEN]) == tg, bar);
            __builtin_amdgcn_fence(__ATOMIC_ACQUIRE, "agent");
            xb_add(&bar[XB_XGEN(b.x)], 1u);
            asm volatile("s_waitcnt vmcnt(0)" ::: "memory");
        } else {
            XB_SPIN(xb_ld(&bar[XB_XGEN(b.x)]) == gen, bar);
            __builtin_amdgcn_fence(__ATOMIC_ACQUIRE, "agent");
            asm volatile("s_waitcnt vmcnt(0)" ::: "memory");
        }
    }
    __syncthreads();
}


constexpr int LO_RSL = 131072, LO_RSPM = LO_RSL + 8 * 256 * 4, LO_BGL = LO_RSPM + 64;
__device__ __forceinline__ float rs_lookup(const LAS unsigned char* lds, int pm, int rowl) {
    const LAS int* spm = (const LAS int*)(lds + LO_RSPM); int sl = 0;
#pragma unroll
    for (int i = 1; i < 8; ++i) sl = spm[i] == pm ? i : sl;
    return ((const LAS float*)(lds + LO_RSL))[sl * 256 + rowl];
}
using pg8::Unit; using pg8::bf16_t; using pg8::cvt_pk_bf16;
typedef pg8::u32x4 u32x4;
struct EpiG1 {
    static constexpr bool PERM = true, AFTER_DRAIN = false, KEEP_ACC = false;
    bf16_t* proj; unsigned char* gate8; const LAS unsigned char* lds; const float* tab;
    __device__ __forceinline__ void operator()(const f32x4 (&acc)[2][2][4][2], const Unit& u, int wr, int wc, int fr, int fq) const {
        const int pn = u.pn;
        const int kind = pn >> 1, col0 = (pn & 1) * 256 + wc * 32 + 8 * fq;
        const bool rope = (pn < 18) && ((kind == 3) || (kind == 4));
        f32x4 cs[4][2], sn[4][2];
        if (rope) {
#pragma unroll
            for (int m = 0; m < 4; ++m)
#pragma unroll
                for (int bj = 0; bj < 2; ++bj) { const int row = u.pm * 256 + wr * 64 + m * 16 + fr, i0 = ((col0 + bj * 128) & 127) >> 1, pos = row & (SEQ - 1);
                    cs[m][bj] = *(const f32x4*)(tab + pos * 64 + i0); sn[m][bj] = *(const f32x4*)(tab + 131072 + pos * 64 + i0); }
        }
        float rsv[2][4];
#pragma unroll
        for (int ai = 0; ai < 2; ++ai)
#pragma unroll
            for (int m = 0; m < 4; ++m) rsv[ai][m] = rs_lookup(lds, u.pm, ai * 128 + wr * 64 + m * 16 + fr);
        if (pn < 18) {
            const int phys = (int)((0x683754210ull >> (4 * kind)) & 15ull);
            bf16_t* base = proj + (size_t)phys * ((size_t)T * 512);
            const float scale = kind == 0 ? 0.125f : (kind == 3 ? 0.08838834764831845f : 1.0f);
#pragma unroll
            for (int ai = 0; ai < 2; ++ai) {
                if (rope && ai == 1) {
#pragma unroll
                    for (int m = 0; m < 4; ++m)
#pragma unroll
                        for (int bj = 0; bj < 2; ++bj) { const int row = u.pm * 256 + ai * 128 + wr * 64 + m * 16 + fr, i0 = ((col0 + bj * 128) & 127) >> 1, pos = row & (SEQ - 1);
                            cs[m][bj] = *(const f32x4*)(tab + pos * 64 + i0); sn[m][bj] = *(const f32x4*)(tab + 131072 + pos * 64 + i0); }
                }
#pragma unroll
                for (int m = 0; m < 4; ++m) {
                    const int row = u.pm * 256 + ai * 128 + wr * 64 + m * 16 + fr;
                    const float rs = rsv[ai][m] * scale;
                    bf16_t* rowp = base + (size_t)row * 512 + col0;
#pragma unroll
                    for (int bj = 0; bj < 2; ++bj) {
                        f32x4 v0 = acc[ai][bj][m][0] * rs, v1 = acc[ai][bj][m][1] * rs;
                        if (rope) {
                            const f32x4 c_ = cs[m][bj], s_ = sn[m][bj];
                            f32x4 w0, w1;
                            w0[0] = v0[0] * c_[0] - v0[1] * s_[0]; w0[1] = v0[0] * s_[0] + v0[1] * c_[0];
                            w0[2] = v0[2] * c_[1] - v0[3] * s_[1]; w0[3] = v0[2] * s_[1] + v0[3] * c_[1];
                            w1[0] = v1[0] * c_[2] - v1[1] * s_[2]; w1[1] = v1[0] * s_[2] + v1[1] * c_[2];
                            w1[2] = v1[2] * c_[3] - v1[3] * s_[3]; w1[3] = v1[2] * s_[3] + v1[3] * c_[3];
                            v0 = w0; v1 = w1;
                        }
                        u32x4 w; w.x = cvt_pk_bf16(v0[0], v0[1]); w.y = cvt_pk_bf16(v0[2], v0[3]); w.z = cvt_pk_bf16(v1[0], v1[1]); w.w = cvt_pk_bf16(v1[2], v1[3]);
                        *(u32x4*)(rowp + bj * 128) = w;
                    }
                }
            }
        } else {
            const int g0 = (pn - 18) * 256 + wc * 32 + 8 * fq;
            f32x4 bg[2][2];
#pragma unroll
            for (int bj = 0; bj < 2; ++bj) { const LAS float* bgl = (const LAS float*)(lds + LO_BGL) + g0 + bj * 128; bg[bj][0] = *(const LAS f32x4*)bgl; bg[bj][1] = *(const LAS f32x4*)(bgl + 4); }
#pragma unroll
            for (int ai = 0; ai < 2; ++ai)
#pragma unroll
                for (int m = 0; m < 4; ++m) {
                    const int row = u.pm * 256 + ai * 128 + wr * 64 + m * 16 + fr;
                    const float rs = rsv[ai][m];
#pragma unroll
                    for (int bj = 0; bj < 2; ++bj) {
                        const int gc = g0 + bj * 128;
                        const f32x4 v0 = acc[ai][bj][m][0] * rs + bg[bj][0], v1 = acc[ai][bj][m][1] * rs + bg[bj][1];
                        unsigned lo = 0, hi = 0;
#pragma unroll
                        for (int e = 0; e < 4; ++e) {
                            lo |= (unsigned)(sigmoidf_(v0[e]) * 255.0f + 0.5f) << (8 * e);
                            hi |= (unsigned)(sigmoidf_(v1[e]) * 255.0f + 0.5f) << (8 * e);
                        }
                        v2u w; w.x = lo; w.y = hi;
                        *(v2u*)(gate8 + (size_t)row * 3072 + gc) = w;
                    }
                }
        }
    }
};
struct EpiG2 {
    static constexpr bool PERM = false, AFTER_DRAIN = false, KEEP_ACC = true;
    const unsigned char* gate8; bf16_t* merged;
    __device__ __forceinline__ void operator()(f32x4 (&acc)[2][2][4][2], const Unit& u, int wr, int wc, int fr, int fq) const {
        const int col0 = u.pn * 256 + wc * 32 + 4 * fq;
        unsigned ga[2][4][2][2], gb[2][4][2][2];
#pragma unroll
        for (int ai = 0; ai < 2; ++ai)
#pragma unroll
            for (int m = 0; m < 4; ++m)
#pragma unroll
                for (int bj = 0; bj < 2; ++bj)
#pragma unroll
                    for (int n = 0; n < 2; ++n) {
                        const size_t o = (size_t)(u.pm * 256 + ai * 128 + wr * 64 + m * 16 + fr) * 3072 + col0 + bj * 128 + n * 16;
                        ga[ai][m][bj][n] = *(const unsigned*)(gate8 + o + u.z * 1024);
                        gb[ai][m][bj][n] = u.z < 2 ? *(const unsigned*)(gate8 + o + (u.z + 1) * 1024) : 0u;
                    }
#pragma unroll
        for (int ai = 0; ai < 2; ++ai)
#pragma unroll
            for (int m = 0; m < 4; ++m) {
                const int row = u.pm * 256 + ai * 128 + wr * 64 + m * 16 + fr;
#pragma unroll
                for (int bj = 0; bj < 2; ++bj)
#pragma unroll
                    for (int n = 0; n < 2; ++n) {
                        const int c = col0 + bj * 128 + n * 16;
                        const unsigned a_ = ga[ai][m][bj][n], b_ = gb[ai][m][bj][n];
                        f32x4 t = acc[ai][bj][m][n];
                        if (u.z < 2) {
#pragma unroll
                            for (int e = 0; e < 4; ++e) { const float a = (float)max((a_ >> (8 * e)) & 255u, 1u), b = (float)max((b_ >> (8 * e)) & 255u, 1u); t[e] = t[e] * a * __builtin_amdgcn_rcpf(b); }
                            acc[ai][bj][m][n] = t;
                        } else {
#pragma unroll
                            for (int e = 0; e < 4; ++e) t[e] *= (float)max((a_ >> (8 * e)) & 255u, 1u) * (1.0f / 255.0f);
                            v2u w; w.x = cvt_pk_bf16(t[0], t[1]); w.y = cvt_pk_bf16(t[2], t[3]);
                            *(v2u*)(merged + (size_t)row * 1024 + c) = w;
                            acc[ai][bj][m][n] = (f32x4){0.f, 0.f, 0.f, 0.f};
                        }
                    }
            }
    }
};
struct EpiRes {
    static constexpr bool PERM = false, AFTER_DRAIN = false, KEEP_ACC = false;
    const float* basef; const bf16_t* baseb; bf16_t* xb; float* ssout;
    __device__ __forceinline__ void operator()(const f32x4 (&acc)[2][2][4][2], const Unit& u, int wr, int wc, int fr, int fq) const {
        const int col0 = u.pn * 256 + wc * 32 + 4 * fq, lane = fr + 16 * fq;
#pragma unroll
        for (int ai = 0; ai < 2; ++ai) {
            f32x4 bv[4][2][2];
            if (basef) {
#pragma unroll
                for (int m = 0; m < 4; ++m)
#pragma unroll
                    for (int bj = 0; bj < 2; ++bj)
#pragma unroll
                        for (int n = 0; n < 2; ++n) bv[m][bj][n] = *(const f32x4*)(basef + (size_t)(u.pm * 256 + ai * 128 + wr * 64 + m * 16 + fr) * 1024 + col0 + bj * 128 + n * 16);
            } else {
                v2u bw[4][2][2];
#pragma unroll
                for (int m = 0; m < 4; ++m)
#pragma unroll
                    for (int bj = 0; bj < 2; ++bj)
#pragma unroll
                        for (int n = 0; n < 2; ++n) bw[m][bj][n] = *(const v2u*)(baseb + (size_t)(u.pm * 256 + ai * 128 + wr * 64 + m * 16 + fr) * 1024 + col0 + bj * 128 + n * 16);
#pragma unroll
                for (int m = 0; m < 4; ++m)
#pragma unroll
                    for (int bj = 0; bj < 2; ++bj)
#pragma unroll
                        for (int n = 0; n < 2; ++n) bv[m][bj][n] = (f32x4){bflo(bw[m][bj][n].x), bfhi(bw[m][bj][n].x), bflo(bw[m][bj][n].y), bfhi(bw[m][bj][n].y)};
            }
#pragma unroll
            for (int m = 0; m < 4; ++m) {
                const int row = u.pm * 256 + ai * 128 + wr * 64 + m * 16 + fr;
                float s = 0.f;
#pragma unroll
                for (int bj = 0; bj < 2; ++bj)
#pragma unroll
                    for (int n = 0; n < 2; ++n) {
                        const size_t off = (size_t)row * 1024 + col0 + bj * 128 + n * 16;
                        const f32x4 v = bv[m][bj][n] + acc[ai][bj][m][n];
                        v2u w; w.x = cvt_pk_bf16(v[0], v[1]); w.y = cvt_pk_bf16(v[2], v[3]);
                        *(v2u*)(xb + off) = w;
                        s += (v[0] * v[0] + v[1] * v[1]) + (v[2] * v[2] + v[3] * v[3]);
                    }
                s += shx(s, lane, 16); s += shx(s, lane, 32);
                if (fq == 0) ssout[(size_t)row * 16 + u.pn * 4 + wc] = s;
            }
        }
    }
};
struct EpiG4 {
    static constexpr bool PERM = true, AFTER_DRAIN = false, KEEP_ACC = false;
    bf16_t* U; const LAS unsigned char* lds;
    __device__ __forceinline__ void operator()(const f32x4 (&acc)[2][2][4][2], const Unit& u, int wr, int wc, int fr, int fq) const {
        const int col0 = u.pn * 256 + wc * 32 + 8 * fq;
        float rsv[2][4];
#pragma unroll
        for (int ai = 0; ai < 2; ++ai)
#pragma unroll
            for (int m = 0; m < 4; ++m) rsv[ai][m] = rs_lookup(lds, u.pm, ai * 128 + wr * 64 + m * 16 + fr);
#pragma unroll
        for (int ai = 0; ai < 2; ++ai)
#pragma unroll
            for (int m = 0; m < 4; ++m) {
                const int row = u.pm * 256 + ai * 128 + wr * 64 + m * 16 + fr;
                const float rs = rsv[ai][m];
                bf16_t* rowp = U + (size_t)row * FF + col0;
#pragma unroll
                for (int bj = 0; bj < 2; ++bj) {
                    f32x4 v0 = acc[ai][bj][m][0] * rs, v1 = acc[ai][bj][m][1] * rs;
#pragma unroll
                    for (int e = 0; e < 4; ++e) { const float a = fmaxf(v0[e], 0.f), b = fmaxf(v1[e], 0.f); v0[e] = a * a; v1[e] = b * b; }
                    u32x4 w; w.x = cvt_pk_bf16(v0[0], v0[1]); w.y = cvt_pk_bf16(v0[2], v0[3]); w.z = cvt_pk_bf16(v1[0], v1[1]); w.w = cvt_pk_bf16(v1[2], v1[3]);
                    *(u32x4*)(rowp + bj * 128) = w;
                }
            }
    }
};
struct EpiE {
    static constexpr bool PERM = false, AFTER_DRAIN = false, KEEP_ACC = false;
    bf16_t* E;
    __device__ __forceinline__ void operator()(const f32x4 (&acc)[2][2][4][2], const Unit& u, int wr, int wc, int fr, int fq) const {
        const int col0 = u.pn * 256 + wc * 32 + 4 * fq;
#pragma unroll
        for (int ai = 0; ai < 2; ++ai)
#pragma unroll
            for (int m = 0; m < 4; ++m) {
                const int row = u.pm * 256 + ai * 128 + wr * 64 + m * 16 + fr;
#pragma unroll
                for (int bj = 0; bj < 2; ++bj)
#pragma unroll
                    for (int n = 0; n < 2; ++n) { const f32x4 v = acc[ai][bj][m][n]; v2u w; w.x = cvt_pk_bf16(v[0], v[1]); w.y = cvt_pk_bf16(v[2], v[3]); *(v2u*)(E + (size_t)row * 1024 + col0 + bj * 128 + n * 16) = w; }
            }
    }
};
struct EpiG6 {
    static constexpr bool PERM = false, AFTER_DRAIN = false, KEEP_ACC = false;
    const bf16_t* baseb; bf16_t* xb; const LAS unsigned char* lds; float* ssout; const bf16_t* E;
    __device__ __forceinline__ void operator()(const f32x4 (&acc)[2][2][4][2], const Unit& u, int wr, int wc, int fr, int fq) const {
        const int col0 = u.pn * 256 + wc * 32 + 4 * fq, lane = fr + 16 * fq;
        float rsv[2][4];
#pragma unroll
        for (int ai = 0; ai < 2; ++ai)
#pragma unroll
            for (int m = 0; m < 4; ++m) rsv[ai][m] = rs_lookup(lds, u.pm, ai * 128 + wr * 64 + m * 16 + fr);
#pragma unroll
        for (int ai = 0; ai < 2; ++ai) {
            v2u bw[4][2][2], ew[4][2][2];
#pragma unroll
            for (int m = 0; m < 4; ++m)
#pragma unroll
                for (int bj = 0; bj < 2; ++bj)
#pragma unroll
                    for (int n = 0; n < 2; ++n) { const size_t off = (size_t)(u.pm * 256 + ai * 128 + wr * 64 + m * 16 + fr) * 1024 + col0 + bj * 128 + n * 16;
                        bw[m][bj][n] = *(const v2u*)(baseb + off); ew[m][bj][n] = *(const v2u*)(E + off); }
#pragma unroll
            for (int m = 0; m < 4; ++m) {
                const int row = u.pm * 256 + ai * 128 + wr * 64 + m * 16 + fr;
                const float rs = rsv[ai][m];
                float s = 0.f;
#pragma unroll
                for (int bj = 0; bj < 2; ++bj)
#pragma unroll
                    for (int n = 0; n < 2; ++n) {
                        const size_t off = (size_t)row * 1024 + col0 + bj * 128 + n * 16;
                        const f32x4 a = acc[ai][bj][m][n] * rs; const v2u e_ = ew[m][bj][n], b_ = bw[m][bj][n];
                        const f32x4 e = (f32x4){bflo(e_.x), bfhi(e_.x), bflo(e_.y), bfhi(e_.y)};
                        f32x4 v = (f32x4){bflo(b_.x), bfhi(b_.x), bflo(b_.y), bfhi(b_.y)};
#pragma unroll
                        for (int k = 0; k < 4; ++k) v[k] += sigmoidf_(a[k]) * e[k];
                        v2u w; w.x = cvt_pk_bf16(v[0], v[1]); w.y = cvt_pk_bf16(v[2], v[3]);
                        *(v2u*)(xb + off) = w;
                        s += (v[0] * v[0] + v[1] * v[1]) + (v[2] * v[2] + v[3] * v[3]);
                    }
                s += shx(s, lane, 16); s += shx(s, lane, 32);
                if (fq == 0) ssout[(size_t)row * 16 + u.pn * 4 + wc] = s;
            }
            asm volatile("" ::: "memory");
        }
    }
};
struct ZOrder {
    pg8::StaticOrder S;
    __device__ __forceinline__ bool next(int i, Unit& u) const { if (!S.next(i / 3, u)) return false; u.z = i % 3; return true; }
    __device__ __forceinline__ void a_ready(const Unit&) const {}
    __device__ __forceinline__ void done(const Unit&) const {}
};

struct Args { const float* in[23]; float* out; unsigned char* ws; int ph_lo, ph_hi; };
typedef const __attribute__((address_space(4))) Args CArgs;
__device__ __forceinline__ CArgs* get_args() {
    CArgs* p = (CArgs*)__builtin_amdgcn_kernarg_segment_ptr();
    asm volatile("" : "+s"(p));
    return p;
}
struct Frame {
    LAS unsigned char* lds;
    int wave0, G, ngw, bid;
    float* out; unsigned char* ws;
    __device__ __forceinline__ int ltid() const { unsigned z = 0u; asm volatile("" : "+v"(z)); return wave0 * 64 + (int)__builtin_amdgcn_mbcnt_hi(~0u, __builtin_amdgcn_mbcnt_lo(~0u, z)); }
    __device__ __forceinline__ int lane() const { return ltid() & 63; }
    __device__ __forceinline__ int wave() const { int w_ = wave0; asm volatile("" : "+s"(w_)); return w_; }
    __device__ __forceinline__ int gw() const { return bid * NWAVES + wave(); }
};

__device__ __forceinline__ void transpose_item(const float* W, const float* g, int K, int N, bf16* WT, LAS float* scr, int item, int lane) {
    const int nblk = N / 32, kb = item / nblk, nb = item % nblk, k0 = 64 * kb, n0 = 32 * nb;
#pragma unroll
    for (int i = 0; i < 32; ++i) { const int kk = 2 * i + (lane >> 5); float v = W[(size_t)(k0 + kk) * N + n0 + (lane & 31)]; if (g) v *= g[k0 + kk]; scr[kk * 33 + (lane & 31)] = v; }
    LDS_WAIT(); asm volatile("" ::: "memory");
    const int c = lane & 7;
#pragma unroll
    for (int j = 0; j < 4; ++j) { const int n = (lane >> 3) + 8 * j; const LAS float* s = scr + (8 * c) * 33 + n;
        v4u o; o.x = pk2(s[0 * 33], s[1 * 33]); o.y = pk2(s[2 * 33], s[3 * 33]); o.z = pk2(s[4 * 33], s[5 * 33]); o.w = pk2(s[6 * 33], s[7 * 33]);
        *(v4u*)(WT + (size_t)(n0 + n) * K + k0 + 8 * c) = o; }
    LDS_WAIT(); asm volatile("" ::: "memory");
}
__device__ __forceinline__ void convert_matrix(const Frame& F, const float* W, const float* g, int K, int N, bf16* WT) {
    LAS float* scr = (LAS float*)(F.lds + F.wave() * 16384);
    const int nitems = (K / 64) * (N / 32);
    for (int it = F.gw(); it < nitems; it += F.ngw) transpose_item(W, g, K, N, WT, scr, it, F.lane());
}
__device__ __forceinline__ void convert_list(const Frame& F, CArgs* A, int l, bool early, bool mid) {
    LAS float* scr = (LAS float*)(F.lds + F.wave() * 16384);
    constexpr int I_IN = (D / 64) * (7680 / 32), I_BR = (512 / 64) * (D / 32), I_SQ = (D / 64) * (D / 32), I_PLE = (PLE / 64) * (D / 32);
    const int n_early = early ? I_IN : 0, n_mid = mid ? 3 * I_BR + 2 * I_SQ + I_PLE : 0, lane = F.lane();
    for (int it = F.gw(); it < n_early + n_mid; it += F.ngw) {
        int r = it;
        if (r < n_early) { transpose_item(A->in[3] + (size_t)l * D * 7680, A->in[2] + l * D, D, 7680, (bf16*)(F.ws + W_IN), scr, r, lane); continue; } r -= n_early;
        if (r < 3 * I_BR) { const int n = r / I_BR; transpose_item(A->in[14] + ((size_t)l * 3 + n) * 512 * D, nullptr, 512, D, (bf16*)(F.ws + W_BR) + (size_t)n * D * 512, scr, r - n * I_BR, lane); continue; } r -= 3 * I_BR;
        if (r < I_SQ) { transpose_item(A->in[15] + (size_t)l * D * D, nullptr, D, D, (bf16*)(F.ws + W_OUT), scr, r, lane); continue; } r -= I_SQ;
        if (r < I_SQ) { transpose_item(A->in[20] + (size_t)l * D * D, A->in[19] + l * D, D, D, (bf16*)(F.ws + W_G(l & 1)), scr, r, lane); continue; } r -= I_SQ;
        transpose_item(A->in[21] + (size_t)l * PLE * D, nullptr, PLE, D, (bf16*)(F.ws + W_PLE(l & 1)), scr, r, lane);
    }
}
__device__ __forceinline__ void convert_layer_early(const Frame& F, CArgs* A, int l) { convert_list(F, A, l, true, false); }
__device__ __forceinline__ void convert_layer_mid(const Frame& F, CArgs* A, int l) { convert_list(F, A, l, false, true); }
__device__ __forceinline__ void convert_layer_mlp(const Frame& F, CArgs* A, int l) {
    LAS float* scr = (LAS float*)(F.lds + F.wave() * 16384);
    constexpr int I_UP = (D / 64) * (FF / 32); const int lane = F.lane();
    for (int it = F.gw(); it < 2 * I_UP; it += F.ngw) {
        if (it < I_UP) transpose_item(A->in[17] + (size_t)l * D * FF, A->in[16] + l * D, D, FF, (bf16*)(F.ws + W_UP), scr, it, lane);
        else transpose_item(A->in[18] + (size_t)l * FF * D, nullptr, FF, D, (bf16*)(F.ws + W_DOWN), scr, it - I_UP, lane);
    }
}

template <class Sched>
__device__ __forceinline__ void stage_epilogue_tables(const Frame& F, const float* ss, const Sched& S, const float* bgate) {
    const int tid = F.ltid(), lane = tid & 63;
    LAS float* rsl = (LAS float*)(F.lds + LO_RSL); LAS int* spm = (LAS int*)(F.lds + LO_RSPM);
    __syncthreads();
    f32x4 sp[4][4]; int pmv[4];
#pragma unroll
    for (int j = 0; j < 4; ++j) { pg8::Unit u; const int i = 2 * j + (tid >> 8); pmv[j] = S.next(i, u) ? u.pm : -1;
        const int row = (pmv[j] < 0 ? 0 : pmv[j]) * 256 + (tid & 255);
#pragma unroll
        for (int q = 0; q < 4; ++q) sp[j][q] = *(const f32x4*)(ss + (size_t)row * 16 + 4 * q); }
#pragma unroll
    for (int j = 0; j < 4; ++j) { const int i = 2 * j + (tid >> 8);
        const f32x4 a = (sp[j][0] + sp[j][1]) + (sp[j][2] + sp[j][3]);
        rsl[i * 256 + (tid & 255)] = 1.0f / sqrtf(((a.x + a.y) + (a.z + a.w)) * (1.0f / D) + RMS_EPS);
        if ((tid & 255) == 0) spm[i] = pmv[j]; }
    if (bgate) { LAS float* bg = (LAS float*)(F.lds + LO_BGL); for (int e = tid; e < 3072; e += NWAVES * 64) bg[e] = bgate[e]; }
    (void)lane;
    __syncthreads();
}
__device__ __forceinline__ void phase_prologue(const Frame& F, CArgs* A) {
    convert_list(F, A, 0, true, false);
    const float* x = A->in[0]; bf16* xb = (bf16*)(F.ws + WS_XB); float* ss = (float*)(F.ws + WS_SSB);
    { const int lane = F.lane();
      for (int m0 = F.gw() * 4; m0 < T; m0 += F.ngw * 4) {
        f32x4 v[4][4];
#pragma unroll
        for (int r = 0; r < 4; ++r)
#pragma unroll
            for (int j = 0; j < 4; ++j) v[r][j] = ((const f32x4*)(x + (size_t)(m0 + r) * D) + lane)[64 * j];
#pragma unroll
        for (int r = 0; r < 4; ++r) {
            v2u* o = (v2u*)(xb + (size_t)(m0 + r) * D) + lane;
            float s = 0.f;
#pragma unroll
            for (int j = 0; j < 4; ++j) { const f32x4 t = v[r][j]; s += (t.x * t.x + t.y * t.y) + (t.z * t.z + t.w * t.w); v2u w; w.x = pk2(t.x, t.y); w.y = pk2(t.z, t.w); o[64 * j] = w; }
            s = wave_sum(s, lane);
            if (lane < 16) ss[(size_t)(m0 + r) * 16 + lane] = lane == 0 ? s : 0.f;
        }
      } }
    { bf16* lw = (bf16*)(F.ws + WS_LW);
      for (int e = F.gw() * 64 + F.lane(); e < DEPTH * 2 * 2 * 8 * 4096; e += F.ngw * 64) {
          const int mat = e >> 12, j = (e >> 6) & 63, i = e & 63, blk = mat & 7, ax = (mat >> 3) & 1, ld = mat >> 4;
          const float* src = (ax ? A->in[11] : A->in[9]) + ((size_t)ld * 8 + blk) * 4096;
          lw[e] = (bf16)f2bf(src[i * 64 + j]); }
      float* sp = (float*)(F.ws + WS_SP);
      for (int e = F.gw() * 64 + F.lane(); e < DEPTH * 2 * 512; e += F.ngw * 64) sp[e] = log1p_small(fexp(-A->in[13][e])); }
    float* tab = (float*)(F.ws + WS_TAB);
    for (int e = F.gw() * 64 + F.lane(); e < SEQ * 64; e += F.ngw * 64) {
        const int pos = e >> 6, i = e & 63;
        const float theta = __builtin_amdgcn_exp2f(-(float)i * (13.287712379549449f / 63.0f));
        double rev = (double)pos * (double)theta * 0.15915494309189535; rev -= __builtin_floor(rev);
        const float fr = (float)rev;
        tab[e] = __builtin_amdgcn_cosf(fr); tab[131072 + e] = __builtin_amdgcn_sinf(fr);
    }
}


typedef short bf16x8_t __attribute__((ext_vector_type(8)));
typedef float f32x2_t __attribute__((ext_vector_type(2))); typedef __bf16 bf16x2_t __attribute__((ext_vector_type(2)));
__device__ __forceinline__ unsigned pkbf(float lo, float hi) { f32x2_t v = {lo, hi}; bf16x2_t b = __builtin_convertvector(v, bf16x2_t); return __builtin_bit_cast(unsigned, b); }
typedef short v4i16_t __attribute__((ext_vector_type(4)));
__device__ __forceinline__ v4i16_t ds_tr16(LAS const unsigned char* p) { return __builtin_amdgcn_ds_read_tr16_b64_v4i16((LAS v4i16_t*)p); }
__device__ __forceinline__ bf16x8_t tr_frag(LAS const unsigned char* p0, LAS const unsigned char* p1) {
    const v4i16_t a = ds_tr16(p0), b = ds_tr16(p1);
    return (bf16x8_t){a[0], a[1], a[2], a[3], b[0], b[1], b[2], b[3]};
}
#define MFMA16(a, b, c) __builtin_amdgcn_mfma_f32_16x16x32_bf16((a), (b), (c), 0, 0, 0)
constexpr int RP = 272;
__device__ __forceinline__ void ret_scan_item(const Frame& F, int item) {
    const int bh = item >> 3, dir = (item >> 2) & 1, dvq = item & 3, b = bh >> 2, h = bh & 3;
    const bf16* Kg = (const bf16*)(F.ws + WS_PROJ + 5 * BLK); const bf16* Vg = (const bf16*)(F.ws + WS_PROJ + 7 * BLK);
    bf16* ST = (bf16*)F.out;
    const float lg = log2_1m(__builtin_amdgcn_exp2f((dir ? -5.5f : -5.0f) - (float)h));
    const float cdec = __builtin_amdgcn_exp2f(128.0f * lg);
    constexpr int VP = 80, BUF = 128 * RP + 128 * VP;
    const int tid = F.ltid(), lane = F.lane(), w = F.wave(), g = lane >> 4, i = lane & 15, q4 = i >> 2, p4 = i & 3;
    v4u kr0[4], kr1[4], vr0, vr1;
    const int vrow = tid >> 2, vch = tid & 3;
#define RS_LOAD(kr, vr, c_) do { const size_t tb = (size_t)b * SEQ + (c_) * 128; \
        _Pragma("unroll") for (int q = 0; q < 4; ++q) { const int idx = tid + 512 * q; kr[q] = *(const v4u*)(Kg + (tb + (idx >> 4)) * 512 + h * 128 + (idx & 15) * 8); } \
        vr = *(const v4u*)(Vg + (tb + vrow) * 512 + h * 128 + dvq * 32 + vch * 8); } while (0)
#define RS_WRITE(kr, vr, buf_) do { LAS unsigned char* Kb_ = F.lds + (buf_) * BUF; LAS unsigned char* Vb_ = Kb_ + 128 * RP; \
        _Pragma("unroll") for (int q = 0; q < 4; ++q) { const int idx = tid + 512 * q, row = idx >> 4; \
            const float dk_ = __builtin_amdgcn_exp2f((float)(dir ? row : 127 - row) * lg); v4u o; \
            _Pragma("unroll") for (int e = 0; e < 4; ++e) o[e] = pkbf(bflo(kr[q][e]) * dk_, bfhi(kr[q][e]) * dk_); \
            *(LAS v4u*)(Kb_ + row * RP + (idx & 15) * 16) = o; } \
        *(LAS v4u*)(Vb_ + vrow * VP + vch * 16) = vr; } while (0)
#define RS_CHUNK(s_) (dir ? 15 - (s_) : (s_))
#define RS_STEP(s_, krN, vrN, krW, vrW) do { const int c = RS_CHUNK(s_), buf = (s_) & 1; \
        if ((s_) + 2 < 16) RS_LOAD(krN, vrN, RS_CHUNK((s_) + 2)); \
        bf16* dst = ST + ((size_t)(bh * 2 + dir) * 16 + c) * 16384; \
        _Pragma("unroll") for (int n = 0; n < 2; ++n) { v2u o; o.x = pkbf(acc[n][0], acc[n][1]); o.y = pkbf(acc[n][2], acc[n][3]); *(v2u*)(dst + (32 * dvq + 16 * n + i) * 128 + 16 * w + 4 * g) = o; } \
        acc[0] = acc[0] * cdec; acc[1] = acc[1] * cdec; \
        const LAS unsigned char* Kb = F.lds + buf * BUF; const LAS unsigned char* Vb = Kb + 128 * RP; \
        _Pragma("unroll") for (int ks = 0; ks < 4; ++ks) { const int r0 = 32 * ks + 8 * g + q4; \
            const bf16x8_t af = tr_frag(Kb + r0 * RP + (16 * w + 4 * p4) * 2, Kb + (r0 + 4) * RP + (16 * w + 4 * p4) * 2); \
            _Pragma("unroll") for (int n = 0; n < 2; ++n) { const bf16x8_t bv = tr_frag(Vb + r0 * VP + (16 * n + 4 * p4) * 2, Vb + (r0 + 4) * VP + (16 * n + 4 * p4) * 2); acc[n] = MFMA16(af, bv, acc[n]); } } \
        if ((s_) + 1 < 16) RS_WRITE(krW, vrW, buf ^ 1); \
        __syncthreads(); } while (0)
    __syncthreads();
    RS_LOAD(kr0, vr0, RS_CHUNK(0));
    RS_LOAD(kr1, vr1, RS_CHUNK(1));
    RS_WRITE(kr0, vr0, 0);
    __syncthreads();
    f32x4 acc[2]; acc[0] = (f32x4){0.f, 0.f, 0.f, 0.f}; acc[1] = acc[0];
    for (int s2 = 0; s2 < 16; s2 += 2) {
        RS_STEP(s2, kr0, vr0, kr1, vr1);
        RS_STEP(s2 + 1, kr1, vr1, kr0, vr0);
    }
#undef RS_STEP
#undef RS_CHUNK
#undef RS_LOAD
#undef RS_WRITE
}
__device__ __forceinline__ void ret_out_item(const Frame& F, const float* gn, int item) {
    const int bh = item >> 4, ci = item & 15, b = bh >> 2, h = bh & 3, t0 = b * SEQ + ci * 128;
    bf16* Gg = (bf16*)(F.ws + WS_PROJ + 3 * BLK); const bf16* Qg = (const bf16*)(F.ws + WS_PROJ + 4 * BLK);
    const bf16* Kg = (const bf16*)(F.ws + WS_PROJ + 5 * BLK); const bf16* Vg = (const bf16*)(F.ws + WS_PROJ + 7 * BLK);
    const bf16* ST = (const bf16*)F.out;
    const float lgf = log2_1m(__builtin_amdgcn_exp2f(-5.0f - (float)h)), lgb = log2_1m(__builtin_amdgcn_exp2f(-5.5f - (float)h));
    LAS unsigned char* Kl = F.lds; LAS unsigned char* Vl = F.lds + 128 * RP; LAS unsigned char* Sf = F.lds + 2 * 128 * RP; LAS unsigned char* Sb = F.lds + 3 * 128 * RP;
    const int lane = F.lane(), w = F.wave(), g = lane >> 4, i = lane & 15, q4 = i >> 2, p4 = i & 3;
    const int nl = 16 * w + i;
    bf16* grow = Gg + (size_t)(t0 + nl) * 512 + h * 128;
    bf16x8_t bq[4]; v2u ggv[8];
#pragma unroll
    for (int ks = 0; ks < 4; ++ks) bq[ks] = *(const bf16x8_t*)(Qg + (size_t)(t0 + nl) * 512 + h * 128 + 32 * ks + 8 * g);
#pragma unroll
    for (int n = 0; n < 8; ++n) ggv[n] = *(const v2u*)(grow + 16 * n + 4 * g);
    __syncthreads();
    {
#pragma unroll
        for (int q = 0; q < 4; ++q) {
            const int idx = F.ltid() + 512 * q, row = idx >> 4, ch = idx & 15;
            *(LAS v4u*)(Kl + row * RP + ch * 16) = *(const v4u*)(Kg + (size_t)(t0 + row) * 512 + h * 128 + ch * 8);
            *(LAS v4u*)(Vl + row * RP + ch * 16) = *(const v4u*)(Vg + (size_t)(t0 + row) * 512 + h * 128 + ch * 8);
        }
        const bf16* sfp = ST + ((size_t)(bh * 2 + 0) * 16 + ci) * 16384; const bf16* sbp = ST + ((size_t)(bh * 2 + 1) * 16 + ci) * 16384;
#pragma unroll
        for (int q = 0; q < 4; ++q) {
            const int idx = F.ltid() + 512 * q, row = idx >> 4, ch = idx & 15;
            *(LAS v4u*)(Sf + row * RP + ch * 16) = *(const v4u*)(sfp + idx * 8);
            *(LAS v4u*)(Sb + row * RP + ch * 16) = *(const v4u*)(sbp + idx * 8);
        }
    }
    __syncthreads();
    bf16x8_t bp[4];
#pragma unroll
    for (int kp = 0; kp < 4; ++kp) {
        f32x4 s0 = (f32x4){0.f, 0.f, 0.f, 0.f}, s1 = s0;
#pragma unroll
        for (int ks = 0; ks < 4; ++ks) {
            const bf16x8_t a0 = *(const LAS bf16x8_t*)(Kl + (32 * kp + i) * RP + (32 * ks + 8 * g) * 2);
            const bf16x8_t a1 = *(const LAS bf16x8_t*)(Kl + (32 * kp + 16 + i) * RP + (32 * ks + 8 * g) * 2);
            s0 = MFMA16(a0, bq[ks], s0); s1 = MFMA16(a1, bq[ks], s1);
        }
        float pv[8];
#pragma unroll
        for (int e = 0; e < 4; ++e) {
            const int m0 = 32 * kp + 4 * g + e, m1 = m0 + 16;
            const float d0 = (float)(nl - m0), d1 = (float)(nl - m1);
            pv[e] = s0[e] * (d0 >= 0.f ? __builtin_amdgcn_exp2f(d0 * lgf) : __builtin_amdgcn_exp2f(-d0 * lgb));
            pv[4 + e] = s1[e] * (d1 >= 0.f ? __builtin_amdgcn_exp2f(d1 * lgf) : __builtin_amdgcn_exp2f(-d1 * lgb));
        }
        v4u pk; pk.x = pkbf(pv[0], pv[1]); pk.y = pkbf(pv[2], pv[3]); pk.z = pkbf(pv[4], pv[5]); pk.w = pkbf(pv[6], pv[7]);
        bp[kp] = __builtin_bit_cast(bf16x8_t, pk);
    }
    f32x4 oi[8], of[8], ob[8];
#pragma unroll
    for (int n = 0; n < 8; ++n) { oi[n] = (f32x4){0.f, 0.f, 0.f, 0.f}; of[n] = oi[n]; ob[n] = oi[n]; }
#pragma unroll
    for (int kp = 0; kp < 4; ++kp) {
        const int r0 = (32 * kp + 4 * g + q4) * RP, r1 = r0 + 16 * RP;
#pragma unroll
        for (int n = 0; n < 8; ++n) { const bf16x8_t av = tr_frag(Vl + r0 + (16 * n + 4 * p4) * 2, Vl + r1 + (16 * n + 4 * p4) * 2); oi[n] = MFMA16(av, bp[kp], oi[n]); }
    }
#pragma unroll
    for (int ks = 0; ks < 4; ++ks)
#pragma unroll
        for (int n = 0; n < 8; ++n) {
            const bf16x8_t af = *(const LAS bf16x8_t*)(Sf + (16 * n + i) * RP + (32 * ks + 8 * g) * 2);
            const bf16x8_t ab = *(const LAS bf16x8_t*)(Sb + (16 * n + i) * RP + (32 * ks + 8 * g) * 2);
            of[n] = MFMA16(af, bq[ks], of[n]); ob[n] = MFMA16(ab, bq[ks], ob[n]);
        }
    const float qdf = __builtin_amdgcn_exp2f((float)(nl + 1) * lgf), qdb = __builtin_amdgcn_exp2f((float)(128 - nl) * lgb);
    float ss = 0.f;
#pragma unroll
    for (int n = 0; n < 8; ++n) { oi[n] = oi[n] + of[n] * qdf + ob[n] * qdb; ss += (oi[n][0] * oi[n][0] + oi[n][1] * oi[n][1]) + (oi[n][2] * oi[n][2] + oi[n][3] * oi[n][3]); }
    ss += shx(ss, lane, 16); ss += shx(ss, lane, 32);
    const float rn = 1.0f / sqrtf(ss * (1.0f / 128.0f) + RMS_EPS);
#pragma unroll
    for (int n = 0; n < 8; ++n) {
        const int dv0 = 16 * n + 4 * g;
        const v2u gg = ggv[n]; const f32x4 gw = *(const f32x4*)(gn + h * 128 + dv0);
        const float g0 = bflo(gg.x), g1 = bfhi(gg.x), g2 = bflo(gg.y), g3 = bfhi(gg.y);
        v2u o; o.x = pkbf(g0 * sigmoidf_(g0) * oi[n][0] * rn * gw[0], g1 * sigmoidf_(g1) * oi[n][1] * rn * gw[1]);
        o.y = pkbf(g2 * sigmoidf_(g2) * oi[n][2] * rn * gw[2], g3 * sigmoidf_(g3) * oi[n][3] * rn * gw[3]);
        *(v2u*)(grow + dv0) = o;
    }
}

constexpr int LO_WL = 0, LO_CST = 36864, LO_XC = 39680, LO_XF = 58688, LO_XB = 93504, LO_GY = 111936, LO_SEG = 130368, LO_HIN = 138560;
__device__ __forceinline__ void lru_stage_consts(const Frame& F, CArgs* A, int l, int blk) {
    const bf16* LW = (const bf16*)(F.ws + WS_LW); const float* SP = (const float*)(F.ws + WS_SP);
    __syncthreads();
#pragma unroll
    for (int q = 0; q < 4; ++q) { const int idx = F.ltid() + 512 * q, m = idx >> 9, row = (idx >> 3) & 63, ch = idx & 7;
        const int d = m >> 1, ax = m & 1;
        *(LAS v4u*)(F.lds + LO_WL + (m * 64 + row) * 144 + ch * 16) = *(const v4u*)(LW + (size_t)((((l * 2 + d) * 2 + ax) * 8 + blk)) * 4096 + row * 64 + ch * 8); }
    LAS float* cst = (LAS float*)(F.lds + LO_CST);
    if (F.ltid() < 128) { const int d = F.ltid() >> 6, j = F.ltid() & 63, pi = (l * 2 + d) * 512 + blk * 64 + j; cst[F.ltid()] = A->in[10][pi]; cst[128 + F.ltid()] = A->in[12][pi]; cst[256 + F.ltid()] = SP[pi]; }
    else if (F.ltid() < 384) { const int e = F.ltid() - 128, tap = e >> 6, j = e & 63; cst[384 + e] = A->in[7][(size_t)l * 2048 + tap * 512 + blk * 64 + j]; }
    else if (F.ltid() < 448) { const int j = F.ltid() - 384; cst[640 + j] = A->in[8][(size_t)l * 512 + blk * 64 + j]; }
}
struct LruPre { v4u xc[3]; v4u gc[2]; float agx[15], agy[15]; };
template <int MODE>
__device__ __forceinline__ void lru_fetch(const Frame& F, int item, LruPre& P) {
    const int b = item >> 7, c = (item >> 3) & 15, blk = item & 7, t0 = b * SEQ + c * 128, s0 = c * 128, tid = F.ltid();
    const bf16* XCg = (const bf16*)(F.ws + WS_PROJ + 8 * BLK); const bf16* GCg = (const bf16*)(F.ws + WS_PROJ + 6 * BLK); const float* AGG = (const float*)(F.ws + WS_AGG);
#pragma unroll
    for (int q = 0; q < 3; ++q) {
        const int idx = tid + 512 * q, row = idx >> 3, ch = idx & 7, s_ = s0 - 2 + row;
        P.xc[q] = (v4u){0u, 0u, 0u, 0u};
        if (idx < 1056 && s_ >= 0 && s_ < SEQ) P.xc[q] = *(const v4u*)(XCg + (size_t)(b * SEQ + s_) * 512 + blk * 64 + ch * 8);
    }
    if (MODE >= 1) {
#pragma unroll
        for (int q = 0; q < 2; ++q) { const int idx = tid + 512 * q, row = idx >> 3, ch = idx & 7; P.gc[q] = *(const v4u*)(GCg + (size_t)(t0 + row) * 512 + blk * 64 + ch * 8); }
        if (MODE == 1 && tid < 128) {
            typedef float f2 __attribute__((ext_vector_type(2)));
            const int d = tid >> 6, ch = blk * 64 + (tid & 63);
#pragma unroll
            for (int k = 0; k < 15; ++k) { const int cc = d ? 15 - k : k; const f2 a = *(const f2*)(AGG + ((size_t)((b * 16 + cc) * 2 + d) * 512 + ch) * 2); P.agx[k] = a.x; P.agy[k] = a.y; }
        }
    }
}
template <int MODE>
__device__ __forceinline__ void lru_item(const Frame& F, int item, const LruPre& P, int l) {
    const int b = item >> 7, c = (item >> 3) & 15, blk = item & 7, t0 = b * SEQ + c * 128;
    bf16* GCg = (bf16*)(F.ws + WS_PROJ + 6 * BLK);
    float* AGG = (float*)(F.ws + WS_AGG);
    LAS unsigned char* WL = F.lds + LO_WL; const LAS float* cst = (const LAS float*)(F.lds + LO_CST);
    LAS unsigned char* XC = F.lds + LO_XC; LAS float* XF = (LAS float*)(F.lds + LO_XF); LAS unsigned char* XB = F.lds + LO_XB; LAS unsigned char* GY = F.lds + LO_GY;
    LAS float* SEG = (LAS float*)(F.lds + LO_SEG); LAS float* HIN = (LAS float*)(F.lds + LO_HIN);
    typedef float f2 __attribute__((ext_vector_type(2)));
    const int tid = F.ltid(), lane = F.lane(), w = F.wave(), g = lane >> 4, i = lane & 15;
    __syncthreads();
#pragma unroll
    for (int q = 0; q < 3; ++q) { const int idx = tid + 512 * q; if (idx < 1056) *(LAS v4u*)(XC + (idx >> 3) * 144 + (idx & 7) * 16) = P.xc[q]; }
    if (MODE >= 1) {
#pragma unroll
        for (int q = 0; q < 2; ++q) { const int idx = tid + 512 * q; *(LAS v4u*)(GY + (idx >> 3) * 144 + (idx & 7) * 16) = P.gc[q]; }
        if (MODE == 1 && tid < 128) {
            const int d = tid >> 6;
            float h = 0.f;
#pragma unroll
            for (int k = 0; k < 15; ++k) { const int cc = d ? 15 - k : k; const bool valid = d ? (cc > c) : (cc < c); h = valid ? P.agx[k] * h + P.agy[k] : h; }
            HIN[tid] = h;
        }
    }
    __syncthreads();
#pragma unroll
    for (int q = 0; q < 2; ++q) {
        const int idx = tid + 512 * q, t = idx >> 3, c8 = idx & 7;
        float xf[8];
        { const f32x4 b0 = *(const LAS f32x4*)(cst + 640 + c8 * 8), b1 = *(const LAS f32x4*)(cst + 640 + c8 * 8 + 4); xf[0] = b0[0]; xf[1] = b0[1]; xf[2] = b0[2]; xf[3] = b0[3]; xf[4] = b1[0]; xf[5] = b1[1]; xf[6] = b1[2]; xf[7] = b1[3]; }
#pragma unroll
        for (int tap = 0; tap < 4; ++tap) {
            const v4u x = *(const LAS v4u*)(XC + (t + tap) * 144 + c8 * 16);
            const f32x4 w0 = *(const LAS f32x4*)(cst + 384 + tap * 64 + c8 * 8), w1 = *(const LAS f32x4*)(cst + 384 + tap * 64 + c8 * 8 + 4);
            xf[0] += w0[0] * bflo(x[0]); xf[1] += w0[1] * bfhi(x[0]); xf[2] += w0[2] * bflo(x[1]); xf[3] += w0[3] * bfhi(x[1]);
            xf[4] += w1[0] * bflo(x[2]); xf[5] += w1[1] * bfhi(x[2]); xf[6] += w1[2] * bflo(x[3]); xf[7] += w1[3] * bfhi(x[3]);
        }
        *(LAS f32x4*)(XF + t * 68 + c8 * 8) = (f32x4){xf[0], xf[1], xf[2], xf[3]}; *(LAS f32x4*)(XF + t * 68 + c8 * 8 + 4) = (f32x4){xf[4], xf[5], xf[6], xf[7]};
        v4u o; o.x = pkbf(xf[0], xf[1]); o.y = pkbf(xf[2], xf[3]); o.z = pkbf(xf[4], xf[5]); o.w = pkbf(xf[6], xf[7]);
        *(LAS v4u*)(XB + t * 144 + c8 * 16) = o;
    }
    __syncthreads();
    float av[2][4][4], bv[2][4][4];
    {
        const bf16x8_t a0 = *(const LAS bf16x8_t*)(XB + (16 * w + i) * 144 + (8 * g) * 2), a1 = *(const LAS bf16x8_t*)(XB + (16 * w + i) * 144 + (32 + 8 * g) * 2);
#pragma unroll
        for (int d = 0; d < 2; ++d) {
#pragma unroll
            for (int jt = 0; jt < 4; ++jt) {
                const LAS unsigned char* wa = WL + ((d * 2 + 0) * 64 + 16 * jt + i) * 144 + (8 * g) * 2; const LAS unsigned char* wx = WL + ((d * 2 + 1) * 64 + 16 * jt + i) * 144 + (8 * g) * 2;
                const f32x4 z = (f32x4){0.f, 0.f, 0.f, 0.f};
                f32x4 ca = MFMA16(a0, *(const LAS bf16x8_t*)wa, z); ca = MFMA16(a1, *(const LAS bf16x8_t*)(wa + 64), ca);
                f32x4 cx = MFMA16(a0, *(const LAS bf16x8_t*)wx, z); cx = MFMA16(a1, *(const LAS bf16x8_t*)(wx + 64), cx);
                const int j = 16 * jt + i;
                const float ba = cst[d * 64 + j], bx = cst[128 + d * 64 + j], sp = cst[256 + d * 64 + j];
#pragma unroll
                for (int r = 0; r < 4; ++r) {
                    const int t = 16 * w + 4 * g + r;
                    const float xfv = XF[t * 68 + j];
                    const float rr = sigmoidf_(ca[r] + ba), ig = sigmoidf_(cx[r] + bx);
                    const float la = -8.0f * rr * sp, a = fexp(la);
                    const float om = fmaxf(__builtin_fmaf(-a, a, 1.0f), 0.0f);
                    float mult = __builtin_amdgcn_sqrtf(om);
                    if (d == 0 ? (c == 0 && t == 0) : (c == 15 && t == 127)) mult = 1.0f;
                    av[d][jt][r] = a; bv[d][jt][r] = mult * ig * xfv;
                }
            }
        }
    }
    float Ae[2][4], Be[2][4];
#pragma unroll
    for (int jt = 0; jt < 4; ++jt) {
        float Af = av[0][jt][0] * av[0][jt][1] * av[0][jt][2] * av[0][jt][3];
        float Bf = ((bv[0][jt][0] * av[0][jt][1] + bv[0][jt][1]) * av[0][jt][2] + bv[0][jt][2]) * av[0][jt][3] + bv[0][jt][3];
        float Ar = av[1][jt][0] * av[1][jt][1] * av[1][jt][2] * av[1][jt][3];
        float Br = ((bv[1][jt][3] * av[1][jt][2] + bv[1][jt][2]) * av[1][jt][1] + bv[1][jt][1]) * av[1][jt][0] + bv[1][jt][0];
#pragma unroll
        for (int st = 16; st <= 32; st <<= 1) {
            const float pAf = lane_get(Af, lane - st), pBf = lane_get(Bf, lane - st), pAr = lane_get(Ar, lane + st), pBr = lane_get(Br, lane + st);
            if (lane >= st) { Bf = Af * pBf + Bf; Af = Af * pAf; }
            if (lane + st < 64) { Br = Ar * pBr + Br; Ar = Ar * pAr; }
        }
        const float eAf = lane_get(Af, lane - 16), eBf = lane_get(Bf, lane - 16), eAr = lane_get(Ar, lane + 16), eBr = lane_get(Br, lane + 16);
        Ae[0][jt] = g > 0 ? eAf : 1.0f; Be[0][jt] = g > 0 ? eBf : 0.0f; Ae[1][jt] = g < 3 ? eAr : 1.0f; Be[1][jt] = g < 3 ? eBr : 0.0f;
        if (g == 3) *(LAS f2*)(SEG + ((0 * 8 + w) * 64 + 16 * jt + i) * 2) = (f2){Af, Bf};
        if (g == 0) *(LAS f2*)(SEG + ((1 * 8 + w) * 64 + 16 * jt + i) * 2) = (f2){Ar, Br};
    }
    __syncthreads();
    if (MODE == 2) {
        if (w < 2) {
            const int d = w, j = lane;
            float h = 0.f, Ap = 1.0f;
#pragma unroll
            for (int k = 0; k < 8; ++k) { const int ww = d ? 7 - k : k; const f2 sg = *(const LAS f2*)(SEG + ((d * 8 + ww) * 64 + j) * 2); h = sg.x * h + sg.y; Ap *= sg.x; }
            typedef GAS unsigned long long gu64;
            gu64* agg = (gu64*)(AGG) + (size_t)((b * 16) * 2 + d) * 512 + blk * 64 + j;
            gu32* flg = (gu32*)(F.ws + WS_CTL) + 8192 + (((l * 8 + b) * 16) * 8 + blk) * 2 + d;
            __hip_atomic_store(agg + (size_t)c * 1024, ((unsigned long long)__builtin_bit_cast(unsigned, h) << 32) | __builtin_bit_cast(unsigned, Ap), RLX_AGENT);
            asm volatile("s_waitcnt vmcnt(0)" ::: "memory");
            if (lane == 0) __hip_atomic_store(flg + c * 16, 1u, RLX_AGENT);
            const int need = d ? 15 - c : c;
            { unsigned spins = 0;
              for (;;) { const int cc = d ? 15 - lane : lane; unsigned v = 1u; if (lane < need) v = __hip_atomic_load(flg + cc * 16, RLX_AGENT);
                  if (__builtin_amdgcn_ballot_w64(v == 0u) == 0ull) break;
                  __builtin_amdgcn_s_sleep(2); if (++spins > (1u << 20)) break; } }
            float hin = 0.f;
#pragma unroll
            for (int k0 = 0; k0 < 16; k0 += 8) {
                unsigned long long gv[8];
#pragma unroll
                for (int k = 0; k < 8; ++k) { const int kk = k0 + k, cc = d ? 15 - kk : kk; gv[k] = (kk < need) ? __hip_atomic_load(agg + (size_t)(cc & 15) * 1024, RLX_AGENT) : 0ull; }
#pragma unroll
                for (int k = 0; k < 8; ++k) { const float a_ = __builtin_bit_cast(float, (unsigned)gv[k]), b_ = __builtin_bit_cast(float, (unsigned)(gv[k] >> 32)); hin = (k0 + k < need) ? a_ * hin + b_ : hin; }
                asm volatile("" : "+v"(hin) :: "memory");
            }
            HIN[d * 64 + j] = hin;
        }
        __syncthreads();
    }
    if (MODE == 0) {
        if (w == 0 && g < 2) {
            const int d = g;
#pragma unroll
            for (int jt = 0; jt < 4; ++jt) {
                const int j = 16 * jt + i; float h = 0.f, Ap = 1.0f;
#pragma unroll
                for (int k = 0; k < 8; ++k) { const int ww = d ? 7 - k : k; const f2 sg = *(const LAS f2*)(SEG + ((d * 8 + ww) * 64 + j) * 2); h = sg.x * h + sg.y; Ap *= sg.x; }
                *(f2*)(AGG + ((size_t)((b * 16 + c) * 2 + d) * 512 + blk * 64 + j) * 2) = (f2){Ap, h};
            }
        }
    } else {
#pragma unroll
        for (int jt = 0; jt < 4; ++jt) {
            const int j = 16 * jt + i;
            float hf = HIN[j], hr = HIN[64 + j];
            f2 sfv[8], srv[8];
#pragma unroll
            for (int k = 0; k < 8; ++k) { sfv[k] = *(const LAS f2*)(SEG + ((0 * 8 + k) * 64 + j) * 2); srv[k] = *(const LAS f2*)(SEG + ((1 * 8 + (7 - k)) * 64 + j) * 2); }
#pragma unroll
            for (int k = 0; k < 8; ++k) {
                const bool uf = k < w, ur = 7 - k > w;
                hf = (uf ? sfv[k].x : 1.0f) * hf + (uf ? sfv[k].y : 0.0f);
                hr = (ur ? srv[k].x : 1.0f) * hr + (ur ? srv[k].y : 0.0f);
            }
            float h = Ae[0][jt] * hf + Be[0][jt];
            float hs[4];
#pragma unroll
            for (int r = 0; r < 4; ++r) { h = av[0][jt][r] * h + bv[0][jt][r]; hs[r] = h; }
            h = Ae[1][jt] * hr + Be[1][jt];
#pragma unroll
            for (int r = 3; r >= 0; --r) { h = av[1][jt][r] * h + bv[1][jt][r]; hs[r] += h; }
#pragma unroll
            for (int r = 0; r < 4; ++r) { LAS bf16* p = (LAS bf16*)(GY + (16 * w + 4 * g + r) * 144) + j; *p = (bf16)f2bf(gelu_tanh(bf2f(*p)) * hs[r]); }
        }
        __syncthreads();
#pragma unroll
        for (int q = 0; q < 2; ++q) { const int idx = tid + 512 * q, row = idx >> 3, ch = idx & 7;
            *(v4u*)(GCg + (size_t)(t0 + row) * 512 + blk * 64 + ch * 8) = *(const LAS v4u*)(GY + row * 144 + ch * 16); }
    }
}
template <int MODE> __device__ __forceinline__ void phase_lru(const Frame& F, CArgs* A, int l) {
    int cur = -1;
    LruPre P0, P1;
    if (F.bid < 1024) lru_fetch<MODE>(F, F.bid, P0);
    for (int it = F.bid; it < 1024; it += 2 * F.G) {
        { const int blk = it & 7; if (blk != cur) { lru_stage_consts(F, A, l, blk); cur = blk; } }
        const int it1 = it + F.G, it2 = it + 2 * F.G;
        if (it1 < 1024) lru_fetch<MODE>(F, it1, P1);
        lru_item<MODE>(F, it, P0, l);
        if (it1 < 1024) {
            { const int blk = it1 & 7; if (blk != cur) { lru_stage_consts(F, A, l, blk); cur = blk; } }
            if (it2 < 1024) lru_fetch<MODE>(F, it2, P0);
            lru_item<MODE>(F, it1, P1, l);
        }
    }
}


struct NaSide { const float* psrc; const float* wup; const float* gup; const float* wdown; bf16* wup_t; bf16* wdown_t;
    int nxt;
    const float* win; const float* gin; const float* wbr; const float* wout; const float* wg; const float* gg; const float* wple;
    int own;
    const float* owbr; const float* owout; const float* owg; const float* ogg; const float* owple; unsigned char* wsb; };
struct Strip { const float* W; const float* g; bf16* WT; int Kd, Nd, sl; bool on; };
__device__ __forceinline__ void strip_load(const Strip& st, int tid, float (&wv)[16]) {
    if (!st.on) return;
    const int nblk = st.Nd / 64, kb = st.sl / nblk, nb = st.sl % nblk, n = nb * 64 + (tid & 63), k0 = kb * 64 + 16 * ((tid >> 6) & 3);
#pragma unroll
    for (int j = 0; j < 16; ++j) wv[j] = st.W[(size_t)(k0 + j) * st.Nd + n];
}
__device__ __forceinline__ void strip_store(const Strip& st, int tid, float (&wv)[16]) {
    if (!st.on) return;
    const int nblk = st.Nd / 64, kb = st.sl / nblk, nb = st.sl % nblk, n = nb * 64 + (tid & 63), k0 = kb * 64 + 16 * ((tid >> 6) & 3);
    if (st.g) {
#pragma unroll
        for (int j = 0; j < 16; ++j) wv[j] *= st.g[k0 + j];
    }
    v4u t0, t1;
    t0.x = pk2(wv[0], wv[1]); t0.y = pk2(wv[2], wv[3]); t0.z = pk2(wv[4], wv[5]); t0.w = pk2(wv[6], wv[7]);
    t1.x = pk2(wv[8], wv[9]); t1.y = pk2(wv[10], wv[11]); t1.z = pk2(wv[12], wv[13]); t1.w = pk2(wv[14], wv[15]);
    *(v4u*)(st.WT + (size_t)n * st.Kd + k0) = t0; *(v4u*)(st.WT + (size_t)n * st.Kd + k0 + 8) = t1;
}
__device__ __forceinline__ void na_group(const Frame& F, const float* rpb, int grp, const NaSide sd) {
    const int b = grp >> 5, h = (grp >> 2) & 7, rg = grp & 3, r0 = rg * 8;
    bf16* Qg = (bf16*)(F.ws + WS_PROJ); const bf16* Kg = (const bf16*)(F.ws + WS_PROJ + BLK); const bf16* Vg = (const bf16*)(F.ws + WS_PROJ + 2 * BLK);
    LAS unsigned char* Kl = F.lds; LAS unsigned char* Vl = F.lds + 512 * 144; LAS float* Bl = (LAS float*)(F.lds + 2 * 512 * 144);
    const int tid = F.ltid();
    int rs = r0 - 4; rs = rs < 0 ? 0 : (rs > 24 ? 24 : rs);
    __syncthreads();
#pragma unroll
    for (int q = 0; q < 8; ++q) {
        const int idx = tid + 512 * q, kidx = idx >> 3, ch = idx & 7, grow = rs + (kidx >> 6), col = kidx & 63;
        const size_t tok = (size_t)b * SEQ + grow * 64 + col; const int lrow = (grow & 7) * 64 + col;
        *(LAS v4u*)(Kl + lrow * 144 + ch * 16) = *(const v4u*)(Kg + tok * 512 + h * 64 + ch * 8);
        *(LAS v4u*)(Vl + lrow * 144 + ch * 16) = *(const v4u*)(Vg + tok * 512 + h * 64 + ch * 8);
    }
    if (tid < 465) Bl[tid] = rpb[h * 465 + tid];
    __syncthreads();
    const int w = F.wave(), lane = F.lane(), g = lane >> 4, i = lane & 15, q4 = i >> 2, p4 = i & 3;
    const int cq = 16 * (w & 3) + i;
    bf16x8_t bq0 = *(const bf16x8_t*)(Qg + ((size_t)b * SEQ + r0 * 64 + cq) * 512 + h * 64 + 8 * g), bq1 = *(const bf16x8_t*)(Qg + ((size_t)b * SEQ + r0 * 64 + cq) * 512 + h * 64 + 32 + 8 * g);
    for (int k = 0; k < 8; ++k) {
        const int r = r0 + k;
        const int rq = k < 7 ? r + 1 : r;
        const bf16x8_t nq0 = *(const bf16x8_t*)(Qg + ((size_t)b * SEQ + rq * 64 + cq) * 512 + h * 64 + 8 * g), nq1 = *(const bf16x8_t*)(Qg + ((size_t)b * SEQ + rq * 64 + cq) * 512 + h * 64 + 32 + 8 * g);
        int rsn = r + 1 - 4; rsn = rsn < 0 ? 0 : (rsn > 24 ? 24 : rsn);
        const bool slide = (k < 7) && (rsn != rs);
        v4u pk = (v4u){0u, 0u, 0u, 0u}, pv = pk;
        if (slide) { const size_t tok = (size_t)b * SEQ + (rsn + 7) * 64 + (tid >> 3);
            pk = *(const v4u*)(Kg + tok * 512 + h * 64 + (tid & 7) * 8); pv = *(const v4u*)(Vg + tok * 512 + h * 64 + (tid & 7) * 8); }
        if (w < 4) {
            const int c = 16 * w + i, cb = w == 0 ? 0 : (w == 1 ? 8 : (w == 2 ? 24 : 32));
            int cst = c - 8; cst = cst < 0 ? 0 : (cst > 48 ? 48 : cst);
            const size_t tq = (size_t)b * SEQ + r * 64 + c;
            float sc[16][4];
            float mx = -1e30f;
            int boff[2][4]; float vmask[2][4];
#pragma unroll
            for (int half = 0; half < 2; ++half)
#pragma unroll
                for (int e = 0; e < 4; ++e) { const int kc = cb + 16 * half + 4 * g + e; const bool valid = (kc >= cst) && (kc < cst + 16);
                    int dc = kc - c + 15; dc = dc < 0 ? 0 : (dc > 30 ? 30 : dc); boff[half][e] = dc; vmask[half][e] = valid ? 0.f : -1e30f; }
#pragma unroll
            for (int t = 0; t < 16; ++t) {
                const int wi = t >> 1, half = t & 1, slot = (rs + wi) & 7;
                const LAS unsigned char* kp = Kl + (slot * 64 + cb + 16 * half + i) * 144 + (8 * g) * 2;
                const bf16x8_t a0 = *(const LAS bf16x8_t*)kp, a1 = *(const LAS bf16x8_t*)(kp + 64);
                f32x4 s_ = (f32x4){0.f, 0.f, 0.f, 0.f};
                s_ = MFMA16(a0, bq0, s_); s_ = MFMA16(a1, bq1, s_);
                const int brow = (rs + wi - r + 7) * 31;
#pragma unroll
                for (int e = 0; e < 4; ++e) {
                    const float bias = Bl[brow + boff[half][e]];
                    const float v = fminf(s_[e] + bias, 1e30f) + vmask[half][e];
                    sc[t][e] = v; mx = fmaxf(mx, v);
                }
            }
            mx = fmaxf(mx, shx(mx, lane, 16)); mx = fmaxf(mx, shx(mx, lane, 32));
            float sum = 0.f;
            bf16x8_t bp[8];
#pragma unroll
            for (int wi = 0; wi < 8; ++wi) {
                float p[8];
#pragma unroll
                for (int e = 0; e < 4; ++e) { p[e] = fexp(sc[2 * wi][e] - mx); p[4 + e] = fexp(sc[2 * wi + 1][e] - mx); sum += p[e] + p[4 + e]; }
                v4u pw; pw.x = pkbf(p[0], p[1]); pw.y = pkbf(p[2], p[3]); pw.z = pkbf(p[4], p[5]); pw.w = pkbf(p[6], p[7]);
                bp[wi] = __builtin_bit_cast(bf16x8_t, pw);
            }
            sum += shx(sum, lane, 16); sum += shx(sum, lane, 32);
            f32x4 o[4];
#pragma unroll
            for (int dt = 0; dt < 4; ++dt) o[dt] = (f32x4){0.f, 0.f, 0.f, 0.f};
#pragma unroll
            for (int wi = 0; wi < 8; ++wi) {
                const int slot = (rs + wi) & 7;
                const LAS unsigned char* vp = Vl + (slot * 64 + cb + 4 * g + q4) * 144 + (4 * p4) * 2;
#pragma unroll
                for (int dt = 0; dt < 4; ++dt) { const bf16x8_t av = tr_frag(vp + 32 * dt, vp + 16 * 144 + 32 * dt); o[dt] = MFMA16(av, bp[wi], o[dt]); }
            }
            const float inv = 1.0f / sum;
#pragma unroll
            for (int dt = 0; dt < 4; ++dt) { v2u ov; ov.x = pkbf(o[dt][0] * inv, o[dt][1] * inv); ov.y = pkbf(o[dt][2] * inv, o[dt][3] * inv);
                *(v2u*)(Qg + tq * 512 + h * 64 + 16 * dt + 4 * g) = ov; }
        }
        else {
            const int e = (grp * 8 + k) * 512 + (tid - 256) * 2;
            const f32x4 v0 = ((const f32x4*)sd.psrc)[e], v1 = ((const f32x4*)sd.psrc)[e + 1];
            v4u o; o.x = pk2(v0.x, v0.y); o.y = pk2(v0.z, v0.w); o.z = pk2(v1.x, v1.y); o.w = pk2(v1.z, v1.w);
            ((v4u*)((unsigned char*)F.out + DO_PB))[e >> 1] = o;
            const int sid = grp * 8 + k;
            unsigned char* dob = (unsigned char*)F.out;
            Strip s0, s1, s2;
            if (sid < 1024) s0 = Strip{sd.wup, sd.gup, sd.wup_t, D, FF, sid, true}; else s0 = Strip{sd.wdown, nullptr, sd.wdown_t, FF, D, sid - 1024, true};
            s1 = Strip{sd.win, sd.gin, (bf16*)(dob + DO_WIN), D, 7680, sid, sd.nxt != 0 && sid < 1920};
            if (sid < 384) s2 = Strip{sd.wbr + (size_t)(sid / 128) * 512 * D, nullptr, (bf16*)(dob + DO_MID) + (size_t)(sid / 128) * D * 512, 512, D, sid % 128, sd.nxt != 0};
            else if (sid < 640) s2 = Strip{sd.wout, nullptr, (bf16*)(dob + DO_MID + 3 * MiB), D, D, sid - 384, sd.nxt != 0};
            else if (sid < 896) s2 = Strip{sd.wg, sd.gg, (bf16*)(dob + DO_MID + 5 * MiB), D, D, sid - 640, sd.nxt != 0};
            else s2 = Strip{sd.wple, nullptr, (bf16*)(dob + DO_MID + 7 * MiB), PLE, D, sid - 896, sd.nxt != 0 && sid < 960};
            Strip s3;
            if (sid < 384) s3 = Strip{sd.owbr + (size_t)(sid / 128) * 512 * D, nullptr, (bf16*)(sd.wsb + W_BR) + (size_t)(sid / 128) * D * 512, 512, D, sid % 128, sd.own != 0};
            else if (sid < 640) s3 = Strip{sd.owout, nullptr, (bf16*)(sd.wsb + W_OUT), D, D, sid - 384, sd.own != 0};
            else if (sid < 896) s3 = Strip{sd.owg, sd.ogg, (bf16*)(sd.wsb + W_G(0)), D, D, sid - 640, sd.own != 0};
            else s3 = Strip{sd.owple, nullptr, (bf16*)(sd.wsb + W_PLE(0)), PLE, D, sid - 896, sd.own != 0 && sid < 960};
            float w0[16], w1[16], w2[16], w3[16];
            strip_load(s0, tid, w0); strip_load(s1, tid, w1); strip_load(s2, tid, w2); strip_load(s3, tid, w3);
            strip_store(s0, tid, w0); strip_store(s1, tid, w1); strip_store(s2, tid, w2); strip_store(s3, tid, w3);
        }
        __syncthreads();
        if (slide) { const int lrow = ((rsn + 7) & 7) * 64 + (tid >> 3);
            *(LAS v4u*)(Kl + lrow * 144 + (tid & 7) * 16) = pk; *(LAS v4u*)(Vl + lrow * 144 + (tid & 7) * 16) = pv; }
        __syncthreads();
        rs = rsn; bq0 = nq0; bq1 = nq1;
    }
}
__device__ __forceinline__ void phase_na(const Frame& F, CArgs* A, int l) { const float* rpb = A->in[5] + (size_t)l * 8 * 465; const int ln = l + 1 < DEPTH ? l + 1 : l;
    const NaSide sd{A->in[1] + (size_t)l * T * PLE, A->in[17] + (size_t)l * D * FF, A->in[16] + (size_t)l * D, A->in[18] + (size_t)l * FF * D, (bf16*)(F.ws + W_UP), (bf16*)(F.ws + W_DOWN),
                    l + 1 < DEPTH ? 1 : 0, A->in[3] + (size_t)ln * D * 7680, A->in[2] + (size_t)ln * D, A->in[14] + (size_t)ln * 3 * 512 * D, A->in[15] + (size_t)ln * D * D, A->in[20] + (size_t)ln * D * D, A->in[19] + (size_t)ln * D, A->in[21] + (size_t)ln * PLE * D,
                    l == 0 ? 1 : 0, A->in[14], A->in[15], A->in[20], A->in[19], A->in[21], F.ws};
    for (int it = F.bid; it < 256; it += F.G) na_group(F, rpb, it, sd); }

__device__ __forceinline__ void phase_ret_state(const Frame& F) { for (int it = F.bid; it < 256; it += F.G) ret_scan_item(F, it); }
__device__ __forceinline__ void phase_ret_out(const Frame& F, CArgs* A, int l) { const float* gn = A->in[6] + (size_t)l * 512; for (int it = F.bid; it < 512; it += F.G) ret_out_item(F, gn, it); }

__device__ __forceinline__ void phase_final(const Frame& F, CArgs* A) {
    const float* g = A->in[22]; const bf16* xb = (const bf16*)(F.ws + WS_XB); const float* ss = (const float*)(F.ws + WS_SSB);
    const int lane = F.lane();
    f32x4 gv[4];
#pragma unroll
    for (int j = 0; j < 4; ++j) gv[j] = ((const f32x4*)g + lane)[64 * j];
    for (int m0 = F.gw() * 4; m0 < T; m0 += F.ngw * 4) {
        v2u w[4][4]; float sp[4];
#pragma unroll
        for (int r = 0; r < 4; ++r) {
            sp[r] = lane < 16 ? ss[(size_t)(m0 + r) * 16 + lane] : 0.f;
#pragma unroll
            for (int j = 0; j < 4; ++j) w[r][j] = ((const v2u*)(xb + (size_t)(m0 + r) * D) + lane)[64 * j];
        }
#pragma unroll
        for (int r = 0; r < 4; ++r) {
            float t = sp[r]; t += shx(t, lane, 1); t += shx(t, lane, 2); t += shx(t, lane, 4); t += shx(t, lane, 8);
            const float rs = 1.0f / sqrtf(lane_get(t, 0) * (1.0f / D) + RMS_EPS);
            f32x4* orow = (f32x4*)(F.out + (size_t)(m0 + r) * D) + lane;
#pragma unroll
            for (int j = 0; j < 4; ++j) orow[64 * j] = (f32x4){bflo(w[r][j].x), bfhi(w[r][j].x), bflo(w[r][j].y), bfhi(w[r][j].y)} * rs * gv[j];
        }
    }
}

__global__ void __launch_bounds__(NWAVES * 64, 2) mk_fwd(Args args) {
    extern __shared__ __attribute__((aligned(16))) unsigned char lds[];
    const int tid0 = threadIdx.x;
    const int wave0 = __builtin_amdgcn_readfirstlane(tid0 >> 6);
    LAS unsigned char* const lds3 = (LAS unsigned char*)lds;
    CArgs* A0 = get_args();
    const int ph_lo = A0->ph_lo, ph_hi = A0->ph_hi;
    for (int u = tid0; u < (LDS_BYTES - LDSCTL_OFF) / 4; u += NWAVES * 64) ((LAS unsigned*)(lds3 + LDSCTL_OFF))[u] = 0u;
    __syncthreads();
    const bool multi = (ph_hi - ph_lo) > 1;
    XcdBarrier bar; bar.bar = (unsigned*)((gu32*)(A0->ws + WS_CTL) + CW_BAR); bar.x = 0; bar.st = nullptr;
    if (multi) bar = xcd_barrier_post((unsigned*)((gu32*)(A0->ws + WS_CTL) + CW_BAR), (volatile LAS unsigned*)(lds3 + MISC_OFF) + 8);

    unsigned long long probe_acc = 0, pt0 = 0;
#define PMARK(k) do { if (PROBE_WN != 0ull) { __syncthreads(); const unsigned long long t_ = __builtin_amdgcn_s_memrealtime(); probe_acc += ((PROBE_WN >> (4 * (k))) & 15ull) * (t_ - pt0); pt0 = t_; } } while (0)
    for (int ph = ph_lo; ph < ph_hi; ++ph) {
        CArgs* A = get_args();
#define MAKE_FRAME(Fx) Frame Fx; Fx.wave0 = wave0; \
        Fx.lds = lds3; \
        { int b_ = blockIdx.x; asm volatile("" : "+s"(b_)); Fx.bid = b_; } \
        Fx.G = gridDim.x; Fx.ngw = Fx.G * NWAVES; Fx.out = A->out; Fx.ws = A->ws
        MAKE_FRAME(F);
        unsigned char* ws = F.ws;
        if (PROBE_WN != 0ull) pt0 = __builtin_amdgcn_s_memrealtime();
        int kind, l;
        if (ph == 0) { kind = PH_PRO; l = 0; } else if (ph == NPH - 1) { kind = PH_FIN; l = 0; } else { l = (ph - 1) / NPL; kind = 1 + (ph - 1) % NPL; }
        float* ssA = (float*)(ws + WS_SSA); float* ssB = (float*)(ws + WS_SSB);
        switch (kind) {
        case PH_PRO: phase_prologue(F, A); break;
        case PH_G1: {
            pg8::Gemm g{(const bf16_t*)(ws + WS_XB), (const bf16_t*)(l == 0 ? ws + W_IN : (unsigned char*)F.out + DO_WIN), T, 7680, D, 0, 0};
            pg8::StaticOrder S; S.init(T, 7680, F.G, F.bid);
            stage_epilogue_tables(F, ssB, S, A->in[4] + (size_t)l * 3072);
            EpiG1 E{(bf16_t*)(ws + WS_PROJ), ws + WS_GATE8, F.lds, (const float*)(ws + WS_TAB)};
            pg8::gemm_phase<EpiG1, pg8::StaticOrder, true, true>(F.lds, g, S, E, F.ltid());
        } break;
        case PH_MIXA: phase_na(F, A, l); PMARK(10); phase_ret_state(F); PMARK(11); PMARK(12); break;
        case PH_MIXB: phase_ret_out(F, A, l); PMARK(14); phase_lru<2>(F, A, l); PMARK(15); break;
        case PH_G2: {
            pg8::Gemm g{(const bf16_t*)(ws + WS_PROJ), (const bf16_t*)(l == 0 ? ws + W_BR : (unsigned char*)F.out + DO_MID), T, D, 512, 3 * BLK, (size_t)D * 512 * 2};
            ZOrder S; S.S.init(T, D, F.G, F.bid);
            EpiG2 E{ws + WS_GATE8, (bf16_t*)(ws + WS_MERGED)};
            pg8::gemm_phase<EpiG2, ZOrder, true, true>(F.lds, g, S, E, F.ltid());
        } break;
        case PH_G3: case PH_G5: {
            const bool g3 = (kind == PH_G3);
            pg8::Gemm g{(const bf16_t*)(ws + (g3 ? WS_MERGED : WS_U)), (const bf16_t*)(g3 ? (l == 0 ? ws + W_OUT : (unsigned char*)F.out + DO_MID + 3 * MiB) : ws + W_DOWN), T, D, g3 ? D : FF, 0, 0};
            pg8::StaticOrder S; S.init(T, D, F.G, F.bid);
            EpiRes E{(g3 && l == 0) ? A->in[0] : nullptr, (const bf16_t*)(ws + (g3 ? WS_XB : WS_GATE8)), (bf16_t*)(ws + WS_GATE8), g3 ? ssB : ssA};
            pg8::gemm_phase<EpiRes, pg8::StaticOrder, false, true>(F.lds, g, S, E, F.ltid());
        } break;
        case PH_G4: {
            pg8::Gemm g{(const bf16_t*)(ws + WS_GATE8), (const bf16_t*)(ws + W_UP), T, FF, D, 0, 0};
            pg8::StaticOrder S; S.init(T, FF, F.G, F.bid);
            stage_epilogue_tables(F, ssB, S, nullptr);
            EpiG4 E{(bf16_t*)(ws + WS_U), F.lds};
            pg8::gemm_phase<EpiG4, pg8::StaticOrder, true, true>(F.lds, g, S, E, F.ltid());
        } break;
        case PH_G6: {
            {
                pg8::Gemm g{(const bf16_t*)((unsigned char*)F.out + DO_PB), (const bf16_t*)(l == 0 ? ws + W_PLE(0) : (unsigned char*)F.out + DO_MID + 7 * MiB), T, D, PLE, 0, 0};
                pg8::StaticOrder S; S.init(T, D, F.G, F.bid);
                EpiE E{(bf16_t*)(ws + WS_E)};
                pg8::gemm_phase<EpiE, pg8::StaticOrder, false, true>(F.lds, g, S, E, F.ltid());
            }
            {
                pg8::Gemm g{(const bf16_t*)(ws + WS_GATE8), (const bf16_t*)(l == 0 ? ws + W_G(0) : (unsigned char*)F.out + DO_MID + 5 * MiB), T, D, D, 0, 0};
                pg8::StaticOrder S; S.init(T, D, F.G, F.bid);
                stage_epilogue_tables(F, ssA, S, nullptr);
                EpiG6 E{(const bf16_t*)(ws + WS_GATE8), (bf16_t*)(ws + WS_XB), F.lds, ssB, (const bf16_t*)(ws + WS_E)};
                pg8::gemm_phase<EpiG6, pg8::StaticOrder, false, true>(F.lds, g, S, E, F.ltid());
            }
        } break;
        case PH_FIN: phase_final(F, A); break;
        default: break;
        }
        if (ph + 1 < ph_hi) xcd_barrier(bar, F.ltid());
        PMARK(kind);
    }
    if (PROBE_WN != 0ull && blockIdx.x == 0) { const unsigned long long te = __builtin_amdgcn_s_memrealtime(); while (__builtin_amdgcn_s_memrealtime() - te < probe_acc) __builtin_amdgcn_s_sleep(32); }
}


#if MK_CHECK
constexpr int CW_CODE = 64, CW_CNT = 128;
__device__ __forceinline__ unsigned hash32(unsigned x) { x ^= x >> 16; x *= 0x7feb352du; x ^= x >> 15; x *= 0x846ca68bu; x ^= x >> 16; return x; }
__device__ __forceinline__ bool near(float a, float b, float rel, float abs_) { return fabsf(a - b) <= rel * fabsf(b) + abs_; }
__device__ float rs_of_x(const float* x, int row) { float s = 0.f; for (int k = 0; k < D; ++k) s += x[(size_t)row * D + k] * x[(size_t)row * D + k]; return 1.0f / sqrtf(s / D + RMS_EPS); }
__global__ void __launch_bounds__(256) mk_check(Args a, int stage) {
    const unsigned id = blockIdx.x * blockDim.x + threadIdx.x;
    const unsigned h = hash32(id * 2654435761u + 12345u * stage);
    unsigned char* ws = a.ws; unsigned* ctl = (unsigned*)(ws + WS_CTL);
    const int row = (int)(h % T);
    bool bad = false;
    const float* x = a.in[0];
    if (stage == 1) {
        const int col = (int)((h >> 14) % D);
        const bf16* xb = (const bf16*)(ws + WS_XB);
        bad |= !near(bf2f(xb[(size_t)row * D + col]), x[(size_t)row * D + col], 0.01f, 1e-3f);
        float s = 0.f; for (int k = 0; k < D; ++k) s += x[(size_t)row * D + k] * x[(size_t)row * D + k];
        const float* ss = (const float*)(ws + WS_SSB); float t = 0.f; for (int k = 0; k < 16; ++k) t += ss[(size_t)row * 16 + k];
        bad |= !near(t, s, 1e-3f, 1e-3f);
        const int n = (int)((h >> 7) % 7680), k = (int)(h % D);
        const bf16* wt = (const bf16*)(ws + W_IN);
        bad |= !near(bf2f(wt[(size_t)n * D + k]), a.in[2][k] * a.in[3][(size_t)k * 7680 + n], 0.01f, 1e-4f);
        const int pos = (int)(h % SEQ), i = (int)((h >> 11) % 64);
        const float th = powf(10000.0f, -(float)i / 63.0f), ang = (float)pos * th;
        const float* tab = (const float*)(ws + WS_TAB);
        bad |= !near(tab[pos * 64 + i], cosf(ang), 0.f, 2e-3f); bad |= !near(tab[131072 + pos * 64 + i], sinf(ang), 0.f, 2e-3f);
    } else if (stage == 2) {
        const int col = (int)((h >> 14) % 7680) & ~1;
        const float rs = rs_of_x(x, row);
        float v0 = 0.f, v1 = 0.f;
        for (int k = 0; k < D; ++k) { const float xv = x[(size_t)row * D + k] * a.in[2][k]; v0 += xv * a.in[3][(size_t)k * 7680 + col]; v1 += xv * a.in[3][(size_t)k * 7680 + col + 1]; }
        v0 *= rs; v1 *= rs;
        if (col < 4608) {
            const int kind = col / 512, cc = col % 512, phys = (int)((0x683754210ull >> (4 * kind)) & 15ull);
            if (kind == 3 || kind == 4) { const int i = (cc & 127) >> 1, pos = row & 2047; const float th = powf(10000.0f, -(float)i / 63.0f), ang = (float)pos * th, c = cosf(ang), sn = sinf(ang);
                const float w0 = v0 * c - v1 * sn, w1 = v0 * sn + v1 * c; v0 = w0; v1 = w1; }
            if (kind == 0) { v0 *= 0.125f; v1 *= 0.125f; } if (kind == 3) { v0 *= 0.08838834764831845f; v1 *= 0.08838834764831845f; }
            const bf16* p = (const bf16*)(ws + WS_PROJ) + (size_t)phys * T * 512 + (size_t)row * 512 + cc;
            bad |= !near(bf2f(p[0]), v0, 0.03f, 0.03f); bad |= !near(bf2f(p[1]), v1, 0.03f, 0.03f);
        } else {
            const int gc = col - 4608; const unsigned char* g8 = ws + WS_GATE8 + (size_t)row * 3072 + gc;
            const float s0 = 1.0f / (1.0f + expf(-(v0 + a.in[4][gc]))), s1 = 1.0f / (1.0f + expf(-(v1 + a.in[4][gc + 1])));
            bad |= !near((float)g8[0] / 255.0f, s0, 0.f, 0.012f); bad |= !near((float)g8[1] / 255.0f, s1, 0.f, 0.012f);
        }
    } else if (stage == 4) {
        const int col = (int)((h >> 14) % D);
        float m = 0.f;
        for (int n = 0; n < 3; ++n) { const bf16* ys = (const bf16*)(ws + WS_PROJ) + (size_t)(3 * n) * T * 512 + (size_t)row * 512; float acc = 0.f;
            for (int k = 0; k < 512; ++k) acc += bf2f(ys[k]) * a.in[14][((size_t)n * 512 + k) * D + col];
            m += acc * (float)ws[WS_GATE8 + (size_t)row * 3072 + n * 1024 + col] / 255.0f; }
        bad |= !near(bf2f(((const bf16*)(ws + WS_MERGED))[(size_t)row * D + col]), m, 0.03f, 0.03f);
    } else if (stage == 5 && false) {
        const int col = (int)((h >> 14) % D);
        const bf16* mg = (const bf16*)(ws + WS_XB) + (size_t)row * D; float acc = 0.f;
        for (int k = 0; k < D; ++k) acc += bf2f(mg[k]) * a.in[15][(size_t)k * D + col];
        const float x1 = x[(size_t)row * D + col] + acc;
        bad |= !near(a.out[(size_t)row * D + col], x1, 0.02f, 0.03f);
        bad |= !near(bf2f(((const bf16*)(ws + WS_GATE8))[(size_t)row * D + col]), a.out[(size_t)row * D + col], 0.01f, 1e-3f);
        float s = 0.f; for (int k = 0; k < D; ++k) s += a.out[(size_t)row * D + k] * a.out[(size_t)row * D + k];
        const float* ss = (const float*)(ws + WS_SSB); float t = 0.f; for (int k = 0; k < 16; ++k) t += ss[(size_t)row * 16 + k];
        bad |= !near(t, s, 1e-3f, 1e-3f);
    } else if (stage == 6 && false) {
        const int col = (int)((h >> 14) % FF);
        const bf16* xb = (const bf16*)(ws + WS_GATE8) + (size_t)row * D; float acc = 0.f;
        for (int k = 0; k < D; ++k) acc += bf2f(xb[k]) * a.in[16][k] * a.in[17][(size_t)k * FF + col];
        const float rs = rs_of_x(a.out, row); float v = fmaxf(acc * rs, 0.f); v *= v;
        bad |= !near(bf2f(((const bf16*)(ws + WS_U))[(size_t)row * FF + col]), v, 0.05f, 0.05f);
    } else if (stage == 7 && false) {
        const int col = (int)((h >> 14) % D);
        const bf16* uu = (const bf16*)(ws + WS_U) + (size_t)row * FF; float acc = 0.f;
        for (int k = 0; k < FF; ++k) acc += bf2f(uu[k]) * a.in[18][(size_t)k * D + col];
        const float x2 = bf2f(((const bf16*)(ws + WS_XB))[(size_t)row * D + col]) + acc;
        bad |= !near(a.out[(size_t)row * D + col], x2, 0.03f, 0.05f);
        bad |= !near(bf2f(((const bf16*)(ws + WS_GATE8))[(size_t)row * D + col]), a.out[(size_t)row * D + col], 0.01f, 1e-3f);
        float s = 0.f; for (int k = 0; k < D; ++k) s += a.out[(size_t)row * D + k] * a.out[(size_t)row * D + k];
        const float* ss = (const float*)(ws + WS_SSA); float t = 0.f; for (int k = 0; k < 16; ++k) t += ss[(size_t)row * 16 + k];
        bad |= !near(t, s, 1e-3f, 1e-3f);
    } else if (stage == 8 && false) {
        const int col = (int)((h >> 14) % D);
        const bf16* xb = (const bf16*)(ws + WS_GATE8) + (size_t)row * D; float acc = 0.f, s = 0.f;
        for (int k = 0; k < D; ++k) { const float xv = bf2f(xb[k]); s += xv * xv; acc += xv * a.in[19][k] * a.in[20][(size_t)k * D + col]; }
        const float rs = 1.0f / sqrtf(s / D + RMS_EPS);
        float e = 0.f; for (int k = 0; k < PLE; ++k) e += a.in[1][(size_t)row * PLE + k] * a.in[21][(size_t)k * D + col];
        const float x3 = bf2f(xb[col]) + e / (1.0f + expf(-acc * rs));
        bad |= !near(a.out[(size_t)row * D + col], x3, 0.03f, 0.05f);
    }
    if (stage == 9) bad = true;
    if (bad) atomicAdd(&ctl[CW_CNT + stage], 1u);
}
__device__ float orig_proj(const Args& a, int l, int row, int col) {
    const float* x = l == 0 ? a.in[0] : a.out; const float* g = a.in[2] + (size_t)l * D; const float* w = a.in[3] + (size_t)l * D * 7680;
    float s = 0.f, acc = 0.f;
    for (int k = 0; k < D; ++k) { const float xv = x[(size_t)row * D + k]; s += xv * xv; acc += xv * g[k] * w[(size_t)k * 7680 + col]; }
    return acc / sqrtf(s / D + RMS_EPS);
}
__global__ void __launch_bounds__(64) mk_check_na(Args a, int l) {
    __shared__ float qs[64]; __shared__ float sc[128];
    const unsigned h = hash32(blockIdx.x * 977u + 31u); const int t = (int)(h % T), hd = (int)((h >> 16) % 8), d = threadIdx.x;
    unsigned char* ws = a.ws; unsigned* ctl = (unsigned*)(ws + WS_CTL);
    const bf16* K = (const bf16*)(ws + WS_PROJ + BLK); const bf16* V = (const bf16*)(ws + WS_PROJ + 2 * BLK); const bf16* Y = (const bf16*)(ws + WS_PROJ);
    qs[d] = bf2f((bf16)f2bf(0.125f * orig_proj(a, l, t, hd * 64 + d)));
    __syncthreads();
    const int b = t / SEQ, s = t % SEQ, r = s / 64, c = s % 64;
    int rs = r - 4; if (rs < 0) rs = 0; if (rs > 24) rs = 24; int cs = c - 8; if (cs < 0) cs = 0; if (cs > 48) cs = 48;
    const float* rpb = a.in[5] + (size_t)l * 8 * 15 * 31 + hd * 465;
    for (int kk = d; kk < 128; kk += 64) { const int i = kk / 16, j = kk % 16; const int tk = b * SEQ + (rs + i) * 64 + cs + j; float acc = 0.f;
        for (int e = 0; e < 64; ++e) acc += qs[e] * bf2f(K[(size_t)tk * 512 + hd * 64 + e]);
        sc[kk] = acc + rpb[(rs + i - r + 7) * 31 + (cs + j - c + 15)]; }
    __syncthreads();
    float mx = -1e30f; for (int kk = 0; kk < 128; ++kk) mx = fmaxf(mx, sc[kk]);
    float den = 0.f, o = 0.f;
    for (int kk = 0; kk < 128; ++kk) { const int i = kk / 16, j = kk % 16; const int tk = b * SEQ + (rs + i) * 64 + cs + j; const float p = expf(sc[kk] - mx); den += p; o += p * bf2f(V[(size_t)tk * 512 + hd * 64 + d]); }
    o /= den;
    if (!near(bf2f(Y[(size_t)t * 512 + hd * 64 + d]), o, 0.04f, 0.04f)) atomicAdd(&ctl[CW_CNT + 31], 1u);
}
__global__ void __launch_bounds__(128) mk_check_ret(Args a, int l) {
    __shared__ float qs[128]; __shared__ float sc[SEQ]; __shared__ float red[128];
    const unsigned h = hash32(blockIdx.x * 1231u + 77u); const int t = (int)(h % T), hd = (int)((h >> 16) % 4), dv = threadIdx.x;
    unsigned char* ws = a.ws; unsigned* ctl = (unsigned*)(ws + WS_CTL);
    const bf16* Y = (const bf16*)(ws + WS_PROJ + 3 * BLK); const bf16* Q = (const bf16*)(ws + WS_PROJ + 4 * BLK); const bf16* K = (const bf16*)(ws + WS_PROJ + 5 * BLK); const bf16* V = (const bf16*)(ws + WS_PROJ + 7 * BLK);
    const int b = t / SEQ, n = t % SEQ;
    qs[dv] = bf2f(Q[(size_t)t * 512 + hd * 128 + dv]);
    __syncthreads();
    const float gf = log2_1m(__builtin_amdgcn_exp2f(-5.0f - (float)hd)), gb = log2_1m(__builtin_amdgcn_exp2f(-5.5f - (float)hd));
    for (int m = dv; m < SEQ; m += 128) { float acc = 0.f; for (int e = 0; e < 128; ++e) acc += qs[e] * bf2f(K[(size_t)(b * SEQ + m) * 512 + hd * 128 + e]);
        sc[m] = acc * (m <= n ? __builtin_amdgcn_exp2f(gf * (float)(n - m)) : __builtin_amdgcn_exp2f(gb * (float)(m - n))); }
    __syncthreads();
    float o = 0.f; for (int m = 0; m < SEQ; ++m) o += sc[m] * bf2f(V[(size_t)(b * SEQ + m) * 512 + hd * 128 + dv]);
    red[dv] = o * o; __syncthreads();
    float ms = 0.f; for (int e = 0; e < 128; ++e) ms += red[e];
    const float rn = 1.0f / sqrtf(ms / 128.0f + RMS_EPS);
    const float g = bf2f((bf16)f2bf(orig_proj(a, l, t, 1536 + 3 * 512 + hd * 128 + dv)));
    const float y = g / (1.0f + expf(-g)) * o * rn * a.in[6][(size_t)l * 512 + hd * 128 + dv];
    if (!near(bf2f(Y[(size_t)t * 512 + hd * 128 + dv]), y, 0.04f, 0.04f)) atomicAdd(&ctl[CW_CNT + 32], 1u);
}
__global__ void __launch_bounds__(128) mk_check_g(Args a, int l, int code) {
    const unsigned h = hash32(blockIdx.x * 1231u + 77u); const int t = (int)(h % T), hd = (int)((h >> 16) % 4), dv = threadIdx.x;
    unsigned* ctl = (unsigned*)(a.ws + WS_CTL);
    const bf16* G = (const bf16*)(a.ws + WS_PROJ + 3 * BLK);
    const float g = orig_proj(a, l, t, 1536 + 3 * 512 + hd * 128 + dv);
    if (!near(bf2f(G[(size_t)t * 512 + hd * 128 + dv]), g, 0.03f, 0.03f)) atomicAdd(&ctl[CW_CNT + code], 1u);
}
__global__ void __launch_bounds__(64) mk_check_lru(Args a, int l) {
    __shared__ float xs[64];
    const unsigned h = hash32(blockIdx.x * 733u + 5u); const int b = (int)(h % 8), blk = (int)((h >> 8) % 8), ts = (int)((h >> 16) % SEQ), j = threadIdx.x, ch = blk * 64 + j;
    unsigned char* ws = a.ws; unsigned* ctl = (unsigned*)(ws + WS_CTL);
    const bf16* XC = (const bf16*)(ws + WS_PROJ + 8 * BLK); const bf16* Y = (const bf16*)(ws + WS_PROJ + 6 * BLK);
    const float* cw = a.in[7] + (size_t)l * 2048; const float cb = a.in[8][(size_t)l * 512 + ch];
    float hsum = 0.f;
    for (int dir = 0; dir < 2; ++dir) {
        const float* wa = a.in[9] + (((size_t)l * 2 + dir) * 8 + blk) * 4096; const float* wx = a.in[11] + (((size_t)l * 2 + dir) * 8 + blk) * 4096;
        const float ba = a.in[10][((size_t)l * 2 + dir) * 512 + ch], bx = a.in[12][((size_t)l * 2 + dir) * 512 + ch], lam = a.in[13][((size_t)l * 2 + dir) * 512 + ch];
        const float sp = log1pf(expf(-lam));
        float hh = 0.f;
        const int nsteps = dir == 0 ? ts + 1 : SEQ - ts;
        for (int st = 0; st < nsteps; ++st) {
            const int t = dir == 0 ? st : SEQ - 1 - st;
            float xf = cb;
            for (int w = 0; w < 4; ++w) { const int t2 = t + w - 2; if (t2 >= 0 && t2 < SEQ) xf += cw[w * 512 + ch] * bf2f(XC[(size_t)(b * SEQ + t2) * 512 + ch]); }
            __syncthreads(); xs[j] = xf; __syncthreads();
            float ra = ba, ia = bx;
            for (int i = 0; i < 64; ++i) { ra += xs[i] * wa[i * 64 + j]; ia += xs[i] * wx[i * 64 + j]; }
            const float r = 1.0f / (1.0f + expf(-ra)), ig = 1.0f / (1.0f + expf(-ia));
            const float la = -8.0f * r * sp, av = expf(la); float mult = sqrtf(-expm1f(2.0f * la)); if (st == 0) mult = 1.0f;
            hh = av * hh + mult * ig * xf;
        }
        hsum += hh;
    }
    const float gc = bf2f((bf16)f2bf(orig_proj(a, l, b * SEQ + ts, 3584 + 512 + ch)));
    const float u = 0.7978845608028654f * (gc + 0.044715f * gc * gc * gc);
    const float y = 0.5f * gc * (1.0f + tanhf(u)) * hsum;
    if (!near(bf2f(Y[(size_t)(b * SEQ + ts) * 512 + ch]), y, 0.04f, 0.04f)) atomicAdd(&ctl[CW_CNT + 33], 1u);
}
__global__ void mk_report(Args a) {
    unsigned* ctl = (unsigned*)(a.ws + WS_CTL);
    const int order[13] = {1, 2, 35, 31, 34, 32, 33, 4, 5, 6, 7, 8, 9};
    const unsigned tot[13] = {16384u, 16384u, 16384u, 32768u, 16384u, 16384u, 8192u, 16384u, 16384u, 16384u, 16384u, 16384u, 64u};
    for (int i = 0; i < 13; ++i) {
        const unsigned cnt = ctl[CW_CNT + order[i]];
        if (cnt * 200u > tot[i]) {
            unsigned tenth = (cnt * 10u) / tot[i]; if (tenth > 9u) tenth = 9u;
            a.out[0] = order[i] >= 10 ? 100.0f * (float)order[i] : 1000.0f * (float)order[i] + 100.0f * (float)tenth;
            return;
        }
    }
}
#endif

#ifndef MK_ONE_LAUNCH
#define MK_ONE_LAUNCH 1
#endif
extern "C" void kernel_launch(void* const* d_in, const int* in_sizes, int n_in, void* d_out, int out_size, void* d_ws, size_t ws_size, hipStream_t stream) {
    static int grid = 0;
    if (grid == 0) {
        if (n_in != 23 || in_sizes[0] != T * D || out_size != T * D || ws_size < WS_END) { fprintf(stderr, "kernel_launch: unexpected shapes (n_in %d, in0 %d, out %d, ws %zu); nothing launched\n", n_in, n_in > 0 ? in_sizes[0] : -1, out_size, ws_size); grid = -1; return; }
        int dev = 0, cus = 0, per_cu = 0;
        if (hipGetDevice(&dev) != hipSuccess || hipDeviceGetAttribute(&cus, hipDeviceAttributeMultiprocessorCount, dev) != hipSuccess) { grid = -1; return; }
        if (hipFuncSetAttribute((const void*)mk_fwd, hipFuncAttributeMaxDynamicSharedMemorySize, LDS_BYTES) != hipSuccess) { fprintf(stderr, "kernel_launch: hipFuncSetAttribute failed\n"); grid = -1; return; }
        if (hipOccupancyMaxActiveBlocksPerMultiprocessor(&per_cu, (const void*)mk_fwd, NWAVES * 64, LDS_BYTES) != hipSuccess || per_cu < 1) { fprintf(stderr, "kernel_launch: occupancy query says %d blocks per CU\n", per_cu); }
        (void)hipGetLastError();
        grid = cus > 256 ? 256 : cus;
    }
    if (grid < 0) return;
    if (hipMemsetAsync((char*)d_ws + WS_CTL, 0, CTL_ZERO_BYTES, stream) != hipSuccess) return;
    Args a{};
    for (int i = 0; i < 23; ++i) a.in[i] = (const float*)d_in[i];
    a.out = (float*)d_out; a.ws = (unsigned char*)d_ws;
#if MK_ONE_LAUNCH
    a.ph_lo = 0; a.ph_hi = NPH;
    hipLaunchKernelGGL(mk_fwd, dim3(grid), dim3(NWAVES * 64), LDS_BYTES, stream, a);
#else
    for (int ph = 0; ph < NPH; ++ph) {
#if MK_CHECK
        if (ph == 1 + 6) (void)hipMemcpyAsync((char*)d_ws + WS_XB, (char*)d_ws + WS_GATE8, (size_t)T * D * 2, hipMemcpyDeviceToDevice, stream);
#endif
        a.ph_lo = ph; a.ph_hi = ph + 1; hipLaunchKernelGGL(mk_fwd, dim3(grid), dim3(NWAVES * 64), LDS_BYTES, stream, a);
#if MK_CHECK
        { int st = 0; if (ph == 0) st = 1; else if (ph == 1) st = 2; else if (ph == 1 + 3) st = 4; else if (ph == 1 + 4) st = 5; else if (ph == 1 + 5) st = 6; else if (ph == 1 + 6) st = 7; else if (ph == 1 + 7) st = 8;
          if (st) hipLaunchKernelGGL(mk_check, dim3(64), dim3(256), 0, stream, a, st);
          if (ph == 1 + 1) hipLaunchKernelGGL(mk_check_na, dim3(512), dim3(64), 0, stream, a, 0);
          if (ph == 1) hipLaunchKernelGGL(mk_check_g, dim3(128), dim3(128), 0, stream, a, 0, 35);
          if (ph == 1 + 1) hipLaunchKernelGGL(mk_check_g, dim3(128), dim3(128), 0, stream, a, 0, 34);
          if (ph == 1 + 2) hipLaunchKernelGGL(mk_check_ret, dim3(128), dim3(128), 0, stream, a, 0);
          if (ph == 1 + 2) hipLaunchKernelGGL(mk_check_lru, dim3(128), dim3(64), 0, stream, a, 0);
          if (ph == NPH - 1) hipLaunchKernelGGL(mk_check, dim3(1), dim3(64), 0, stream, a, 9); }
#endif
    }
#if MK_CHECK
    hipLaunchKernelGGL(mk_report, dim3(1), dim3(1), 0, stream, a);
#endif
#endif
}
```

```cpp
#include <hip/hip_runtime.h>
#include <cstdio>
#include <cstdint>
#ifndef MK_CHECK
#define MK_CHECK 0
#endif
#ifndef PROBE_EPI
#define PROBE_EPI 0
#endif
#ifndef PROBE_WN
#define PROBE_WN 0x0ull
#endif
namespace pg8 {
#define PG8_LAS __attribute__((address_space(3)))
typedef unsigned short bf16_t;
typedef short bf16x8 __attribute__((ext_vector_type(8)));
typedef float f32x4 __attribute__((ext_vector_type(4)));
typedef unsigned u32x4 __attribute__((ext_vector_type(4)));
constexpr int BM = 256, BK = 64, HALF = 128, HTB = HALF * BK * 2  , STAGE_BYTES = 8 * HTB, NXCD = 8, WGM = 8;

__host__ __device__ __forceinline__ int lds_byte(int r, int c) { const int st = (r >> 4) * 2 + (c >> 5), rr = r & 15, cc = c & 31, ob = rr * 64 + cc * 2; return st * 1024 + (ob ^ (((ob >> 9) & 1) << 5)); }
__host__ __device__ __forceinline__ void stage_rc(int b, int& R, int& C) { const int st = b / 1024, sb = b % 1024, swz = sb ^ (((sb >> 9) & 1) << 5); R = (st >> 1) * 16 + swz / 64; C = (st & 1) * 32 + (swz % 64) / 2; }
__host__ __device__ __forceinline__ int perm32(int rho) { const int n = rho >> 4, i = rho & 15; return 8 * (i >> 2) + 4 * n + (i & 3); }

struct Unit { int pm, pn, z; };
struct Gemm { const bf16_t* A; const bf16_t* Bt; int M, N, K; size_t zA, zB; };

struct StaticOrder {
    int nM, nN, nwg, G, c;
    __host__ __device__ void init(int M, int N, int G_, int c_) { nM = M / BM; nN = N / BM; nwg = nM * nN; G = G_; c = c_; }
    __host__ __device__ bool next(int i, Unit& u) const {
        const long L = (long)i * G + c; if (L >= nwg) return false;
        int wgid = (int)L; { const int q = nwg / NXCD, r = nwg % NXCD, xcd = wgid % NXCD, off = wgid / NXCD; wgid = (xcd < r ? xcd * (q + 1) : r * (q + 1) + (xcd - r) * q) + off; }
        const int nig = WGM * nN, gid = wgid / nig, fm = gid * WGM, gsz = (nM - fm) < WGM ? (nM - fm) : WGM;
        u.pm = fm + ((wgid % nig) % gsz); u.pn = (wgid % nig) / gsz; u.z = 0; return true;
    }
    __device__ __forceinline__ void a_ready(const Unit&) const {}
    __device__ __forceinline__ void done(const Unit&) const {}
};

__device__ __forceinline__ unsigned cvt_pk_bf16(float lo, float hi) { unsigned r; asm volatile("v_cvt_pk_bf16_f32 %0, %1, %2" : "=v"(r) : "v"(lo), "v"(hi)); return r; }
typedef float f32x2 __attribute__((ext_vector_type(2)));
template <class Epi, class Sched, bool ALIGN_EPI = false, bool SP2 = false>
__device__ __forceinline__ void gemm_phase(PG8_LAS unsigned char* lds, const Gemm g, const Sched& S, const Epi& E, const int tid, unsigned long long* epi_ticks = nullptr) {
    const int wid = __builtin_amdgcn_readfirstlane(tid >> 6), lane = tid & 63, wr = wid >> 2, wc = wid & 3, fr = lane & 15, fq = lane >> 4;
    const int K = g.K, nt = K / BK;
    unsigned voffA[2], voffB[2];
#pragma unroll
    for (int i = 0; i < 2; ++i) { int R, C; stage_rc(tid * 16 + i * 8192, R, C); const int Rb = Epi::PERM ? ((R & ~31) + perm32(R & 31)) : R;
        voffA[i] = (unsigned)(R * K + C) * 2u; voffB[i] = (unsigned)(Rb * K + C) * 2u; }
    const size_t kstep = (size_t)(BK * 2);
    const size_t hstep = (size_t)HALF * K * 2;
    const size_t tstep = 2 * hstep;
    const unsigned ldsw = (unsigned)wid * 1024u;
    const int aoff = lds_byte(wr * 64 + fr, fq * 8), boff = lds_byte(wc * 32 + fr, fq * 8);
#define PG8_SA(b, h) (((b) * 2 + (h)) * HTB)
#define PG8_SB(b, h) ((4 + (b) * 2 + (h)) * HTB)
#define PG8_STAGE(bufoff, gbase, voff) do { _Pragma("unroll") for (int _i = 0; _i < 2; ++_i) \
        __builtin_amdgcn_global_load_lds((const unsigned*)((const char*)(gbase) + (voff)[_i]), (PG8_LAS unsigned*)(lds + (bufoff) + ldsw + _i * 8192), 16, 0, 0); } while (0)
#define PG8_LDA(dst, b, h) do { _Pragma("unroll") for (int m = 0; m < 4; ++m) _Pragma("unroll") for (int k = 0; k < 2; ++k) dst[m][k] = *(const PG8_LAS bf16x8*)(lds + PG8_SA(b, h) + aoff + m * 2048 + k * 1024); } while (0)
#define PG8_LDB(dst, b, h) do { _Pragma("unroll") for (int n = 0; n < 2; ++n) _Pragma("unroll") for (int k = 0; k < 2; ++k) dst[n][k] = *(const PG8_LAS bf16x8*)(lds + PG8_SB(b, h) + boff + n * 2048 + k * 1024); } while (0)
#define PG8_MMA(ai, bj, At, Bt) do { __builtin_amdgcn_s_setprio(1); _Pragma("unroll") for (int m = 0; m < 4; ++m) _Pragma("unroll") for (int n = 0; n < 2; ++n) _Pragma("unroll") for (int k = 0; k < 2; ++k) \
        acc[ai][bj][m][n] = __builtin_amdgcn_mfma_f32_16x16x32_bf16(Bt[n][k], At[m][k], acc[ai][bj][m][n], 0, 0, 0); __builtin_amdgcn_s_setprio(0); } while (0)
#define PG8_WAIT_V(n) asm volatile("s_waitcnt vmcnt(" #n ")" ::: "memory")
#define PG8_WAIT_L(n) asm volatile("s_waitcnt lgkmcnt(" #n ")" ::: "memory")
#define PG8_BAR __builtin_amdgcn_s_barrier()
#define PG8_SCHED __builtin_amdgcn_sched_barrier(0)
    Unit cur, nxt; int ui = 0;
    if (!S.next(0, cur)) return;
    f32x4 acc[2][2][4][2];
#pragma unroll
    for (int a = 0; a < 2; ++a)
#pragma unroll
        for (int b = 0; b < 2; ++b)
#pragma unroll
            for (int m = 0; m < 4; ++m)
#pragma unroll
                for (int n = 0; n < 2; ++n) acc[a][b][m][n] = (f32x4){0.f, 0.f, 0.f, 0.f};
    bf16x8 At[4][2], B0[2][2], B1[2][2];
    const char* cA = (const char*)g.A + (size_t)cur.z * g.zA + (size_t)cur.pm * tstep; const char* cB = (const char*)g.Bt + (size_t)cur.z * g.zB + (size_t)cur.pn * tstep;
    S.a_ready(cur);
    if constexpr (SP2) {
        PG8_STAGE(PG8_SB(0, 0), cB, voffB); PG8_STAGE(PG8_SB(0, 1), cB + hstep, voffB); PG8_STAGE(PG8_SA(0, 0), cA, voffA); PG8_STAGE(PG8_SA(0, 1), cA + hstep, voffA);
        if (wr == 1) PG8_BAR;
        PG8_WAIT_V(2); PG8_BAR;
        PG8_STAGE(PG8_SB(1, 0), cB + kstep, voffB); PG8_STAGE(PG8_SA(1, 0), cA + kstep, voffA); PG8_STAGE(PG8_SB(1, 1), cB + hstep + kstep, voffB);
        PG8_WAIT_V(6); PG8_BAR;
    } else {
        PG8_STAGE(PG8_SB(0, 0), cB, voffB); PG8_STAGE(PG8_SA(0, 0), cA, voffA); PG8_STAGE(PG8_SB(0, 1), cB + hstep, voffB); PG8_STAGE(PG8_SA(0, 1), cA + hstep, voffA);
        if (wr == 1) PG8_BAR;
        PG8_WAIT_V(4); PG8_BAR;
        PG8_STAGE(PG8_SB(1, 0), cB + kstep, voffB); PG8_STAGE(PG8_SA(1, 0), cA + kstep, voffA); PG8_STAGE(PG8_SB(1, 1), cB + hstep + kstep, voffB);
        PG8_WAIT_V(6); PG8_BAR;
    }
    for (;;) {
        const bool has_next = S.next(ui + 1, nxt);
        const char* nA = has_next ? (const char*)g.A + (size_t)nxt.z * g.zA + (size_t)nxt.pm * tstep : cA; const char* nB = has_next ? (const char*)g.Bt + (size_t)nxt.z * g.zB + (size_t)nxt.pn * tstep : cB;
        for (int t = 0; t < nt; t += 2) {
            const bool last = (t == nt - 2);
            const char* a1 = cA + (size_t)(t + 1) * kstep;
            const char* a2 = last ? nA : cA + (size_t)(t + 2) * kstep; const char* b2 = last ? nB : cB + (size_t)(t + 2) * kstep;
            const char* a3 = a2 + kstep; const char* b3 = b2 + kstep;
            if (last && has_next) S.a_ready(nxt);
            if constexpr (SP2) {
            PG8_LDB(B0, 0, 0); PG8_LDB(B1, 0, 1); PG8_SCHED; PG8_LDA(At, 0, 0); PG8_STAGE(PG8_SA(1, 1), a1 + hstep, voffA);
            PG8_WAIT_V(8); PG8_WAIT_L(0); PG8_BAR; PG8_MMA(0, 0, At, B0); PG8_MMA(0, 1, At, B1); PG8_BAR; PG8_SCHED;
            PG8_LDA(At, 0, 1); PG8_STAGE(PG8_SB(0, 0), b2, voffB); PG8_STAGE(PG8_SB(0, 1), b2 + hstep, voffB); PG8_STAGE(PG8_SA(0, 0), a2, voffA);
            PG8_WAIT_V(8); PG8_WAIT_L(0); PG8_BAR; PG8_MMA(1, 0, At, B0); PG8_MMA(1, 1, At, B1); PG8_BAR; PG8_SCHED;
            PG8_LDB(B0, 1, 0); PG8_LDB(B1, 1, 1); PG8_SCHED; PG8_LDA(At, 1, 0); PG8_STAGE(PG8_SA(0, 1), a2 + hstep, voffA);
            PG8_WAIT_V(8); PG8_WAIT_L(0); PG8_BAR; PG8_MMA(0, 0, At, B0); PG8_MMA(0, 1, At, B1); PG8_BAR; PG8_SCHED;
            PG8_LDA(At, 1, 1); PG8_STAGE(PG8_SB(1, 0), b3, voffB); PG8_STAGE(PG8_SB(1, 1), b3 + hstep, voffB); PG8_STAGE(PG8_SA(1, 0), a3, voffA);
            PG8_WAIT_V(8); PG8_WAIT_L(0); PG8_BAR; PG8_MMA(1, 0, At, B0); PG8_MMA(1, 1, At, B1); PG8_BAR; PG8_SCHED;
            } else {
            PG8_LDB(B0, 0, 0); PG8_SCHED; PG8_LDA(At, 0, 0); PG8_STAGE(PG8_SA(1, 1), a1 + hstep, voffA);
            PG8_WAIT_L(8); PG8_BAR; PG8_WAIT_L(0); PG8_MMA(0, 0, At, B0); PG8_BAR; PG8_SCHED;
            PG8_LDB(B1, 0, 1); PG8_STAGE(PG8_SB(0, 0), b2, voffB);
            PG8_BAR; PG8_WAIT_L(0); PG8_MMA(0, 1, At, B1); PG8_BAR;
            PG8_LDA(At, 0, 1); PG8_STAGE(PG8_SA(0, 0), a2, voffA);
            PG8_BAR; PG8_WAIT_L(0); PG8_MMA(1, 0, At, B0); PG8_BAR; PG8_SCHED;
            PG8_STAGE(PG8_SB(0, 1), b2 + hstep, voffB);
            PG8_WAIT_V(6); PG8_BAR; PG8_MMA(1, 1, At, B1); PG8_BAR;
            PG8_LDB(B0, 1, 0); PG8_SCHED; PG8_LDA(At, 1, 0); PG8_STAGE(PG8_SA(0, 1), a2 + hstep, voffA);
            PG8_WAIT_L(8); PG8_BAR; PG8_WAIT_L(0); PG8_MMA(0, 0, At, B0); PG8_BAR; PG8_SCHED;
            PG8_LDB(B1, 1, 1); PG8_STAGE(PG8_SB(1, 0), b3, voffB);
            PG8_BAR; PG8_WAIT_L(0); PG8_MMA(0, 1, At, B1); PG8_BAR;
            PG8_LDA(At, 1, 1); PG8_STAGE(PG8_SA(1, 0), a3, voffA);
            PG8_BAR; PG8_WAIT_L(0); PG8_MMA(1, 0, At, B0); PG8_BAR; PG8_SCHED;
            PG8_STAGE(PG8_SB(1, 1), b3 + hstep, voffB);
            PG8_WAIT_V(6); PG8_BAR; PG8_MMA(1, 1, At, B1); PG8_BAR;
            }
        }
        if constexpr (ALIGN_EPI) { if (wr == 0) PG8_BAR; }
        if constexpr (!Epi::AFTER_DRAIN) { unsigned long long t0_ = 0; if (epi_ticks) { t0_ = __builtin_amdgcn_s_memrealtime(); } E(acc, cur, wr, wc, fr, fq); S.done(cur); if (epi_ticks) { asm volatile("s_waitcnt vmcnt(0)" ::: "memory"); *epi_ticks += __builtin_amdgcn_s_memrealtime() - t0_; } }
        if (!has_next) break;
        if constexpr (!Epi::KEEP_ACC)
#pragma unroll
        for (int a = 0; a < 2; ++a)
#pragma unroll
            for (int b = 0; b < 2; ++b)
#pragma unroll
                for (int m = 0; m < 4; ++m)
#pragma unroll
                    for (int n = 0; n < 2; ++n) acc[a][b][m][n] = (f32x4){0.f, 0.f, 0.f, 0.f};
        cur = nxt; cA = nA; cB = nB; ++ui;
        if constexpr (ALIGN_EPI) { if (wr == 1) PG8_BAR; }
    }
    PG8_WAIT_V(0);
    if constexpr (!ALIGN_EPI) { if (wr == 0) PG8_BAR; }
    PG8_BAR;
    if constexpr (Epi::AFTER_DRAIN) { E.fused(acc, cur, wr, wc, fr, fq, lds, wid, lane); S.done(cur); }
#undef PG8_SA
#undef PG8_SB
#undef PG8_STAGE
#undef PG8_LDA
#undef PG8_LDB
#undef PG8_MMA
#undef PG8_WAIT_V
#undef PG8_WAIT_L
#undef PG8_BAR
#undef PG8_SCHED
}
}

constexpr int T = 16384, D = 1024, SEQ = 2048, DEPTH = 2, FF = 4096, PLE = 256;
constexpr float RMS_EPS = 1e-6f;
constexpr size_t MiB = 1u << 20;
constexpr size_t WS_CTL = 0, CTL_ZERO_BYTES = 65536;
constexpr size_t WS_TAB = 1 * MiB;
constexpr size_t WS_SSA = 2 * MiB, WS_SSB = 3 * MiB;
constexpr size_t WS_PROJ = 6 * MiB, BLK = 16 * MiB;
constexpr size_t WS_GATE8 = 150 * MiB;
constexpr size_t WS_XB = 198 * MiB;
constexpr size_t WS_W = 230 * MiB, WS_END = 256 * MiB;
constexpr size_t W_IN = WS_W, W_UP = WS_W, W_DOWN = WS_W + 8 * MiB, W_BR = WS_W + 16 * MiB, W_OUT = WS_W + 19 * MiB;
__host__ __device__ constexpr size_t W_G(int slot) { return WS_W + 21 * MiB + (size_t)slot * (5 * MiB / 2); }
__host__ __device__ constexpr size_t W_PLE(int slot) { return W_G(slot) + 2 * MiB; }
constexpr size_t WS_U = WS_PROJ;
constexpr size_t WS_E = WS_PROJ;
constexpr size_t DO_WIN = 32 * MiB, DO_MID = 56 * MiB;
constexpr size_t DO_PB = 48 * MiB;
constexpr size_t WS_HF = WS_PROJ + 1 * BLK;
constexpr size_t WS_AGG = 4 * MiB;
constexpr size_t WS_LW = 5 * MiB;
constexpr size_t WS_SP = 5 * MiB + 512 * 1024;
constexpr size_t WS_MERGED = WS_PROJ + 1 * BLK;
constexpr size_t WS_ST = WS_XB;
constexpr int CW_TMO = 0, CW_BAR = 4096;

enum { PH_PRO = 0, PH_G1, PH_MIXA, PH_MIXB, PH_G2, PH_G3, PH_G4, PH_G5, PH_G6, PH_FIN };
constexpr int NPL = 8, NPH = 1 + DEPTH * NPL + 1;

constexpr int NWAVES = 8;
constexpr int RING_BYTES = 131072, LDS_BYTES = 155648, LDSCTL_OFF = LDS_BYTES - 1024, MISC_OFF = LDSCTL_OFF + 320;

#define GAS __attribute__((address_space(1)))
#define LAS __attribute__((address_space(3)))
typedef unsigned short bf16;
typedef unsigned v4u __attribute__((ext_vector_type(4)));
typedef unsigned v2u __attribute__((ext_vector_type(2)));
typedef float f32x4 __attribute__((ext_vector_type(4)));
typedef GAS unsigned gu32;
#define RLX_AGENT __ATOMIC_RELAXED, __HIP_MEMORY_SCOPE_AGENT
#define LDS_WAIT() asm volatile("s_waitcnt lgkmcnt(0)" ::: "memory")
#define VM_WAIT() asm volatile("s_waitcnt vmcnt(0)" ::: "memory")
__device__ __forceinline__ unsigned f2bf(float f) { unsigned u = __builtin_bit_cast(unsigned, f); return (u + 0x7fffu + ((u >> 16) & 1u)) >> 16; }
__device__ __forceinline__ unsigned pk2(float lo, float hi) { return f2bf(lo) | (f2bf(hi) << 16); }
__device__ __forceinline__ float bf2f(unsigned short b) { return __builtin_bit_cast(float, (unsigned)b << 16); }
__device__ __forceinline__ float bflo(unsigned w) { return __builtin_bit_cast(float, w << 16); }
__device__ __forceinline__ float bfhi(unsigned w) { return __builtin_bit_cast(float, w & 0xffff0000u); }
__device__ __forceinline__ float rdlane(float v, int l) { return __builtin_bit_cast(float, __builtin_amdgcn_readlane(__builtin_bit_cast(int, v), l)); }
__device__ __forceinline__ float fexp(float x) { return __builtin_amdgcn_exp2f(x * 1.4426950408889634f); }
__device__ __forceinline__ float sigmoidf_(float x) { return __builtin_amdgcn_rcpf(1.0f + fexp(-x)); }
__device__ __forceinline__ float lane_get(float v, int srclane) { return __builtin_bit_cast(float, __builtin_amdgcn_ds_bpermute(srclane << 2, __builtin_bit_cast(int, v))); }
__device__ __forceinline__ float shx(float v, int lane, int o) { return lane_get(v, lane ^ o); }
__device__ __forceinline__ float wave_sum(float v, int lane) {
#pragma unroll
    for (int o = 1; o < 64; o <<= 1) v += shx(v, lane, o);
    return v;
}
__device__ __forceinline__ float wave_max(float v, int lane) {
#pragma unroll
    for (int o = 1; o < 64; o <<= 1) v = fmaxf(v, shx(v, lane, o));
    return v;
}
__device__ __forceinline__ float log2_1m(float x) {
    const float p = x * (1.0f + x * (0.5f + x * (0.33333333f + x * (0.25f + x * (0.2f + x * (0.16666667f + x * 0.14285714f))))));
    return -p * 1.4426950408889634f;
}
__device__ __forceinline__ float log1p_small(float y) {
    if (y < 0.01f) return y * (1.0f - y * (0.5f - y * (0.33333333f - 0.25f * y)));
    return __builtin_amdgcn_logf(1.0f + y) * 0.6931471805599453f;
}
__device__ __forceinline__ float gelu_tanh(float x) {
    const float u = 0.7978845608028654f * (x + 0.044715f * x * x * x);
    const float t = 1.0f - 2.0f * __builtin_amdgcn_rcpf(1.0f + fexp(2.0f * u));
    return 0.5f * x * (1.0f + t);
}
__device__ __forceinline__ float row_rs(const float* ss, int row, int fq, int lane) {
    const f32x4 a = *(const f32x4*)(ss + (size_t)row * 16 + 4 * fq);
    float s = (a.x + a.y) + (a.z + a.w);
    s += shx(s, lane, 16); s += shx(s, lane, 32);
    return 1.0f / sqrtf(s * (1.0f / D) + RMS_EPS);
}

#define XB_TMO      128
#define XB_XCNT(j)  (256  + 64 * (j))
#define XB_XSUB(j)  (1280 + 64 * (j))
#define XB_XGEN(j)  (2304 + 64 * (j))
#define XB_TOP      3328
#define XB_TOPGEN   3392
#define XCD_BAR_WORDS 3456
#define XB_SPIN_CAP (1u << 18)

__device__ __forceinline__ unsigned xb_ld(unsigned* p)              { return __hip_atomic_load(p, __ATOMIC_RELAXED, __HIP_MEMORY_SCOPE_AGENT); }
__device__ __forceinline__ unsigned xb_add(unsigned* p, unsigned v) { return __hip_atomic_fetch_add(p, v, __ATOMIC_RELAXED, __HIP_MEMORY_SCOPE_AGENT); }
__device__ __forceinline__ unsigned xb_xcc_id() { return (unsigned)__builtin_amdgcn_s_getreg((3 << 11) | 20) & 0xFu; }
#define XB_SPIN(cond, bar) do { unsigned _sp = 0; while (cond) { __builtin_amdgcn_s_sleep(1); \
    if ((++_sp & 255u) == 0u) { if (xb_ld(&(bar)[XB_TMO])) break; if (_sp > XB_SPIN_CAP) { atomicAdd(&(bar)[XB_TMO], 1u); break; } } } } while (0)

struct XcdBarrier {
    unsigned* bar; unsigned x;
    volatile LAS unsigned* st;
};

__device__ __forceinline__ XcdBarrier xcd_barrier_post(unsigned* bar, volatile LAS unsigned* st) {
    XcdBarrier b; b.bar = bar; b.x = xb_xcc_id(); b.st = st;
    if (threadIdx.x == 0) (void)xb_add(&bar[XB_XCNT(b.x)], 1u);
    return b;
}
__device__ __forceinline__ void xcd_barrier_complete(unsigned* bar, unsigned x, unsigned& nloc, unsigned& nx) {
    const unsigned G = gridDim.x * gridDim.y * gridDim.z;
    unsigned sum, cnt, mine, sp = 0u;
    for (;;) {
        sum = 0u; cnt = 0u; mine = 0u;
#pragma unroll
        for (unsigned j = 0; j < 16; ++j) { const unsigned c = xb_ld(&bar[XB_XCNT(j)]); sum += c; cnt += (c > 0u) ? 1u : 0u; mine = (j == x) ? c : mine; }
        if (sum == G) break;
        __builtin_amdgcn_s_sleep(1);
        if ((++sp & 255u) == 0u) { if (xb_ld(&bar[XB_TMO])) break; if (sp > XB_SPIN_CAP) { atomicAdd(&bar[XB_TMO], 1u); break; } }
    }
    nloc = mine > 0u ? mine : 1u; nx = cnt > 0u ? cnt : 1u;
}

__device__ __forceinline__ void xcd_barrier(const XcdBarrier& b, const int tid_) {
    asm volatile("s_waitcnt vmcnt(0)" ::: "memory");
    __syncthreads();
    if (tid_ == 0) {
        unsigned* bar = b.bar;
        __builtin_amdgcn_s_waitcnt(0);
        unsigned nloc = b.st[0], nx = b.st[1];
        if (nloc == 0u) { xcd_barrier_complete(bar, b.x, nloc, nx); b.st[0] = nloc; b.st[1] = nx; }
        const unsigned old = xb_add(&bar[XB_XSUB(b.x)], 1u);
        const unsigned gen = old / nloc;
        if (old + 1u == (gen + 1u) * nloc) {
            __builtin_amdgcn_fence(__ATOMIC_RELEASE, "agent");
            asm volatile("s_waitcnt vmcnt(0)" ::: "memory");
            const unsigned og = xb_add(&bar[XB_TOP], 1u);
            const unsigned tg = og / nx;
            if (og + 1u == (tg + 1u) * nx) xb_add(&bar[XB_TOPGEN], 1u);
            else XB_SPIN(xb_ld(&bar[XB_TOPGEN]) == tg, bar);
            __builtin_amdgcn_fence(__ATOMIC_ACQUIRE, "agent");
            xb_add(&bar[XB_XGEN(b.x)], 1u);
            asm volatile("s_waitcnt vmcnt(0)" ::: "memory");
        } else {
            XB_SPIN(xb_ld(&bar[XB_XGEN(b.x)]) == gen, bar);
            __builtin_amdgcn_fence(__ATOMIC_ACQUIRE, "agent");
            asm volatile("s_waitcnt vmcnt(0)" ::: "memory");
        }
    }
    __syncthreads();
}


constexpr int LO_RSL = 131072, LO_RSPM = LO_RSL + 8 * 256 * 4, LO_BGL = LO_RSPM + 64;
__device__ __forceinline__ float rs_lookup(const LAS unsigned char* lds, int pm, int rowl) {
    const LAS int* spm = (const LAS int*)(lds + LO_RSPM); int sl = 0;
#pragma unroll
    for (int i = 1; i < 8; ++i) sl = spm[i] == pm ? i : sl;
    return ((const LAS float*)(lds + LO_RSL))[sl * 256 + rowl];
}
using pg8::Unit; using pg8::bf16_t; using pg8::cvt_pk_bf16;
typedef pg8::u32x4 u32x4;
struct EpiG1 {
    static constexpr bool PERM = true, AFTER_DRAIN = false, KEEP_ACC = false;
    bf16_t* proj; unsigned char* gate8; const LAS unsigned char* lds; const float* tab;
    __device__ __forceinline__ void operator()(const f32x4 (&acc)[2][2][4][2], const Unit& u, int wr, int wc, int fr, int fq) const {
        const int pn = u.pn;
        const int kind = pn >> 1, col0 = (pn & 1) * 256 + wc * 32 + 8 * fq;
        const bool rope = (pn < 18) && ((kind == 3) || (kind == 4));
        f32x4 cs[4][2], sn[4][2];
        if (rope) {
#pragma unroll
            for (int m = 0; m < 4; ++m)
#pragma unroll
                for (int bj = 0; bj < 2; ++bj) { const int row = u.pm * 256 + wr * 64 + m * 16 + fr, i0 = ((col0 + bj * 128) & 127) >> 1, pos = row & (SEQ - 1);
                    cs[m][bj] = *(const f32x4*)(tab + pos * 64 + i0); sn[m][bj] = *(const f32x4*)(tab + 131072 + pos * 64 + i0); }
        }
        float rsv[2][4];
#pragma unroll
        for (int ai = 0; ai < 2; ++ai)
#pragma unroll
            for (int m = 0; m < 4; ++m) rsv[ai][m] = rs_lookup(lds, u.pm, ai * 128 + wr * 64 + m * 16 + fr);
        if (pn < 18) {
            const int phys = (int)((0x683754210ull >> (4 * kind)) & 15ull);
            bf16_t* base = proj + (size_t)phys * ((size_t)T * 512);
            const float scale = kind == 0 ? 0.125f : (kind == 3 ? 0.08838834764831845f : 1.0f);
#pragma unroll
            for (int ai = 0; ai < 2; ++ai) {
                if (rope && ai == 1) {
#pragma unroll
                    for (int m = 0; m < 4; ++m)
#pragma unroll
                        for (int bj = 0; bj < 2; ++bj) { const int row = u.pm * 256 + ai * 128 + wr * 64 + m * 16 + fr, i0 = ((col0 + bj * 128) & 127) >> 1, pos = row & (SEQ - 1);
                            cs[m][bj] = *(const f32x4*)(tab + pos * 64 + i0); sn[m][bj] = *(const f32x4*)(tab + 131072 + pos * 64 + i0); }
                }
#pragma unroll
                for (int m = 0; m < 4; ++m) {
                    const int row = u.pm * 256 + ai * 128 + wr * 64 + m * 16 + fr;
                    const float rs = rsv[ai][m] * scale;
                    bf16_t* rowp = base + (size_t)row * 512 + col0;
#pragma unroll
                    for (int bj = 0; bj < 2; ++bj) {
                        f32x4 v0 = acc[ai][bj][m][0] * rs, v1 = acc[ai][bj][m][1] * rs;
                        if (rope) {
                            const f32x4 c_ = cs[m][bj], s_ = sn[m][bj];
                            f32x4 w0, w1;
                            w0[0] = v0[0] * c_[0] - v0[1] * s_[0]; w0[1] = v0[0] * s_[0] + v0[1] * c_[0];
                            w0[2] = v0[2] * c_[1] - v0[3] * s_[1]; w0[3] = v0[2] * s_[1] + v0[3] * c_[1];
                            w1[0] = v1[0] * c_[2] - v1[1] * s_[2]; w1[1] = v1[0] * s_[2] + v1[1] * c_[2];
                            w1[2] = v1[2] * c_[3] - v1[3] * s_[3]; w1[3] = v1[2] * s_[3] + v1[3] * c_[3];
                            v0 = w0; v1 = w1;
                        }
                        u32x4 w; w.x = cvt_pk_bf16(v0[0], v0[1]); w.y = cvt_pk_bf16(v0[2], v0[3]); w.z = cvt_pk_bf16(v1[0], v1[1]); w.w = cvt_pk_bf16(v1[2], v1[3]);
                        *(u32x4*)(rowp + bj * 128) = w;
                    }
                }
            }
        } else {
            const int g0 = (pn - 18) * 256 + wc * 32 + 8 * fq;
            f32x4 bg[2][2];
#pragma unroll
            for (int bj = 0; bj < 2; ++bj) { const LAS float* bgl = (const LAS float*)(lds + LO_BGL) + g0 + bj * 128; bg[bj][0] = *(const LAS f32x4*)bgl; bg[bj][1] = *(const LAS f32x4*)(bgl + 4); }
#pragma unroll
            for (int ai = 0; ai < 2; ++ai)
#pragma unroll
                for (int m = 0; m < 4; ++m) {
                    const int row = u.pm * 256 + ai * 128 + wr * 64 + m * 16 + fr;
                    const float rs = rsv[ai][m];
#pragma unroll
                    for (int bj = 0; bj < 2; ++bj) {
                        const int gc = g0 + bj * 128;
                        const f32x4 v0 = acc[ai][bj][m][0] * rs + bg[bj][0], v1 = acc[ai][bj][m][1] * rs + bg[bj][1];
                        unsigned lo = 0, hi = 0;
#pragma unroll
                        for (int e = 0; e < 4; ++e) {
                            lo |= (unsigned)(sigmoidf_(v0[e]) * 255.0f + 0.5f) << (8 * e);
                            hi |= (unsigned)(sigmoidf_(v1[e]) * 255.0f + 0.5f) << (8 * e);
                        }
                        v2u w; w.x = lo; w.y = hi;
                        *(v2u*)(gate8 + (size_t)row * 3072 + gc) = w;
                    }
                }
        }
    }
};
struct EpiG2 {
    static constexpr bool PERM = false, AFTER_DRAIN = false, KEEP_ACC = true;
    const unsigned char* gate8; bf16_t* merged;
    __device__ __forceinline__ void operator()(f32x4 (&acc)[2][2][4][2], const Unit& u, int wr, int wc, int fr, int fq) const {
        const int col0 = u.pn * 256 + wc * 32 + 4 * fq;
        unsigned ga[2][4][2][2], gb[2][4][2][2];
#pragma unroll
        for (int ai = 0; ai < 2; ++ai)
#pragma unroll
            for (int m = 0; m < 4; ++m)
#pragma unroll
                for (int bj = 0; bj < 2; ++bj)
#pragma unroll
                    for (int n = 0; n < 2; ++n) {
                        const size_t o = (size_t)(u.pm * 256 + ai * 128 + wr * 64 + m * 16 + fr) * 3072 + col0 + bj * 128 + n * 16;
                        ga[ai][m][bj][n] = *(const unsigned*)(gate8 + o + u.z * 1024);
                        gb[ai][m][bj][n] = u.z < 2 ? *(const unsigned*)(gate8 + o + (u.z + 1) * 1024) : 0u;
                    }
#pragma unroll
        for (int ai = 0; ai < 2; ++ai)
#pragma unroll
            for (int m = 0; m < 4; ++m) {
                const int row = u.pm * 256 + ai * 128 + wr * 64 + m * 16 + fr;
#pragma unroll
                for (int bj = 0; bj < 2; ++bj)
#pragma unroll
                    for (int n = 0; n < 2; ++n) {
                        const int c = col0 + bj * 128 + n * 16;
                        const unsigned a_ = ga[ai][m][bj][n], b_ = gb[ai][m][bj][n];
                        f32x4 t = acc[ai][bj][m][n];
                        if (u.z < 2) {
#pragma unroll
                            for (int e = 0; e < 4; ++e) { const float a = (float)max((a_ >> (8 * e)) & 255u, 1u), b = (float)max((b_ >> (8 * e)) & 255u, 1u); t[e] = t[e] * a * __builtin_amdgcn_rcpf(b); }
                            acc[ai][bj][m][n] = t;
                        } else {
#pragma unroll
                            for (int e = 0; e < 4; ++e) t[e] *= (float)max((a_ >> (8 * e)) & 255u, 1u) * (1.0f / 255.0f);
                            v2u w; w.x = cvt_pk_bf16(t[0], t[1]); w.y = cvt_pk_bf16(t[2], t[3]);
                            *(v2u*)(merged + (size_t)row * 1024 + c) = w;
                            acc[ai][bj][m][n] = (f32x4){0.f, 0.f, 0.f, 0.f};
                        }
                    }
            }
    }
};
struct EpiRes {
    static constexpr bool PERM = false, AFTER_DRAIN = false, KEEP_ACC = false;
    const float* basef; const bf16_t* baseb; bf16_t* xb; float* ssout;
    __device__ __forceinline__ void operator()(const f32x4 (&acc)[2][2][4][2], const Unit& u, int wr, int wc, int fr, int fq) const {
        const int col0 = u.pn * 256 + wc * 32 + 4 * fq, lane = fr + 16 * fq;
#pragma unroll
        for (int ai = 0; ai < 2; ++ai) {
            f32x4 bv[4][2][2];
            if (basef) {
#pragma unroll
                for (int m = 0; m < 4; ++m)
#pragma unroll
                    for (int bj = 0; bj < 2; ++bj)
#pragma unroll
                        for (int n = 0; n < 2; ++n) bv[m][bj][n] = *(const f32x4*)(basef + (size_t)(u.pm * 256 + ai * 128 + wr * 64 + m * 16 + fr) * 1024 + col0 + bj * 128 + n * 16);
            } else {
                v2u bw[4][2][2];
#pragma unroll
                for (int m = 0; m < 4; ++m)
#pragma unroll
                    for (int bj = 0; bj < 2; ++bj)
#pragma unroll
                        for (int n = 0; n < 2; ++n) bw[m][bj][n] = *(const v2u*)(baseb + (size_t)(u.pm * 256 + ai * 128 + wr * 64 + m * 16 + fr) * 1024 + col0 + bj * 128 + n * 16);
#pragma unroll
                for (int m = 0; m < 4; ++m)
#pragma unroll
                    for (int bj = 0; bj < 2; ++bj)
#pragma unroll
                        for (int n = 0; n < 2; ++n) bv[m][bj][n] = (f32x4){bflo(bw[m][bj][n].x), bfhi(bw[m][bj][n].x), bflo(bw[m][bj][n].y), bfhi(bw[m][bj][n].y)};
            }
#pragma unroll
            for (int m = 0; m < 4; ++m) {
                const int row = u.pm * 256 + ai * 128 + wr * 64 + m * 16 + fr;
                float s = 0.f;
#pragma unroll
                for (int bj = 0; bj < 2; ++bj)
#pragma unroll
                    for (int n = 0; n < 2; ++n) {
                        const size_t off = (size_t)row * 1024 + col0 + bj * 128 + n * 16;
                        const f32x4 v = bv[m][bj][n] + acc[ai][bj][m][n];
                        v2u w; w.x = cvt_pk_bf16(v[0], v[1]); w.y = cvt_pk_bf16(v[2], v[3]);
                        *(v2u*)(xb + off) = w;
                        s += (v[0] * v[0] + v[1] * v[1]) + (v[2] * v[2] + v[3] * v[3]);
                    }
                s += shx(s, lane, 16); s += shx(s, lane, 32);
                if (fq == 0) ssout[(size_t)row * 16 + u.pn * 4 + wc] = s;
            }
        }
    }
};
struct EpiG4 {
    static constexpr bool PERM = true, AFTER_DRAIN = false, KEEP_ACC = false;
    bf16_t* U; const LAS unsigned char* lds;
    __device__ __forceinline__ void operator()(const f32x4 (&acc)[2][2][4][2], const Unit& u, int wr, int wc, int fr, int fq) const {
        const int col0 = u.pn * 256 + wc * 32 + 8 * fq;
        float rsv[2][4];
#pragma unroll
        for (int ai = 0; ai < 2; ++ai)
#pragma unroll
            for (int m = 0; m < 4; ++m) rsv[ai][m] = rs_lookup(lds, u.pm, ai * 128 + wr * 64 + m * 16 + fr);
#pragma unroll
        for (int ai = 0; ai < 2; ++ai)
#pragma unroll
            for (int m = 0; m < 4; ++m) {
                const int row = u.pm * 256 + ai * 128 + wr * 64 + m * 16 + fr;
                const float rs = rsv[ai][m];
                bf16_t* rowp = U + (size_t)row * FF + col0;
#pragma unroll
                for (int bj = 0; bj < 2; ++bj) {
                    f32x4 v0 = acc[ai][bj][m][0] * rs, v1 = acc[ai][bj][m][1] * rs;
#pragma unroll
                    for (int e = 0; e < 4; ++e) { const float a = fmaxf(v0[e], 0.f), b = fmaxf(v1[e], 0.f); v0[e] = a * a; v1[e] = b * b; }
                    u32x4 w; w.x = cvt_pk_bf16(v0[0], v0[1]); w.y = cvt_pk_bf16(v0[2], v0[3]); w.z = cvt_pk_bf16(v1[0], v1[1]); w.w = cvt_pk_bf16(v1[2], v1[3]);
                    *(u32x4*)(rowp + bj * 128) = w;
                }
            }
    }
};
struct EpiE {
    static constexpr bool PERM = false, AFTER_DRAIN = false, KEEP_ACC = false;
    bf16_t* E;
    __device__ __forceinline__ void operator()(const f32x4 (&acc)[2][2][4][2], const Unit& u, int wr, int wc, int fr, int fq) const {
        const int col0 = u.pn * 256 + wc * 32 + 4 * fq;
#pragma unroll
        for (int ai = 0; ai < 2; ++ai)
#pragma unroll
            for (int m = 0; m < 4; ++m) {
                const int row = u.pm * 256 + ai * 128 + wr * 64 + m * 16 + fr;
#pragma unroll
                for (int bj = 0; bj < 2; ++bj)
#pragma unroll
                    for (int n = 0; n < 2; ++n) { const f32x4 v = acc[ai][bj][m][n]; v2u w; w.x = cvt_pk_bf16(v[0], v[1]); w.y = cvt_pk_bf16(v[2], v[3]); *(v2u*)(E + (size_t)row * 1024 + col0 + bj * 128 + n * 16) = w; }
            }
    }
};
struct EpiG6 {
    static constexpr bool PERM = false, AFTER_DRAIN = false, KEEP_ACC = false;
    const bf16_t* baseb; bf16_t* xb; const LAS unsigned char* lds; float* ssout; const bf16_t* E;
    __device__ __forceinline__ void operator()(const f32x4 (&acc)[2][2][4][2], const Unit& u, int wr, int wc, int fr, int fq) const {
        const int col0 = u.pn * 256 + wc * 32 + 4 * fq, lane = fr + 16 * fq;
        float rsv[2][4];
#pragma unroll
        for (int ai = 0; ai < 2; ++ai)
#pragma unroll
            for (int m = 0; m < 4; ++m) rsv[ai][m] = rs_lookup(lds, u.pm, ai * 128 + wr * 64 + m * 16 + fr);
#pragma unroll
        for (int ai = 0; ai < 2; ++ai) {
            v2u bw[4][2][2], ew[4][2][2];
#pragma unroll
            for (int m = 0; m < 4; ++m)
#pragma unroll
                for (int bj = 0; bj < 2; ++bj)
#pragma unroll
                    for (int n = 0; n < 2; ++n) { const size_t off = (size_t)(u.pm * 256 + ai * 128 + wr * 64 + m * 16 + fr) * 1024 + col0 + bj * 128 + n * 16;
                        bw[m][bj][n] = *(const v2u*)(baseb + off); ew[m][bj][n] = *(const v2u*)(E + off); }
#pragma unroll
            for (int m = 0; m < 4; ++m) {
                const int row = u.pm * 256 + ai * 128 + wr * 64 + m * 16 + fr;
                const float rs = rsv[ai][m];
                float s = 0.f;
#pragma unroll
                for (int bj = 0; bj < 2; ++bj)
#pragma unroll
                    for (int n = 0; n < 2; ++n) {
                        const size_t off = (size_t)row * 1024 + col0 + bj * 128 + n * 16;
                        const f32x4 a = acc[ai][bj][m][n] * rs; const v2u e_ = ew[m][bj][n], b_ = bw[m][bj][n];
                        const f32x4 e = (f32x4){bflo(e_.x), bfhi(e_.x), bflo(e_.y), bfhi(e_.y)};
                        f32x4 v = (f32x4){bflo(b_.x), bfhi(b_.x), bflo(b_.y), bfhi(b_.y)};
#pragma unroll
                        for (int k = 0; k < 4; ++k) v[k] += sigmoidf_(a[k]) * e[k];
                        v2u w; w.x = cvt_pk_bf16(v[0], v[1]); w.y = cvt_pk_bf16(v[2], v[3]);
                        *(v2u*)(xb + off) = w;
                        s += (v[0] * v[0] + v[1] * v[1]) + (v[2] * v[2] + v[3] * v[3]);
                    }
                s += shx(s, lane, 16); s += shx(s, lane, 32);
                if (fq == 0) ssout[(size_t)row * 16 + u.pn * 4 + wc] = s;
            }
            asm volatile("" ::: "memory");
        }
    }
};
struct ZOrder {
    pg8::StaticOrder S;
    __device__ __forceinline__ bool next(int i, Unit& u) const { if (!S.next(i / 3, u)) return false; u.z = i % 3; return true; }
    __device__ __forceinline__ void a_ready(const Unit&) const {}
    __device__ __forceinline__ void done(const Unit&) const {}
};

struct Args { const float* in[23]; float* out; unsigned char* ws; int ph_lo, ph_hi; };
typedef const __attribute__((address_space(4))) Args CArgs;
__device__ __forceinline__ CArgs* get_args() {
    CArgs* p = (CArgs*)__builtin_amdgcn_kernarg_segment_ptr();
    asm volatile("" : "+s"(p));
    return p;
}
struct Frame {
    LAS unsigned char* lds;
    int wave0, G, ngw, bid;
    float* out; unsigned char* ws;
    __device__ __forceinline__ int ltid() const { unsigned z = 0u; asm volatile("" : "+v"(z)); return wave0 * 64 + (int)__builtin_amdgcn_mbcnt_hi(~0u, __builtin_amdgcn_mbcnt_lo(~0u, z)); }
    __device__ __forceinline__ int lane() const { return ltid() & 63; }
    __device__ __forceinline__ int wave() const { int w_ = wave0; asm volatile("" : "+s"(w_)); return w_; }
    __device__ __forceinline__ int gw() const { return bid * NWAVES + wave(); }
};

__device__ __forceinline__ void transpose_item(const float* W, const float* g, int K, int N, bf16* WT, LAS float* scr, int item, int lane) {
    const int nblk = N / 32, kb = item / nblk, nb = item % nblk, k0 = 64 * kb, n0 = 32 * nb;
#pragma unroll
    for (int i = 0; i < 32; ++i) { const int kk = 2 * i + (lane >> 5); float v = W[(size_t)(k0 + kk) * N + n0 + (lane & 31)]; if (g) v *= g[k0 + kk]; scr[kk * 33 + (lane & 31)] = v; }
    LDS_WAIT(); asm volatile("" ::: "memory");
    const int c = lane & 7;
#pragma unroll
    for (int j = 0; j < 4; ++j) { const int n = (lane >> 3) + 8 * j; const LAS float* s = scr + (8 * c) * 33 + n;
        v4u o; o.x = pk2(s[0 * 33], s[1 * 33]); o.y = pk2(s[2 * 33], s[3 * 33]); o.z = pk2(s[4 * 33], s[5 * 33]); o.w = pk2(s[6 * 33], s[7 * 33]);
        *(v4u*)(WT + (size_t)(n0 + n) * K + k0 + 8 * c) = o; }
    LDS_WAIT(); asm volatile("" ::: "memory");
}
__device__ __forceinline__ void convert_matrix(const Frame& F, const float* W, const float* g, int K, int N, bf16* WT) {
    LAS float* scr = (LAS float*)(F.lds + F.wave() * 16384);
    const int nitems = (K / 64) * (N / 32);
    for (int it = F.gw(); it < nitems; it += F.ngw) transpose_item(W, g, K, N, WT, scr, it, F.lane());
}
__device__ __forceinline__ void convert_list(const Frame& F, CArgs* A, int l, bool early, bool mid) {
    LAS float* scr = (LAS float*)(F.lds + F.wave() * 16384);
    constexpr int I_IN = (D / 64) * (7680 / 32), I_BR = (512 / 64) * (D / 32), I_SQ = (D / 64) * (D / 32), I_PLE = (PLE / 64) * (D / 32);
    const int n_early = early ? I_IN : 0, n_mid = mid ? 3 * I_BR + 2 * I_SQ + I_PLE : 0, lane = F.lane();
    for (int it = F.gw(); it < n_early + n_mid; it += F.ngw) {
        int r = it;
        if (r < n_early) { transpose_item(A->in[3] + (size_t)l * D * 7680, A->in[2] + l * D, D, 7680, (bf16*)(F.ws + W_IN), scr, r, lane); continue; } r -= n_early;
        if (r < 3 * I_BR) { const int n = r / I_BR; transpose_item(A->in[14] + ((size_t)l * 3 + n) * 512 * D, nullptr, 512, D, (bf16*)(F.ws + W_BR) + (size_t)n * D * 512, scr, r - n * I_BR, lane); continue; } r -= 3 * I_BR;
        if (r < I_SQ) { transpose_item(A->in[15] + (size_t)l * D * D, nullptr, D, D, (bf16*)(F.ws + W_OUT), scr, r, lane); continue; } r -= I_SQ;
        if (r < I_SQ) { transpose_item(A->in[20] + (size_t)l * D * D, A->in[19] + l * D, D, D, (bf16*)(F.ws + W_G(l & 1)), scr, r, lane); continue; } r -= I_SQ;
        transpose_item(A->in[21] + (size_t)l * PLE * D, nullptr, PLE, D, (bf16*)(F.ws + W_PLE(l & 1)), scr, r, lane);
    }
}
__device__ __forceinline__ void convert_layer_early(const Frame& F, CArgs* A, int l) { convert_list(F, A, l, true, false); }
__device__ __forceinline__ void convert_layer_mid(const Frame& F, CArgs* A, int l) { convert_list(F, A, l, false, true); }
__device__ __forceinline__ void convert_layer_mlp(const Frame& F, CArgs* A, int l) {
    LAS float* scr = (LAS float*)(F.lds + F.wave() * 16384);
    constexpr int I_UP = (D / 64) * (FF / 32); const int lane = F.lane();
    for (int it = F.gw(); it < 2 * I_UP; it += F.ngw) {
        if (it < I_UP) transpose_item(A->in[17] + (size_t)l * D * FF, A->in[16] + l * D, D, FF, (bf16*)(F.ws + W_UP), scr, it, lane);
        else transpose_item(A->in[18] + (size_t)l * FF * D, nullptr, FF, D, (bf16*)(F.ws + W_DOWN), scr, it - I_UP, lane);
    }
}

template <class Sched>
__device__ __forceinline__ void stage_epilogue_tables(const Frame& F, const float* ss, const Sched& S, const float* bgate) {
    const int tid = F.ltid(), lane = tid & 63;
    LAS float* rsl = (LAS float*)(F.lds + LO_RSL); LAS int* spm = (LAS int*)(F.lds + LO_RSPM);
    __syncthreads();
    f32x4 sp[4][4]; int pmv[4];
#pragma unroll
    for (int j = 0; j < 4; ++j) { pg8::Unit u; const int i = 2 * j + (tid >> 8); pmv[j] = S.next(i, u) ? u.pm : -1;
        const int row = (pmv[j] < 0 ? 0 : pmv[j]) * 256 + (tid & 255);
#pragma unroll
        for (int q = 0; q < 4; ++q) sp[j][q] = *(const f32x4*)(ss + (size_t)row * 16 + 4 * q); }
#pragma unroll
    for (int j = 0; j < 4; ++j) { const int i = 2 * j + (tid >> 8);
        const f32x4 a = (sp[j][0] + sp[j][1]) + (sp[j][2] + sp[j][3]);
        rsl[i * 256 + (tid & 255)] = 1.0f / sqrtf(((a.x + a.y) + (a.z + a.w)) * (1.0f / D) + RMS_EPS);
        if ((tid & 255) == 0) spm[i] = pmv[j]; }
    if (bgate) { LAS float* bg = (LAS float*)(F.lds + LO_BGL); for (int e = tid; e < 3072; e += NWAVES * 64) bg[e] = bgate[e]; }
    (void)lane;
    __syncthreads();
}
__device__ __forceinline__ void phase_prologue(const Frame& F, CArgs* A) {
    convert_list(F, A, 0, true, false);
    const float* x = A->in[0]; bf16* xb = (bf16*)(F.ws + WS_XB); float* ss = (float*)(F.ws + WS_SSB);
    { const int lane = F.lane();
      for (int m0 = F.gw() * 4; m0 < T; m0 += F.ngw * 4) {
        f32x4 v[4][4];
#pragma unroll
        for (int r = 0; r < 4; ++r)
#pragma unroll
            for (int j = 0; j < 4; ++j) v[r][j] = ((const f32x4*)(x + (size_t)(m0 + r) * D) + lane)[64 * j];
#pragma unroll
        for (int r = 0; r < 4; ++r) {
            v2u* o = (v2u*)(xb + (size_t)(m0 + r) * D) + lane;
            float s = 0.f;
#pragma unroll
            for (int j = 0; j < 4; ++j) { const f32x4 t = v[r][j]; s += (t.x * t.x + t.y * t.y) + (t.z * t.z + t.w * t.w); v2u w; w.x = pk2(t.x, t.y); w.y = pk2(t.z, t.w); o[64 * j] = w; }
            s = wave_sum(s, lane);
            if (lane < 16) ss[(size_t)(m0 + r) * 16 + lane] = lane == 0 ? s : 0.f;
        }
      } }
    { bf16* lw = (bf16*)(F.ws + WS_LW);
      for (int e = F.gw() * 64 + F.lane(); e < DEPTH * 2 * 2 * 8 * 4096; e += F.ngw * 64) {
          const int mat = e >> 12, j = (e >> 6) & 63, i = e & 63, blk = mat & 7, ax = (mat >> 3) & 1, ld = mat >> 4;
          const float* src = (ax ? A->in[11] : A->in[9]) + ((size_t)ld * 8 + blk) * 4096;
          lw[e] = (bf16)f2bf(src[i * 64 + j]); }
      float* sp = (float*)(F.ws + WS_SP);
      for (int e = F.gw() * 64 + F.lane(); e < DEPTH * 2 * 512; e += F.ngw * 64) sp[e] = log1p_small(fexp(-A->in[13][e])); }
    float* tab = (float*)(F.ws + WS_TAB);
    for (int e = F.gw() * 64 + F.lane(); e < SEQ * 64; e += F.ngw * 64) {
        const int pos = e >> 6, i = e & 63;
        const float theta = __builtin_amdgcn_exp2f(-(float)i * (13.287712379549449f / 63.0f));
        double rev = (double)pos * (double)theta * 0.15915494309189535; rev -= __builtin_floor(rev);
        const float fr = (float)rev;
        tab[e] = __builtin_amdgcn_cosf(fr); tab[131072 + e] = __builtin_amdgcn_sinf(fr);
    }
}


typedef short bf16x8_t __attribute__((ext_vector_type(8)));
typedef float f32x2_t __attribute__((ext_vector_type(2))); typedef __bf16 bf16x2_t __attribute__((ext_vector_type(2)));
__device__ __forceinline__ unsigned pkbf(float lo, float hi) { f32x2_t v = {lo, hi}; bf16x2_t b = __builtin_convertvector(v, bf16x2_t); return __builtin_bit_cast(unsigned, b); }
typedef short v4i16_t __attribute__((ext_vector_type(4)));
__device__ __forceinline__ v4i16_t ds_tr16(LAS const unsigned char* p) { return __builtin_amdgcn_ds_read_tr16_b64_v4i16((LAS v4i16_t*)p); }
__device__ __forceinline__ bf16x8_t tr_frag(LAS const unsigned char* p0, LAS const unsigned char* p1) {
    const v4i16_t a = ds_tr16(p0), b = ds_tr16(p1);
    return (bf16x8_t){a[0], a[1], a[2], a[3], b[0], b[1], b[2], b[3]};
}
#define MFMA16(a, b, c) __builtin_amdgcn_mfma_f32_16x16x32_bf16((a), (b), (c), 0, 0, 0)
constexpr int RP = 272;
__device__ __forceinline__ void ret_scan_item(const Frame& F, int item) {
    const int bh = item >> 3, dir = (item >> 2) & 1, dvq = item & 3, b = bh >> 2, h = bh & 3;
    const bf16* Kg = (const bf16*)(F.ws + WS_PROJ + 5 * BLK); const bf16* Vg = (const bf16*)(F.ws + WS_PROJ + 7 * BLK);
    bf16* ST = (bf16*)F.out;
    const float lg = log2_1m(__builtin_amdgcn_exp2f((dir ? -5.5f : -5.0f) - (float)h));
    const float cdec = __builtin_amdgcn_exp2f(128.0f * lg);
    constexpr int VP = 80, BUF = 128 * RP + 128 * VP;
    const int tid = F.ltid(), lane = F.lane(), w = F.wave(), g = lane >> 4, i = lane & 15, q4 = i >> 2, p4 = i & 3;
    v4u kr0[4], kr1[4], vr0, vr1;
    const int vrow = tid >> 2, vch = tid & 3;
#define RS_LOAD(kr, vr, c_) do { const size_t tb = (size_t)b * SEQ + (c_) * 128; \
        _Pragma("unroll") for (int q = 0; q < 4; ++q) { const int idx = tid + 512 * q; kr[q] = *(const v4u*)(Kg + (tb + (idx >> 4)) * 512 + h * 128 + (idx & 15) * 8); } \
        vr = *(const v4u*)(Vg + (tb + vrow) * 512 + h * 128 + dvq * 32 + vch * 8); } while (0)
#define RS_WRITE(kr, vr, buf_) do { LAS unsigned char* Kb_ = F.lds + (buf_) * BUF; LAS unsigned char* Vb_ = Kb_ + 128 * RP; \
        _Pragma("unroll") for (int q = 0; q < 4; ++q) { const int idx = tid + 512 * q, row = idx >> 4; \
            const float dk_ = __builtin_amdgcn_exp2f((float)(dir ? row : 127 - row) * lg); v4u o; \
            _Pragma("unroll") for (int e = 0; e < 4; ++e) o[e] = pkbf(bflo(kr[q][e]) * dk_, bfhi(kr[q][e]) * dk_); \
            *(LAS v4u*)(Kb_ + row * RP + (idx & 15) * 16) = o; } \
        *(LAS v4u*)(Vb_ + vrow * VP + vch * 16) = vr; } while (0)
#define RS_CHUNK(s_) (dir ? 15 - (s_) : (s_))
#define RS_STEP(s_, krN, vrN, krW, vrW) do { const int c = RS_CHUNK(s_), buf = (s_) & 1; \
        if ((s_) + 2 < 16) RS_LOAD(krN, vrN, RS_CHUNK((s_) + 2)); \
        bf16* dst = ST + ((size_t)(bh * 2 + dir) * 16 + c) * 16384; \
        _Pragma("unroll") for (int n = 0; n < 2; ++n) { v2u o; o.x = pkbf(acc[n][0], acc[n][1]); o.y = pkbf(acc[n][2], acc[n][3]); *(v2u*)(dst + (32 * dvq + 16 * n + i) * 128 + 16 * w + 4 * g) = o; } \
        acc[0] = acc[0] * cdec; acc[1] = acc[1] * cdec; \
        const LAS unsigned char* Kb = F.lds + buf * BUF; const LAS unsigned char* Vb = Kb + 128 * RP; \
        _Pragma("unroll") for (int ks = 0; ks < 4; ++ks) { const int r0 = 32 * ks + 8 * g + q4; \
            const bf16x8_t af = tr_frag(Kb + r0 * RP + (16 * w + 4 * p4) * 2, Kb + (r0 + 4) * RP + (16 * w + 4 * p4) * 2); \
            _Pragma("unroll") for (int n = 0; n < 2; ++n) { const bf16x8_t bv = tr_frag(Vb + r0 * VP + (16 * n + 4 * p4) * 2, Vb + (r0 + 4) * VP + (16 * n + 4 * p4) * 2); acc[n] = MFMA16(af, bv, acc[n]); } } \
        if ((s_) + 1 < 16) RS_WRITE(krW, vrW, buf ^ 1); \
        __syncthreads(); } while (0)
    __syncthreads();
    RS_LOAD(kr0, vr0, RS_CHUNK(0));
    RS_LOAD(kr1, vr1, RS_CHUNK(1));
    RS_WRITE(kr0, vr0, 0);
    __syncthreads();
    f32x4 acc[2]; acc[0] = (f32x4){0.f, 0.f, 0.f, 0.f}; acc[1] = acc[0];
    for (int s2 = 0; s2 < 16; s2 += 2) {
        RS_STEP(s2, kr0, vr0, kr1, vr1);
        RS_STEP(s2 + 1, kr1, vr1, kr0, vr0);
    }
#undef RS_STEP
#undef RS_CHUNK
#undef RS_LOAD
#undef RS_WRITE
}
__device__ __forceinline__ void ret_out_item(const Frame& F, const float* gn, int item) {
    const int bh = item >> 4, ci = item & 15, b = bh >> 2, h = bh & 3, t0 = b * SEQ + ci * 128;
    bf16* Gg = (bf16*)(F.ws + WS_PROJ + 3 * BLK); const bf16* Qg = (const bf16*)(F.ws + WS_PROJ + 4 * BLK);
    const bf16* Kg = (const bf16*)(F.ws + WS_PROJ + 5 * BLK); const bf16* Vg = (const bf16*)(F.ws + WS_PROJ + 7 * BLK);
    const bf16* ST = (const bf16*)F.out;
    const float lgf = log2_1m(__builtin_amdgcn_exp2f(-5.0f - (float)h)), lgb = log2_1m(__builtin_amdgcn_exp2f(-5.5f - (float)h));
    LAS unsigned char* Kl = F.lds; LAS unsigned char* Vl = F.lds + 128 * RP; LAS unsigned char* Sf = F.lds + 2 * 128 * RP; LAS unsigned char* Sb = F.lds + 3 * 128 * RP;
    const int lane = F.lane(), w = F.wave(), g = lane >> 4, i = lane & 15, q4 = i >> 2, p4 = i & 3;
    const int nl = 16 * w + i;
    bf16* grow = Gg + (size_t)(t0 + nl) * 512 + h * 128;
    bf16x8_t bq[4]; v2u ggv[8];
#pragma unroll
    for (int ks = 0; ks < 4; ++ks) bq[ks] = *(const bf16x8_t*)(Qg + (size_t)(t0 + nl) * 512 + h * 128 + 32 * ks + 8 * g);
#pragma unroll
    for (int n = 0; n < 8; ++n) ggv[n] = *(const v2u*)(grow + 16 * n + 4 * g);
    __syncthreads();
    {
#pragma unroll
        for (int q = 0; q < 4; ++q) {
            const int idx = F.ltid() + 512 * q, row = idx >> 4, ch = idx & 15;
            *(LAS v4u*)(Kl + row * RP + ch * 16) = *(const v4u*)(Kg + (size_t)(t0 + row) * 512 + h * 128 + ch * 8);
            *(LAS v4u*)(Vl + row * RP + ch * 16) = *(const v4u*)(Vg + (size_t)(t0 + row) * 512 + h * 128 + ch * 8);
        }
        const bf16* sfp = ST + ((size_t)(bh * 2 + 0) * 16 + ci) * 16384; const bf16* sbp = ST + ((size_t)(bh * 2 + 1) * 16 + ci) * 16384;
#pragma unroll
        for (int q = 0; q < 4; ++q) {
            const int idx = F.ltid() + 512 * q, row = idx >> 4, ch = idx & 15;
            *(LAS v4u*)(Sf + row * RP + ch * 16) = *(const v4u*)(sfp + idx * 8);
            *(LAS v4u*)(Sb + row * RP + ch * 16) = *(const v4u*)(sbp + idx * 8);
        }
    }
    __syncthreads();
    bf16x8_t bp[4];
#pragma unroll
    for (int kp = 0; kp < 4; ++kp) {
        f32x4 s0 = (f32x4){0.f, 0.f, 0.f, 0.f}, s1 = s0;
#pragma unroll
        for (int ks = 0; ks < 4; ++ks) {
            const bf16x8_t a0 = *(const LAS bf16x8_t*)(Kl + (32 * kp + i) * RP + (32 * ks + 8 * g) * 2);
            const bf16x8_t a1 = *(const LAS bf16x8_t*)(Kl + (32 * kp + 16 + i) * RP + (32 * ks + 8 * g) * 2);
            s0 = MFMA16(a0, bq[ks], s0); s1 = MFMA16(a1, bq[ks], s1);
        }
        float pv[8];
#pragma unroll
        for (int e = 0; e < 4; ++e) {
            const int m0 = 32 * kp + 4 * g + e, m1 = m0 + 16;
            const float d0 = (float)(nl - m0), d1 = (float)(nl - m1);
            pv[e] = s0[e] * (d0 >= 0.f ? __builtin_amdgcn_exp2f(d0 * lgf) : __builtin_amdgcn_exp2f(-d0 * lgb));
            pv[4 + e] = s1[e] * (d1 >= 0.f ? __builtin_amdgcn_exp2f(d1 * lgf) : __builtin_amdgcn_exp2f(-d1 * lgb));
        }
        v4u pk; pk.x = pkbf(pv[0], pv[1]); pk.y = pkbf(pv[2], pv[3]); pk.z = pkbf(pv[4], pv[5]); pk.w = pkbf(pv[6], pv[7]);
        bp[kp] = __builtin_bit_cast(bf16x8_t, pk);
    }
    f32x4 oi[8], of[8], ob[8];
#pragma unroll
    for (int n = 0; n < 8; ++n) { oi[n] = (f32x4){0.f, 0.f, 0.f, 0.f}; of[n] = oi[n]; ob[n] = oi[n]; }
#pragma unroll
    for (int kp = 0; kp < 4; ++kp) {
        const int r0 = (32 * kp + 4 * g + q4) * RP, r1 = r0 + 16 * RP;
#pragma unroll
        for (int n = 0; n < 8; ++n) { const bf16x8_t av = tr_frag(Vl + r0 + (16 * n + 4 * p4) * 2, Vl + r1 + (16 * n + 4 * p4) * 2); oi[n] = MFMA16(av, bp[kp], oi[n]); }
    }
#pragma unroll
    for (int ks = 0; ks < 4; ++ks)
#pragma unroll
        for (int n = 0; n < 8; ++n) {
            const bf16x8_t af = *(const LAS bf16x8_t*)(Sf + (16 * n + i) * RP + (32 * ks + 8 * g) * 2);
            const bf16x8_t ab = *(const LAS bf16x8_t*)(Sb + (16 * n + i) * RP + (32 * ks + 8 * g) * 2);
            of[n] = MFMA16(af, bq[ks], of[n]); ob[n] = MFMA16(ab, bq[ks], ob[n]);
        }
    const float qdf = __builtin_amdgcn_exp2f((float)(nl + 1) * lgf), qdb = __builtin_amdgcn_exp2f((float)(128 - nl) * lgb);
    float ss = 0.f;
#pragma unroll
    for (int n = 0; n < 8; ++n) { oi[n] = oi[n] + of[n] * qdf + ob[n] * qdb; ss += (oi[n][0] * oi[n][0] + oi[n][1] * oi[n][1]) + (oi[n][2] * oi[n][2] + oi[n][3] * oi[n][3]); }
    ss += shx(ss, lane, 16); ss += shx(ss, lane, 32);
    const float rn = 1.0f / sqrtf(ss * (1.0f / 128.0f) + RMS_EPS);
#pragma unroll
    for (int n = 0; n < 8; ++n) {
        const int dv0 = 16 * n + 4 * g;
        const v2u gg = ggv[n]; const f32x4 gw = *(const f32x4*)(gn + h * 128 + dv0);
        const float g0 = bflo(gg.x), g1 = bfhi(gg.x), g2 = bflo(gg.y), g3 = bfhi(gg.y);
        v2u o; o.x = pkbf(g0 * sigmoidf_(g0) * oi[n][0] * rn * gw[0], g1 * sigmoidf_(g1) * oi[n][1] * rn * gw[1]);
        o.y = pkbf(g2 * sigmoidf_(g2) * oi[n][2] * rn * gw[2], g3 * sigmoidf_(g3) * oi[n][3] * rn * gw[3]);
        *(v2u*)(grow + dv0) = o;
    }
}

constexpr int LO_WL = 0, LO_CST = 36864, LO_XC = 39680, LO_XF = 58688, LO_XB = 93504, LO_GY = 111936, LO_SEG = 130368, LO_HIN = 138560;
__device__ __forceinline__ void lru_stage_consts(const Frame& F, CArgs* A, int l, int blk) {
    const bf16* LW = (const bf16*)(F.ws + WS_LW); const float* SP = (const float*)(F.ws + WS_SP);
    __syncthreads();
#pragma unroll
    for (int q = 0; q < 4; ++q) { const int idx = F.ltid() + 512 * q, m = idx >> 9, row = (idx >> 3) & 63, ch = idx & 7;
        const int d = m >> 1, ax = m & 1;
        *(LAS v4u*)(F.lds + LO_WL + (m * 64 + row) * 144 + ch * 16) = *(const v4u*)(LW + (size_t)((((l * 2 + d) * 2 + ax) * 8 + blk)) * 4096 + row * 64 + ch * 8); }
    LAS float* cst = (LAS float*)(F.lds + LO_CST);
    if (F.ltid() < 128) { const int d = F.ltid() >> 6, j = F.ltid() & 63, pi = (l * 2 + d) * 512 + blk * 64 + j; cst[F.ltid()] = A->in[10][pi]; cst[128 + F.ltid()] = A->in[12][pi]; cst[256 + F.ltid()] = SP[pi]; }
    else if (F.ltid() < 384) { const int e = F.ltid() - 128, tap = e >> 6, j = e & 63; cst[384 + e] = A->in[7][(size_t)l * 2048 + tap * 512 + blk * 64 + j]; }
    else if (F.ltid() < 448) { const int j = F.ltid() - 384; cst[640 + j] = A->in[8][(size_t)l * 512 + blk * 64 + j]; }
}
struct LruPre { v4u xc[3]; v4u gc[2]; float agx[15], agy[15]; };
template <int MODE>
__device__ __forceinline__ void lru_fetch(const Frame& F, int item, LruPre& P) {
    const int b = item >> 7, c = (item >> 3) & 15, blk = item & 7, t0 = b * SEQ + c * 128, s0 = c * 128, tid = F.ltid();
    const bf16* XCg = (const bf16*)(F.ws + WS_PROJ + 8 * BLK); const bf16* GCg = (const bf16*)(F.ws + WS_PROJ + 6 * BLK); const float* AGG = (const float*)(F.ws + WS_AGG);
#pragma unroll
    for (int q = 0; q < 3; ++q) {
        const int idx = tid + 512 * q, row = idx >> 3, ch = idx & 7, s_ = s0 - 2 + row;
        P.xc[q] = (v4u){0u, 0u, 0u, 0u};
        if (idx < 1056 && s_ >= 0 && s_ < SEQ) P.xc[q] = *(const v4u*)(XCg + (size_t)(b * SEQ + s_) * 512 + blk * 64 + ch * 8);
    }
    if (MODE >= 1) {
#pragma unroll
        for (int q = 0; q < 2; ++q) { const int idx = tid + 512 * q, row = idx >> 3, ch = idx & 7; P.gc[q] = *(const v4u*)(GCg + (size_t)(t0 + row) * 512 + blk * 64 + ch * 8); }
        if (MODE == 1 && tid < 128) {
            typedef float f2 __attribute__((ext_vector_type(2)));
            const int d = tid >> 6, ch = blk * 64 + (tid & 63);
#pragma unroll
            for (int k = 0; k < 15; ++k) { const int cc = d ? 15 - k : k; const f2 a = *(const f2*)(AGG + ((size_t)((b * 16 + cc) * 2 + d) * 512 + ch) * 2); P.agx[k] = a.x; P.agy[k] = a.y; }
        }
    }
}
template <int MODE>
__device__ __forceinline__ void lru_item(const Frame& F, int item, const LruPre& P, int l) {
    const int b = item >> 7, c = (item >> 3) & 15, blk = item & 7, t0 = b * SEQ + c * 128;
    bf16* GCg = (bf16*)(F.ws + WS_PROJ + 6 * BLK);
    float* AGG = (float*)(F.ws + WS_AGG);
    LAS unsigned char* WL = F.lds + LO_WL; const LAS float* cst = (const LAS float*)(F.lds + LO_CST);
    LAS unsigned char* XC = F.lds + LO_XC; LAS float* XF = (LAS float*)(F.lds + LO_XF); LAS unsigned char* XB = F.lds + LO_XB; LAS unsigned char* GY = F.lds + LO_GY;
    LAS float* SEG = (LAS float*)(F.lds + LO_SEG); LAS float* HIN = (LAS float*)(F.lds + LO_HIN);
    typedef float f2 __attribute__((ext_vector_type(2)));
    const int tid = F.ltid(), lane = F.lane(), w = F.wave(), g = lane >> 4, i = lane & 15;
    __syncthreads();
#pragma unroll
    for (int q = 0; q < 3; ++q) { const int idx = tid + 512 * q; if (idx < 1056) *(LAS v4u*)(XC + (idx >> 3) * 144 + (idx & 7) * 16) = P.xc[q]; }
    if (MODE >= 1) {
#pragma unroll
        for (int q = 0; q < 2; ++q) { const int idx = tid + 512 * q; *(LAS v4u*)(GY + (idx >> 3) * 144 + (idx & 7) * 16) = P.gc[q]; }
        if (MODE == 1 && tid < 128) {
            const int d = tid >> 6;
            float h = 0.f;
#pragma unroll
            for (int k = 0; k < 15; ++k) { const int cc = d ? 15 - k : k; const bool valid = d ? (cc > c) : (cc < c); h = valid ? P.agx[k] * h + P.agy[k] : h; }
            HIN[tid] = h;
        }
    }
    __syncthreads();
#pragma unroll
    for (int q = 0; q < 2; ++q) {
        const int idx = tid + 512 * q, t = idx >> 3, c8 = idx & 7;
        float xf[8];
        { const f32x4 b0 = *(const LAS f32x4*)(cst + 640 + c8 * 8), b1 = *(const LAS f32x4*)(cst + 640 + c8 * 8 + 4); xf[0] = b0[0]; xf[1] = b0[1]; xf[2] = b0[2]; xf[3] = b0[3]; xf[4] = b1[0]; xf[5] = b1[1]; xf[6] = b1[2]; xf[7] = b1[3]; }
#pragma unroll
        for (int tap = 0; tap < 4; ++tap) {
            const v4u x = *(const LAS v4u*)(XC + (t + tap) * 144 + c8 * 16);
            const f32x4 w0 = *(const LAS f32x4*)(cst + 384 + tap * 64 + c8 * 8), w1 = *(const LAS f32x4*)(cst + 384 + tap * 64 + c8 * 8 + 4);
            xf[0] += w0[0] * bflo(x[0]); xf[1] += w0[1] * bfhi(x[0]); xf[2] += w0[2] * bflo(x[1]); xf[3] += w0[3] * bfhi(x[1]);
            xf[4] += w1[0] * bflo(x[2]); xf[5] += w1[1] * bfhi(x[2]); xf[6] += w1[2] * bflo(x[3]); xf[7] += w1[3] * bfhi(x[3]);
        }
        *(LAS f32x4*)(XF + t * 68 + c8 * 8) = (f32x4){xf[0], xf[1], xf[2], xf[3]}; *(LAS f32x4*)(XF + t * 68 + c8 * 8 + 4) = (f32x4){xf[4], xf[5], xf[6], xf[7]};
        v4u o; o.x = pkbf(xf[0], xf[1]); o.y = pkbf(xf[2], xf[3]); o.z = pkbf(xf[4], xf[5]); o.w = pkbf(xf[6], xf[7]);
        *(LAS v4u*)(XB + t * 144 + c8 * 16) = o;
    }
    __syncthreads();
    float av[2][4][4], bv[2][4][4];
    {
        const bf16x8_t a0 = *(const LAS bf16x8_t*)(XB + (16 * w + i) * 144 + (8 * g) * 2), a1 = *(const LAS bf16x8_t*)(XB + (16 * w + i) * 144 + (32 + 8 * g) * 2);
#pragma unroll
        for (int d = 0; d < 2; ++d) {
#pragma unroll
            for (int jt = 0; jt < 4; ++jt) {
                const LAS unsigned char* wa = WL + ((d * 2 + 0) * 64 + 16 * jt + i) * 144 + (8 * g) * 2; const LAS unsigned char* wx = WL + ((d * 2 + 1) * 64 + 16 * jt + i) * 144 + (8 * g) * 2;
                const f32x4 z = (f32x4){0.f, 0.f, 0.f, 0.f};
                f32x4 ca = MFMA16(a0, *(const LAS bf16x8_t*)wa, z); ca = MFMA16(a1, *(const LAS bf16x8_t*)(wa + 64), ca);
                f32x4 cx = MFMA16(a0, *(const LAS bf16x8_t*)wx, z); cx = MFMA16(a1, *(const LAS bf16x8_t*)(wx + 64), cx);
                const int j = 16 * jt + i;
                const float ba = cst[d * 64 + j], bx = cst[128 + d * 64 + j], sp = cst[256 + d * 64 + j];
#pragma unroll
                for (int r = 0; r < 4; ++r) {
                    const int t = 16 * w + 4 * g + r;
                    const float xfv = XF[t * 68 + j];
                    const float rr = sigmoidf_(ca[r] + ba), ig = sigmoidf_(cx[r] + bx);
                    const float la = -8.0f * rr * sp, a = fexp(la);
                    const float om = fmaxf(__builtin_fmaf(-a, a, 1.0f), 0.0f);
                    float mult = __builtin_amdgcn_sqrtf(om);
                    if (d == 0 ? (c == 0 && t == 0) : (c == 15 && t == 127)) mult = 1.0f;
                    av[d][jt][r] = a; bv[d][jt][r] = mult * ig * xfv;
                }
            }
        }
    }
    float Ae[2][4], Be[2][4];
#pragma unroll
    for (int jt = 0; jt < 4; ++jt) {
        float Af = av[0][jt][0] * av[0][jt][1] * av[0][jt][2] * av[0][jt][3];
        float Bf = ((bv[0][jt][0] * av[0][jt][1] + bv[0][jt][1]) * av[0][jt][2] + bv[0][jt][2]) * av[0][jt][3] + bv[0][jt][3];
        float Ar = av[1][jt][0] * av[1][jt][1] * av[1][jt][2] * av[1][jt][3];
        float Br = ((bv[1][jt][3] * av[1][jt][2] + bv[1][jt][2]) * av[1][jt][1] + bv[1][jt][1]) * av[1][jt][0] + bv[1][jt][0];
#pragma unroll
        for (int st = 16; st <= 32; st <<= 1) {
            const float pAf = lane_get(Af, lane - st), pBf = lane_get(Bf, lane - st), pAr = lane_get(Ar, lane + st), pBr = lane_get(Br, lane + st);
            if (lane >= st) { Bf = Af * pBf + Bf; Af = Af * pAf; }
            if (lane + st < 64) { Br = Ar * pBr + Br; Ar = Ar * pAr; }
        }
        const float eAf = lane_get(Af, lane - 16), eBf = lane_get(Bf, lane - 16), eAr = lane_get(Ar, lane + 16), eBr = lane_get(Br, lane + 16);
        Ae[0][jt] = g > 0 ? eAf : 1.0f; Be[0][jt] = g > 0 ? eBf : 0.0f; Ae[1][jt] = g < 3 ? eAr : 1.0f; Be[1][jt] = g < 3 ? eBr : 0.0f;
        if (g == 3) *(LAS f2*)(SEG + ((0 * 8 + w) * 64 + 16 * jt + i) * 2) = (f2){Af, Bf};
        if (g == 0) *(LAS f2*)(SEG + ((1 * 8 + w) * 64 + 16 * jt + i) * 2) = (f2){Ar, Br};
    }
    __syncthreads();
    if (MODE == 2) {
        if (w < 2) {
            const int d = w, j = lane;
            float h = 0.f, Ap = 1.0f;
#pragma unroll
            for (int k = 0; k < 8; ++k) { const int ww = d ? 7 - k : k; const f2 sg = *(const LAS f2*)(SEG + ((d * 8 + ww) * 64 + j) * 2); h = sg.x * h + sg.y; Ap *= sg.x; }
            typedef GAS unsigned long long gu64;
            gu64* agg = (gu64*)(AGG) + (size_t)((b * 16) * 2 + d) * 512 + blk * 64 + j;
            gu32* flg = (gu32*)(F.ws + WS_CTL) + 8192 + (((l * 8 + b) * 16) * 8 + blk) * 2 + d;
            __hip_atomic_store(agg + (size_t)c * 1024, ((unsigned long long)__builtin_bit_cast(unsigned, h) << 32) | __builtin_bit_cast(unsigned, Ap), RLX_AGENT);
            asm volatile("s_waitcnt vmcnt(0)" ::: "memory");
            if (lane == 0) __hip_atomic_store(flg + c * 16, 1u, RLX_AGENT);
            const int need = d ? 15 - c : c;
            { unsigned spins = 0;
              for (;;) { const int cc = d ? 15 - lane : lane; unsigned v = 1u; if (lane < need) v = __hip_atomic_load(flg + cc * 16, RLX_AGENT);
                  if (__builtin_amdgcn_ballot_w64(v == 0u) == 0ull) break;
                  __builtin_amdgcn_s_sleep(2); if (++spins > (1u << 20)) break; } }
            float hin = 0.f;
#pragma unroll
            for (int k0 = 0; k0 < 16; k0 += 8) {
                unsigned long long gv[8];
#pragma unroll
                for (int k = 0; k < 8; ++k) { const int kk = k0 + k, cc = d ? 15 - kk : kk; gv[k] = (kk < need) ? __hip_atomic_load(agg + (size_t)(cc & 15) * 1024, RLX_AGENT) : 0ull; }
#pragma unroll
                for (int k = 0; k < 8; ++k) { const float a_ = __builtin_bit_cast(float, (unsigned)gv[k]), b_ = __builtin_bit_cast(float, (unsigned)(gv[k] >> 32)); hin = (k0 + k < need) ? a_ * hin + b_ : hin; }
                asm volatile("" : "+v"(hin) :: "memory");
            }
            HIN[d * 64 + j] = hin;
        }
        __syncthreads();
    }
    if (MODE == 0) {
        if (w == 0 && g < 2) {
            const int d = g;
#pragma unroll
            for (int jt = 0; jt < 4; ++jt) {
                const int j = 16 * jt + i; float h = 0.f, Ap = 1.0f;
#pragma unroll
                for (int k = 0; k < 8; ++k) { const int ww = d ? 7 - k : k; const f2 sg = *(const LAS f2*)(SEG + ((d * 8 + ww) * 64 + j) * 2); h = sg.x * h + sg.y; Ap *= sg.x; }
                *(f2*)(AGG + ((size_t)((b * 16 + c) * 2 + d) * 512 + blk * 64 + j) * 2) = (f2){Ap, h};
            }
        }
    } else {
#pragma unroll
        for (int jt = 0; jt < 4; ++jt) {
            const int j = 16 * jt + i;
            float hf = HIN[j], hr = HIN[64 + j];
            f2 sfv[8], srv[8];
#pragma unroll
            for (int k = 0; k < 8; ++k) { sfv[k] = *(const LAS f2*)(SEG + ((0 * 8 + k) * 64 + j) * 2); srv[k] = *(const LAS f2*)(SEG + ((1 * 8 + (7 - k)) * 64 + j) * 2); }
#pragma unroll
            for (int k = 0; k < 8; ++k) {
                const bool uf = k < w, ur = 7 - k > w;
                hf = (uf ? sfv[k].x : 1.0f) * hf + (uf ? sfv[k].y : 0.0f);
                hr = (ur ? srv[k].x : 1.0f) * hr + (ur ? srv[k].y : 0.0f);
            }
            float h = Ae[0][jt] * hf + Be[0][jt];
            float hs[4];
#pragma unroll
            for (int r = 0; r < 4; ++r) { h = av[0][jt][r] * h + bv[0][jt][r]; hs[r] = h; }
            h = Ae[1][jt] * hr + Be[1][jt];
#pragma unroll
            for (int r = 3; r >= 0; --r) { h = av[1][jt][r] * h + bv[1][jt][r]; hs[r] += h; }
#pragma unroll
            for (int r = 0; r < 4; ++r) { LAS bf16* p = (LAS bf16*)(GY + (16 * w + 4 * g + r) * 144) + j; *p = (bf16)f2bf(gelu_tanh(bf2f(*p)) * hs[r]); }
        }
        __syncthreads();
#pragma unroll
        for (int q = 0; q < 2; ++q) { const int idx = tid + 512 * q, row = idx >> 3, ch = idx & 7;
            *(v4u*)(GCg + (size_t)(t0 + row) * 512 + blk * 64 + ch * 8) = *(const LAS v4u*)(GY + row * 144 + ch * 16); }
    }
}
__device__ __forceinline__ int na_map(int it, int G) { if (G != 256) return it; const int b = it & 7, rest = it >> 3; return (b * 8 + (rest >> 2)) * 4 + (rest & 3); }
__device__ __forceinline__ int scan_map(int it, int G) { if (G != 256) return it; const int b = it & 7, rest = it >> 3; return (b * 4 + (rest >> 3)) * 8 + (rest & 7); }
__device__ __forceinline__ int retout_map(int it, int G) { if (G != 256) return it; const int b = it & 7, rest = ((it & 255) >> 3) + 32 * (it >> 8); return (b * 4 + (rest >> 4)) * 16 + (rest & 15); }
__device__ __forceinline__ int lru_map(int it, int G) { if (G != 256) return it; const int b = it & 7, r32 = (it & 255) >> 3, k = it >> 8; return (b * 16 + (r32 & 15)) * 8 + 2 * k + (r32 >> 4); }
template <int MODE> __device__ __forceinline__ void phase_lru(const Frame& F, CArgs* A, int l) {
    int cur = -1;
    LruPre P0, P1;
    if (F.bid < 1024) lru_fetch<MODE>(F, lru_map(F.bid, F.G), P0);
    for (int it = F.bid; it < 1024; it += 2 * F.G) {
        const int i0 = lru_map(it, F.G);
        { const int blk = i0 & 7; if (blk != cur) { lru_stage_consts(F, A, l, blk); cur = blk; } }
        const int it1 = it + F.G, it2 = it + 2 * F.G;
        const int i1 = it1 < 1024 ? lru_map(it1, F.G) : 0;
        if (it1 < 1024) lru_fetch<MODE>(F, i1, P1);
        lru_item<MODE>(F, i0, P0, l);
        if (it1 < 1024) {
            { const int blk = i1 & 7; if (blk != cur) { lru_stage_consts(F, A, l, blk); cur = blk; } }
            if (it2 < 1024) lru_fetch<MODE>(F, lru_map(it2, F.G), P0);
            lru_item<MODE>(F, i1, P1, l);
        }
    }
}


struct NaSide { const float* psrc; const float* wup; const float* gup; const float* wdown; bf16* wup_t; bf16* wdown_t;
    int nxt;
    const float* win; const float* gin; const float* wbr; const float* wout; const float* wg; const float* gg; const float* wple;
    int own;
    const float* owbr; const float* owout; const float* owg; const float* ogg; const float* owple; unsigned char* wsb; };
struct Strip { const float* W; const float* g; bf16* WT; int Kd, Nd, sl; bool on; };
__device__ __forceinline__ void strip_load(const Strip& st, int tid, float (&wv)[16]) {
    if (!st.on) return;
    const int nblk = st.Nd / 64, kb = st.sl / nblk, nb = st.sl % nblk, n = nb * 64 + (tid & 63), k0 = kb * 64 + 16 * ((tid >> 6) & 3);
#pragma unroll
    for (int j = 0; j < 16; ++j) wv[j] = st.W[(size_t)(k0 + j) * st.Nd + n];
}
__device__ __forceinline__ void strip_store(const Strip& st, int tid, float (&wv)[16]) {
    if (!st.on) return;
    const int nblk = st.Nd / 64, kb = st.sl / nblk, nb = st.sl % nblk, n = nb * 64 + (tid & 63), k0 = kb * 64 + 16 * ((tid >> 6) & 3);
    if (st.g) {
#pragma unroll
        for (int j = 0; j < 16; ++j) wv[j] *= st.g[k0 + j];
    }
    v4u t0, t1;
    t0.x = pk2(wv[0], wv[1]); t0.y = pk2(wv[2], wv[3]); t0.z = pk2(wv[4], wv[5]); t0.w = pk2(wv[6], wv[7]);
    t1.x = pk2(wv[8], wv[9]); t1.y = pk2(wv[10], wv[11]); t1.z = pk2(wv[12], wv[13]); t1.w = pk2(wv[14], wv[15]);
    *(v4u*)(st.WT + (size_t)n * st.Kd + k0) = t0; *(v4u*)(st.WT + (size_t)n * st.Kd + k0 + 8) = t1;
}
__device__ __forceinline__ void na_group(const Frame& F, const float* rpb, int grp, const NaSide sd) {
    const int b = grp >> 5, h = (grp >> 2) & 7, rg = grp & 3, r0 = rg * 8;
    bf16* Qg = (bf16*)(F.ws + WS_PROJ); const bf16* Kg = (const bf16*)(F.ws + WS_PROJ + BLK); const bf16* Vg = (const bf16*)(F.ws + WS_PROJ + 2 * BLK);
    LAS unsigned char* Kl = F.lds; LAS unsigned char* Vl = F.lds + 512 * 144; LAS float* Bl = (LAS float*)(F.lds + 2 * 512 * 144);
    const int tid = F.ltid();
    int rs = r0 - 4; rs = rs < 0 ? 0 : (rs > 24 ? 24 : rs);
    __syncthreads();
#pragma unroll
    for (int q = 0; q < 8; ++q) {
        const int idx = tid + 512 * q, kidx = idx >> 3, ch = idx & 7, grow = rs + (kidx >> 6), col = kidx & 63;
        const size_t tok = (size_t)b * SEQ + grow * 64 + col; const int lrow = (grow & 7) * 64 + col;
        *(LAS v4u*)(Kl + lrow * 144 + ch * 16) = *(const v4u*)(Kg + tok * 512 + h * 64 + ch * 8);
        *(LAS v4u*)(Vl + lrow * 144 + ch * 16) = *(const v4u*)(Vg + tok * 512 + h * 64 + ch * 8);
    }
    if (tid < 465) Bl[tid] = rpb[h * 465 + tid];
    __syncthreads();
    const int w = F.wave(), lane = F.lane(), g = lane >> 4, i = lane & 15, q4 = i >> 2, p4 = i & 3;
    const int cq = 16 * (w & 3) + i;
    bf16x8_t bq0 = *(const bf16x8_t*)(Qg + ((size_t)b * SEQ + r0 * 64 + cq) * 512 + h * 64 + 8 * g), bq1 = *(const bf16x8_t*)(Qg + ((size_t)b * SEQ + r0 * 64 + cq) * 512 + h * 64 + 32 + 8 * g);
    for (int k = 0; k < 8; ++k) {
        const int r = r0 + k;
        const int rq = k < 7 ? r + 1 : r;
        const bf16x8_t nq0 = *(const bf16x8_t*)(Qg + ((size_t)b * SEQ + rq * 64 + cq) * 512 + h * 64 + 8 * g), nq1 = *(const bf16x8_t*)(Qg + ((size_t)b * SEQ + rq * 64 + cq) * 512 + h * 64 + 32 + 8 * g);
        int rsn = r + 1 - 4; rsn = rsn < 0 ? 0 : (rsn > 24 ? 24 : rsn);
        const bool slide = (k < 7) && (rsn != rs);
        v4u pk = (v4u){0u, 0u, 0u, 0u}, pv = pk;
        if (slide) { const size_t tok = (size_t)b * SEQ + (rsn + 7) * 64 + (tid >> 3);
            pk = *(const v4u*)(Kg + tok * 512 + h * 64 + (tid & 7) * 8); pv = *(const v4u*)(Vg + tok * 512 + h * 64 + (tid & 7) * 8); }
        if (w < 4) {
            const int c = 16 * w + i, cb = w == 0 ? 0 : (w == 1 ? 8 : (w == 2 ? 24 : 32));
            int cst = c - 8; cst = cst < 0 ? 0 : (cst > 48 ? 48 : cst);
            const size_t tq = (size_t)b * SEQ + r * 64 + c;
            float sc[8][4];
            float mx = -1e30f;
            int bsel[4]; bool v0[4];
#pragma unroll
            for (int e = 0; e < 4; ++e) { const int kc0 = cb + 4 * g + e; v0[e] = kc0 >= cst; bsel[e] = (v0[e] ? kc0 : kc0 + 16) - c + 15; }
#pragma unroll
            for (int wi = 0; wi < 8; ++wi) {
                const int slot = (rs + wi) & 7;
                const LAS unsigned char* kp = Kl + (slot * 64 + cb + i) * 144 + (8 * g) * 2;
                const bf16x8_t a0 = *(const LAS bf16x8_t*)kp, a1 = *(const LAS bf16x8_t*)(kp + 64), c0 = *(const LAS bf16x8_t*)(kp + 16 * 144), c1 = *(const LAS bf16x8_t*)(kp + 16 * 144 + 64);
                f32x4 s0 = (f32x4){0.f, 0.f, 0.f, 0.f}, s1 = s0;
                s0 = MFMA16(a0, bq0, s0); s1 = MFMA16(c0, bq0, s1); s0 = MFMA16(a1, bq1, s0); s1 = MFMA16(c1, bq1, s1);
                const int brow = (rs + wi - r + 7) * 31;
#pragma unroll
                for (int e = 0; e < 4; ++e) { const float v = (v0[e] ? s0[e] : s1[e]) + Bl[brow + bsel[e]]; sc[wi][e] = v; mx = fmaxf(mx, v); }
            }
            mx = fmaxf(mx, shx(mx, lane, 16)); mx = fmaxf(mx, shx(mx, lane, 32));
            float sum = 0.f;
            bf16x8_t bp[8];
#pragma unroll
            for (int wi = 0; wi < 8; ++wi) {
                float p[8];
#pragma unroll
                for (int e = 0; e < 4; ++e) { const float pe = fexp(sc[wi][e] - mx); sum += pe; p[e] = v0[e] ? pe : 0.f; p[4 + e] = v0[e] ? 0.f : pe; }
                v4u pw; pw.x = pkbf(p[0], p[1]); pw.y = pkbf(p[2], p[3]); pw.z = pkbf(p[4], p[5]); pw.w = pkbf(p[6], p[7]);
                bp[wi] = __builtin_bit_cast(bf16x8_t, pw);
            }
            sum += shx(sum, lane, 16); sum += shx(sum, lane, 32);
            f32x4 o[4];
#pragma unroll
            for (int dt = 0; dt < 4; ++dt) o[dt] = (f32x4){0.f, 0.f, 0.f, 0.f};
#pragma unroll
            for (int wi = 0; wi < 8; ++wi) {
                const int slot = (rs + wi) & 7;
                const LAS unsigned char* vp = Vl + (slot * 64 + cb + 4 * g + q4) * 144 + (4 * p4) * 2;
#pragma unroll
                for (int dt = 0; dt < 4; ++dt) { const bf16x8_t av = tr_frag(vp + 32 * dt, vp + 16 * 144 + 32 * dt); o[dt] = MFMA16(av, bp[wi], o[dt]); }
            }
            const float inv = 1.0f / sum;
#pragma unroll
            for (int dt = 0; dt < 4; ++dt) { v2u ov; ov.x = pkbf(o[dt][0] * inv, o[dt][1] * inv); ov.y = pkbf(o[dt][2] * inv, o[dt][3] * inv);
                *(v2u*)(Qg + tq * 512 + h * 64 + 16 * dt + 4 * g) = ov; }
        }
        else {
            const int e = (grp * 8 + k) * 512 + (tid - 256) * 2;
            const f32x4 v0 = ((const f32x4*)sd.psrc)[e], v1 = ((const f32x4*)sd.psrc)[e + 1];
            v4u o; o.x = pk2(v0.x, v0.y); o.y = pk2(v0.z, v0.w); o.z = pk2(v1.x, v1.y); o.w = pk2(v1.z, v1.w);
            ((v4u*)((unsigned char*)F.out + DO_PB))[e >> 1] = o;
            const int sid = grp * 8 + k;
            unsigned char* dob = (unsigned char*)F.out;
            Strip s0, s1, s2;
            if (sid < 1024) s0 = Strip{sd.wup, sd.gup, sd.wup_t, D, FF, sid, true}; else s0 = Strip{sd.wdown, nullptr, sd.wdown_t, FF, D, sid - 1024, true};
            s1 = Strip{sd.win, sd.gin, (bf16*)(dob + DO_WIN), D, 7680, sid, sd.nxt != 0 && sid < 1920};
            if (sid < 384) s2 = Strip{sd.wbr + (size_t)(sid / 128) * 512 * D, nullptr, (bf16*)(dob + DO_MID) + (size_t)(sid / 128) * D * 512, 512, D, sid % 128, sd.nxt != 0};
            else if (sid < 640) s2 = Strip{sd.wout, nullptr, (bf16*)(dob + DO_MID + 3 * MiB), D, D, sid - 384, sd.nxt != 0};
            else if (sid < 896) s2 = Strip{sd.wg, sd.gg, (bf16*)(dob + DO_MID + 5 * MiB), D, D, sid - 640, sd.nxt != 0};
            else s2 = Strip{sd.wple, nullptr, (bf16*)(dob + DO_MID + 7 * MiB), PLE, D, sid - 896, sd.nxt != 0 && sid < 960};
            Strip s3;
            if (sid < 384) s3 = Strip{sd.owbr + (size_t)(sid / 128) * 512 * D, nullptr, (bf16*)(sd.wsb + W_BR) + (size_t)(sid / 128) * D * 512, 512, D, sid % 128, sd.own != 0};
            else if (sid < 640) s3 = Strip{sd.owout, nullptr, (bf16*)(sd.wsb + W_OUT), D, D, sid - 384, sd.own != 0};
            else if (sid < 896) s3 = Strip{sd.owg, sd.ogg, (bf16*)(sd.wsb + W_G(0)), D, D, sid - 640, sd.own != 0};
            else s3 = Strip{sd.owple, nullptr, (bf16*)(sd.wsb + W_PLE(0)), PLE, D, sid - 896, sd.own != 0 && sid < 960};
            float w0[16], w1[16], w2[16], w3[16];
            strip_load(s0, tid, w0); strip_load(s1, tid, w1); strip_load(s2, tid, w2); strip_load(s3, tid, w3);
            strip_store(s0, tid, w0); strip_store(s1, tid, w1); strip_store(s2, tid, w2); strip_store(s3, tid, w3);
        }
        __syncthreads();
        if (slide) { const int lrow = ((rsn + 7) & 7) * 64 + (tid >> 3);
            *(LAS v4u*)(Kl + lrow * 144 + (tid & 7) * 16) = pk; *(LAS v4u*)(Vl + lrow * 144 + (tid & 7) * 16) = pv; }
        __syncthreads();
        rs = rsn; bq0 = nq0; bq1 = nq1;
    }
}
__device__ __forceinline__ void phase_na(const Frame& F, CArgs* A, int l) { const float* rpb = A->in[5] + (size_t)l * 8 * 465; const int ln = l + 1 < DEPTH ? l + 1 : l;
    const NaSide sd{A->in[1] + (size_t)l * T * PLE, A->in[17] + (size_t)l * D * FF, A->in[16] + (size_t)l * D, A->in[18] + (size_t)l * FF * D, (bf16*)(F.ws + W_UP), (bf16*)(F.ws + W_DOWN),
                    l + 1 < DEPTH ? 1 : 0, A->in[3] + (size_t)ln * D * 7680, A->in[2] + (size_t)ln * D, A->in[14] + (size_t)ln * 3 * 512 * D, A->in[15] + (size_t)ln * D * D, A->in[20] + (size_t)ln * D * D, A->in[19] + (size_t)ln * D, A->in[21] + (size_t)ln * PLE * D,
                    l == 0 ? 1 : 0, A->in[14], A->in[15], A->in[20], A->in[19], A->in[21], F.ws};
    for (int it = F.bid; it < 256; it += F.G) na_group(F, rpb, na_map(it, F.G), sd); }

__device__ __forceinline__ void phase_ret_state(const Frame& F) { for (int it = F.bid; it < 256; it += F.G) ret_scan_item(F, scan_map(it, F.G)); }
__device__ __forceinline__ void phase_ret_out(const Frame& F, CArgs* A, int l) { const float* gn = A->in[6] + (size_t)l * 512; for (int it = F.bid; it < 512; it += F.G) ret_out_item(F, gn, retout_map(it, F.G)); }

__device__ __forceinline__ void phase_final(const Frame& F, CArgs* A) {
    const float* g = A->in[22]; const bf16* xb = (const bf16*)(F.ws + WS_XB); const float* ss = (const float*)(F.ws + WS_SSB);
    const int lane = F.lane();
    f32x4 gv[4];
#pragma unroll
    for (int j = 0; j < 4; ++j) gv[j] = ((const f32x4*)g + lane)[64 * j];
    for (int m0 = F.gw() * 4; m0 < T; m0 += F.ngw * 4) {
        v2u w[4][4]; float sp[4];
#pragma unroll
        for (int r = 0; r < 4; ++r) {
            sp[r] = lane < 16 ? ss[(size_t)(m0 + r) * 16 + lane] : 0.f;
#pragma unroll
            for (int j = 0; j < 4; ++j) w[r][j] = ((const v2u*)(xb + (size_t)(m0 + r) * D) + lane)[64 * j];
        }
#pragma unroll
        for (int r = 0; r < 4; ++r) {
            float t = sp[r]; t += shx(t, lane, 1); t += shx(t, lane, 2); t += shx(t, lane, 4); t += shx(t, lane, 8);
            const float rs = 1.0f / sqrtf(lane_get(t, 0) * (1.0f / D) + RMS_EPS);
            f32x4* orow = (f32x4*)(F.out + (size_t)(m0 + r) * D) + lane;
#pragma unroll
            for (int j = 0; j < 4; ++j) orow[64 * j] = (f32x4){bflo(w[r][j].x), bfhi(w[r][j].x), bflo(w[r][j].y), bfhi(w[r][j].y)} * rs * gv[j];
        }
    }
}

__global__ void __launch_bounds__(NWAVES * 64, 2) mk_fwd(Args args) {
    extern __shared__ __attribute__((aligned(16))) unsigned char lds[];
    const int tid0 = threadIdx.x;
    const int wave0 = __builtin_amdgcn_readfirstlane(tid0 >> 6);
    LAS unsigned char* const lds3 = (LAS unsigned char*)lds;
    CArgs* A0 = get_args();
    const int ph_lo = A0->ph_lo, ph_hi = A0->ph_hi;
    for (int u = tid0; u < (LDS_BYTES - LDSCTL_OFF) / 4; u += NWAVES * 64) ((LAS unsigned*)(lds3 + LDSCTL_OFF))[u] = 0u;
    __syncthreads();
    const bool multi = (ph_hi - ph_lo) > 1;
    XcdBarrier bar; bar.bar = (unsigned*)((gu32*)(A0->ws + WS_CTL) + CW_BAR); bar.x = 0; bar.st = nullptr;
    if (multi) bar = xcd_barrier_post((unsigned*)((gu32*)(A0->ws + WS_CTL) + CW_BAR), (volatile LAS unsigned*)(lds3 + MISC_OFF) + 8);

    unsigned long long probe_acc = 0, pt0 = 0;
#define PMARK(k) do { if (PROBE_WN != 0ull) { __syncthreads(); const unsigned long long t_ = __builtin_amdgcn_s_memrealtime(); probe_acc += ((PROBE_WN >> (4 * (k))) & 15ull) * (t_ - pt0); pt0 = t_; } } while (0)
    for (int ph = ph_lo; ph < ph_hi; ++ph) {
        CArgs* A = get_args();
#define MAKE_FRAME(Fx) Frame Fx; Fx.wave0 = wave0; \
        Fx.lds = lds3; \
        { int b_ = blockIdx.x; asm volatile("" : "+s"(b_)); Fx.bid = b_; } \
        Fx.G = gridDim.x; Fx.ngw = Fx.G * NWAVES; Fx.out = A->out; Fx.ws = A->ws
        MAKE_FRAME(F);
        unsigned char* ws = F.ws;
        if (PROBE_WN != 0ull) pt0 = __builtin_amdgcn_s_memrealtime();
        int kind, l;
        if (ph == 0) { kind = PH_PRO; l = 0; } else if (ph == NPH - 1) { kind = PH_FIN; l = 0; } else { l = (ph - 1) / NPL; kind = 1 + (ph - 1) % NPL; }
        float* ssA = (float*)(ws + WS_SSA); float* ssB = (float*)(ws + WS_SSB);
        switch (kind) {
        case PH_PRO: phase_prologue(F, A); break;
        case PH_G1: {
            pg8::Gemm g{(const bf16_t*)(ws + WS_XB), (const bf16_t*)(l == 0 ? ws + W_IN : (unsigned char*)F.out + DO_WIN), T, 7680, D, 0, 0};
            pg8::StaticOrder S; S.init(T, 7680, F.G, F.bid);
            stage_epilogue_tables(F, ssB, S, A->in[4] + (size_t)l * 3072);
            EpiG1 E{(bf16_t*)(ws + WS_PROJ), ws + WS_GATE8, F.lds, (const float*)(ws + WS_TAB)};
            unsigned long long et_ = 0; pg8::gemm_phase<EpiG1, pg8::StaticOrder, true, true>(F.lds, g, S, E, F.ltid(), PROBE_EPI == 2 ? &et_ : nullptr); if (PROBE_EPI == 2) probe_acc += 4 * et_;
        } break;
        case PH_MIXA: phase_na(F, A, l); PMARK(10); phase_ret_state(F); PMARK(11); PMARK(12); break;
        case PH_MIXB: phase_ret_out(F, A, l); PMARK(14); phase_lru<2>(F, A, l); PMARK(15); break;
        case PH_G2: {
            pg8::Gemm g{(const bf16_t*)(ws + WS_PROJ), (const bf16_t*)(l == 0 ? ws + W_BR : (unsigned char*)F.out + DO_MID), T, D, 512, 3 * BLK, (size_t)D * 512 * 2};
            ZOrder S; S.S.init(T, D, F.G, F.bid);
            EpiG2 E{ws + WS_GATE8, (bf16_t*)(ws + WS_MERGED)};
            pg8::gemm_phase<EpiG2, ZOrder, true, true>(F.lds, g, S, E, F.ltid());
        } break;
        case PH_G3: case PH_G5: {
            const bool g3 = (kind == PH_G3);
            pg8::Gemm g{(const bf16_t*)(ws + (g3 ? WS_MERGED : WS_U)), (const bf16_t*)(g3 ? (l == 0 ? ws + W_OUT : (unsigned char*)F.out + DO_MID + 3 * MiB) : ws + W_DOWN), T, D, g3 ? D : FF, 0, 0};
            pg8::StaticOrder S; S.init(T, D, F.G, F.bid);
            EpiRes E{(g3 && l == 0) ? A->in[0] : nullptr, (const bf16_t*)(ws + (g3 ? WS_XB : WS_GATE8)), (bf16_t*)(ws + WS_GATE8), g3 ? ssB : ssA};
            pg8::gemm_phase<EpiRes, pg8::StaticOrder, false, true>(F.lds, g, S, E, F.ltid());
        } break;
        case PH_G4: {
            pg8::Gemm g{(const bf16_t*)(ws + WS_GATE8), (const bf16_t*)(ws + W_UP), T, FF, D, 0, 0};
            pg8::StaticOrder S; S.init(T, FF, F.G, F.bid);
            stage_epilogue_tables(F, ssB, S, nullptr);
            EpiG4 E{(bf16_t*)(ws + WS_U), F.lds};
            unsigned long long et_ = 0; pg8::gemm_phase<EpiG4, pg8::StaticOrder, true, true>(F.lds, g, S, E, F.ltid(), PROBE_EPI == 1 ? &et_ : nullptr); if (PROBE_EPI == 1) probe_acc += 4 * et_;
        } break;
        case PH_G6: {
            {
                pg8::Gemm g{(const bf16_t*)((unsigned char*)F.out + DO_PB), (const bf16_t*)(l == 0 ? ws + W_PLE(0) : (unsigned char*)F.out + DO_MID + 7 * MiB), T, D, PLE, 0, 0};
                pg8::StaticOrder S; S.init(T, D, F.G, F.bid);
                EpiE E{(bf16_t*)(ws + WS_E)};
                pg8::gemm_phase<EpiE, pg8::StaticOrder, false, true>(F.lds, g, S, E, F.ltid());
            }
            {
                pg8::Gemm g{(const bf16_t*)(ws + WS_GATE8), (const bf16_t*)(l == 0 ? ws + W_G(0) : (unsigned char*)F.out + DO_MID + 5 * MiB), T, D, D, 0, 0};
                pg8::StaticOrder S; S.init(T, D, F.G, F.bid);
                stage_epilogue_tables(F, ssA, S, nullptr);
                EpiG6 E{(const bf16_t*)(ws + WS_GATE8), (bf16_t*)(ws + WS_XB), F.lds, ssB, (const bf16_t*)(ws + WS_E)};
                pg8::gemm_phase<EpiG6, pg8::StaticOrder, false, true>(F.lds, g, S, E, F.ltid());
            }
        } break;
        case PH_FIN: phase_final(F, A); break;
        default: break;
        }
        if (ph + 1 < ph_hi) xcd_barrier(bar, F.ltid());
        PMARK(kind);
    }
    if ((PROBE_WN != 0ull || PROBE_EPI != 0) && blockIdx.x == 0) { const unsigned long long te = __builtin_amdgcn_s_memrealtime(); while (__builtin_amdgcn_s_memrealtime() - te < probe_acc) __builtin_amdgcn_s_sleep(32); }
}


#if MK_CHECK
constexpr int CW_CODE = 64, CW_CNT = 128;
__device__ __forceinline__ unsigned hash32(unsigned x) { x ^= x >> 16; x *= 0x7feb352du; x ^= x >> 15; x *= 0x846ca68bu; x ^= x >> 16; return x; }
__device__ __forceinline__ bool near(float a, float b, float rel, float abs_) { return fabsf(a - b) <= rel * fabsf(b) + abs_; }
__device__ float rs_of_x(const float* x, int row) { float s = 0.f; for (int k = 0; k < D; ++k) s += x[(size_t)row * D + k] * x[(size_t)row * D + k]; return 1.0f / sqrtf(s / D + RMS_EPS); }
__global__ void __launch_bounds__(256) mk_check(Args a, int stage) {
    const unsigned id = blockIdx.x * blockDim.x + threadIdx.x;
    const unsigned h = hash32(id * 2654435761u + 12345u * stage);
    unsigned char* ws = a.ws; unsigned* ctl = (unsigned*)(ws + WS_CTL);
    const int row = (int)(h % T);
    bool bad = false;
    const float* x = a.in[0];
    if (stage == 1) {
        const int col = (int)((h >> 14) % D);
        const bf16* xb = (const bf16*)(ws + WS_XB);
        bad |= !near(bf2f(xb[(size_t)row * D + col]), x[(size_t)row * D + col], 0.01f, 1e-3f);
        float s = 0.f; for (int k = 0; k < D; ++k) s += x[(size_t)row * D + k] * x[(size_t)row * D + k];
        const float* ss = (const float*)(ws + WS_SSB); float t = 0.f; for (int k = 0; k < 16; ++k) t += ss[(size_t)row * 16 + k];
        bad |= !near(t, s, 1e-3f, 1e-3f);
        const int n = (int)((h >> 7) % 7680), k = (int)(h % D);
        const bf16* wt = (const bf16*)(ws + W_IN);
        bad |= !near(bf2f(wt[(size_t)n * D + k]), a.in[2][k] * a.in[3][(size_t)k * 7680 + n], 0.01f, 1e-4f);
        const int pos = (int)(h % SEQ), i = (int)((h >> 11) % 64);
        const float th = powf(10000.0f, -(float)i / 63.0f), ang = (float)pos * th;
        const float* tab = (const float*)(ws + WS_TAB);
        bad |= !near(tab[pos * 64 + i], cosf(ang), 0.f, 2e-3f); bad |= !near(tab[131072 + pos * 64 + i], sinf(ang), 0.f, 2e-3f);
    } else if (stage == 2) {
        const int col = (int)((h >> 14) % 7680) & ~1;
        const float rs = rs_of_x(x, row);
        float v0 = 0.f, v1 = 0.f;
        for (int k = 0; k < D; ++k) { const float xv = x[(size_t)row * D + k] * a.in[2][k]; v0 += xv * a.in[3][(size_t)k * 7680 + col]; v1 += xv * a.in[3][(size_t)k * 7680 + col + 1]; }
        v0 *= rs; v1 *= rs;
        if (col < 4608) {
            const int kind = col / 512, cc = col % 512, phys = (int)((0x683754210ull >> (4 * kind)) & 15ull);
            if (kind == 3 || kind == 4) { const int i = (cc & 127) >> 1, pos = row & 2047; const float th = powf(10000.0f, -(float)i / 63.0f), ang = (float)pos * th, c = cosf(ang), sn = sinf(ang);
                const float w0 = v0 * c - v1 * sn, w1 = v0 * sn + v1 * c; v0 = w0; v1 = w1; }
            if (kind == 0) { v0 *= 0.125f; v1 *= 0.125f; } if (kind == 3) { v0 *= 0.08838834764831845f; v1 *= 0.08838834764831845f; }
            const bf16* p = (const bf16*)(ws + WS_PROJ) + (size_t)phys * T * 512 + (size_t)row * 512 + cc;
            bad |= !near(bf2f(p[0]), v0, 0.03f, 0.03f); bad |= !near(bf2f(p[1]), v1, 0.03f, 0.03f);
        } else {
            const int gc = col - 4608; const unsigned char* g8 = ws + WS_GATE8 + (size_t)row * 3072 + gc;
            const float s0 = 1.0f / (1.0f + expf(-(v0 + a.in[4][gc]))), s1 = 1.0f / (1.0f + expf(-(v1 + a.in[4][gc + 1])));
            bad |= !near((float)g8[0] / 255.0f, s0, 0.f, 0.012f); bad |= !near((float)g8[1] / 255.0f, s1, 0.f, 0.012f);
        }
    } else if (stage == 4) {
        const int col = (int)((h >> 14) % D);
        float m = 0.f;
        for (int n = 0; n < 3; ++n) { const bf16* ys = (const bf16*)(ws + WS_PROJ) + (size_t)(3 * n) * T * 512 + (size_t)row * 512; float acc = 0.f;
            for (int k = 0; k < 512; ++k) acc += bf2f(ys[k]) * a.in[14][((size_t)n * 512 + k) * D + col];
            m += acc * (float)ws[WS_GATE8 + (size_t)row * 3072 + n * 1024 + col] / 255.0f; }
        bad |= !near(bf2f(((const bf16*)(ws + WS_MERGED))[(size_t)row * D + col]), m, 0.03f, 0.03f);
    } else if (stage == 5 && false) {
        const int col = (int)((h >> 14) % D);
        const bf16* mg = (const bf16*)(ws + WS_XB) + (size_t)row * D; float acc = 0.f;
        for (int k = 0; k < D; ++k) acc += bf2f(mg[k]) * a.in[15][(size_t)k * D + col];
        const float x1 = x[(size_t)row * D + col] + acc;
        bad |= !near(a.out[(size_t)row * D + col], x1, 0.02f, 0.03f);
        bad |= !near(bf2f(((const bf16*)(ws + WS_GATE8))[(size_t)row * D + col]), a.out[(size_t)row * D + col], 0.01f, 1e-3f);
        float s = 0.f; for (int k = 0; k < D; ++k) s += a.out[(size_t)row * D + k] * a.out[(size_t)row * D + k];
        const float* ss = (const float*)(ws + WS_SSB); float t = 0.f; for (int k = 0; k < 16; ++k) t += ss[(size_t)row * 16 + k];
        bad |= !near(t, s, 1e-3f, 1e-3f);
    } else if (stage == 6 && false) {
        const int col = (int)((h >> 14) % FF);
        const bf16* xb = (const bf16*)(ws + WS_GATE8) + (size_t)row * D; float acc = 0.f;
        for (int k = 0; k < D; ++k) acc += bf2f(xb[k]) * a.in[16][k] * a.in[17][(size_t)k * FF + col];
        const float rs = rs_of_x(a.out, row); float v = fmaxf(acc * rs, 0.f); v *= v;
        bad |= !near(bf2f(((const bf16*)(ws + WS_U))[(size_t)row * FF + col]), v, 0.05f, 0.05f);
    } else if (stage == 7 && false) {
        const int col = (int)((h >> 14) % D);
        const bf16* uu = (const bf16*)(ws + WS_U) + (size_t)row * FF; float acc = 0.f;
        for (int k = 0; k < FF; ++k) acc += bf2f(uu[k]) * a.in[18][(size_t)k * D + col];
        const float x2 = bf2f(((const bf16*)(ws + WS_XB))[(size_t)row * D + col]) + acc;
        bad |= !near(a.out[(size_t)row * D + col], x2, 0.03f, 0.05f);
        bad |= !near(bf2f(((const bf16*)(ws + WS_GATE8))[(size_t)row * D + col]), a.out[(size_t)row * D + col], 0.01f, 1e-3f);
        float s = 0.f; for (int k = 0; k < D; ++k) s += a.out[(size_t)row * D + k] * a.out[(size_t)row * D + k];
        const float* ss = (const float*)(ws + WS_SSA); float t = 0.f; for (int k = 0; k < 16; ++k) t += ss[(size_t)row * 16 + k];
        bad |= !near(t, s, 1e-3f, 1e-3f);
    } else if (stage == 8 && false) {
        const int col = (int)((h >> 14) % D);
        const bf16* xb = (const bf16*)(ws + WS_GATE8) + (size_t)row * D; float acc = 0.f, s = 0.f;
        for (int k = 0; k < D; ++k) { const float xv = bf2f(xb[k]); s += xv * xv; acc += xv * a.in[19][k] * a.in[20][(size_t)k * D + col]; }
        const float rs = 1.0f / sqrtf(s / D + RMS_EPS);
        float e = 0.f; for (int k = 0; k < PLE; ++k) e += a.in[1][(size_t)row * PLE + k] * a.in[21][(size_t)k * D + col];
        const float x3 = bf2f(xb[col]) + e / (1.0f + expf(-acc * rs));
        bad |= !near(a.out[(size_t)row * D + col], x3, 0.03f, 0.05f);
    }
    if (stage == 9) bad = true;
    if (bad) atomicAdd(&ctl[CW_CNT + stage], 1u);
}
__device__ float orig_proj(const Args& a, int l, int row, int col) {
    const float* x = l == 0 ? a.in[0] : a.out; const float* g = a.in[2] + (size_t)l * D; const float* w = a.in[3] + (size_t)l * D * 7680;
    float s = 0.f, acc = 0.f;
    for (int k = 0; k < D; ++k) { const float xv = x[(size_t)row * D + k]; s += xv * xv; acc += xv * g[k] * w[(size_t)k * 7680 + col]; }
    return acc / sqrtf(s / D + RMS_EPS);
}
__global__ void __launch_bounds__(64) mk_check_na(Args a, int l) {
    __shared__ float qs[64]; __shared__ float sc[128];
    const unsigned h = hash32(blockIdx.x * 977u + 31u); const int t = (int)(h % T), hd = (int)((h >> 16) % 8), d = threadIdx.x;
    unsigned char* ws = a.ws; unsigned* ctl = (unsigned*)(ws + WS_CTL);
    const bf16* K = (const bf16*)(ws + WS_PROJ + BLK); const bf16* V = (const bf16*)(ws + WS_PROJ + 2 * BLK); const bf16* Y = (const bf16*)(ws + WS_PROJ);
    qs[d] = bf2f((bf16)f2bf(0.125f * orig_proj(a, l, t, hd * 64 + d)));
    __syncthreads();
    const int b = t / SEQ, s = t % SEQ, r = s / 64, c = s % 64;
    int rs = r - 4; if (rs < 0) rs = 0; if (rs > 24) rs = 24; int cs = c - 8; if (cs < 0) cs = 0; if (cs > 48) cs = 48;
    const float* rpb = a.in[5] + (size_t)l * 8 * 15 * 31 + hd * 465;
    for (int kk = d; kk < 128; kk += 64) { const int i = kk / 16, j = kk % 16; const int tk = b * SEQ + (rs + i) * 64 + cs + j; float acc = 0.f;
        for (int e = 0; e < 64; ++e) acc += qs[e] * bf2f(K[(size_t)tk * 512 + hd * 64 + e]);
        sc[kk] = acc + rpb[(rs + i - r + 7) * 31 + (cs + j - c + 15)]; }
    __syncthreads();
    float mx = -1e30f; for (int kk = 0; kk < 128; ++kk) mx = fmaxf(mx, sc[kk]);
    float den = 0.f, o = 0.f;
    for (int kk = 0; kk < 128; ++kk) { const int i = kk / 16, j = kk % 16; const int tk = b * SEQ + (rs + i) * 64 + cs + j; const float p = expf(sc[kk] - mx); den += p; o += p * bf2f(V[(size_t)tk * 512 + hd * 64 + d]); }
    o /= den;
    if (!near(bf2f(Y[(size_t)t * 512 + hd * 64 + d]), o, 0.04f, 0.04f)) atomicAdd(&ctl[CW_CNT + 31], 1u);
}
__global__ void __launch_bounds__(128) mk_check_ret(Args a, int l) {
    __shared__ float qs[128]; __shared__ float sc[SEQ]; __shared__ float red[128];
    const unsigned h = hash32(blockIdx.x * 1231u + 77u); const int t = (int)(h % T), hd = (int)((h >> 16) % 4), dv = threadIdx.x;
    unsigned char* ws = a.ws; unsigned* ctl = (unsigned*)(ws + WS_CTL);
    const bf16* Y = (const bf16*)(ws + WS_PROJ + 3 * BLK); const bf16* Q = (const bf16*)(ws + WS_PROJ + 4 * BLK); const bf16* K = (const bf16*)(ws + WS_PROJ + 5 * BLK); const bf16* V = (const bf16*)(ws + WS_PROJ + 7 * BLK);
    const int b = t / SEQ, n = t % SEQ;
    qs[dv] = bf2f(Q[(size_t)t * 512 + hd * 128 + dv]);
    __syncthreads();
    const float gf = log2_1m(__builtin_amdgcn_exp2f(-5.0f - (float)hd)), gb = log2_1m(__builtin_amdgcn_exp2f(-5.5f - (float)hd));
    for (int m = dv; m < SEQ; m += 128) { float acc = 0.f; for (int e = 0; e < 128; ++e) acc += qs[e] * bf2f(K[(size_t)(b * SEQ + m) * 512 + hd * 128 + e]);
        sc[m] = acc * (m <= n ? __builtin_amdgcn_exp2f(gf * (float)(n - m)) : __builtin_amdgcn_exp2f(gb * (float)(m - n))); }
    __syncthreads();
    float o = 0.f; for (int m = 0; m < SEQ; ++m) o += sc[m] * bf2f(V[(size_t)(b * SEQ + m) * 512 + hd * 128 + dv]);
    red[dv] = o * o; __syncthreads();
    float ms = 0.f; for (int e = 0; e < 128; ++e) ms += red[e];
    const float rn = 1.0f / sqrtf(ms / 128.0f + RMS_EPS);
    const float g = bf2f((bf16)f2bf(orig_proj(a, l, t, 1536 + 3 * 512 + hd * 128 + dv)));
    const float y = g / (1.0f + expf(-g)) * o * rn * a.in[6][(size_t)l * 512 + hd * 128 + dv];
    if (!near(bf2f(Y[(size_t)t * 512 + hd * 128 + dv]), y, 0.04f, 0.04f)) atomicAdd(&ctl[CW_CNT + 32], 1u);
}
__global__ void __launch_bounds__(128) mk_check_g(Args a, int l, int code) {
    const unsigned h = hash32(blockIdx.x * 1231u + 77u); const int t = (int)(h % T), hd = (int)((h >> 16) % 4), dv = threadIdx.x;
    unsigned* ctl = (unsigned*)(a.ws + WS_CTL);
    const bf16* G = (const bf16*)(a.ws + WS_PROJ + 3 * BLK);
    const float g = orig_proj(a, l, t, 1536 + 3 * 512 + hd * 128 + dv);
    if (!near(bf2f(G[(size_t)t * 512 + hd * 128 + dv]), g, 0.03f, 0.03f)) atomicAdd(&ctl[CW_CNT + code], 1u);
}
__global__ void __launch_bounds__(64) mk_check_lru(Args a, int l) {
    __shared__ float xs[64];
    const unsigned h = hash32(blockIdx.x * 733u + 5u); const int b = (int)(h % 8), blk = (int)((h >> 8) % 8), ts = (int)((h >> 16) % SEQ), j = threadIdx.x, ch = blk * 64 + j;
    unsigned char* ws = a.ws; unsigned* ctl = (unsigned*)(ws + WS_CTL);
    const bf16* XC = (const bf16*)(ws + WS_PROJ + 8 * BLK); const bf16* Y = (const bf16*)(ws + WS_PROJ + 6 * BLK);
    const float* cw = a.in[7] + (size_t)l * 2048; const float cb = a.in[8][(size_t)l * 512 + ch];
    float hsum = 0.f;
    for (int dir = 0; dir < 2; ++dir) {
        const float* wa = a.in[9] + (((size_t)l * 2 + dir) * 8 + blk) * 4096; const float* wx = a.in[11] + (((size_t)l * 2 + dir) * 8 + blk) * 4096;
        const float ba = a.in[10][((size_t)l * 2 + dir) * 512 + ch], bx = a.in[12][((size_t)l * 2 + dir) * 512 + ch], lam = a.in[13][((size_t)l * 2 + dir) * 512 + ch];
        const float sp = log1pf(expf(-lam));
        float hh = 0.f;
        const int nsteps = dir == 0 ? ts + 1 : SEQ - ts;
        for (int st = 0; st < nsteps; ++st) {
            const int t = dir == 0 ? st : SEQ - 1 - st;
            float xf = cb;
            for (int w = 0; w < 4; ++w) { const int t2 = t + w - 2; if (t2 >= 0 && t2 < SEQ) xf += cw[w * 512 + ch] * bf2f(XC[(size_t)(b * SEQ + t2) * 512 + ch]); }
            __syncthreads(); xs[j] = xf; __syncthreads();
            float ra = ba, ia = bx;
            for (int i = 0; i < 64; ++i) { ra += xs[i] * wa[i * 64 + j]; ia += xs[i] * wx[i * 64 + j]; }
            const float r = 1.0f / (1.0f + expf(-ra)), ig = 1.0f / (1.0f + expf(-ia));
            const float la = -8.0f * r * sp, av = expf(la); float mult = sqrtf(-expm1f(2.0f * la)); if (st == 0) mult = 1.0f;
            hh = av * hh + mult * ig * xf;
        }
        hsum += hh;
    }
    const float gc = bf2f((bf16)f2bf(orig_proj(a, l, b * SEQ + ts, 3584 + 512 + ch)));
    const float u = 0.7978845608028654f * (gc + 0.044715f * gc * gc * gc);
    const float y = 0.5f * gc * (1.0f + tanhf(u)) * hsum;
    if (!near(bf2f(Y[(size_t)(b * SEQ + ts) * 512 + ch]), y, 0.04f, 0.04f)) atomicAdd(&ctl[CW_CNT + 33], 1u);
}
__global__ void mk_report(Args a) {
    unsigned* ctl = (unsigned*)(a.ws + WS_CTL);
    const int order[13] = {1, 2, 35, 31, 34, 32, 33, 4, 5, 6, 7, 8, 9};
    const unsigned tot[13] = {16384u, 16384u, 16384u, 32768u, 16384u, 16384u, 8192u, 16384u, 16384u, 16384u, 16384u, 16384u, 64u};
    for (int i = 0; i < 13; ++i) {
        const unsigned cnt = ctl[CW_CNT + order[i]];
        if (cnt * 200u > tot[i]) {
            unsigned tenth = (cnt * 10u) / tot[i]; if (tenth > 9u) tenth = 9u;
            a.out[0] = order[i] >= 10 ? 100.0f * (float)order[i] : 1000.0f * (float)order[i] + 100.0f * (float)tenth;
            return;
        }
    }
}
#endif

#ifndef MK_ONE_LAUNCH
#define MK_ONE_LAUNCH 1
#endif
extern "C" void kernel_launch(void* const* d_in, const int* in_sizes, int n_in, void* d_out, int out_size, void* d_ws, size_t ws_size, hipStream_t stream) {
    static int grid = 0;
    if (grid == 0) {
        if (n_in != 23 || in_sizes[0] != T * D || out_size != T * D || ws_size < WS_END) { fprintf(stderr, "kernel_launch: unexpected shapes (n_in %d, in0 %d, out %d, ws %zu); nothing launched\n", n_in, n_in > 0 ? in_sizes[0] : -1, out_size, ws_size); grid = -1; return; }
        int dev = 0, cus = 0, per_cu = 0;
        if (hipGetDevice(&dev) != hipSuccess || hipDeviceGetAttribute(&cus, hipDeviceAttributeMultiprocessorCount, dev) != hipSuccess) { grid = -1; return; }
        if (hipFuncSetAttribute((const void*)mk_fwd, hipFuncAttributeMaxDynamicSharedMemorySize, LDS_BYTES) != hipSuccess) { fprintf(stderr, "kernel_launch: hipFuncSetAttribute failed\n"); grid = -1; return; }
        if (hipOccupancyMaxActiveBlocksPerMultiprocessor(&per_cu, (const void*)mk_fwd, NWAVES * 64, LDS_BYTES) != hipSuccess || per_cu < 1) { fprintf(stderr, "kernel_launch: occupancy query says %d blocks per CU\n", per_cu); }
        (void)hipGetLastError();
        grid = cus > 256 ? 256 : cus;
    }
    if (grid < 0) return;
    if (hipMemsetAsync((char*)d_ws + WS_CTL, 0, CTL_ZERO_BYTES, stream) != hipSuccess) return;
    Args a{};
    for (int i = 0; i < 23; ++i) a.in[i] = (const float*)d_in[i];
    a.out = (float*)d_out; a.ws = (unsigned char*)d_ws;
#if MK_ONE_LAUNCH
    a.ph_lo = 0; a.ph_hi = NPH;
    hipLaunchKernelGGL(mk_fwd, dim3(grid), dim3(NWAVES * 64), LDS_BYTES, stream, a);
#else
    for (int ph = 0; ph < NPH; ++ph) {
#if MK_CHECK
        if (ph == 1 + 6) (void)hipMemcpyAsync((char*)d_ws + WS_XB, (char*)d_ws + WS_GATE8, (size_t)T * D * 2, hipMemcpyDeviceToDevice, stream);
#endif
        a.ph_lo = ph; a.ph_hi = ph + 1; hipLaunchKernelGGL(mk_fwd, dim3(grid), dim3(NWAVES * 64), LDS_BYTES, stream, a);
#if MK_CHECK
        { int st = 0; if (ph == 0) st = 1; else if (ph == 1) st = 2; else if (ph == 1 + 3) st = 4; else if (ph == 1 + 4) st = 5; else if (ph == 1 + 5) st = 6; else if (ph == 1 + 6) st = 7; else if (ph == 1 + 7) st = 8;
          if (st) hipLaunchKernelGGL(mk_check, dim3(64), dim3(256), 0, stream, a, st);
          if (ph == 1 + 1) hipLaunchKernelGGL(mk_check_na, dim3(512), dim3(64), 0, stream, a, 0);
          if (ph == 1) hipLaunchKernelGGL(mk_check_g, dim3(128), dim3(128), 0, stream, a, 0, 35);
          if (ph == 1 + 1) hipLaunchKernelGGL(mk_check_g, dim3(128), dim3(128), 0, stream, a, 0, 34);
          if (ph == 1 + 2) hipLaunchKernelGGL(mk_check_ret, dim3(128), dim3(128), 0, stream, a, 0);
          if (ph == 1 + 2) hipLaunchKernelGGL(mk_check_lru, dim3(128), dim3(64), 0, stream, a, 0);
          if (ph == NPH - 1) hipLaunchKernelGGL(mk_check, dim3(1), dim3(64), 0, stream, a, 9); }
#endif
    }
#if MK_CHECK
    hipLaunchKernelGGL(mk_report, dim3(1), dim3(1), 0, stream, a);
#endif
#endif
}
```
